# Optimizing an MI355X kernel written in HIP

```python
import math
import jax, jax.numpy as jnp
from jax import lax
import numpy as np

D_MODEL = 2048
BATCH = 4
SEQ = 2048
DEPTH = 1
DEC_BATCH = 128
DEC_SEQ = 4
PAST_LEN = 16384
PAGE_SIZE = 128

MIX_WIDTH = D_MODEL
POOL_WIDTH = MIX_WIDTH // 2
RET_WIDTH = MIX_WIDTH - POOL_WIDTH
POOL_WINDOWS = (2, 4, 8, 16)
N_POOL_GROUPS = len(POOL_WINDOWS)
POOL_GROUP_DIM = POOL_WIDTH // N_POOL_GROUPS
POOL_BUF = max(POOL_WINDOWS) - 1
RET_HEADS = 4
RET_HEAD_DIM = RET_WIDTH // RET_HEADS
RET_CHUNK = 128
ROPE_BASE = 10000.0
D_FF = 5632
N_MOD = 9
EPS = 1e-6
IN_COLS = POOL_WIDTH + 4 * RET_WIDTH

kernel_name = "hymba_pool_retnet_macaron_adaln_step"


def rmsnorm(x, gain):
    x32 = x.astype(jnp.float32)
    y = x32 * lax.rsqrt(jnp.mean(x32 * x32, axis=-1, keepdims=True) + EPS)
    return (y * gain.astype(jnp.float32)).astype(x.dtype)


def modulate(h, shift, scale):
    return h * (1 + scale[:, None, :]) + shift[:, None, :]


def swiglu(h, w_gate, w_up, w_down):
    return (jax.nn.silu(h @ w_gate) * (h @ w_up)) @ w_down


def rotary(x, pos):
    half = x.shape[-1] // 2
    inv = ROPE_BASE ** (-jnp.arange(half, dtype=jnp.float32) / half)
    ang = pos[:, None] * inv[None, :]
    cos = jnp.cos(ang)[None, :, None, :]
    sin = jnp.sin(ang)[None, :, None, :]
    x1, x2 = x[..., :half], x[..., half:]
    return jnp.concatenate([x1 * cos - x2 * sin, x2 * cos + x1 * sin], axis=-1)


def pool_mixer(u, buf, pos0, pool_w, pool_scale):
    B, T, _ = u.shape
    u32 = u.astype(jnp.float32)
    ue = jnp.concatenate([buf.astype(jnp.float32), u32], axis=1)
    cs = jnp.cumsum(ue, axis=1)
    cs = jnp.concatenate([jnp.zeros_like(cs[:, :1]), cs], axis=1)
    end = POOL_BUF + 1
    pos = jnp.arange(T, dtype=jnp.float32) + pos0
    parts = []
    for g, w in enumerate(POOL_WINDOWS):
        sl = slice(g * POOL_GROUP_DIM, (g + 1) * POOL_GROUP_DIM)
        wsum = cs[:, end:end + T, sl] - cs[:, end - w:end - w + T, sl]
        count = jnp.minimum(pos + 1.0, float(w))
        parts.append(wsum / count[None, :, None] - u32[:, :, sl])
    m = jnp.stack(parts, axis=2)
    out = jnp.einsum('btgc,gcd->btgd', m, pool_w.astype(jnp.float32)).reshape(B, T, POOL_WIDTH)
    out = out * pool_scale.astype(jnp.float32)
    new_buf = ue[:, -POOL_BUF:]
    return out.astype(u.dtype), new_buf.astype(buf.dtype)


def retention(q, k, v, s0, pos0):
    B, T, _ = q.shape
    C = math.gcd(T, RET_CHUNK)
    n = T // C
    pos = jnp.arange(T, dtype=jnp.float32) + pos0

    def heads(t):
        return t.astype(jnp.float32).reshape(B, T, RET_HEADS, RET_HEAD_DIM)

    qh = rotary(heads(q), pos)
    kh = rotary(heads(k), pos) * (RET_HEAD_DIM ** -0.5)
    vh = heads(v)

    def chunks(t):
        return t.reshape(B, n, C, RET_HEADS, RET_HEAD_DIM).transpose(1, 0, 3, 2, 4)

    log_g = jnp.log(1.0 - jnp.power(2.0, -5.0 - jnp.arange(RET_HEADS, dtype=jnp.float32)))
    idx = jnp.arange(C, dtype=jnp.float32)
    diff = idx[:, None] - idx[None, :]
    intra = jnp.where(diff[None] >= 0, jnp.exp(jnp.maximum(diff, 0.0)[None] * log_g[:, None, None]), 0.0)
    q_dec = jnp.exp((idx + 1.0)[None, :] * log_g[:, None])
    k_dec = jnp.exp((C - 1.0 - idx)[None, :] * log_g[:, None])
    c_dec = jnp.exp(C * log_g)

    def step(S, xs):
        qc, kc, vc = xs
        scores = jnp.einsum('bhnd,bhmd->bhnm', qc, kc) * intra[None]
        o = jnp.einsum('bhnm,bhmv->bhnv', scores, vc)
        o = o + jnp.einsum('bhnd,bhdv->bhnv', qc, S) * q_dec[None, :, :, None]
        S = S * c_dec[None, :, None, None] + jnp.einsum('bhmd,bhmv->bhdv', kc * k_dec[None, :, :, None], vc)
        return S, o

    S, o = lax.scan(step, s0.astype(jnp.float32), (chunks(qh), chunks(kh), chunks(vh)))
    o = o.transpose(1, 0, 3, 2, 4).reshape(B, T, RET_HEADS, RET_HEAD_DIM)
    o = o * lax.rsqrt(jnp.mean(o * o, axis=-1, keepdims=True) + EPS)
    return o.reshape(B, T, RET_WIDTH), S.astype(s0.dtype)


def layer(x, c, pool_buf, ret_state, pos0, lw):
    (ada_w, ada_b, norm_ffn1, ffn1_w_gate, ffn1_w_up, ffn1_w_down, norm_mix, w_in, pool_w,
     pool_scale, w_out, norm_ffn2, ffn2_w_gate, ffn2_w_up, ffn2_w_down) = lw
    mods = jax.nn.silu(c) @ ada_w + ada_b
    sh1, sc1, gt1, sh2, sc2, gt2, sh3, sc3, gt3 = jnp.split(mods, N_MOD, axis=-1)
    h = modulate(rmsnorm(x, norm_ffn1), sh1, sc1)
    x = x + 0.5 * gt1[:, None, :] * swiglu(h, ffn1_w_gate, ffn1_w_up, ffn1_w_down)
    h = modulate(rmsnorm(x, norm_mix), sh2, sc2)
    proj = h @ w_in
    u, q, k, v, g = jnp.split(proj, [POOL_WIDTH, POOL_WIDTH + RET_WIDTH, POOL_WIDTH + 2 * RET_WIDTH,
                                     POOL_WIDTH + 3 * RET_WIDTH], axis=-1)
    pool_out, new_buf = pool_mixer(u, pool_buf, pos0, pool_w, pool_scale)
    ret_out, new_state = retention(q, k, v, ret_state, pos0)
    ret_out = (jax.nn.silu(g.astype(jnp.float32)) * ret_out).astype(x.dtype)
    mix = jnp.concatenate([pool_out, ret_out], axis=-1) @ w_out
    x = x + gt2[:, None, :] * mix
    h = modulate(rmsnorm(x, norm_ffn2), sh3, sc3)
    x = x + 0.5 * gt3[:, None, :] * swiglu(h, ffn2_w_gate, ffn2_w_up, ffn2_w_down)
    return x, new_buf, new_state


def trunk(x, c, pool_state, ret_state, pos0, weights, norm_final):
    new_pool, new_ret = [], []
    for l in range(DEPTH):
        lw = tuple(w[l] for w in weights)
        x, pb, rs = layer(x, c, pool_state[l], ret_state[l], pos0, lw)
        new_pool.append(pb)
        new_ret.append(rs)
    y = rmsnorm(x, norm_final)
    return y, jnp.stack(new_pool), jnp.stack(new_ret)


def setup_inputs(seed: int = 0) -> dict:
    key = jax.random.key(seed)
    ks = jax.random.split(key, 24)
    f = jnp.float32
    D, F = D_MODEL, D_FF

    def nrm(k, shape, scale):
        return jax.random.normal(k, shape, f) * scale

    def gain(k, shape):
        return 1.0 + 0.05 * jax.random.normal(k, shape, f)

    return {
        "x_prompt": nrm(ks[0], (BATCH, SEQ, D), 1.0),
        "x_sample": nrm(ks[1], (DEC_BATCH, DEC_SEQ, D), 1.0),
        "c_prompt": nrm(ks[2], (BATCH, D), 1.0),
        "c_sample": nrm(ks[3], (DEC_BATCH, D), 1.0),
        "state_pool": nrm(ks[4], (DEPTH, DEC_BATCH, POOL_BUF, POOL_WIDTH), 1.0),
        "state_ret": nrm(ks[5], (DEPTH, DEC_BATCH, RET_HEADS, RET_HEAD_DIM, RET_HEAD_DIM), 0.5),
        "ada_w": nrm(ks[6], (DEPTH, D, N_MOD * D), 0.3 * D ** -0.5),
        "ada_b": nrm(ks[7], (DEPTH, N_MOD * D), 0.01),
        "norm_ffn1": gain(ks[8], (DEPTH, D)),
        "ffn1_w_gate": nrm(ks[9], (DEPTH, D, F), D ** -0.5),
        "ffn1_w_up": nrm(ks[10], (DEPTH, D, F), D ** -0.5),
        "ffn1_w_down": nrm(ks[11], (DEPTH, F, D), F ** -0.5),
        "norm_mix": gain(ks[12], (DEPTH, D)),
        "w_in": nrm(ks[13], (DEPTH, D, IN_COLS), D ** -0.5),
        "pool_w": nrm(ks[14], (DEPTH, N_POOL_GROUPS, POOL_GROUP_DIM, POOL_GROUP_DIM), POOL_GROUP_DIM ** -0.5),
        "pool_scale": gain(ks[15], (DEPTH, POOL_WIDTH)),
        "w_out": nrm(ks[16], (DEPTH, MIX_WIDTH, D), MIX_WIDTH ** -0.5),
        "norm_ffn2": gain(ks[17], (DEPTH, D)),
        "ffn2_w_gate": nrm(ks[18], (DEPTH, D, F), D ** -0.5),
        "ffn2_w_up": nrm(ks[19], (DEPTH, D, F), D ** -0.5),
        "ffn2_w_down": nrm(ks[20], (DEPTH, F, D), F ** -0.5),
        "norm_final": gain(ks[21], (D,)),
    }


def reference(x_prompt, x_sample, c_prompt, c_sample, state_pool, state_ret,
              ada_w, ada_b, norm_ffn1, ffn1_w_gate, ffn1_w_up, ffn1_w_down,
              norm_mix, w_in, pool_w, pool_scale, w_out,
              norm_ffn2, ffn2_w_gate, ffn2_w_up, ffn2_w_down, norm_final):
    weights = (ada_w, ada_b, norm_ffn1, ffn1_w_gate, ffn1_w_up, ffn1_w_down, norm_mix, w_in,
               pool_w, pool_scale, w_out, norm_ffn2, ffn2_w_gate, ffn2_w_up, ffn2_w_down)
    bp = x_prompt.shape[0]
    pool0 = jnp.zeros((DEPTH, bp, POOL_BUF, POOL_WIDTH), state_pool.dtype)
    ret0 = jnp.zeros((DEPTH, bp, RET_HEADS, RET_HEAD_DIM, RET_HEAD_DIM), state_ret.dtype)
    y_prompt, pool_prompt, ret_prompt = trunk(x_prompt, c_prompt, pool0, ret0, 0, weights, norm_final)
    y_sample, pool_sample, ret_sample = trunk(x_sample, c_sample, state_pool, state_ret, PAST_LEN,
                                              weights, norm_final)
    return (y_prompt, y_sample, pool_prompt, ret_prompt, pool_sample, ret_sample)
```

```cpp
#include <hip/hip_runtime.h>
#include <cstdio>
#include <cstdint>
#include <cmath>

#ifndef MK_PER_PHASE
#define MK_PER_PHASE 0
#endif

constexpr int DM = 2048, DFF = 5632, SEQ = 2048, NB = 4, DB = 128, DS = 4;
constexpr int MP = NB * SEQ;
constexpr int MS = DB * DS;
constexpr int MTOK = MP + MS;
constexpr int NMODROW = NB + DB;
constexpr int NMOD = 9 * DM;
constexpr int PW = 1024, RW = 1024, HD = 256, NH = 4, CH = 128, NCH = SEQ / CH;
constexpr int INC = PW + 4 * RW;
constexpr int PAST = 16384;
constexpr float EPS = 1e-6f;
constexpr int NPOS = SEQ + DS;

constexpr size_t O_YP = 0, O_YS = (size_t)MP * DM, O_POOLP = O_YS + (size_t)MS * DM, O_RETP = O_POOLP + (size_t)NB * 15 * PW,
                 O_POOLS = O_RETP + (size_t)NB * NH * HD * HD, O_RETS = O_POOLS + (size_t)DB * 15 * PW, O_END = O_RETS + (size_t)DB * NH * HD * HD;

constexpr size_t SLAB_MINUS_X = (size_t)(568 - 210) << 20;

namespace pg8 {
#define PG8_LAS __attribute__((address_space(3)))
typedef unsigned short bf16_t;
typedef short bf16x8 __attribute__((ext_vector_type(8)));
typedef float f32x4 __attribute__((ext_vector_type(4)));
typedef unsigned u32x4 __attribute__((ext_vector_type(4)));
typedef unsigned u32x2 __attribute__((ext_vector_type(2)));
constexpr int BM = 256, BK = 64, HALF = 128, HTB = HALF * BK * 2  , STAGE_BYTES = 8 * HTB, NXCD = 8, WGM = 8;

__host__ __device__ __forceinline__ int lds_byte(int r, int c) { const int st = (r >> 4) * 2 + (c >> 5), rr = r & 15, cc = c & 31, ob = rr * 64 + cc * 2; return st * 1024 + (ob ^ (((ob >> 9) & 1) << 5)); }
__host__ __device__ __forceinline__ void stage_rc(int b, int& R, int& C) { const int st = b / 1024, sb = b % 1024, swz = sb ^ (((sb >> 9) & 1) << 5); R = (st >> 1) * 16 + swz / 64; C = (st & 1) * 32 + (swz % 64) / 2; }
__host__ __device__ __forceinline__ int perm32(int rho) { const int n = rho >> 4, i = rho & 15; return 8 * (i >> 2) + 4 * n + (i & 3); }

struct Unit { int pm, pn, kp; };
struct Gemm { const bf16_t* A; const bf16_t* Bt; int lda, ldb, K, acol, kpiece; };

struct StaticOrder {
    int nM, nN, nwg, G, c;
    __host__ __device__ __forceinline__ void init(int M, int N, int G_, int c_) { nM = M / BM; nN = N / BM; nwg = nM * nN; G = G_; c = c_; }
    __host__ __device__ __forceinline__ bool next(int i, Unit& u) const {
        const long L = (long)i * G + c; if (L >= nwg) return false;
        int wgid = (int)L; { const int q = nwg / NXCD, r = nwg % NXCD, xcd = wgid % NXCD, off = wgid / NXCD; wgid = (xcd < r ? xcd * (q + 1) : r * (q + 1) + (xcd - r) * q) + off; }
        const int nig = WGM * nN, gid = wgid / nig, fm = gid * WGM, gsz = (nM - fm) < WGM ? (nM - fm) : WGM;
        u.pm = fm + ((wgid % nig) % gsz); u.pn = (wgid % nig) / gsz; u.kp = -1; return true;
    }
    __device__ __forceinline__ void a_ready(const Unit&) const {}
    __device__ __forceinline__ void done(const Unit&) const {}
};

struct SplitOrder {
    int nN, nfull, np, G, c;
    __host__ __device__ __forceinline__ void init(int N, int np_, int G_, int c_) { nN = N / BM; nfull = (MP / BM) * nN; np = np_; G = G_; c = c_; }
    __host__ __device__ __forceinline__ bool next(int i, Unit& u) const {
        const int L = i * G + c;
        int pm, pn, kp; bool ok = true;
        if (L < nfull) {
            int wgid = L; { const int q = nfull / NXCD, xcd = wgid % NXCD, off = wgid / NXCD; wgid = xcd * q + off; }
            const int nig = WGM * nN, gid = wgid / nig, fm = gid * WGM;
            pm = fm + ((wgid % nig) % WGM); pn = (wgid % nig) / WGM; kp = -1;
        } else {
            const int j = L - nfull; ok = j < 2 * nN * np;
            const int t = j / np; kp = j - t * np; pm = MP / BM + t / nN; pn = t % nN;
        }
        u.pm = pm; u.pn = pn; u.kp = kp; return ok;
    }
    __device__ __forceinline__ void a_ready(const Unit&) const {}
    __device__ __forceinline__ void done(const Unit&) const {}
};

__device__ __forceinline__ unsigned cvt_pk_bf16(float lo, float hi) { unsigned r; asm volatile("v_cvt_pk_bf16_f32 %0, %1, %2" : "=v"(r) : "v"(lo), "v"(hi)); return r; }
__device__ __forceinline__ float silu_f(float x) { return x * __builtin_amdgcn_rcpf(1.0f + __builtin_amdgcn_exp2f(-1.4426950408889634f * x)); }
__device__ __forceinline__ int modrow_of(int row) { return row < MP ? (row >> 11) : NB + ((row - MP) >> 2); }
__device__ __forceinline__ int ptab_of(int row) { return row < MP ? (row & (SEQ - 1)) : SEQ + ((row - MP) & 3); }

struct EpiSwiglu {
    static constexpr bool PERM = true, AFTER_DRAIN = false;
    bf16_t* O;
    __device__ __forceinline__ void operator()(const f32x4 (&acc)[2][2][4][2], const Unit& u, int wr, int wc, int fr, int fq) const {
        const int row0 = u.pm * BM + wr * 64 + fr, col0 = u.pn * HALF + wc * 32 + 8 * fq;
#pragma unroll
        for (int ai = 0; ai < 2; ++ai)
#pragma unroll
            for (int m = 0; m < 4; ++m) {
                bf16_t* rowp = O + (size_t)(row0 + ai * HALF + m * 16) * DFF + col0;
                const f32x4 g0 = acc[ai][0][m][0], g1 = acc[ai][0][m][1], u0 = acc[ai][1][m][0], u1 = acc[ai][1][m][1];
                u32x4 w;
                w.x = cvt_pk_bf16(silu_f(g0[0]) * u0[0], silu_f(g0[1]) * u0[1]); w.y = cvt_pk_bf16(silu_f(g0[2]) * u0[2], silu_f(g0[3]) * u0[3]);
                w.z = cvt_pk_bf16(silu_f(g1[0]) * u1[0], silu_f(g1[1]) * u1[1]); w.w = cvt_pk_bf16(silu_f(g1[2]) * u1[2], silu_f(g1[3]) * u1[3]);
                *(u32x4*)rowp = w;
            }
    }
};
struct EpiResid {
    static constexpr bool PERM = false, AFTER_DRAIN = false;
    const float* baseP; const float* baseS; float* out; const float* gate; float coef;
    __device__ __forceinline__ void operator()(const f32x4 (&acc)[2][2][4][2], const Unit& u, int wr, int wc, int fr, int fq) const {
        const int row0 = u.pm * BM + wr * 64 + fr, col0 = u.pn * BM + wc * 32 + 4 * fq;
        if (u.kp < 0) {
#pragma unroll
            for (int ai = 0; ai < 2; ++ai)
#pragma unroll
                for (int m = 0; m < 4; ++m) {
                    const int row = row0 + ai * HALF + m * 16;
                    const float* bp = (row < MP ? baseP + (size_t)row * DM : baseS + (size_t)(row - MP) * DM) + col0;
                    const float* gp = gate + (size_t)modrow_of(row) * NMOD + col0;
                    float* op = out + (size_t)row * DM + col0;
#pragma unroll
                    for (int bj = 0; bj < 2; ++bj)
#pragma unroll
                        for (int n = 0; n < 2; ++n) {
                            const f32x4 bs = *(const f32x4*)(bp + bj * HALF + n * 16), gt = *(const f32x4*)(gp + bj * HALF + n * 16);
                            *(f32x4*)(op + bj * HALF + n * 16) = bs + (gt * coef) * acc[ai][bj][m][n];
                        }
                    if (m & 1) asm volatile("" ::: "memory");
                }
        } else {
#pragma unroll
            for (int ai = 0; ai < 2; ++ai)
#pragma unroll
                for (int m = 0; m < 4; ++m) {
                    const int row = row0 + ai * HALF + m * 16;
                    const float* gp = gate + (size_t)modrow_of(row) * NMOD + col0;
                    float* op = (float*)((char*)out + SLAB_MINUS_X) + ((size_t)u.kp * MS + (row - MP)) * DM + col0;
#pragma unroll
                    for (int bj = 0; bj < 2; ++bj)
#pragma unroll
                        for (int n = 0; n < 2; ++n) {
                            const f32x4 gt = *(const f32x4*)(gp + bj * HALF + n * 16);
                            *(f32x4*)(op + bj * HALF + n * 16) = (gt * coef) * acc[ai][bj][m][n];
                        }
                    if (m & 1) asm volatile("" ::: "memory");
                }
        }
    }
};
struct EpiWin {
    static constexpr bool PERM = true, AFTER_DRAIN = false;
    float* U; bf16_t* QKVG; const float* rot;
    __device__ __forceinline__ void operator()(const f32x4 (&acc)[2][2][4][2], const Unit& u, int wr, int wc, int fr, int fq) const {
        const int row0 = u.pm * BM + wr * 64 + fr, cw = wc * 32 + 8 * fq;
        if (u.pn < 4) {
#pragma unroll
            for (int ai = 0; ai < 2; ++ai)
#pragma unroll
                for (int m = 0; m < 4; ++m) {
                    float* rowp = U + (size_t)(row0 + ai * HALF + m * 16) * PW + u.pn * BM + cw;
#pragma unroll
                    for (int bj = 0; bj < 2; ++bj)
#pragma unroll
                        for (int n = 0; n < 2; ++n) *(f32x4*)(rowp + bj * HALF + 4 * n) = acc[ai][bj][m][n];
                }
        } else {
            const int t = (u.pn - 4) >> 2, hd = (u.pn - 4) & 3;
            bf16_t* dst = QKVG + (size_t)t * MTOK * RW + hd * HD + cw;
            if (t < 2) {
                const float sc = (t == 1) ? 0.0625f : 1.0f;
#pragma unroll
                for (int ai = 0; ai < 2; ++ai)
#pragma unroll
                    for (int m = 0; m < 4; ++m) {
                        const int row = row0 + ai * HALF + m * 16;
                        const float* rp = rot + ((size_t)ptab_of(row) * 128 + cw) * 2;
                        u32x4 w1, w2;
#pragma unroll
                        for (int n = 0; n < 2; ++n) {
                            const f32x4 cs0 = *(const f32x4*)(rp + 8 * n), cs1 = *(const f32x4*)(rp + 8 * n + 4);
                            const f32x4 x1 = acc[ai][0][m][n] * sc, x2 = acc[ai][1][m][n] * sc;
                            const float a0 = x1[0] * cs0[0] - x2[0] * cs0[1], b0 = x2[0] * cs0[0] + x1[0] * cs0[1];
                            const float a1 = x1[1] * cs0[2] - x2[1] * cs0[3], b1 = x2[1] * cs0[2] + x1[1] * cs0[3];
                            const float a2 = x1[2] * cs1[0] - x2[2] * cs1[1], b2 = x2[2] * cs1[0] + x1[2] * cs1[1];
                            const float a3 = x1[3] * cs1[2] - x2[3] * cs1[3], b3 = x2[3] * cs1[2] + x1[3] * cs1[3];
                            if (n == 0) { w1.x = cvt_pk_bf16(a0, a1); w1.y = cvt_pk_bf16(a2, a3); w2.x = cvt_pk_bf16(b0, b1); w2.y = cvt_pk_bf16(b2, b3); }
                            else        { w1.z = cvt_pk_bf16(a0, a1); w1.w = cvt_pk_bf16(a2, a3); w2.z = cvt_pk_bf16(b0, b1); w2.w = cvt_pk_bf16(b2, b3); }
                        }
                        bf16_t* rowp = dst + (size_t)row * RW;
                        *(u32x4*)rowp = w1; *(u32x4*)(rowp + HALF) = w2;
                    }
            } else {
#pragma unroll
                for (int ai = 0; ai < 2; ++ai)
#pragma unroll
                    for (int m = 0; m < 4; ++m) {
                        bf16_t* rowp = dst + (size_t)(row0 + ai * HALF + m * 16) * RW;
#pragma unroll
                        for (int bj = 0; bj < 2; ++bj) { const f32x4 v0 = acc[ai][bj][m][0], v1 = acc[ai][bj][m][1]; u32x4 w;
                            w.x = cvt_pk_bf16(v0[0], v0[1]); w.y = cvt_pk_bf16(v0[2], v0[3]); w.z = cvt_pk_bf16(v1[0], v1[1]); w.w = cvt_pk_bf16(v1[2], v1[3]);
                            *(u32x4*)(rowp + bj * HALF) = w; }
                    }
            }
        }
    }
};
struct EpiPool {
    static constexpr bool PERM = true, AFTER_DRAIN = false;
    bf16_t* MIX; const float* pscale;
    __device__ __forceinline__ void operator()(const f32x4 (&acc)[2][2][4][2], const Unit& u, int wr, int wc, int fr, int fq) const {
        const int row0 = u.pm * BM + wr * 64 + fr, col0 = u.pn * BM + wc * 32 + 8 * fq;
#pragma unroll
        for (int ai = 0; ai < 2; ++ai)
#pragma unroll
            for (int m = 0; m < 4; ++m) {
                bf16_t* rowp = MIX + (size_t)(row0 + ai * HALF + m * 16) * DM + col0;
#pragma unroll
                for (int bj = 0; bj < 2; ++bj) { const f32x4 v0 = acc[ai][bj][m][0] * *(const f32x4*)(pscale + col0 + bj * HALF), v1 = acc[ai][bj][m][1] * *(const f32x4*)(pscale + col0 + bj * HALF + 4); u32x4 w;
                    w.x = cvt_pk_bf16(v0[0], v0[1]); w.y = cvt_pk_bf16(v0[2], v0[3]); w.z = cvt_pk_bf16(v1[0], v1[1]); w.w = cvt_pk_bf16(v1[2], v1[3]);
                    *(u32x4*)(rowp + bj * HALF) = w; }
            }
    }
};

template <class Epi, class Sched, bool ALIGN_EPI = false>
__device__ __forceinline__ void gemm_phase(PG8_LAS unsigned char* lds, const Gemm g, const Sched& S, const Epi& E) {
    const int tid = threadIdx.x, wid = __builtin_amdgcn_readfirstlane(tid >> 6), lane = tid & 63, wr = wid >> 2, wc = wid & 3, fr = lane & 15, fq = lane >> 4;
    unsigned voffA[2], voffB[2];
#pragma unroll
    for (int i = 0; i < 2; ++i) { int R, C; stage_rc(tid * 16 + i * 8192, R, C); const int Rb = Epi::PERM ? ((R & ~31) + perm32(R & 31)) : R;
        voffA[i] = (unsigned)(R * g.lda + C) * 2u; voffB[i] = (unsigned)(Rb * g.ldb + C) * 2u; }
    const size_t kstep = (size_t)(BK * 2);
    const size_t hstepA = (size_t)HALF * g.lda * 2, hstepB = (size_t)HALF * g.ldb * 2;
    const size_t tstepA = 2 * hstepA, tstepB = 2 * hstepB;
    const size_t astep = (size_t)g.acol * 2;
    const unsigned ldsw = (unsigned)wid * 1024u;
    const int aoff = lds_byte(wr * 64 + fr, fq * 8), boff = lds_byte(wc * 32 + fr, fq * 8);
#define PG8_SA(b, h) (((b) * 2 + (h)) * HTB)
#define PG8_SB(b, h) ((4 + (b) * 2 + (h)) * HTB)
#define PG8_STAGE(bufoff, gbase, voff) do { _Pragma("unroll") for (int _i = 0; _i < 2; ++_i) \
        __builtin_amdgcn_global_load_lds((const unsigned*)((const char*)(gbase) + (voff)[_i]), (PG8_LAS unsigned*)(lds + (bufoff) + ldsw + _i * 8192), 16, 0, 0); } while (0)
#define PG8_LDA(dst, b, h) do { _Pragma("unroll") for (int m = 0; m < 4; ++m) _Pragma("unroll") for (int k = 0; k < 2; ++k) dst[m][k] = *(const PG8_LAS bf16x8*)(lds + PG8_SA(b, h) + aoff + m * 2048 + k * 1024); } while (0)
#define PG8_LDB(dst, b, h) do { _Pragma("unroll") for (int n = 0; n < 2; ++n) _Pragma("unroll") for (int k = 0; k < 2; ++k) dst[n][k] = *(const PG8_LAS bf16x8*)(lds + PG8_SB(b, h) + boff + n * 2048 + k * 1024); } while (0)
#define PG8_MMA(ai, bj, At, Bt) do { __builtin_amdgcn_s_setprio(1); _Pragma("unroll") for (int m = 0; m < 4; ++m) _Pragma("unroll") for (int n = 0; n < 2; ++n) _Pragma("unroll") for (int k = 0; k < 2; ++k) \
        acc[ai][bj][m][n] = __builtin_amdgcn_mfma_f32_16x16x32_bf16(Bt[n][k], At[m][k], acc[ai][bj][m][n], 0, 0, 0); __builtin_amdgcn_s_setprio(0); } while (0)
#define PG8_WAIT_V(n) asm volatile("s_waitcnt vmcnt(" #n ")" ::: "memory")
#define PG8_WAIT_L(n) asm volatile("s_waitcnt lgkmcnt(" #n ")" ::: "memory")
#define PG8_BAR __builtin_amdgcn_s_barrier()
#define PG8_SCHED __builtin_amdgcn_sched_barrier(0)
    Unit cur, nxt; int ui = 0;
    if (!S.next(0, cur)) return;
    f32x4 acc[2][2][4][2];
#pragma unroll
    for (int a = 0; a < 2; ++a)
#pragma unroll
        for (int b = 0; b < 2; ++b)
#pragma unroll
            for (int m = 0; m < 4; ++m)
#pragma unroll
                for (int n = 0; n < 2; ++n) acc[a][b][m][n] = (f32x4){0.f, 0.f, 0.f, 0.f};
    bf16x8 At[4][2], B0[2][2], B1[2][2];
    const char* cA = (const char*)g.A + (size_t)cur.pm * tstepA + (size_t)cur.pn * astep + (cur.kp > 0 ? (size_t)cur.kp * g.kpiece * 2 : 0); const char* cB = (const char*)g.Bt + (size_t)cur.pn * tstepB + (cur.kp > 0 ? (size_t)cur.kp * g.kpiece * 2 : 0);
    S.a_ready(cur);
    PG8_STAGE(PG8_SB(0, 0), cB, voffB); PG8_STAGE(PG8_SB(0, 1), cB + hstepB, voffB); PG8_STAGE(PG8_SA(0, 0), cA, voffA); PG8_STAGE(PG8_SA(0, 1), cA + hstepA, voffA);
    if (wr == 1) PG8_BAR;
    PG8_WAIT_V(2); PG8_BAR;
    PG8_STAGE(PG8_SB(1, 0), cB + kstep, voffB); PG8_STAGE(PG8_SA(1, 0), cA + kstep, voffA); PG8_STAGE(PG8_SB(1, 1), cB + hstepB + kstep, voffB);
    PG8_WAIT_V(6); PG8_BAR;
    for (;;) {
        const bool has_next = S.next(ui + 1, nxt);
        const size_t nko = (has_next && nxt.kp > 0) ? (size_t)nxt.kp * g.kpiece * 2 : 0;
        const char* nA = has_next ? (const char*)g.A + (size_t)nxt.pm * tstepA + (size_t)nxt.pn * astep + nko : cA; const char* nB = has_next ? (const char*)g.Bt + (size_t)nxt.pn * tstepB + nko : cB;
        const int nt = (cur.kp < 0 ? g.K : g.kpiece) / BK;
        for (int t = 0; t < nt; t += 2) {
            const bool last = (t == nt - 2);
            const char* a1 = cA + (size_t)(t + 1) * kstep;
            const char* a2 = last ? nA : cA + (size_t)(t + 2) * kstep; const char* b2 = last ? nB : cB + (size_t)(t + 2) * kstep;
            const char* a3 = a2 + kstep; const char* b3 = b2 + kstep;
            if (last && has_next) S.a_ready(nxt);
            PG8_LDB(B0, 0, 0); PG8_LDB(B1, 0, 1); PG8_SCHED; PG8_LDA(At, 0, 0); PG8_STAGE(PG8_SA(1, 1), a1 + hstepA, voffA);
            PG8_WAIT_V(8); PG8_WAIT_L(0); PG8_BAR; PG8_MMA(0, 0, At, B0); PG8_MMA(0, 1, At, B1); PG8_BAR; PG8_SCHED;
            PG8_LDA(At, 0, 1); PG8_STAGE(PG8_SB(0, 0), b2, voffB); PG8_STAGE(PG8_SB(0, 1), b2 + hstepB, voffB); PG8_STAGE(PG8_SA(0, 0), a2, voffA);
            PG8_WAIT_V(8); PG8_WAIT_L(0); PG8_BAR; PG8_MMA(1, 0, At, B0); PG8_MMA(1, 1, At, B1); PG8_BAR; PG8_SCHED;
            PG8_LDB(B0, 1, 0); PG8_LDB(B1, 1, 1); PG8_SCHED; PG8_LDA(At, 1, 0); PG8_STAGE(PG8_SA(0, 1), a2 + hstepA, voffA);
            PG8_WAIT_V(8); PG8_WAIT_L(0); PG8_BAR; PG8_MMA(0, 0, At, B0); PG8_MMA(0, 1, At, B1); PG8_BAR; PG8_SCHED;
            PG8_LDA(At, 1, 1); PG8_STAGE(PG8_SB(1, 0), b3, voffB); PG8_STAGE(PG8_SB(1, 1), b3 + hstepB, voffB); PG8_STAGE(PG8_SA(1, 0), a3, voffA);
            PG8_WAIT_V(8); PG8_WAIT_L(0); PG8_BAR; PG8_MMA(1, 0, At, B0); PG8_MMA(1, 1, At, B1); PG8_BAR; PG8_SCHED;
        }
        if constexpr (ALIGN_EPI) { if (wr == 0) PG8_BAR; }
        E(acc, cur, wr, wc, fr, fq); S.done(cur);
        if (!has_next) break;
#pragma unroll
        for (int a = 0; a < 2; ++a)
#pragma unroll
            for (int b = 0; b < 2; ++b)
#pragma unroll
                for (int m = 0; m < 4; ++m)
#pragma unroll
                    for (int n = 0; n < 2; ++n) acc[a][b][m][n] = (f32x4){0.f, 0.f, 0.f, 0.f};
        cur = nxt; cA = nA; cB = nB; ++ui;
        if constexpr (ALIGN_EPI) { if (wr == 1) PG8_BAR; }
    }
    PG8_WAIT_V(0);
    if constexpr (!ALIGN_EPI) { if (wr == 0) PG8_BAR; }
    PG8_BAR;
#undef PG8_SA
#undef PG8_SB
#undef PG8_STAGE
#undef PG8_LDA
#undef PG8_LDB
#undef PG8_MMA
#undef PG8_WAIT_V
#undef PG8_WAIT_L
#undef PG8_BAR
#undef PG8_SCHED
}
}

constexpr int NWAVES = 8;
constexpr int N_PHASES = 15;
constexpr size_t MiB = 1u << 20;
constexpr size_t WS_CTL = 0, CTL_ZERO_BYTES = 64 * 1024;
constexpr size_t WS_SC = 1 * MiB;
constexpr size_t WS_ROT = 2 * MiB;
constexpr size_t WS_MODS = 5 * MiB;
constexpr size_t WS_WPOOL = 15 * MiB;
constexpr size_t WS_WOUT = 16 * MiB;
constexpr size_t WS_WIN = 24 * MiB;
constexpr size_t WS_W1 = 44 * MiB;
constexpr size_t WS_W1D = 88 * MiB;
constexpr size_t WS_W2 = 110 * MiB;
constexpr size_t WS_W2D = 154 * MiB;
constexpr size_t WS_H = 176 * MiB;
constexpr size_t WS_X = 210 * MiB;
constexpr size_t WS_ACT = 278 * MiB;
constexpr size_t WS_QKVG = WS_ACT;
constexpr size_t WS_PM = WS_ACT + 68 * MiB;
constexpr size_t WS_U = 372 * MiB;
constexpr size_t WS_MIX = 406 * MiB;
constexpr size_t WS_UT = 440 * MiB;
constexpr size_t WS_OI = 504 * MiB;
constexpr size_t WS_ST = 536 * MiB;
constexpr size_t WS_SLAB = 568 * MiB;
constexpr size_t WS_END = 612 * MiB;
static_assert(WS_SLAB - WS_X == SLAB_MINUS_X, "slab offset");
constexpr int KP_DOWN = 512, KP_OUT = 256;
static_assert(WS_SC + 160 * 2048 * 2 <= WS_ROT && WS_ROT + (size_t)NPOS * 128 * 8 <= WS_MODS && WS_MODS + (size_t)NMODROW * NMOD * 4 <= WS_WPOOL, "ws map 1");
static_assert(WS_W1 + (size_t)2 * DFF * DM * 2 <= WS_W1D && WS_W1D + (size_t)DM * DFF * 2 <= WS_W2 && WS_W2D + (size_t)DM * DFF * 2 <= WS_H, "ws map 2");
static_assert(WS_H + (size_t)MTOK * DM * 2 <= WS_X && WS_X + (size_t)MTOK * DM * 4 <= WS_ACT && WS_ACT + (size_t)MTOK * DFF * 2 <= WS_U, "ws map 3");
static_assert(WS_PM + (size_t)MTOK * PW * 2 <= WS_U && WS_U + (size_t)MTOK * PW * 4 <= WS_MIX && WS_MIX + (size_t)MTOK * DM * 2 <= WS_UT, "ws map 4");
constexpr int CW_BAR = 1024;

constexpr int RING_BYTES = 131072;
constexpr int LDSCTL_OFF = RING_BYTES, MISC_OFF = LDSCTL_OFF + 320;
constexpr int LDS_BYTES = 147456;

#define GAS __attribute__((address_space(1)))
#define LAS __attribute__((address_space(3)))
typedef unsigned short bf16;
typedef unsigned v4u __attribute__((ext_vector_type(4)));
typedef unsigned v2u __attribute__((ext_vector_type(2)));
typedef float f32x4 __attribute__((ext_vector_type(4)));
typedef float f32x16 __attribute__((ext_vector_type(16)));
typedef short bf16x8 __attribute__((ext_vector_type(8)));
typedef short bf16x4 __attribute__((ext_vector_type(4)));
typedef GAS unsigned gu32;
#define RLX_AGENT __ATOMIC_RELAXED, __HIP_MEMORY_SCOPE_AGENT
#define LDS_WAIT() asm volatile("s_waitcnt lgkmcnt(0)" ::: "memory")
#define VM_WAIT() asm volatile("s_waitcnt vmcnt(0)" ::: "memory")
__device__ __forceinline__ unsigned f2bf(float f) { unsigned u = __builtin_bit_cast(unsigned, f); return (u + 0x7fffu + ((u >> 16) & 1u)) >> 16; }
__device__ __forceinline__ unsigned pk2(float lo, float hi) { return f2bf(lo) | (f2bf(hi) << 16); }
__device__ __forceinline__ float bf2f(unsigned short v) { return __builtin_bit_cast(float, (unsigned)v << 16); }
__device__ __forceinline__ float silu1(float x) { return x / (1.0f + __expf(-x)); }

#define XB_TMO      128
#define XB_XCNT(j)  (256  + 64 * (j))
#define XB_XSUB(j)  (1280 + 64 * (j))
#define XB_XGEN(j)  (2304 + 64 * (j))
#define XB_TOP      3328
#define XB_TOPGEN   3392
#define XCD_BAR_WORDS 3456
#define XB_SPIN_CAP (1u << 20)
static_assert((CW_BAR + 2 * XCD_BAR_WORDS) * 4 <= (int)CTL_ZERO_BYTES, "barrier words inside the memset region");

__device__ __forceinline__ unsigned xb_ld(unsigned* p)              { return __hip_atomic_load(p, __ATOMIC_RELAXED, __HIP_MEMORY_SCOPE_AGENT); }
__device__ __forceinline__ unsigned xb_add(unsigned* p, unsigned v) { return __hip_atomic_fetch_add(p, v, __ATOMIC_RELAXED, __HIP_MEMORY_SCOPE_AGENT); }
__device__ __forceinline__ unsigned xb_xcc_id() { return (unsigned)__builtin_amdgcn_s_getreg((3 << 11) | 20) & 0xFu; }
#define XB_SPIN(cond, bar) do { unsigned _sp = 0; while (cond) { __builtin_amdgcn_s_sleep(1); \
    if ((++_sp & 255u) == 0u) { if (xb_ld(&(bar)[XB_TMO])) break; if (_sp > XB_SPIN_CAP) { atomicAdd(&(bar)[XB_TMO], 1u); break; } } } } while (0)

struct XcdBarrier { unsigned* bar; unsigned x; volatile LAS unsigned* st; };
__device__ __forceinline__ XcdBarrier xcd_barrier_post(unsigned* bar, volatile LAS unsigned* st) {
    XcdBarrier b; b.bar = bar; b.x = xb_xcc_id(); b.st = st;
    if (threadIdx.x == 0) (void)xb_add(&bar[XB_XCNT(b.x)], 1u);
    return b;
}
__device__ __forceinline__ void xcd_barrier_complete(unsigned* bar, unsigned x, unsigned& nloc, unsigned& nx) {
    const unsigned G = gridDim.x * gridDim.y * gridDim.z;
    unsigned sum, cnt, mine, sp = 0u;
    for (;;) {
        sum = 0u; cnt = 0u; mine = 0u;
#pragma unroll
        for (unsigned j = 0; j < 16; ++j) { const unsigned c = xb_ld(&bar[XB_XCNT(j)]); sum += c; cnt += (c > 0u) ? 1u : 0u; mine = (j == x) ? c : mine; }
        if (sum == G) break;
        __builtin_amdgcn_s_sleep(1);
        if ((++sp & 255u) == 0u) { if (xb_ld(&bar[XB_TMO])) break; if (sp > XB_SPIN_CAP) { atomicAdd(&bar[XB_TMO], 1u); break; } }
    }
    nloc = mine > 0u ? mine : 1u; nx = cnt > 0u ? cnt : 1u;
}
__device__ __forceinline__ void xcd_barrier(const XcdBarrier& b) {
    asm volatile("s_waitcnt vmcnt(0)" ::: "memory");
    __syncthreads();
    if (threadIdx.x == 0) {
        unsigned* bar = b.bar;
        __builtin_amdgcn_s_waitcnt(0);
        unsigned nloc = b.st[0], nx = b.st[1];
        if (nloc == 0u) { xcd_barrier_complete(bar, b.x, nloc, nx); b.st[0] = nloc; b.st[1] = nx; }
        const unsigned old = xb_add(&bar[XB_XSUB(b.x)], 1u);
        const unsigned gen = old / nloc;
        if (old + 1u == (gen + 1u) * nloc) {
            __builtin_amdgcn_fence(__ATOMIC_RELEASE, "agent");
            asm volatile("s_waitcnt vmcnt(0)" ::: "memory");
            const unsigned og = xb_add(&bar[XB_TOP], 1u);
            const unsigned tg = og / nx;
            if (og + 1u == (tg + 1u) * nx) xb_add(&bar[XB_TOPGEN], 1u);
            else XB_SPIN(xb_ld(&bar[XB_TOPGEN]) == tg, bar);
            __builtin_amdgcn_fence(__ATOMIC_ACQUIRE, "agent");
            xb_add(&bar[XB_XGEN(b.x)], 1u);
            asm volatile("s_waitcnt vmcnt(0)" ::: "memory");
        } else {
            XB_SPIN(xb_ld(&bar[XB_XGEN(b.x)]) == gen, bar);
            __builtin_amdgcn_fence(__ATOMIC_ACQUIRE, "agent");
            asm volatile("s_waitcnt vmcnt(0)" ::: "memory");
        }
    }
    __syncthreads();
}

struct Args { const float* in[22]; float* out; unsigned char* ws; int ph_lo, ph_hi, bar_region, pad; };
static_assert(sizeof(Args) == 22 * 8 + 8 + 8 + 16, "Args has no padding");
#define INP(i) (A.in[i])
struct Frame {
    LAS unsigned char* lds;
    volatile LAS unsigned* MISC;
    int tid, lane, wave;
    int vcu, G;
    unsigned char* ws;
    float* out;
};
#define WSP(T, off) ((T*)(F.ws + (off)))
__device__ __forceinline__ int lane_of(const Frame& F) { int l = F.tid & 63; asm volatile("" : "+v"(l)); return l; }

__device__ __forceinline__ float wave_sum(float v) {
#pragma unroll
    for (int o = 1; o < 64; o <<= 1) v += __shfl_xor(v, o);
    return v;
}

__device__ __forceinline__ void p0_transpose_item(const float* W, int N, bf16* WT, int ldk, int dst_row0, int k0, int n0, LAS float* scr, int lane) {
    f32x4 t[8];
#pragma unroll
    for (int i = 0; i < 8; ++i) t[i] = *(const f32x4*)(W + (size_t)(k0 + 8 * i + (lane >> 3)) * N + n0 + 4 * (lane & 7));
#pragma unroll
    for (int i = 0; i < 8; ++i) { LAS float* d = scr + (8 * i + (lane >> 3)) * 33 + 4 * (lane & 7); d[0] = t[i][0]; d[1] = t[i][1]; d[2] = t[i][2]; d[3] = t[i][3]; }
    LDS_WAIT(); asm volatile("" ::: "memory");
    const int c = lane & 7;
#pragma unroll
    for (int j = 0; j < 4; ++j) { const int n = (lane >> 3) + 8 * j; const LAS float* s = scr + (8 * c) * 33 + n;
        v4u o; o.x = pk2(s[0 * 33], s[1 * 33]); o.y = pk2(s[2 * 33], s[3 * 33]); o.z = pk2(s[4 * 33], s[5 * 33]); o.w = pk2(s[6 * 33], s[7 * 33]);
        *(GAS v4u*)(WT + (size_t)(dst_row0 + n) * ldk + k0 + 8 * c) = o; }
    LDS_WAIT(); asm volatile("" ::: "memory");
}
__device__ __forceinline__ void p0_matrix_item(const float* W, int K, int N, bf16* WT, int mode, int item, LAS float* scr, int lane) {
    const int nblk = N / 32, kb = item / nblk, nb = item % nblk, k0 = 64 * kb, n0 = 32 * nb;
    const int dst = (mode == 0) ? n0 : (256 * (n0 >> 7) + (n0 & 127) + (mode == 2 ? 128 : 0));
    p0_transpose_item(W, N, WT, K, dst, k0, n0, scr, lane);
}
__device__ __forceinline__ void p0_prologue(Frame& F, const Args& A) {
    const int flane = lane_of(F);
    LAS float* scr = (LAS float*)(F.lds + F.wave * 16384);
    const int gw = F.vcu * NWAVES + F.wave, NGW = F.G * NWAVES;
    constexpr int I_F = (DM / 64) * (DFF / 32), I_D = (DFF / 64) * (DM / 32), I_IN = (DM / 64) * (INC / 32), I_OUT = (DM / 64) * (DM / 32), I_P = (HD / 64) * (HD / 32);
    constexpr int NITEMS = 4 * I_F + 2 * I_D + I_IN + I_OUT + 4 * I_P;
    for (int it = gw; it < NITEMS; it += NGW) {
        int r = it;
        if (r < I_F) { p0_matrix_item(INP(9), DM, DFF, WSP(bf16, WS_W1), 1, r, scr, flane); continue; } r -= I_F;
        if (r < I_F) { p0_matrix_item(INP(10), DM, DFF, WSP(bf16, WS_W1), 2, r, scr, flane); continue; } r -= I_F;
        if (r < I_D) { p0_matrix_item(INP(11), DFF, DM, WSP(bf16, WS_W1D), 0, r, scr, flane); continue; } r -= I_D;
        if (r < I_IN) { p0_matrix_item(INP(13), DM, INC, WSP(bf16, WS_WIN), 0, r, scr, flane); continue; } r -= I_IN;
        if (r < I_OUT) { p0_matrix_item(INP(16), DM, DM, WSP(bf16, WS_WOUT), 0, r, scr, flane); continue; } r -= I_OUT;
        if (r < 4 * I_P) { const int g = r / I_P; p0_matrix_item(INP(14) + (size_t)g * HD * HD, HD, HD, WSP(bf16, WS_WPOOL) + (size_t)g * HD * HD, 0, r % I_P, scr, flane); continue; } r -= 4 * I_P;
        if (r < I_F) { p0_matrix_item(INP(18), DM, DFF, WSP(bf16, WS_W2), 1, r, scr, flane); continue; } r -= I_F;
        if (r < I_F) { p0_matrix_item(INP(19), DM, DFF, WSP(bf16, WS_W2), 2, r, scr, flane); continue; } r -= I_F;
        p0_matrix_item(INP(20), DFF, DM, WSP(bf16, WS_W2D), 0, r, scr, flane);
    }
    const int gt = F.vcu * (NWAVES * 64) + F.tid, NT = F.G * NWAVES * 64;
    for (int i = gt; i < 160 * DM / 4; i += NT) {
        const int m = (4 * i) / DM, k = (4 * i) % DM;
        f32x4 v = (f32x4){0.f, 0.f, 0.f, 0.f};
        if (m < NB) v = *(const f32x4*)(INP(2) + (size_t)m * DM + k); else if (m < NMODROW) v = *(const f32x4*)(INP(3) + (size_t)(m - NB) * DM + k);
        v2u o; o.x = pk2(silu1(v[0]), silu1(v[1])); o.y = pk2(silu1(v[2]), silu1(v[3]));
        *(GAS v2u*)(WSP(bf16, WS_SC) + ((size_t)(((k >> 4) * 5 + (m >> 5)) * 64 + ((k >> 3) & 1) * 32 + (m & 31)) * 8 + (k & 7))) = o;
    }
    for (int i = gt; i < NPOS * 128; i += NT) {
        const int p = i >> 7, fi = i & 127;
        const float pos = (float)(p < SEQ ? p : PAST + (p - SEQ));
        const float inv = (float)exp(-(double)fi * (9.210340371976184 / 128.0));
        const float ang = pos * inv;
        double s, c; sincos((double)ang, &s, &c);
        WSP(float, WS_ROT)[2 * (size_t)i] = (float)c; WSP(float, WS_ROT)[2 * (size_t)i + 1] = (float)s;
    }
}

__device__ __forceinline__ void p1_adaln(Frame& F, const Args& A) {
    const int flane = lane_of(F);
    LAS float* red = (LAS float*)F.lds;
    const int lane = flane, w = F.wave, r = lane & 31, hh = lane >> 5;
    for (int strip = F.vcu; strip < NMOD / 32; strip += F.G) {
        for (int i = F.tid; i < 160 * 33; i += NWAVES * 64) red[i] = 0.f;
        __syncthreads();
        const int n0 = strip * 32;
        f32x16 acc[5];
#pragma unroll
        for (int t = 0; t < 5; ++t)
#pragma unroll
            for (int i = 0; i < 16; ++i) acc[t][i] = 0.f;
        const float* Wp = INP(6) + (size_t)(256 * w + 8 * hh) * NMOD + n0 + r;
        const bf16* Sp = WSP(bf16, WS_SC) + ((size_t)(16 * w) * 5 * 64 + lane) * 8;
#pragma unroll 4
        for (int s = 0; s < 16; ++s) {
            float wv[8];
#pragma unroll
            for (int j = 0; j < 8; ++j) wv[j] = Wp[(size_t)(16 * s + j) * NMOD];
            v4u au; au.x = pk2(wv[0], wv[1]); au.y = pk2(wv[2], wv[3]); au.z = pk2(wv[4], wv[5]); au.w = pk2(wv[6], wv[7]);
            const bf16x8 a = __builtin_bit_cast(bf16x8, au);
#pragma unroll
            for (int t = 0; t < 5; ++t) {
                const bf16x8 b = *(const bf16x8*)(Sp + (size_t)((s * 5 + t) * 64) * 8);
                acc[t] = __builtin_amdgcn_mfma_f32_32x32x16_bf16(a, b, acc[t], 0, 0, 0);
            }
        }
#pragma unroll
        for (int t = 0; t < 5; ++t)
#pragma unroll
            for (int i = 0; i < 16; ++i) {
                const int n = (i & 3) + 8 * (i >> 2) + 4 * hh, m = 32 * t + r;
                __hip_atomic_fetch_add(red + m * 33 + n, acc[t][i], __ATOMIC_RELAXED, __HIP_MEMORY_SCOPE_WORKGROUP);
            }
        __syncthreads();
        for (int idx = F.tid; idx < NMODROW * 32; idx += NWAVES * 64) { const int m = idx >> 5, n = idx & 31; WSP(float, WS_MODS)[(size_t)m * NMOD + n0 + n] = red[m * 33 + n] + INP(7)[n0 + n]; }
        __syncthreads();
    }
}

__device__ __forceinline__ void norm_mod(Frame& F, const float* srcP, const float* srcS, const float* gain, int sub, bf16* Hd, const float* slab, int np, float* xs_out) {
    const int flane = lane_of(F);
    const int gw = F.vcu * NWAVES + F.wave, NGW = F.G * NWAVES;
    for (int mi = gw; mi < MTOK; mi += NGW) {
        const int m = (mi + MS) % MTOK;
        const float* xr = (m < MP) ? srcP + (size_t)m * DM : srcS + (size_t)(m - MP) * DM;
        const float* sh = WSP(float, WS_MODS) + (size_t)pg8::modrow_of(m) * NMOD + (size_t)(3 * sub) * DM; const float* sc = sh + DM;
        f32x4 v[8]; float ss = 0.f;
#pragma unroll
        for (int j = 0; j < 8; ++j) v[j] = *(const f32x4*)(xr + 4 * (flane + 64 * j));
        if (m >= MP && np > 0) {
            for (int p = 0; p < np; ++p) { const float* sp = slab + ((size_t)p * MS + (m - MP)) * DM;
#pragma unroll
                for (int j = 0; j < 8; ++j) v[j] += *(const f32x4*)(sp + 4 * (flane + 64 * j)); }
#pragma unroll
            for (int j = 0; j < 8; ++j) *(f32x4*)(xs_out + (size_t)(m - MP) * DM + 4 * (flane + 64 * j)) = v[j];
        }
#pragma unroll
        for (int j = 0; j < 8; ++j) ss += (v[j][0] * v[j][0] + v[j][1] * v[j][1]) + (v[j][2] * v[j][2] + v[j][3] * v[j][3]);
        const float rstd = 1.0f / sqrtf(wave_sum(ss) * (1.0f / DM) + EPS);
#pragma unroll
        for (int j = 0; j < 8; ++j) { const int k = 4 * (flane + 64 * j);
            const f32x4 g4 = *(const f32x4*)(gain + k), s4 = *(const f32x4*)(sc + k), h4 = *(const f32x4*)(sh + k);
            const f32x4 o = (v[j] * rstd) * g4 * (s4 + 1.0f) + h4;
            v2u pk; pk.x = pk2(o[0], o[1]); pk.y = pk2(o[2], o[3]);
            *(GAS v2u*)(Hd + (size_t)m * DM + k) = pk; }
    }
}
__device__ __forceinline__ void final_norm(Frame& F, const Args& A, const float* slab, int np) {
    const int flane = lane_of(F);
    const int gw = F.vcu * NWAVES + F.wave, NGW = F.G * NWAVES;
    for (int mi = gw; mi < MTOK; mi += NGW) {
        const int m = (mi + MS) % MTOK;
        const float* xr = WSP(float, WS_X) + (size_t)m * DM;
        float* yr = F.out + ((m < MP) ? O_YP + (size_t)m * DM : O_YS + (size_t)(m - MP) * DM);
        f32x4 v[8]; float ss = 0.f;
#pragma unroll
        for (int j = 0; j < 8; ++j) v[j] = *(const f32x4*)(xr + 4 * (flane + 64 * j));
        if (m >= MP) {
            for (int p = 0; p < np; ++p) { const float* sp = slab + ((size_t)p * MS + (m - MP)) * DM;
#pragma unroll
                for (int j = 0; j < 8; ++j) v[j] += *(const f32x4*)(sp + 4 * (flane + 64 * j)); }
        }
#pragma unroll
        for (int j = 0; j < 8; ++j) ss += (v[j][0] * v[j][0] + v[j][1] * v[j][1]) + (v[j][2] * v[j][2] + v[j][3] * v[j][3]);
        const float rstd = 1.0f / sqrtf(wave_sum(ss) * (1.0f / DM) + EPS);
#pragma unroll
        for (int j = 0; j < 8; ++j) { const int k = 4 * (flane + 64 * j); const f32x4 g4 = *(const f32x4*)(INP(21) + k); *(f32x4*)(yr + k) = (v[j] * rstd) * g4; }
    }
}

#define MFMA16(a, b, c) __builtin_amdgcn_mfma_f32_16x16x32_bf16(a, b, c, 0, 0, 0)
__device__ __forceinline__ float log2_gamma(int h) { return h == 0 ? -0.045803689613124747f : h == 1 ? -0.022720076500083405f : h == 2 ? -0.011315313227834146f : -0.0056465631411130581f; }
constexpr int TP = 136;

__device__ __forceinline__ void retA_unit(Frame& F, int unit) {
    const int flane = lane_of(F);
    const int half = unit & 1, c = (unit >> 1) & 15, bh = unit >> 5, b = bh >> 2, h = bh & 3;
    const int m0 = b * SEQ + c * CH;
    const int tid = F.tid, lane = flane, w = F.wave, fr = lane & 15, fq = lane >> 4;
    LAS bf16* VT = (LAS bf16*)F.lds; LAS bf16* KT = VT + 256 * TP; LAS bf16* PP = KT + 128 * TP;
    const bf16* Qg = WSP(bf16, WS_QKVG) + (size_t)m0 * RW + h * HD;
    const bf16* Kg = Qg + (size_t)MTOK * RW; const bf16* Vg = Kg + (size_t)MTOK * RW;
    const float l2g = log2_gamma(h);
#pragma unroll 4
    for (int it = 0; it < 8; ++it) { const int idx = it * 512 + tid, tok = idx & 127, ch = idx >> 7;
        const bf16x8 v = *(const bf16x8*)(Vg + (size_t)tok * RW + ch * 8);
#pragma unroll
        for (int e = 0; e < 8; ++e) VT[(ch * 8 + e) * TP + tok] = (bf16)v[e]; }
#pragma unroll 4
    for (int it = 0; it < 4; ++it) { const int idx = it * 512 + tid, tok = idx & 127, ch = idx >> 7;
        const bf16x8 k = *(const bf16x8*)(Kg + (size_t)tok * RW + half * 128 + ch * 8);
        const float kd = __builtin_amdgcn_exp2f((float)(127 - tok) * l2g);
#pragma unroll
        for (int e = 0; e < 8; ++e) KT[(ch * 8 + e) * TP + tok] = (bf16)f2bf(bf2f((bf16)k[e]) * kd); }
    {
        f32x4 acc[4];
#pragma unroll
        for (int i = 0; i < 4; ++i) acc[i] = (f32x4){0.f, 0.f, 0.f, 0.f};
        if (16 * w < 64 * half + 64) {
#pragma unroll 2
            for (int s = 0; s < 8; ++s) {
                const bf16x8 bb = *(const bf16x8*)(Kg + (size_t)(16 * w + fr) * RW + 32 * s + 8 * fq);
#pragma unroll
                for (int i = 0; i < 4; ++i) { const bf16x8 aa = *(const bf16x8*)(Qg + (size_t)(64 * half + 16 * i + fr) * RW + 32 * s + 8 * fq); acc[i] = MFMA16(aa, bb, acc[i]); }
            }
        }
#pragma unroll
        for (int i = 0; i < 4; ++i)
#pragma unroll
            for (int r = 0; r < 4; ++r) { const int nl = 16 * i + 4 * fq + r, n = 64 * half + nl, m = 16 * w + fr, dn = n - m;
                const float val = dn >= 0 ? acc[i][r] * __builtin_amdgcn_exp2f((float)dn * l2g) : 0.f;
                PP[nl * TP + m] = (bf16)f2bf(val); }
    }
    __syncthreads();
    {
        f32x4 o[2][4];
#pragma unroll
        for (int j = 0; j < 2; ++j)
#pragma unroll
            for (int i = 0; i < 4; ++i) o[j][i] = (f32x4){0.f, 0.f, 0.f, 0.f};
#pragma unroll
        for (int s = 0; s < 4; ++s) {
            bf16x8 a[4];
#pragma unroll
            for (int i = 0; i < 4; ++i) a[i] = *(const LAS bf16x8*)(PP + (16 * i + fr) * TP + 32 * s + 8 * fq);
#pragma unroll
            for (int j = 0; j < 2; ++j) { const bf16x8 bb = *(const LAS bf16x8*)(VT + (16 * (2 * w + j) + fr) * TP + 32 * s + 8 * fq);
#pragma unroll
                for (int i = 0; i < 4; ++i) o[j][i] = MFMA16(a[i], bb, o[j][i]); }
        }
#pragma unroll
        for (int j = 0; j < 2; ++j)
#pragma unroll
            for (int i = 0; i < 4; ++i)
#pragma unroll
                for (int r = 0; r < 4; ++r) WSP(float, WS_OI)[(size_t)(m0 + 64 * half + 16 * i + 4 * fq + r) * RW + h * HD + 16 * (2 * w + j) + fr] = o[j][i][r];
    }
    {
        f32x4 ua[2][8];
#pragma unroll
        for (int i = 0; i < 2; ++i)
#pragma unroll
            for (int j = 0; j < 8; ++j) ua[i][j] = (f32x4){0.f, 0.f, 0.f, 0.f};
#pragma unroll
        for (int s = 0; s < 4; ++s) {
            bf16x8 a[2];
#pragma unroll
            for (int i = 0; i < 2; ++i) a[i] = *(const LAS bf16x8*)(VT + (16 * (2 * w + i) + fr) * TP + 32 * s + 8 * fq);
#pragma unroll
            for (int j = 0; j < 8; ++j) { const bf16x8 bb = *(const LAS bf16x8*)(KT + (16 * j + fr) * TP + 32 * s + 8 * fq);
#pragma unroll
                for (int i = 0; i < 2; ++i) ua[i][j] = MFMA16(a[i], bb, ua[i][j]); }
        }
        float* UTu = WSP(float, WS_UT) + (size_t)(bh * NCH + c) * HD * HD;
#pragma unroll
        for (int i = 0; i < 2; ++i)
#pragma unroll
            for (int j = 0; j < 8; ++j)
#pragma unroll
                for (int r = 0; r < 4; ++r) UTu[(size_t)(16 * (2 * w + i) + 4 * fq + r) * HD + 128 * half + 16 * j + fr] = ua[i][j][r];
    }
    __syncthreads();
}

__device__ __forceinline__ void retC_unit(Frame& F, int unit) {
    const int flane = lane_of(F);
    const int c = unit & 15, bh = unit >> 4, b = bh >> 2, h = bh & 3;
    const int m0 = b * SEQ + c * CH;
    const int lane = flane, w = F.wave, fr = lane & 15, fq = lane >> 4;
    const bf16* Qg = WSP(bf16, WS_QKVG) + (size_t)m0 * RW + h * HD;
    const bf16* Gg = Qg + (size_t)3 * MTOK * RW;
    const float l2g = log2_gamma(h);
    f32x4 acc[16];
#pragma unroll
    for (int j = 0; j < 16; ++j) acc[j] = (f32x4){0.f, 0.f, 0.f, 0.f};
    if (c > 0) {
        const bf16* STc = WSP(bf16, WS_ST) + (size_t)(bh * NCH + c) * HD * HD;
#pragma unroll 2
        for (int s = 0; s < 8; ++s) {
            const bf16x8 aa = *(const bf16x8*)(Qg + (size_t)(16 * w + fr) * RW + 32 * s + 8 * fq);
#pragma unroll
            for (int j = 0; j < 16; ++j) { const bf16x8 bb = *(const bf16x8*)(STc + (size_t)(16 * j + fr) * HD + 32 * s + 8 * fq); acc[j] = MFMA16(aa, bb, acc[j]); }
        }
    }
#pragma unroll
    for (int r = 0; r < 4; ++r) {
        const int n = 16 * w + 4 * fq + r; const size_t row = (size_t)(m0 + n);
        const float qd = __builtin_amdgcn_exp2f((float)(n + 1) * l2g);
        float ss = 0.f;
#pragma unroll
        for (int j = 0; j < 16; ++j) { const float o = WSP(float, WS_OI)[row * RW + h * HD + 16 * j + fr] + qd * acc[j][r]; acc[j][r] = o; ss += o * o; }
        ss += __shfl_xor(ss, 1); ss += __shfl_xor(ss, 2); ss += __shfl_xor(ss, 4); ss += __shfl_xor(ss, 8);
        const float rs = 1.0f / sqrtf(ss * (1.0f / HD) + EPS);
#pragma unroll
        for (int j = 0; j < 16; ++j) { const float g = bf2f(Gg[(size_t)n * RW + 16 * j + fr]); WSP(bf16, WS_MIX)[row * DM + PW + h * HD + 16 * j + fr] = (bf16)f2bf(silu1(g) * acc[j][r] * rs); }
    }
}

__device__ __forceinline__ void retS_unit(Frame& F, const Args& A, int unit) {
    const int flane = lane_of(F);
    const int b = unit >> 2, h = unit & 3, row0 = MP + 4 * b;
    const int tid = F.tid, lane = flane, w = F.wave;
    LAS float* qs = (LAS float*)F.lds; LAS float* kr = qs + 1024; LAS float* vs = kr + 1024; LAS float* red = vs + 1024; LAS float* dots = red + 8192;
    const bf16* Qg = WSP(bf16, WS_QKVG); const bf16* Kg = Qg + (size_t)MTOK * RW; const bf16* Vg = Kg + (size_t)MTOK * RW; const bf16* Gg = Vg + (size_t)MTOK * RW;
    const float l2g = log2_gamma(h);
    for (int i = tid; i < 1024; i += NWAVES * 64) { const int t = i >> 8, d = i & 255; const size_t off = (size_t)(row0 + t) * RW + h * HD + d;
        qs[i] = bf2f(Qg[off]); kr[i] = bf2f(Kg[off]); vs[i] = bf2f(Vg[off]); }
    __syncthreads();
#pragma unroll
    for (int jj = 0; jj < 2; ++jj) { const int p = 2 * w + jj, t = p >> 2, m = p & 3;
        const f32x4 a = *(const LAS f32x4*)(qs + t * 256 + 4 * lane), k4 = *(const LAS f32x4*)(kr + m * 256 + 4 * lane);
        const float d = wave_sum((a[0] * k4[0] + a[1] * k4[1]) + (a[2] * k4[2] + a[3] * k4[3]));
        if (lane == 0) dots[p] = d; }
    const f32x4* S0 = (const f32x4*)(INP(5) + (size_t)unit * HD * HD);
    f32x4* S1 = (f32x4*)(F.out + O_RETS + (size_t)unit * HD * HD);
    f32x4 v4[4], oq[4];
#pragma unroll
    for (int t = 0; t < 4; ++t) { v4[t] = *(const LAS f32x4*)(vs + t * 256 + 4 * lane); oq[t] = (f32x4){0.f, 0.f, 0.f, 0.f}; }
    const float cdec = __builtin_amdgcn_exp2f(4.0f * l2g);
    const float kd0 = __builtin_amdgcn_exp2f(3.0f * l2g), kd1 = __builtin_amdgcn_exp2f(2.0f * l2g), kd2 = __builtin_amdgcn_exp2f(l2g);
    for (int dk0 = 32 * w; dk0 < 32 * w + 32; dk0 += 8) {
        f32x4 s[8];
#pragma unroll
        for (int u = 0; u < 8; ++u) s[u] = S0[(size_t)(dk0 + u) * 64 + lane];
#pragma unroll
        for (int u = 0; u < 8; ++u) { const int dk = dk0 + u;
            const float q0 = qs[dk], q1 = qs[256 + dk], q2 = qs[512 + dk], q3 = qs[768 + dk];
            const float k0 = kr[dk] * kd0, k1 = kr[256 + dk] * kd1, k2 = kr[512 + dk] * kd2, k3 = kr[768 + dk];
            oq[0] += s[u] * q0; oq[1] += s[u] * q1; oq[2] += s[u] * q2; oq[3] += s[u] * q3;
            S1[(size_t)dk * 64 + lane] = s[u] * cdec + v4[0] * k0 + v4[1] * k1 + v4[2] * k2 + v4[3] * k3; }
    }
#pragma unroll
    for (int t = 0; t < 4; ++t) *(LAS f32x4*)(red + (w * 4 + t) * 256 + 4 * lane) = oq[t];
    __syncthreads();
    if (w < 4) {
        const int t = w;
        f32x4 o = (f32x4){0.f, 0.f, 0.f, 0.f};
#pragma unroll
        for (int ww = 0; ww < 8; ++ww) o += *(const LAS f32x4*)(red + (ww * 4 + t) * 256 + 4 * lane);
        o = o * __builtin_amdgcn_exp2f((float)(t + 1) * l2g);
#pragma unroll
        for (int m = 0; m < 4; ++m) if (m <= t) o += v4[m] * (dots[t * 4 + m] * __builtin_amdgcn_exp2f((float)(t - m) * l2g));
        const float ss = wave_sum((o[0] * o[0] + o[1] * o[1]) + (o[2] * o[2] + o[3] * o[3]));
        const float rs = 1.0f / sqrtf(ss * (1.0f / HD) + EPS);
        const size_t row = (size_t)(row0 + t);
        const v2u gp = *(const v2u*)(Gg + row * RW + h * HD + 4 * lane);
        const float g0 = bf2f((bf16)(gp.x & 0xffffu)), g1 = bf2f((bf16)(gp.x >> 16)), g2 = bf2f((bf16)(gp.y & 0xffffu)), g3 = bf2f((bf16)(gp.y >> 16));
        v2u pk; pk.x = pk2(silu1(g0) * o[0] * rs, silu1(g1) * o[1] * rs); pk.y = pk2(silu1(g2) * o[2] * rs, silu1(g3) * o[3] * rs);
        *(GAS v2u*)(WSP(bf16, WS_MIX) + row * DM + PW + h * HD + 4 * lane) = pk;
    }
    __syncthreads();
}

__device__ __forceinline__ void scan_states(Frame& F) {
    const int gt = F.vcu * (NWAVES * 64) + F.tid, NT = F.G * NWAVES * 64;
    for (int i = gt; i < 16 * 16384; i += NT) {
        const int bh = i >> 14, e4 = i & 16383, h = bh & 3;
        const f32x4* up = (const f32x4*)WSP(float, WS_UT) + (size_t)bh * NCH * 16384 + e4;
        f32x4 uv[16];
#pragma unroll
        for (int c = 0; c < 16; ++c) uv[c] = up[(size_t)c * 16384];
        const float g128 = __builtin_amdgcn_exp2f(128.0f * log2_gamma(h));
        f32x4 S = (f32x4){0.f, 0.f, 0.f, 0.f};
#pragma unroll
        for (int c = 0; c < 16; ++c) {
            S = S * g128 + uv[c];
            if (c < 15) { v2u pk; pk.x = pk2(S[0], S[1]); pk.y = pk2(S[2], S[3]); *(GAS v2u*)(WSP(bf16, WS_ST) + ((size_t)(bh * NCH + c + 1) * 16384 + e4) * 4) = pk; }
        }
        const int dv = (4 * e4) >> 8, dk = (4 * e4) & 255;
        float* rp = F.out + O_RETP + (size_t)bh * HD * HD + dv;
#pragma unroll
        for (int q = 0; q < 4; ++q) rp[(size_t)(dk + q) * HD] = S[q];
    }
}

__device__ __forceinline__ void pool_prompt_item(Frame& F, int item, int q) {
    const int b = item >> 7, t0 = (item & 127) * 16, g = q >> 6, wn = 2 << g;
    const f32x4* U4 = (const f32x4*)(WSP(float, WS_U) + (size_t)b * SEQ * PW) + q;
    f32x4 hv[15], cur[16], old[16];
#pragma unroll
    for (int j = 1; j < 16; ++j) { const int t = t0 - j; const bool ok = (j < wn) && (t >= 0); hv[j - 1] = U4[(size_t)(ok ? t : t0) * 256] * (ok ? 1.0f : 0.0f); }
#pragma unroll
    for (int i = 0; i < 16; ++i) { const int t = t0 + i, to = t - wn; const bool ok = (i >= 1) && (to >= 0);
        cur[i] = U4[(size_t)t * 256]; old[i] = U4[(size_t)(ok ? to : t) * 256] * (ok ? 1.0f : 0.0f); }
    f32x4 sum = (f32x4){0.f, 0.f, 0.f, 0.f};
#pragma unroll
    for (int j = 0; j < 15; ++j) sum += hv[j];
#pragma unroll
    for (int i = 0; i < 16; ++i) {
        const int t = t0 + i;
        sum += cur[i]; sum -= old[i];
        const float cnt = (float)((t + 1 < wn) ? (t + 1) : wn);
        const f32x4 mv = sum / cnt - cur[i];
        v2u pk; pk.x = pk2(mv[0], mv[1]); pk.y = pk2(mv[2], mv[3]);
        *(GAS v2u*)(WSP(bf16, WS_PM) + ((size_t)(b * SEQ + t) * PW + 4 * q)) = pk;
    }
}
__device__ __forceinline__ void pool_sample_item(Frame& F, const Args& A, int b, int q) {
    const int g = q >> 6, wn = 2 << g;
    const f32x4* SP4 = (const f32x4*)(INP(4) + (size_t)b * 15 * PW) + q;
    const f32x4* US4 = (const f32x4*)(WSP(float, WS_U) + (size_t)(MP + 4 * b) * PW) + q;
    for (int t = 0; t < 4; ++t) {
        f32x4 sum = (f32x4){0.f, 0.f, 0.f, 0.f};
        for (int j = 0; j < wn; ++j) { const int i = 15 + t - j; sum += (i < 15) ? SP4[(size_t)i * 256] : US4[(size_t)(i - 15) * 256]; }
        const f32x4 cur = US4[(size_t)t * 256];
        const f32x4 mv = sum / (float)wn - cur;
        v2u pk; pk.x = pk2(mv[0], mv[1]); pk.y = pk2(mv[2], mv[3]);
        *(GAS v2u*)(WSP(bf16, WS_PM) + ((size_t)(MP + 4 * b + t) * PW + 4 * q)) = pk;
    }
}
__device__ __forceinline__ void pool_phase(Frame& F, const Args& A) {
    const int q = F.tid & 255, sub = F.tid >> 8;
    for (int bi = F.vcu; bi < 256; bi += F.G) pool_prompt_item(F, 2 * bi + sub, q);
    for (int bi = F.G - 1 - F.vcu; bi < 64; bi += F.G) pool_sample_item(F, A, 2 * bi + sub, q);
    const int gt = F.vcu * (NWAVES * 64) + F.tid, NT = F.G * NWAVES * 64;
    f32x4* o4 = (f32x4*)F.out;
    for (int i = gt; i < NB * 15 * 256; i += NT) { const int qq = i & 255, r = (i >> 8) % 15, b = (i >> 8) / 15;
        o4[O_POOLP / 4 + i] = ((const f32x4*)WSP(float, WS_U))[((size_t)b * SEQ + (SEQ - 15) + r) * 256 + qq]; }
    for (int i = gt; i < DB * 15 * 256; i += NT) { const int qq = i & 255, r = (i >> 8) % 15, b = (i >> 8) / 15;
        o4[O_POOLS / 4 + i] = (r < 11) ? ((const f32x4*)INP(4))[((size_t)b * 15 + r + 4) * 256 + qq] : ((const f32x4*)WSP(float, WS_U))[((size_t)(MP + 4 * b) + (r - 11)) * 256 + qq]; }
}


__global__ void __launch_bounds__(NWAVES * 64, 2) mk_fwd(Args args) {
    extern __shared__ __attribute__((aligned(16))) unsigned char lds[];
    Frame F;
    F.lds = (LAS unsigned char*)lds;
    F.MISC = (volatile LAS unsigned*)(F.lds + MISC_OFF);
    F.tid = threadIdx.x; F.wave = __builtin_amdgcn_readfirstlane(F.tid >> 6);
    F.G = gridDim.x; { const int bx = blockIdx.x; F.vcu = (F.G % 8 == 0) ? (bx % 8) * (F.G / 8) + bx / 8 : bx; }
    unsigned char* ws = args.ws; const Args& A = args;
    F.out = args.out;
    F.ws = ws;
    for (int u = F.tid; u < (LDS_BYTES - LDSCTL_OFF) / 4; u += NWAVES * 64) ((LAS unsigned*)(F.lds + LDSCTL_OFF))[u] = 0u;
    __syncthreads();
    if (!MK_PER_PHASE) (void)xcd_barrier_post((unsigned*)(ws + WS_CTL) + CW_BAR + args.bar_region * XCD_BAR_WORDS, F.MISC + 8);
    const int lo = args.ph_lo, hi = args.ph_hi;
#ifndef PH_MASK
#define PH_MASK 0x7fff
#endif
#define IN(k) (((PH_MASK >> (k)) & 1) && lo <= (k) && (k) < hi)
#ifndef REP_MASK
#define REP_MASK 0
#endif
#define NREP(k) ((((REP_MASK) >> (k)) & 1) ? 2 : 1)
#define SEAM(k) do { if (!MK_PER_PHASE && (IN((k) + 1) || rep_ + 1 < NREP(k))) { XcdBarrier bar_; bar_.bar = (unsigned*)(A.ws + WS_CTL) + CW_BAR + A.bar_region * XCD_BAR_WORDS; bar_.x = xb_xcc_id(); bar_.st = (volatile LAS unsigned*)(F.lds + MISC_OFF) + 8; xcd_barrier(bar_); } } while (0)

    if (IN(0)) for (int rep_ = 0; rep_ < NREP(0); ++rep_) { p0_prologue(F, A); SEAM(0); }
    if (IN(1)) for (int rep_ = 0; rep_ < NREP(1); ++rep_) { p1_adaln(F, A); SEAM(1); }
    if (IN(2)) for (int rep_ = 0; rep_ < NREP(2); ++rep_) { norm_mod(F, INP(0), INP(1), INP(8), 0, WSP(bf16, WS_H), nullptr, 0, nullptr); SEAM(2); }
    if (IN(3)) for (int rep_ = 0; rep_ < NREP(3); ++rep_) {
        pg8::Gemm g{WSP(bf16, WS_H), WSP(bf16, WS_W1), DM, DM, DM, 0, 0}; pg8::StaticOrder S; S.init(MTOK, 2 * DFF, F.G, (int)blockIdx.x);
        pg8::EpiSwiglu E{WSP(bf16, WS_ACT)};
        pg8::gemm_phase<pg8::EpiSwiglu, pg8::StaticOrder, true>(F.lds, g, S, E);
        SEAM(3);
    }
    if (IN(4)) for (int rep_ = 0; rep_ < NREP(4); ++rep_) {
        pg8::Gemm g{WSP(bf16, WS_ACT), WSP(bf16, WS_W1D), DFF, DFF, DFF, 0, KP_DOWN}; pg8::SplitOrder S; S.init(DM, DFF / KP_DOWN, F.G, (int)blockIdx.x);
        pg8::EpiResid E{INP(0), INP(1), WSP(float, WS_X), WSP(float, WS_MODS) + 2 * DM, 0.5f};
        pg8::gemm_phase<pg8::EpiResid, pg8::SplitOrder, true>(F.lds, g, S, E);
        SEAM(4);
    }
    if (IN(5)) for (int rep_ = 0; rep_ < NREP(5); ++rep_) { norm_mod(F, WSP(float, WS_X), INP(1), INP(12), 1, WSP(bf16, WS_H), WSP(float, WS_SLAB), DFF / KP_DOWN, WSP(float, WS_X) + (size_t)MP * DM); SEAM(5); }
    if (IN(6)) for (int rep_ = 0; rep_ < NREP(6); ++rep_) {
        pg8::Gemm g{WSP(bf16, WS_H), WSP(bf16, WS_WIN), DM, DM, DM, 0, 0}; pg8::StaticOrder S; S.init(MTOK, INC, F.G, (int)blockIdx.x);
        pg8::EpiWin E{WSP(float, WS_U), WSP(bf16, WS_QKVG), WSP(float, WS_ROT)};
        pg8::gemm_phase<pg8::EpiWin, pg8::StaticOrder, true>(F.lds, g, S, E);
        SEAM(6);
    }
    if (IN(7)) for (int rep_ = 0; rep_ < NREP(7); ++rep_) {
        for (int u = F.vcu; u < NB * NH * NCH * 2; u += F.G) retA_unit(F, u);
        pool_phase(F, A);
        SEAM(7);
    }
    if (IN(8)) for (int rep_ = 0; rep_ < NREP(8); ++rep_) {
        {
            pg8::Gemm g{WSP(bf16, WS_PM), WSP(bf16, WS_WPOOL), PW, HD, HD, HD, 0}; pg8::StaticOrder S; S.init(MTOK, PW, F.G, (int)blockIdx.x);
            pg8::EpiPool E{WSP(bf16, WS_MIX), INP(15)};
            pg8::gemm_phase<pg8::EpiPool, pg8::StaticOrder, true>(F.lds, g, S, E);
        }
        __syncthreads();
        { int t2 = threadIdx.x; asm volatile("" : "+v"(t2)); F.tid = t2; }
        for (int u = F.vcu; u < DB * NH; u += F.G) retS_unit(F, A, u);
        scan_states(F);
        SEAM(8);
    }
    if (IN(9)) for (int rep_ = 0; rep_ < NREP(9); ++rep_) { for (int u = F.vcu; u < NB * NH * NCH; u += F.G) retC_unit(F, u); SEAM(9); }
    if (IN(10)) for (int rep_ = 0; rep_ < NREP(10); ++rep_) {
        pg8::Gemm g{WSP(bf16, WS_MIX), WSP(bf16, WS_WOUT), DM, DM, DM, 0, KP_OUT}; pg8::SplitOrder S; S.init(DM, DM / KP_OUT, F.G, (int)blockIdx.x);
        pg8::EpiResid E{WSP(float, WS_X), WSP(float, WS_X) + (size_t)MP * DM, WSP(float, WS_X), WSP(float, WS_MODS) + 5 * DM, 1.0f};
        pg8::gemm_phase<pg8::EpiResid, pg8::SplitOrder, true>(F.lds, g, S, E);
        SEAM(10);
    }
    if (IN(11)) for (int rep_ = 0; rep_ < NREP(11); ++rep_) { norm_mod(F, WSP(float, WS_X), WSP(float, WS_X) + (size_t)MP * DM, INP(17), 2, WSP(bf16, WS_H), WSP(float, WS_SLAB), DM / KP_OUT, WSP(float, WS_X) + (size_t)MP * DM); SEAM(11); }
    if (IN(12)) for (int rep_ = 0; rep_ < NREP(12); ++rep_) {
        pg8::Gemm g{WSP(bf16, WS_H), WSP(bf16, WS_W2), DM, DM, DM, 0, 0}; pg8::StaticOrder S; S.init(MTOK, 2 * DFF, F.G, (int)blockIdx.x);
        pg8::EpiSwiglu E{WSP(bf16, WS_ACT)};
        pg8::gemm_phase<pg8::EpiSwiglu, pg8::StaticOrder, true>(F.lds, g, S, E);
        SEAM(12);
    }
    if (IN(13)) for (int rep_ = 0; rep_ < NREP(13); ++rep_) {
        pg8::Gemm g{WSP(bf16, WS_ACT), WSP(bf16, WS_W2D), DFF, DFF, DFF, 0, KP_DOWN}; pg8::SplitOrder S; S.init(DM, DFF / KP_DOWN, F.G, (int)blockIdx.x);
        pg8::EpiResid E{WSP(float, WS_X), WSP(float, WS_X) + (size_t)MP * DM, WSP(float, WS_X), WSP(float, WS_MODS) + 8 * DM, 0.5f};
        pg8::gemm_phase<pg8::EpiResid, pg8::SplitOrder, true>(F.lds, g, S, E);
        SEAM(13);
    }
    if (IN(14)) for (int rep_ = 0; rep_ < NREP(14); ++rep_) { final_norm(F, A, WSP(float, WS_SLAB), DFF / KP_DOWN); if (rep_ + 1 < NREP(14)) { SEAM(14); } }
#undef IN
#undef SEAM
}

extern "C" void kernel_launch(void* const* d_in, const int* in_sizes, int n_in, void* d_out, int out_size, void* d_ws, size_t ws_size, hipStream_t stream) {
    static int grid = 0;
    if (grid == 0) {
        if (n_in != 22 || (size_t)out_size != O_END || ws_size < WS_END) { fprintf(stderr, "kernel_launch: unexpected shapes (n_in %d out %d ws %zu)\n", n_in, out_size, ws_size); grid = -1; return; }
        int dev = 0, cus = 0, per_cu = 0;
        if (hipGetDevice(&dev) != hipSuccess || hipDeviceGetAttribute(&cus, hipDeviceAttributeMultiprocessorCount, dev) != hipSuccess) { grid = -1; return; }
        if (hipFuncSetAttribute((const void*)mk_fwd, hipFuncAttributeMaxDynamicSharedMemorySize, LDS_BYTES) != hipSuccess) { fprintf(stderr, "kernel_launch: hipFuncSetAttribute failed\n"); grid = -1; return; }
        if (hipOccupancyMaxActiveBlocksPerMultiprocessor(&per_cu, (const void*)mk_fwd, NWAVES * 64, LDS_BYTES) != hipSuccess || per_cu < 1) { fprintf(stderr, "kernel_launch: occupancy query says %d blocks/CU\n", per_cu); (void)hipGetLastError(); grid = -1; return; }
        grid = cus;
    }
    if (grid < 0) return;
    (void)hipMemsetAsync((char*)d_ws + WS_CTL, 0, CTL_ZERO_BYTES, stream);
    Args a{};
    for (int i = 0; i < 22; ++i) a.in[i] = (const float*)d_in[i];
    a.out = (float*)d_out; a.ws = (unsigned char*)d_ws;
#if MK_PER_PHASE
    for (int p = 0; p < N_PHASES; ++p) { a.ph_lo = p; a.ph_hi = p + 1; hipLaunchKernelGGL(mk_fwd, dim3(grid), dim3(NWAVES * 64), LDS_BYTES, stream, a); }
#else
    a.ph_lo = 0; a.ph_hi = N_PHASES;
    hipLaunchKernelGGL(mk_fwd, dim3(grid), dim3(NWAVES * 64), LDS_BYTES, stream, a);
#ifdef PROBE_LO
    a.ph_lo = PROBE_LO; a.ph_hi = PROBE_HI; a.bar_region = 1;
    hipLaunchKernelGGL(mk_fwd, dim3(grid), dim3(NWAVES * 64), LDS_BYTES, stream, a);
#endif
#endif
}
```

```cpp
#include <hip/hip_runtime.h>
#include <cstdio>
#include <cstdint>
#include <cmath>

#ifndef MK_PER_PHASE
#define MK_PER_PHASE 0
#endif

constexpr int DM = 2048, DFF = 5632, SEQ = 2048, NB = 4, DB = 128, DS = 4;
constexpr int MP = NB * SEQ;
constexpr int MS = DB * DS;
constexpr int MTOK = MP + MS;
constexpr int NMODROW = NB + DB;
constexpr int NMOD = 9 * DM;
constexpr int PW = 1024, RW = 1024, HD = 256, NH = 4, CH = 128, NCH = SEQ / CH;
constexpr int INC = PW + 4 * RW;
constexpr int PAST = 16384;
constexpr float EPS = 1e-6f;
constexpr int NPOS = SEQ + DS;

constexpr size_t O_YP = 0, O_YS = (size_t)MP * DM, O_POOLP = O_YS + (size_t)MS * DM, O_RETP = O_POOLP + (size_t)NB * 15 * PW,
                 O_POOLS = O_RETP + (size_t)NB * NH * HD * HD, O_RETS = O_POOLS + (size_t)DB * 15 * PW, O_END = O_RETS + (size_t)DB * NH * HD * HD;

constexpr size_t SLAB_MINUS_X = (size_t)(568 - 210) << 20;

namespace pg8 {
#define PG8_LAS __attribute__((address_space(3)))
typedef unsigned short bf16_t;
typedef short bf16x8 __attribute__((ext_vector_type(8)));
typedef float f32x4 __attribute__((ext_vector_type(4)));
typedef unsigned u32x4 __attribute__((ext_vector_type(4)));
typedef unsigned u32x2 __attribute__((ext_vector_type(2)));
constexpr int BM = 256, BK = 64, HALF = 128, HTB = HALF * BK * 2  , STAGE_BYTES = 8 * HTB, NXCD = 8, WGM = 8;

__host__ __device__ __forceinline__ int lds_byte(int r, int c) { const int st = (r >> 4) * 2 + (c >> 5), rr = r & 15, cc = c & 31, ob = rr * 64 + cc * 2; return st * 1024 + (ob ^ (((ob >> 9) & 1) << 5)); }
__host__ __device__ __forceinline__ void stage_rc(int b, int& R, int& C) { const int st = b / 1024, sb = b % 1024, swz = sb ^ (((sb >> 9) & 1) << 5); R = (st >> 1) * 16 + swz / 64; C = (st & 1) * 32 + (swz % 64) / 2; }
__host__ __device__ __forceinline__ int perm32(int rho) { const int n = rho >> 4, i = rho & 15; return 8 * (i >> 2) + 4 * n + (i & 3); }

struct Unit { int pm, pn, kp; };
struct Gemm { const bf16_t* A; const bf16_t* Bt; int lda, ldb, K, acol, kpiece; };

struct StaticOrder {
    int nM, nN, nwg, G, c;
    __host__ __device__ __forceinline__ void init(int M, int N, int G_, int c_) { nM = M / BM; nN = N / BM; nwg = nM * nN; G = G_; c = c_; }
    __host__ __device__ __forceinline__ bool next(int i, Unit& u) const {
        const long L = (long)i * G + c; if (L >= nwg) return false;
        int wgid = (int)L; { const int q = nwg / NXCD, r = nwg % NXCD, xcd = wgid % NXCD, off = wgid / NXCD; wgid = (xcd < r ? xcd * (q + 1) : r * (q + 1) + (xcd - r) * q) + off; }
        const int nig = WGM * nN, gid = wgid / nig, fm = gid * WGM, gsz = (nM - fm) < WGM ? (nM - fm) : WGM;
        u.pm = fm + ((wgid % nig) % gsz); u.pn = (wgid % nig) / gsz; u.kp = -1; return true;
    }
    __device__ __forceinline__ void a_ready(const Unit&) const {}
    __device__ __forceinline__ void done(const Unit&) const {}
};

struct SplitOrder {
    int nN, nfull, np, G, c;
    __host__ __device__ __forceinline__ void init(int N, int np_, int G_, int c_) { nN = N / BM; nfull = (MP / BM) * nN; np = np_; G = G_; c = c_; }
    __host__ __device__ __forceinline__ bool next(int i, Unit& u) const {
        const int L = i * G + c;
        int pm, pn, kp; bool ok = true;
        if (L < nfull) {
            int wgid = L; { const int q = nfull / NXCD, xcd = wgid % NXCD, off = wgid / NXCD; wgid = xcd * q + off; }
            const int nig = WGM * nN, gid = wgid / nig, fm = gid * WGM;
            pm = fm + ((wgid % nig) % WGM); pn = (wgid % nig) / WGM; kp = -1;
        } else {
            const int j = L - nfull; ok = j < 2 * nN * np;
            const int t = j / np; kp = j - t * np; pm = MP / BM + t / nN; pn = t % nN;
        }
        u.pm = pm; u.pn = pn; u.kp = kp; return ok;
    }
    __device__ __forceinline__ void a_ready(const Unit&) const {}
    __device__ __forceinline__ void done(const Unit&) const {}
};

__device__ __forceinline__ unsigned cvt_pk_bf16(float lo, float hi) { unsigned r; asm volatile("v_cvt_pk_bf16_f32 %0, %1, %2" : "=v"(r) : "v"(lo), "v"(hi)); return r; }
__device__ __forceinline__ float silu_f(float x) { return x * __builtin_amdgcn_rcpf(1.0f + __builtin_amdgcn_exp2f(-1.4426950408889634f * x)); }
__device__ __forceinline__ int modrow_of(int row) { return row < MP ? (row >> 11) : NB + ((row - MP) >> 2); }
__device__ __forceinline__ int ptab_of(int row) { return row < MP ? (row & (SEQ - 1)) : SEQ + ((row - MP) & 3); }

struct EpiSwiglu {
    static constexpr bool PERM = true, AFTER_DRAIN = false;
    bf16_t* O;
    __device__ __forceinline__ void operator()(const f32x4 (&acc)[2][2][4][2], const Unit& u, int wr, int wc, int fr, int fq) const {
        const int row0 = u.pm * BM + wr * 64 + fr, col0 = u.pn * HALF + wc * 32 + 8 * fq;
#pragma unroll
        for (int ai = 0; ai < 2; ++ai)
#pragma unroll
            for (int m = 0; m < 4; ++m) {
                bf16_t* rowp = O + (size_t)(row0 + ai * HALF + m * 16) * DFF + col0;
                const f32x4 g0 = acc[ai][0][m][0], g1 = acc[ai][0][m][1], u0 = acc[ai][1][m][0], u1 = acc[ai][1][m][1];
                u32x4 w;
                w.x = cvt_pk_bf16(silu_f(g0[0]) * u0[0], silu_f(g0[1]) * u0[1]); w.y = cvt_pk_bf16(silu_f(g0[2]) * u0[2], silu_f(g0[3]) * u0[3]);
                w.z = cvt_pk_bf16(silu_f(g1[0]) * u1[0], silu_f(g1[1]) * u1[1]); w.w = cvt_pk_bf16(silu_f(g1[2]) * u1[2], silu_f(g1[3]) * u1[3]);
                *(u32x4*)rowp = w;
            }
    }
};
struct EpiResid {
    static constexpr bool PERM = false, AFTER_DRAIN = false;
    const float* baseP; const float* baseS; float* out; const float* gate; float coef;
    __device__ __forceinline__ void operator()(const f32x4 (&acc)[2][2][4][2], const Unit& u, int wr, int wc, int fr, int fq) const {
        const int row0 = u.pm * BM + wr * 64 + fr, col0 = u.pn * BM + wc * 32 + 4 * fq;
        if (u.kp < 0) {
#pragma unroll
            for (int ai = 0; ai < 2; ++ai)
#pragma unroll
                for (int m = 0; m < 4; ++m) {
                    const int row = row0 + ai * HALF + m * 16;
                    const float* bp = (row < MP ? baseP + (size_t)row * DM : baseS + (size_t)(row - MP) * DM) + col0;
                    const float* gp = gate + (size_t)modrow_of(row) * NMOD + col0;
                    float* op = out + (size_t)row * DM + col0;
#pragma unroll
                    for (int bj = 0; bj < 2; ++bj)
#pragma unroll
                        for (int n = 0; n < 2; ++n) {
                            const f32x4 bs = *(const f32x4*)(bp + bj * HALF + n * 16), gt = *(const f32x4*)(gp + bj * HALF + n * 16);
                            *(f32x4*)(op + bj * HALF + n * 16) = bs + (gt * coef) * acc[ai][bj][m][n];
                        }
                    if (m & 1) asm volatile("" ::: "memory");
                }
        } else {
#pragma unroll
            for (int ai = 0; ai < 2; ++ai)
#pragma unroll
                for (int m = 0; m < 4; ++m) {
                    const int row = row0 + ai * HALF + m * 16;
                    const float* gp = gate + (size_t)modrow_of(row) * NMOD + col0;
                    float* op = (float*)((char*)out + SLAB_MINUS_X) + ((size_t)u.kp * MS + (row - MP)) * DM + col0;
#pragma unroll
                    for (int bj = 0; bj < 2; ++bj)
#pragma unroll
                        for (int n = 0; n < 2; ++n) {
                            const f32x4 gt = *(const f32x4*)(gp + bj * HALF + n * 16);
                            *(f32x4*)(op + bj * HALF + n * 16) = (gt * coef) * acc[ai][bj][m][n];
                        }
                    if (m & 1) asm volatile("" ::: "memory");
                }
        }
    }
};
struct EpiWin {
    static constexpr bool PERM = true, AFTER_DRAIN = false;
    float* U; bf16_t* QKVG; const float* rot;
    __device__ __forceinline__ void operator()(const f32x4 (&acc)[2][2][4][2], const Unit& u, int wr, int wc, int fr, int fq) const {
        const int row0 = u.pm * BM + wr * 64 + fr, cw = wc * 32 + 8 * fq;
        if (u.pn < 4) {
#pragma unroll
            for (int ai = 0; ai < 2; ++ai)
#pragma unroll
                for (int m = 0; m < 4; ++m) {
                    float* rowp = U + (size_t)(row0 + ai * HALF + m * 16) * PW + u.pn * BM + cw;
#pragma unroll
                    for (int bj = 0; bj < 2; ++bj)
#pragma unroll
                        for (int n = 0; n < 2; ++n) *(f32x4*)(rowp + bj * HALF + 4 * n) = acc[ai][bj][m][n];
                }
        } else {
            const int t = (u.pn - 4) >> 2, hd = (u.pn - 4) & 3;
            bf16_t* dst = QKVG + (size_t)t * MTOK * RW + hd * HD + cw;
            if (t < 2) {
                const float sc = (t == 1) ? 0.0625f : 1.0f;
#pragma unroll
                for (int ai = 0; ai < 2; ++ai)
#pragma unroll
                    for (int m = 0; m < 4; ++m) {
                        const int row = row0 + ai * HALF + m * 16;
                        const float* rp = rot + ((size_t)ptab_of(row) * 128 + cw) * 2;
                        u32x4 w1, w2;
#pragma unroll
                        for (int n = 0; n < 2; ++n) {
                            const f32x4 cs0 = *(const f32x4*)(rp + 8 * n), cs1 = *(const f32x4*)(rp + 8 * n + 4);
                            const f32x4 x1 = acc[ai][0][m][n] * sc, x2 = acc[ai][1][m][n] * sc;
                            const float a0 = x1[0] * cs0[0] - x2[0] * cs0[1], b0 = x2[0] * cs0[0] + x1[0] * cs0[1];
                            const float a1 = x1[1] * cs0[2] - x2[1] * cs0[3], b1 = x2[1] * cs0[2] + x1[1] * cs0[3];
                            const float a2 = x1[2] * cs1[0] - x2[2] * cs1[1], b2 = x2[2] * cs1[0] + x1[2] * cs1[1];
                            const float a3 = x1[3] * cs1[2] - x2[3] * cs1[3], b3 = x2[3] * cs1[2] + x1[3] * cs1[3];
                            if (n == 0) { w1.x = cvt_pk_bf16(a0, a1); w1.y = cvt_pk_bf16(a2, a3); w2.x = cvt_pk_bf16(b0, b1); w2.y = cvt_pk_bf16(b2, b3); }
                            else        { w1.z = cvt_pk_bf16(a0, a1); w1.w = cvt_pk_bf16(a2, a3); w2.z = cvt_pk_bf16(b0, b1); w2.w = cvt_pk_bf16(b2, b3); }
                        }
                        bf16_t* rowp = dst + (size_t)row * RW;
                        *(u32x4*)rowp = w1; *(u32x4*)(rowp + HALF) = w2;
                    }
            } else {
#pragma unroll
                for (int ai = 0; ai < 2; ++ai)
#pragma unroll
                    for (int m = 0; m < 4; ++m) {
                        bf16_t* rowp = dst + (size_t)(row0 + ai * HALF + m * 16) * RW;
#pragma unroll
                        for (int bj = 0; bj < 2; ++bj) { const f32x4 v0 = acc[ai][bj][m][0], v1 = acc[ai][bj][m][1]; u32x4 w;
                            w.x = cvt_pk_bf16(v0[0], v0[1]); w.y = cvt_pk_bf16(v0[2], v0[3]); w.z = cvt_pk_bf16(v1[0], v1[1]); w.w = cvt_pk_bf16(v1[2], v1[3]);
                            *(u32x4*)(rowp + bj * HALF) = w; }
                    }
            }
        }
    }
};
struct EpiPool {
    static constexpr bool PERM = true, AFTER_DRAIN = false;
    bf16_t* MIX; const float* pscale;
    __device__ __forceinline__ void operator()(const f32x4 (&acc)[2][2][4][2], const Unit& u, int wr, int wc, int fr, int fq) const {
        const int row0 = u.pm * BM + wr * 64 + fr, col0 = u.pn * BM + wc * 32 + 8 * fq;
#pragma unroll
        for (int ai = 0; ai < 2; ++ai)
#pragma unroll
            for (int m = 0; m < 4; ++m) {
                bf16_t* rowp = MIX + (size_t)(row0 + ai * HALF + m * 16) * DM + col0;
#pragma unroll
                for (int bj = 0; bj < 2; ++bj) { const f32x4 v0 = acc[ai][bj][m][0] * *(const f32x4*)(pscale + col0 + bj * HALF), v1 = acc[ai][bj][m][1] * *(const f32x4*)(pscale + col0 + bj * HALF + 4); u32x4 w;
                    w.x = cvt_pk_bf16(v0[0], v0[1]); w.y = cvt_pk_bf16(v0[2], v0[3]); w.z = cvt_pk_bf16(v1[0], v1[1]); w.w = cvt_pk_bf16(v1[2], v1[3]);
                    *(u32x4*)(rowp + bj * HALF) = w; }
            }
    }
};

template <class Epi, class Sched, bool ALIGN_EPI = false>
__device__ __forceinline__ void gemm_phase(PG8_LAS unsigned char* lds, const Gemm g, const Sched& S, const Epi& E) {
    const int tid = threadIdx.x, wid = __builtin_amdgcn_readfirstlane(tid >> 6), lane = tid & 63, wr = wid >> 2, wc = wid & 3, fr = lane & 15, fq = lane >> 4;
    unsigned voffA[2], voffB[2];
#pragma unroll
    for (int i = 0; i < 2; ++i) { int R, C; stage_rc(tid * 16 + i * 8192, R, C); const int Rb = Epi::PERM ? ((R & ~31) + perm32(R & 31)) : R;
        voffA[i] = (unsigned)(R * g.lda + C) * 2u; voffB[i] = (unsigned)(Rb * g.ldb + C) * 2u; }
    const size_t kstep = (size_t)(BK * 2);
    const size_t hstepA = (size_t)HALF * g.lda * 2, hstepB = (size_t)HALF * g.ldb * 2;
    const size_t tstepA = 2 * hstepA, tstepB = 2 * hstepB;
    const size_t astep = (size_t)g.acol * 2;
    const unsigned ldsw = (unsigned)wid * 1024u;
    const int aoff = lds_byte(wr * 64 + fr, fq * 8), boff = lds_byte(wc * 32 + fr, fq * 8);
#define PG8_SA(b, h) (((b) * 2 + (h)) * HTB)
#define PG8_SB(b, h) ((4 + (b) * 2 + (h)) * HTB)
#define PG8_STAGE(bufoff, gbase, voff) do { _Pragma("unroll") for (int _i = 0; _i < 2; ++_i) \
        __builtin_amdgcn_global_load_lds((const unsigned*)((const char*)(gbase) + (voff)[_i]), (PG8_LAS unsigned*)(lds + (bufoff) + ldsw + _i * 8192), 16, 0, 0); } while (0)
#define PG8_LDA(dst, b, h) do { _Pragma("unroll") for (int m = 0; m < 4; ++m) _Pragma("unroll") for (int k = 0; k < 2; ++k) dst[m][k] = *(const PG8_LAS bf16x8*)(lds + PG8_SA(b, h) + aoff + m * 2048 + k * 1024); } while (0)
#define PG8_LDB(dst, b, h) do { _Pragma("unroll") for (int n = 0; n < 2; ++n) _Pragma("unroll") for (int k = 0; k < 2; ++k) dst[n][k] = *(const PG8_LAS bf16x8*)(lds + PG8_SB(b, h) + boff + n * 2048 + k * 1024); } while (0)
#define PG8_MMA(ai, bj, At, Bt) do { __builtin_amdgcn_s_setprio(1); _Pragma("unroll") for (int m = 0; m < 4; ++m) _Pragma("unroll") for (int n = 0; n < 2; ++n) _Pragma("unroll") for (int k = 0; k < 2; ++k) \
        acc[ai][bj][m][n] = __builtin_amdgcn_mfma_f32_16x16x32_bf16(Bt[n][k], At[m][k], acc[ai][bj][m][n], 0, 0, 0); __builtin_amdgcn_s_setprio(0); } while (0)
#define PG8_WAIT_V(n) asm volatile("s_waitcnt vmcnt(" #n ")" ::: "memory")
#define PG8_WAIT_L(n) asm volatile("s_waitcnt lgkmcnt(" #n ")" ::: "memory")
#define PG8_BAR __builtin_amdgcn_s_barrier()
#define PG8_SCHED __builtin_amdgcn_sched_barrier(0)
    Unit cur, nxt; int ui = 0;
    if (!S.next(0, cur)) return;
    f32x4 acc[2][2][4][2];
#pragma unroll
    for (int a = 0; a < 2; ++a)
#pragma unroll
        for (int b = 0; b < 2; ++b)
#pragma unroll
            for (int m = 0; m < 4; ++m)
#pragma unroll
                for (int n = 0; n < 2; ++n) acc[a][b][m][n] = (f32x4){0.f, 0.f, 0.f, 0.f};
    bf16x8 At[4][2], B0[2][2], B1[2][2];
    const char* cA = (const char*)g.A + (size_t)cur.pm * tstepA + (size_t)cur.pn * astep + (cur.kp > 0 ? (size_t)cur.kp * g.kpiece * 2 : 0); const char* cB = (const char*)g.Bt + (size_t)cur.pn * tstepB + (cur.kp > 0 ? (size_t)cur.kp * g.kpiece * 2 : 0);
    S.a_ready(cur);
    PG8_STAGE(PG8_SB(0, 0), cB, voffB); PG8_STAGE(PG8_SB(0, 1), cB + hstepB, voffB); PG8_STAGE(PG8_SA(0, 0), cA, voffA); PG8_STAGE(PG8_SA(0, 1), cA + hstepA, voffA);
    if (wr == 1) PG8_BAR;
    PG8_WAIT_V(2); PG8_BAR;
    PG8_STAGE(PG8_SB(1, 0), cB + kstep, voffB); PG8_STAGE(PG8_SA(1, 0), cA + kstep, voffA); PG8_STAGE(PG8_SB(1, 1), cB + hstepB + kstep, voffB);
    PG8_WAIT_V(6); PG8_BAR;
    for (;;) {
        const bool has_next = S.next(ui + 1, nxt);
        const size_t nko = (has_next && nxt.kp > 0) ? (size_t)nxt.kp * g.kpiece * 2 : 0;
        const char* nA = has_next ? (const char*)g.A + (size_t)nxt.pm * tstepA + (size_t)nxt.pn * astep + nko : cA; const char* nB = has_next ? (const char*)g.Bt + (size_t)nxt.pn * tstepB + nko : cB;
        const int nt = (cur.kp < 0 ? g.K : g.kpiece) / BK;
        for (int t = 0; t < nt; t += 2) {
            const bool last = (t == nt - 2);
            const char* a1 = cA + (size_t)(t + 1) * kstep;
            const char* a2 = last ? nA : cA + (size_t)(t + 2) * kstep; const char* b2 = last ? nB : cB + (size_t)(t + 2) * kstep;
            const char* a3 = a2 + kstep; const char* b3 = b2 + kstep;
            if (last && has_next) S.a_ready(nxt);
            PG8_LDB(B0, 0, 0); PG8_LDB(B1, 0, 1); PG8_SCHED; PG8_LDA(At, 0, 0); PG8_STAGE(PG8_SA(1, 1), a1 + hstepA, voffA);
            PG8_WAIT_V(8); PG8_WAIT_L(0); PG8_BAR; PG8_MMA(0, 0, At, B0); PG8_MMA(0, 1, At, B1); PG8_BAR; PG8_SCHED;
            PG8_LDA(At, 0, 1); PG8_STAGE(PG8_SB(0, 0), b2, voffB); PG8_STAGE(PG8_SB(0, 1), b2 + hstepB, voffB); PG8_STAGE(PG8_SA(0, 0), a2, voffA);
            PG8_WAIT_V(8); PG8_WAIT_L(0); PG8_BAR; PG8_MMA(1, 0, At, B0); PG8_MMA(1, 1, At, B1); PG8_BAR; PG8_SCHED;
            PG8_LDB(B0, 1, 0); PG8_LDB(B1, 1, 1); PG8_SCHED; PG8_LDA(At, 1, 0); PG8_STAGE(PG8_SA(0, 1), a2 + hstepA, voffA);
            PG8_WAIT_V(8); PG8_WAIT_L(0); PG8_BAR; PG8_MMA(0, 0, At, B0); PG8_MMA(0, 1, At, B1); PG8_BAR; PG8_SCHED;
            PG8_LDA(At, 1, 1); PG8_STAGE(PG8_SB(1, 0), b3, voffB); PG8_STAGE(PG8_SB(1, 1), b3 + hstepB, voffB); PG8_STAGE(PG8_SA(1, 0), a3, voffA);
            PG8_WAIT_V(8); PG8_WAIT_L(0); PG8_BAR; PG8_MMA(1, 0, At, B0); PG8_MMA(1, 1, At, B1); PG8_BAR; PG8_SCHED;
        }
        if constexpr (ALIGN_EPI) { if (wr == 0) PG8_BAR; }
        E(acc, cur, wr, wc, fr, fq); S.done(cur);
        if (!has_next) break;
#pragma unroll
        for (int a = 0; a < 2; ++a)
#pragma unroll
            for (int b = 0; b < 2; ++b)
#pragma unroll
                for (int m = 0; m < 4; ++m)
#pragma unroll
                    for (int n = 0; n < 2; ++n) acc[a][b][m][n] = (f32x4){0.f, 0.f, 0.f, 0.f};
        cur = nxt; cA = nA; cB = nB; ++ui;
        if constexpr (ALIGN_EPI) { if (wr == 1) PG8_BAR; }
    }
    PG8_WAIT_V(0);
    if constexpr (!ALIGN_EPI) { if (wr == 0) PG8_BAR; }
    PG8_BAR;
#undef PG8_SA
#undef PG8_SB
#undef PG8_STAGE
#undef PG8_LDA
#undef PG8_LDB
#undef PG8_MMA
#undef PG8_WAIT_V
#undef PG8_WAIT_L
#undef PG8_BAR
#undef PG8_SCHED
}
}

constexpr int NWAVES = 8;
constexpr int N_PHASES = 15;
constexpr size_t MiB = 1u << 20;
constexpr size_t WS_CTL = 0, CTL_ZERO_BYTES = 64 * 1024;
constexpr size_t WS_SC = 1 * MiB;
constexpr size_t WS_ROT = 2 * MiB;
constexpr size_t WS_MODS = 5 * MiB;
constexpr size_t WS_WPOOL = 15 * MiB;
constexpr size_t WS_WOUT = 16 * MiB;
constexpr size_t WS_WIN = 24 * MiB;
constexpr size_t WS_W1 = 44 * MiB;
constexpr size_t WS_W1D = 88 * MiB;
constexpr size_t WS_W2 = 110 * MiB;
constexpr size_t WS_W2D = 154 * MiB;
constexpr size_t WS_H = 176 * MiB;
constexpr size_t WS_X = 210 * MiB;
constexpr size_t WS_ACT = 278 * MiB;
constexpr size_t WS_QKVG = WS_ACT;
constexpr size_t WS_PM = WS_ACT + 68 * MiB;
constexpr size_t WS_U = 372 * MiB;
constexpr size_t WS_MIX = 406 * MiB;
constexpr size_t WS_UT = 440 * MiB;
constexpr size_t WS_OI = 504 * MiB;
constexpr size_t WS_ST = 536 * MiB;
constexpr size_t WS_SLAB = 568 * MiB;
constexpr size_t WS_END = 612 * MiB;
static_assert(WS_SLAB - WS_X == SLAB_MINUS_X, "slab offset");
constexpr int KP_DOWN = 512, KP_OUT = 256;
static_assert(WS_SC + 160 * 2048 * 2 <= WS_ROT && WS_ROT + (size_t)NPOS * 128 * 8 <= WS_MODS && WS_MODS + (size_t)NMODROW * NMOD * 4 <= WS_WPOOL, "ws map 1");
static_assert(WS_W1 + (size_t)2 * DFF * DM * 2 <= WS_W1D && WS_W1D + (size_t)DM * DFF * 2 <= WS_W2 && WS_W2D + (size_t)DM * DFF * 2 <= WS_H, "ws map 2");
static_assert(WS_H + (size_t)MTOK * DM * 2 <= WS_X && WS_X + (size_t)MTOK * DM * 4 <= WS_ACT && WS_ACT + (size_t)MTOK * DFF * 2 <= WS_U, "ws map 3");
static_assert(WS_PM + (size_t)MTOK * PW * 2 <= WS_U && WS_U + (size_t)MTOK * PW * 4 <= WS_MIX && WS_MIX + (size_t)MTOK * DM * 2 <= WS_UT, "ws map 4");
constexpr int CW_BAR = 1024;

constexpr int RING_BYTES = 131072;
constexpr int LDSCTL_OFF = RING_BYTES, MISC_OFF = LDSCTL_OFF + 320;
constexpr int LDS_BYTES = 147456;

#define GAS __attribute__((address_space(1)))
#define LAS __attribute__((address_space(3)))
typedef unsigned short bf16;
typedef unsigned v4u __attribute__((ext_vector_type(4)));
typedef unsigned v2u __attribute__((ext_vector_type(2)));
typedef float f32x4 __attribute__((ext_vector_type(4)));
typedef float f32x16 __attribute__((ext_vector_type(16)));
typedef short bf16x8 __attribute__((ext_vector_type(8)));
typedef short bf16x4 __attribute__((ext_vector_type(4)));
typedef GAS unsigned gu32;
#define RLX_AGENT __ATOMIC_RELAXED, __HIP_MEMORY_SCOPE_AGENT
#define LDS_WAIT() asm volatile("s_waitcnt lgkmcnt(0)" ::: "memory")
#define VM_WAIT() asm volatile("s_waitcnt vmcnt(0)" ::: "memory")
__device__ __forceinline__ unsigned f2bf(float f) { unsigned u = __builtin_bit_cast(unsigned, f); return (u + 0x7fffu + ((u >> 16) & 1u)) >> 16; }
__device__ __forceinline__ unsigned pk2(float lo, float hi) { return f2bf(lo) | (f2bf(hi) << 16); }
__device__ __forceinline__ float bf2f(unsigned short v) { return __builtin_bit_cast(float, (unsigned)v << 16); }
__device__ __forceinline__ float silu1(float x) { return x / (1.0f + __expf(-x)); }

#define XB_TMO      128
#define XB_XCNT(j)  (256  + 64 * (j))
#define XB_XSUB(j)  (1280 + 64 * (j))
#define XB_XGEN(j)  (2304 + 64 * (j))
#define XB_TOP      3328
#define XB_TOPGEN   3392
#define XCD_BAR_WORDS 3456
#define XB_SPIN_CAP (1u << 20)
static_assert((CW_BAR + 2 * XCD_BAR_WORDS) * 4 <= (int)CTL_ZERO_BYTES, "barrier words inside the memset region");

__device__ __forceinline__ unsigned xb_ld(unsigned* p)              { return __hip_atomic_load(p, __ATOMIC_RELAXED, __HIP_MEMORY_SCOPE_AGENT); }
__device__ __forceinline__ unsigned xb_add(unsigned* p, unsigned v) { return __hip_atomic_fetch_add(p, v, __ATOMIC_RELAXED, __HIP_MEMORY_SCOPE_AGENT); }
__device__ __forceinline__ unsigned xb_xcc_id() { return (unsigned)__builtin_amdgcn_s_getreg((3 << 11) | 20) & 0xFu; }
#define XB_SPIN(cond, bar) do { unsigned _sp = 0; while (cond) { __builtin_amdgcn_s_sleep(1); \
    if ((++_sp & 255u) == 0u) { if (xb_ld(&(bar)[XB_TMO])) break; if (_sp > XB_SPIN_CAP) { atomicAdd(&(bar)[XB_TMO], 1u); break; } } } } while (0)

struct XcdBarrier { unsigned* bar; unsigned x; volatile LAS unsigned* st; };
__device__ __forceinline__ XcdBarrier xcd_barrier_post(unsigned* bar, volatile LAS unsigned* st) {
    XcdBarrier b; b.bar = bar; b.x = xb_xcc_id(); b.st = st;
    if (threadIdx.x == 0) (void)xb_add(&bar[XB_XCNT(b.x)], 1u);
    return b;
}
__device__ __forceinline__ void xcd_barrier_complete(unsigned* bar, unsigned x, unsigned& nloc, unsigned& nx) {
    const unsigned G = gridDim.x * gridDim.y * gridDim.z;
    unsigned sum, cnt, mine, sp = 0u;
    for (;;) {
        sum = 0u; cnt = 0u; mine = 0u;
#pragma unroll
        for (unsigned j = 0; j < 16; ++j) { const unsigned c = xb_ld(&bar[XB_XCNT(j)]); sum += c; cnt += (c > 0u) ? 1u : 0u; mine = (j == x) ? c : mine; }
        if (sum == G) break;
        __builtin_amdgcn_s_sleep(1);
        if ((++sp & 255u) == 0u) { if (xb_ld(&bar[XB_TMO])) break; if (sp > XB_SPIN_CAP) { atomicAdd(&bar[XB_TMO], 1u); break; } }
    }
    nloc = mine > 0u ? mine : 1u; nx = cnt > 0u ? cnt : 1u;
}
__device__ __forceinline__ void xcd_barrier(const XcdBarrier& b) {
    asm volatile("s_waitcnt vmcnt(0)" ::: "memory");
    __syncthreads();
    if (threadIdx.x == 0) {
        unsigned* bar = b.bar;
        __builtin_amdgcn_s_waitcnt(0);
        unsigned nloc = b.st[0], nx = b.st[1];
        if (nloc == 0u) { xcd_barrier_complete(bar, b.x, nloc, nx); b.st[0] = nloc; b.st[1] = nx; }
        const unsigned old = xb_add(&bar[XB_XSUB(b.x)], 1u);
        const unsigned gen = old / nloc;
        if (old + 1u == (gen + 1u) * nloc) {
            __builtin_amdgcn_fence(__ATOMIC_RELEASE, "agent");
            asm volatile("s_waitcnt vmcnt(0)" ::: "memory");
            const unsigned og = xb_add(&bar[XB_TOP], 1u);
            const unsigned tg = og / nx;
            if (og + 1u == (tg + 1u) * nx) xb_add(&bar[XB_TOPGEN], 1u);
            else XB_SPIN(xb_ld(&bar[XB_TOPGEN]) == tg, bar);
            __builtin_amdgcn_fence(__ATOMIC_ACQUIRE, "agent");
            xb_add(&bar[XB_XGEN(b.x)], 1u);
            asm volatile("s_waitcnt vmcnt(0)" ::: "memory");
        } else {
            XB_SPIN(xb_ld(&bar[XB_XGEN(b.x)]) == gen, bar);
            __builtin_amdgcn_fence(__ATOMIC_ACQUIRE, "agent");
            asm volatile("s_waitcnt vmcnt(0)" ::: "memory");
        }
    }
    __syncthreads();
}

struct Args { const float* in[22]; float* out; unsigned char* ws; int ph_lo, ph_hi, bar_region, pad; };
static_assert(sizeof(Args) == 22 * 8 + 8 + 8 + 16, "Args has no padding");
#define INP(i) (A.in[i])
struct Frame {
    LAS unsigned char* lds;
    volatile LAS unsigned* MISC;
    int tid, lane, wave;
    int vcu, G;
    unsigned char* ws;
    float* out;
};
#define WSP(T, off) ((T*)(F.ws + (off)))
__device__ __forceinline__ int lane_of(const Frame& F) { int l = F.tid & 63; asm volatile("" : "+v"(l)); return l; }

__device__ __forceinline__ float wave_sum(float v) {
#pragma unroll
    for (int o = 1; o < 64; o <<= 1) v += __shfl_xor(v, o);
    return v;
}

__device__ __forceinline__ void p0_transpose_item(const float* W, int N, bf16* WT, int ldk, int dst_row0, int k0, int n0, LAS float* scr, int lane) {
    f32x4 t[8];
#pragma unroll
    for (int i = 0; i < 8; ++i) t[i] = *(const f32x4*)(W + (size_t)(k0 + 8 * i + (lane >> 3)) * N + n0 + 4 * (lane & 7));
#pragma unroll
    for (int i = 0; i < 8; ++i) { LAS float* d = scr + (8 * i + (lane >> 3)) * 33 + 4 * (lane & 7); d[0] = t[i][0]; d[1] = t[i][1]; d[2] = t[i][2]; d[3] = t[i][3]; }
    LDS_WAIT(); asm volatile("" ::: "memory");
    const int c = lane & 7;
#pragma unroll
    for (int j = 0; j < 4; ++j) { const int n = (lane >> 3) + 8 * j; const LAS float* s = scr + (8 * c) * 33 + n;
        v4u o; o.x = pk2(s[0 * 33], s[1 * 33]); o.y = pk2(s[2 * 33], s[3 * 33]); o.z = pk2(s[4 * 33], s[5 * 33]); o.w = pk2(s[6 * 33], s[7 * 33]);
        *(GAS v4u*)(WT + (size_t)(dst_row0 + n) * ldk + k0 + 8 * c) = o; }
    LDS_WAIT(); asm volatile("" ::: "memory");
}
__device__ __forceinline__ void p0_matrix_item(const float* W, int K, int N, bf16* WT, int mode, int item, LAS float* scr, int lane) {
    const int nblk = N / 32, kb = item / nblk, nb = item % nblk, k0 = 64 * kb, n0 = 32 * nb;
    const int dst = (mode == 0) ? n0 : (256 * (n0 >> 7) + (n0 & 127) + (mode == 2 ? 128 : 0));
    p0_transpose_item(W, N, WT, K, dst, k0, n0, scr, lane);
}
__device__ __forceinline__ void p0_prologue(Frame& F, const Args& A) {
    const int flane = lane_of(F);
    LAS float* scr = (LAS float*)(F.lds + F.wave * 16384);
    const int gw = F.vcu * NWAVES + F.wave, NGW = F.G * NWAVES;
    constexpr int I_F = (DM / 64) * (DFF / 32), I_D = (DFF / 64) * (DM / 32), I_IN = (DM / 64) * (INC / 32), I_OUT = (DM / 64) * (DM / 32), I_P = (HD / 64) * (HD / 32);
    constexpr int NITEMS = 4 * I_F + 2 * I_D + I_IN + I_OUT + 4 * I_P;
    for (int it = gw; it < NITEMS; it += NGW) {
        int r = it;
        if (r < I_F) { p0_matrix_item(INP(9), DM, DFF, WSP(bf16, WS_W1), 1, r, scr, flane); continue; } r -= I_F;
        if (r < I_F) { p0_matrix_item(INP(10), DM, DFF, WSP(bf16, WS_W1), 2, r, scr, flane); continue; } r -= I_F;
        if (r < I_D) { p0_matrix_item(INP(11), DFF, DM, WSP(bf16, WS_W1D), 0, r, scr, flane); continue; } r -= I_D;
        if (r < I_IN) { p0_matrix_item(INP(13), DM, INC, WSP(bf16, WS_WIN), 0, r, scr, flane); continue; } r -= I_IN;
        if (r < I_OUT) { p0_matrix_item(INP(16), DM, DM, WSP(bf16, WS_WOUT), 0, r, scr, flane); continue; } r -= I_OUT;
        if (r < 4 * I_P) { const int g = r / I_P; p0_matrix_item(INP(14) + (size_t)g * HD * HD, HD, HD, WSP(bf16, WS_WPOOL) + (size_t)g * HD * HD, 0, r % I_P, scr, flane); continue; } r -= 4 * I_P;
        if (r < I_F) { p0_matrix_item(INP(18), DM, DFF, WSP(bf16, WS_W2), 1, r, scr, flane); continue; } r -= I_F;
        if (r < I_F) { p0_matrix_item(INP(19), DM, DFF, WSP(bf16, WS_W2), 2, r, scr, flane); continue; } r -= I_F;
        p0_matrix_item(INP(20), DFF, DM, WSP(bf16, WS_W2D), 0, r, scr, flane);
    }
    const int gt = F.vcu * (NWAVES * 64) + F.tid, NT = F.G * NWAVES * 64;
    for (int i = gt; i < 160 * DM / 4; i += NT) {
        const int m = (4 * i) / DM, k = (4 * i) % DM;
        f32x4 v = (f32x4){0.f, 0.f, 0.f, 0.f};
        if (m < NB) v = *(const f32x4*)(INP(2) + (size_t)m * DM + k); else if (m < NMODROW) v = *(const f32x4*)(INP(3) + (size_t)(m - NB) * DM + k);
        v2u o; o.x = pk2(silu1(v[0]), silu1(v[1])); o.y = pk2(silu1(v[2]), silu1(v[3]));
        *(GAS v2u*)(WSP(bf16, WS_SC) + ((size_t)(((k >> 4) * 5 + (m >> 5)) * 64 + ((k >> 3) & 1) * 32 + (m & 31)) * 8 + (k & 7))) = o;
    }
    for (int i = gt; i < NPOS * 128; i += NT) {
        const int p = i >> 7, fi = i & 127;
        const float pos = (float)(p < SEQ ? p : PAST + (p - SEQ));
        const float inv = (float)exp(-(double)fi * (9.210340371976184 / 128.0));
        const float ang = pos * inv;
        double s, c; sincos((double)ang, &s, &c);
        WSP(float, WS_ROT)[2 * (size_t)i] = (float)c; WSP(float, WS_ROT)[2 * (size_t)i + 1] = (float)s;
    }
}

__device__ __forceinline__ void p1_adaln(Frame& F, const Args& A) {
    const int flane = lane_of(F);
    LAS float* red = (LAS float*)F.lds;
    const int lane = flane, w = F.wave, r = lane & 31, hh = lane >> 5, sl = w & 3, kh = w >> 2;
    for (int u = F.vcu; u < NMOD / 128; u += F.G) {
        const int n0 = (4 * u + sl) * 32;
        f32x16 acc[5];
#pragma unroll
        for (int t = 0; t < 5; ++t)
#pragma unroll
            for (int i = 0; i < 16; ++i) acc[t][i] = 0.f;
        const float* Wp = INP(6) + (size_t)(1024 * kh + 8 * hh) * NMOD + n0 + r;
        const bf16* Sp = WSP(bf16, WS_SC) + ((size_t)(64 * kh) * 5 * 64 + lane) * 8;
#pragma unroll 4
        for (int s = 0; s < 64; ++s) {
            float wv[8];
#pragma unroll
            for (int j = 0; j < 8; ++j) wv[j] = Wp[(size_t)(16 * s + j) * NMOD];
            v4u au; au.x = pk2(wv[0], wv[1]); au.y = pk2(wv[2], wv[3]); au.z = pk2(wv[4], wv[5]); au.w = pk2(wv[6], wv[7]);
            const bf16x8 a = __builtin_bit_cast(bf16x8, au);
#pragma unroll
            for (int t = 0; t < 5; ++t) {
                const bf16x8 b = *(const bf16x8*)(Sp + (size_t)((s * 5 + t) * 64) * 8);
                acc[t] = __builtin_amdgcn_mfma_f32_32x32x16_bf16(a, b, acc[t], 0, 0, 0);
            }
        }
        LAS float* rs = red + sl * (160 * 33);
        if (kh == 1) {
#pragma unroll
            for (int t = 0; t < 5; ++t)
#pragma unroll
                for (int i = 0; i < 16; ++i) rs[(32 * t + r) * 33 + (i & 3) + 8 * (i >> 2) + 4 * hh] = acc[t][i];
        }
        __syncthreads();
        if (kh == 0) {
#pragma unroll
            for (int t = 0; t < 5; ++t)
#pragma unroll
                for (int i = 0; i < 16; ++i) rs[(32 * t + r) * 33 + (i & 3) + 8 * (i >> 2) + 4 * hh] += acc[t][i];
        }
        __syncthreads();
        for (int idx = F.tid; idx < NMODROW * 128; idx += NWAVES * 64) { const int m = idx >> 7, c = idx & 127;
            WSP(float, WS_MODS)[(size_t)m * NMOD + 128 * u + c] = red[(c >> 5) * (160 * 33) + m * 33 + (c & 31)] + INP(7)[128 * u + c]; }
        __syncthreads();
    }
}

__device__ __forceinline__ void norm_mod(Frame& F, const float* srcP, const float* srcS, const float* gain, int sub, bf16* Hd, const float* slab, int np, float* xs_out) {
    const int flane = lane_of(F);
    const int gw = F.vcu * NWAVES + F.wave, NGW = F.G * NWAVES;
    for (int mi = gw; mi < MTOK; mi += NGW) {
        const int m = (mi + MS) % MTOK;
        const float* xr = (m < MP) ? srcP + (size_t)m * DM : srcS + (size_t)(m - MP) * DM;
        const float* sh = WSP(float, WS_MODS) + (size_t)pg8::modrow_of(m) * NMOD + (size_t)(3 * sub) * DM; const float* sc = sh + DM;
        f32x4 v[8]; float ss = 0.f;
#pragma unroll
        for (int j = 0; j < 8; ++j) v[j] = *(const f32x4*)(xr + 4 * (flane + 64 * j));
        if (m >= MP && np > 0) {
            for (int p = 0; p < np; ++p) { const float* sp = slab + ((size_t)p * MS + (m - MP)) * DM;
#pragma unroll
                for (int j = 0; j < 8; ++j) v[j] += *(const f32x4*)(sp + 4 * (flane + 64 * j)); }
#pragma unroll
            for (int j = 0; j < 8; ++j) *(f32x4*)(xs_out + (size_t)(m - MP) * DM + 4 * (flane + 64 * j)) = v[j];
        }
#pragma unroll
        for (int j = 0; j < 8; ++j) ss += (v[j][0] * v[j][0] + v[j][1] * v[j][1]) + (v[j][2] * v[j][2] + v[j][3] * v[j][3]);
        const float rstd = 1.0f / sqrtf(wave_sum(ss) * (1.0f / DM) + EPS);
#pragma unroll
        for (int j = 0; j < 8; ++j) { const int k = 4 * (flane + 64 * j);
            const f32x4 g4 = *(const f32x4*)(gain + k), s4 = *(const f32x4*)(sc + k), h4 = *(const f32x4*)(sh + k);
            const f32x4 o = (v[j] * rstd) * g4 * (s4 + 1.0f) + h4;
            v2u pk; pk.x = pk2(o[0], o[1]); pk.y = pk2(o[2], o[3]);
            *(GAS v2u*)(Hd + (size_t)m * DM + k) = pk; }
    }
}
__device__ __forceinline__ void final_norm(Frame& F, const Args& A, const float* slab, int np) {
    const int flane = lane_of(F);
    const int gw = F.vcu * NWAVES + F.wave, NGW = F.G * NWAVES;
    for (int mi = gw; mi < MTOK; mi += NGW) {
        const int m = (mi + MS) % MTOK;
        const float* xr = WSP(float, WS_X) + (size_t)m * DM;
        float* yr = F.out + ((m < MP) ? O_YP + (size_t)m * DM : O_YS + (size_t)(m - MP) * DM);
        f32x4 v[8]; float ss = 0.f;
#pragma unroll
        for (int j = 0; j < 8; ++j) v[j] = *(const f32x4*)(xr + 4 * (flane + 64 * j));
        if (m >= MP) {
            for (int p = 0; p < np; ++p) { const float* sp = slab + ((size_t)p * MS + (m - MP)) * DM;
#pragma unroll
                for (int j = 0; j < 8; ++j) v[j] += *(const f32x4*)(sp + 4 * (flane + 64 * j)); }
        }
#pragma unroll
        for (int j = 0; j < 8; ++j) ss += (v[j][0] * v[j][0] + v[j][1] * v[j][1]) + (v[j][2] * v[j][2] + v[j][3] * v[j][3]);
        const float rstd = 1.0f / sqrtf(wave_sum(ss) * (1.0f / DM) + EPS);
#pragma unroll
        for (int j = 0; j < 8; ++j) { const int k = 4 * (flane + 64 * j); const f32x4 g4 = *(const f32x4*)(INP(21) + k); *(f32x4*)(yr + k) = (v[j] * rstd) * g4; }
    }
}

#define MFMA16(a, b, c) __builtin_amdgcn_mfma_f32_16x16x32_bf16(a, b, c, 0, 0, 0)
__device__ __forceinline__ float log2_gamma(int h) { return h == 0 ? -0.045803689613124747f : h == 1 ? -0.022720076500083405f : h == 2 ? -0.011315313227834146f : -0.0056465631411130581f; }
constexpr int TP = 136;

__device__ __forceinline__ void retA_unit(Frame& F, int unit) {
    const int flane = lane_of(F);
    const int half = unit & 1, c = (unit >> 1) & 15, bh = unit >> 5, b = bh >> 2, h = bh & 3;
    const int m0 = b * SEQ + c * CH;
    const int tid = F.tid, lane = flane, w = F.wave, fr = lane & 15, fq = lane >> 4;
    LAS bf16* VT = (LAS bf16*)F.lds; LAS bf16* KT = VT + 256 * TP; LAS bf16* PP = KT + 128 * TP;
    const bf16* Qg = WSP(bf16, WS_QKVG) + (size_t)m0 * RW + h * HD;
    const bf16* Kg = Qg + (size_t)MTOK * RW; const bf16* Vg = Kg + (size_t)MTOK * RW;
    const float l2g = log2_gamma(h);
#pragma unroll 4
    for (int it = 0; it < 8; ++it) { const int idx = it * 512 + tid, tok = idx & 127, ch = idx >> 7;
        const bf16x8 v = *(const bf16x8*)(Vg + (size_t)tok * RW + ch * 8);
#pragma unroll
        for (int e = 0; e < 8; ++e) VT[(ch * 8 + e) * TP + tok] = (bf16)v[e]; }
#pragma unroll 4
    for (int it = 0; it < 4; ++it) { const int idx = it * 512 + tid, tok = idx & 127, ch = idx >> 7;
        const bf16x8 k = *(const bf16x8*)(Kg + (size_t)tok * RW + half * 128 + ch * 8);
        const float kd = __builtin_amdgcn_exp2f((float)(127 - tok) * l2g);
#pragma unroll
        for (int e = 0; e < 8; ++e) KT[(ch * 8 + e) * TP + tok] = (bf16)f2bf(bf2f((bf16)k[e]) * kd); }
    {
        f32x4 acc[4];
#pragma unroll
        for (int i = 0; i < 4; ++i) acc[i] = (f32x4){0.f, 0.f, 0.f, 0.f};
        if (16 * w < 64 * half + 64) {
#pragma unroll 2
            for (int s = 0; s < 8; ++s) {
                const bf16x8 bb = *(const bf16x8*)(Kg + (size_t)(16 * w + fr) * RW + 32 * s + 8 * fq);
#pragma unroll
                for (int i = 0; i < 4; ++i) { const bf16x8 aa = *(const bf16x8*)(Qg + (size_t)(64 * half + 16 * i + fr) * RW + 32 * s + 8 * fq); acc[i] = MFMA16(aa, bb, acc[i]); }
            }
        }
#pragma unroll
        for (int i = 0; i < 4; ++i)
#pragma unroll
            for (int r = 0; r < 4; ++r) { const int nl = 16 * i + 4 * fq + r, n = 64 * half + nl, m = 16 * w + fr, dn = n - m;
                const float val = dn >= 0 ? acc[i][r] * __builtin_amdgcn_exp2f((float)dn * l2g) : 0.f;
                PP[nl * TP + m] = (bf16)f2bf(val); }
    }
    __syncthreads();
    {
        f32x4 o[2][4];
#pragma unroll
        for (int j = 0; j < 2; ++j)
#pragma unroll
            for (int i = 0; i < 4; ++i) o[j][i] = (f32x4){0.f, 0.f, 0.f, 0.f};
#pragma unroll
        for (int s = 0; s < 4; ++s) {
            bf16x8 a[4];
#pragma unroll
            for (int i = 0; i < 4; ++i) a[i] = *(const LAS bf16x8*)(PP + (16 * i + fr) * TP + 32 * s + 8 * fq);
#pragma unroll
            for (int j = 0; j < 2; ++j) { const bf16x8 bb = *(const LAS bf16x8*)(VT + (16 * (2 * w + j) + fr) * TP + 32 * s + 8 * fq);
#pragma unroll
                for (int i = 0; i < 4; ++i) o[j][i] = MFMA16(a[i], bb, o[j][i]); }
        }
#pragma unroll
        for (int j = 0; j < 2; ++j)
#pragma unroll
            for (int i = 0; i < 4; ++i)
#pragma unroll
                for (int r = 0; r < 4; ++r) WSP(float, WS_OI)[(size_t)(m0 + 64 * half + 16 * i + 4 * fq + r) * RW + h * HD + 16 * (2 * w + j) + fr] = o[j][i][r];
    }
    {
        f32x4 ua[2][8];
#pragma unroll
        for (int i = 0; i < 2; ++i)
#pragma unroll
            for (int j = 0; j < 8; ++j) ua[i][j] = (f32x4){0.f, 0.f, 0.f, 0.f};
#pragma unroll
        for (int s = 0; s < 4; ++s) {
            bf16x8 a[2];
#pragma unroll
            for (int i = 0; i < 2; ++i) a[i] = *(const LAS bf16x8*)(VT + (16 * (2 * w + i) + fr) * TP + 32 * s + 8 * fq);
#pragma unroll
            for (int j = 0; j < 8; ++j) { const bf16x8 bb = *(const LAS bf16x8*)(KT + (16 * j + fr) * TP + 32 * s + 8 * fq);
#pragma unroll
                for (int i = 0; i < 2; ++i) ua[i][j] = MFMA16(a[i], bb, ua[i][j]); }
        }
        float* UTu = WSP(float, WS_UT) + (size_t)(bh * NCH + c) * HD * HD;
#pragma unroll
        for (int i = 0; i < 2; ++i)
#pragma unroll
            for (int j = 0; j < 8; ++j)
#pragma unroll
                for (int r = 0; r < 4; ++r) UTu[(size_t)(16 * (2 * w + i) + 4 * fq + r) * HD + 128 * half + 16 * j + fr] = ua[i][j][r];
    }
    __syncthreads();
}

__device__ __forceinline__ void retC_unit(Frame& F, int unit) {
    const int flane = lane_of(F);
    const int c = unit & 15, bh = unit >> 4, b = bh >> 2, h = bh & 3;
    const int m0 = b * SEQ + c * CH;
    const int lane = flane, w = F.wave, fr = lane & 15, fq = lane >> 4;
    const bf16* Qg = WSP(bf16, WS_QKVG) + (size_t)m0 * RW + h * HD;
    const bf16* Gg = Qg + (size_t)3 * MTOK * RW;
    const float l2g = log2_gamma(h);
    f32x4 acc[16];
#pragma unroll
    for (int j = 0; j < 16; ++j) acc[j] = (f32x4){0.f, 0.f, 0.f, 0.f};
    if (c > 0) {
        const bf16* STc = WSP(bf16, WS_ST) + (size_t)(bh * NCH + c) * HD * HD;
#pragma unroll 2
        for (int s = 0; s < 8; ++s) {
            const bf16x8 aa = *(const bf16x8*)(Qg + (size_t)(16 * w + fr) * RW + 32 * s + 8 * fq);
#pragma unroll
            for (int j = 0; j < 16; ++j) { const bf16x8 bb = *(const bf16x8*)(STc + (size_t)(16 * j + fr) * HD + 32 * s + 8 * fq); acc[j] = MFMA16(aa, bb, acc[j]); }
        }
    }
#pragma unroll
    for (int r = 0; r < 4; ++r) {
        const int n = 16 * w + 4 * fq + r; const size_t row = (size_t)(m0 + n);
        const float qd = __builtin_amdgcn_exp2f((float)(n + 1) * l2g);
        float ss = 0.f;
#pragma unroll
        for (int j = 0; j < 16; ++j) { const float o = WSP(float, WS_OI)[row * RW + h * HD + 16 * j + fr] + qd * acc[j][r]; acc[j][r] = o; ss += o * o; }
        ss += __shfl_xor(ss, 1); ss += __shfl_xor(ss, 2); ss += __shfl_xor(ss, 4); ss += __shfl_xor(ss, 8);
        const float rs = 1.0f / sqrtf(ss * (1.0f / HD) + EPS);
#pragma unroll
        for (int j = 0; j < 16; ++j) { const float g = bf2f(Gg[(size_t)n * RW + 16 * j + fr]); WSP(bf16, WS_MIX)[row * DM + PW + h * HD + 16 * j + fr] = (bf16)f2bf(silu1(g) * acc[j][r] * rs); }
    }
}

__device__ __forceinline__ void retS_unit(Frame& F, const Args& A, int unit) {
    const int flane = lane_of(F);
    const int b = unit >> 2, h = unit & 3, row0 = MP + 4 * b;
    const int tid = F.tid, lane = flane, w = F.wave;
    LAS float* qs = (LAS float*)F.lds; LAS float* kr = qs + 1024; LAS float* vs = kr + 1024; LAS float* red = vs + 1024; LAS float* dots = red + 8192;
    const bf16* Qg = WSP(bf16, WS_QKVG); const bf16* Kg = Qg + (size_t)MTOK * RW; const bf16* Vg = Kg + (size_t)MTOK * RW; const bf16* Gg = Vg + (size_t)MTOK * RW;
    const float l2g = log2_gamma(h);
    for (int i = tid; i < 1024; i += NWAVES * 64) { const int t = i >> 8, d = i & 255; const size_t off = (size_t)(row0 + t) * RW + h * HD + d;
        qs[i] = bf2f(Qg[off]); kr[i] = bf2f(Kg[off]); vs[i] = bf2f(Vg[off]); }
    __syncthreads();
#pragma unroll
    for (int jj = 0; jj < 2; ++jj) { const int p = 2 * w + jj, t = p >> 2, m = p & 3;
        const f32x4 a = *(const LAS f32x4*)(qs + t * 256 + 4 * lane), k4 = *(const LAS f32x4*)(kr + m * 256 + 4 * lane);
        const float d = wave_sum((a[0] * k4[0] + a[1] * k4[1]) + (a[2] * k4[2] + a[3] * k4[3]));
        if (lane == 0) dots[p] = d; }
    const f32x4* S0 = (const f32x4*)(INP(5) + (size_t)unit * HD * HD);
    f32x4* S1 = (f32x4*)(F.out + O_RETS + (size_t)unit * HD * HD);
    f32x4 v4[4], oq[4];
#pragma unroll
    for (int t = 0; t < 4; ++t) { v4[t] = *(const LAS f32x4*)(vs + t * 256 + 4 * lane); oq[t] = (f32x4){0.f, 0.f, 0.f, 0.f}; }
    const float cdec = __builtin_amdgcn_exp2f(4.0f * l2g);
    const float kd0 = __builtin_amdgcn_exp2f(3.0f * l2g), kd1 = __builtin_amdgcn_exp2f(2.0f * l2g), kd2 = __builtin_amdgcn_exp2f(l2g);
    for (int dk0 = 32 * w; dk0 < 32 * w + 32; dk0 += 8) {
        f32x4 s[8];
#pragma unroll
        for (int u = 0; u < 8; ++u) s[u] = S0[(size_t)(dk0 + u) * 64 + lane];
#pragma unroll
        for (int u = 0; u < 8; ++u) { const int dk = dk0 + u;
            const float q0 = qs[dk], q1 = qs[256 + dk], q2 = qs[512 + dk], q3 = qs[768 + dk];
            const float k0 = kr[dk] * kd0, k1 = kr[256 + dk] * kd1, k2 = kr[512 + dk] * kd2, k3 = kr[768 + dk];
            oq[0] += s[u] * q0; oq[1] += s[u] * q1; oq[2] += s[u] * q2; oq[3] += s[u] * q3;
            S1[(size_t)dk * 64 + lane] = s[u] * cdec + v4[0] * k0 + v4[1] * k1 + v4[2] * k2 + v4[3] * k3; }
    }
#pragma unroll
    for (int t = 0; t < 4; ++t) *(LAS f32x4*)(red + (w * 4 + t) * 256 + 4 * lane) = oq[t];
    __syncthreads();
    if (w < 4) {
        const int t = w;
        f32x4 o = (f32x4){0.f, 0.f, 0.f, 0.f};
#pragma unroll
        for (int ww = 0; ww < 8; ++ww) o += *(const LAS f32x4*)(red + (ww * 4 + t) * 256 + 4 * lane);
        o = o * __builtin_amdgcn_exp2f((float)(t + 1) * l2g);
#pragma unroll
        for (int m = 0; m < 4; ++m) if (m <= t) o += v4[m] * (dots[t * 4 + m] * __builtin_amdgcn_exp2f((float)(t - m) * l2g));
        const float ss = wave_sum((o[0] * o[0] + o[1] * o[1]) + (o[2] * o[2] + o[3] * o[3]));
        const float rs = 1.0f / sqrtf(ss * (1.0f / HD) + EPS);
        const size_t row = (size_t)(row0 + t);
        const v2u gp = *(const v2u*)(Gg + row * RW + h * HD + 4 * lane);
        const float g0 = bf2f((bf16)(gp.x & 0xffffu)), g1 = bf2f((bf16)(gp.x >> 16)), g2 = bf2f((bf16)(gp.y & 0xffffu)), g3 = bf2f((bf16)(gp.y >> 16));
        v2u pk; pk.x = pk2(silu1(g0) * o[0] * rs, silu1(g1) * o[1] * rs); pk.y = pk2(silu1(g2) * o[2] * rs, silu1(g3) * o[3] * rs);
        *(GAS v2u*)(WSP(bf16, WS_MIX) + row * DM + PW + h * HD + 4 * lane) = pk;
    }
    __syncthreads();
}

__device__ __forceinline__ void scan_states(Frame& F) {
    const int gt = F.vcu * (NWAVES * 64) + F.tid, NT = F.G * NWAVES * 64;
    for (int i = gt; i < 16 * 16384; i += NT) {
        const int bh = i >> 14, e4 = i & 16383, h = bh & 3;
        const f32x4* up = (const f32x4*)WSP(float, WS_UT) + (size_t)bh * NCH * 16384 + e4;
        f32x4 uv[16];
#pragma unroll
        for (int c = 0; c < 16; ++c) uv[c] = up[(size_t)c * 16384];
        const float g128 = __builtin_amdgcn_exp2f(128.0f * log2_gamma(h));
        f32x4 S = (f32x4){0.f, 0.f, 0.f, 0.f};
#pragma unroll
        for (int c = 0; c < 16; ++c) {
            S = S * g128 + uv[c];
            if (c < 15) { v2u pk; pk.x = pk2(S[0], S[1]); pk.y = pk2(S[2], S[3]); *(GAS v2u*)(WSP(bf16, WS_ST) + ((size_t)(bh * NCH + c + 1) * 16384 + e4) * 4) = pk; }
        }
        const int dv = (4 * e4) >> 8, dk = (4 * e4) & 255;
        float* rp = F.out + O_RETP + (size_t)bh * HD * HD + dv;
#pragma unroll
        for (int q = 0; q < 4; ++q) rp[(size_t)(dk + q) * HD] = S[q];
    }
}

__device__ __forceinline__ void pool_prompt_item(Frame& F, int item, int q) {
    const int b = item >> 7, t0 = (item & 127) * 16, g = q >> 6, wn = 2 << g;
    const f32x4* U4 = (const f32x4*)(WSP(float, WS_U) + (size_t)b * SEQ * PW) + q;
    f32x4 hv[15], cur[16], old[16];
#pragma unroll
    for (int j = 1; j < 16; ++j) { const int t = t0 - j; const bool ok = (j < wn) && (t >= 0); hv[j - 1] = U4[(size_t)(ok ? t : t0) * 256] * (ok ? 1.0f : 0.0f); }
#pragma unroll
    for (int i = 0; i < 16; ++i) { const int t = t0 + i, to = t - wn; const bool ok = (i >= 1) && (to >= 0);
        cur[i] = U4[(size_t)t * 256]; old[i] = U4[(size_t)(ok ? to : t) * 256] * (ok ? 1.0f : 0.0f); }
    f32x4 sum = (f32x4){0.f, 0.f, 0.f, 0.f};
#pragma unroll
    for (int j = 0; j < 15; ++j) sum += hv[j];
#pragma unroll
    for (int i = 0; i < 16; ++i) {
        const int t = t0 + i;
        sum += cur[i]; sum -= old[i];
        const float cnt = (float)((t + 1 < wn) ? (t + 1) : wn);
        const f32x4 mv = sum / cnt - cur[i];
        v2u pk; pk.x = pk2(mv[0], mv[1]); pk.y = pk2(mv[2], mv[3]);
        *(GAS v2u*)(WSP(bf16, WS_PM) + ((size_t)(b * SEQ + t) * PW + 4 * q)) = pk;
    }
}
__device__ __forceinline__ void pool_sample_item(Frame& F, const Args& A, int b, int q) {
    const int g = q >> 6, wn = 2 << g;
    const f32x4* SP4 = (const f32x4*)(INP(4) + (size_t)b * 15 * PW) + q;
    const f32x4* US4 = (const f32x4*)(WSP(float, WS_U) + (size_t)(MP + 4 * b) * PW) + q;
    for (int t = 0; t < 4; ++t) {
        f32x4 sum = (f32x4){0.f, 0.f, 0.f, 0.f};
        for (int j = 0; j < wn; ++j) { const int i = 15 + t - j; sum += (i < 15) ? SP4[(size_t)i * 256] : US4[(size_t)(i - 15) * 256]; }
        const f32x4 cur = US4[(size_t)t * 256];
        const f32x4 mv = sum / (float)wn - cur;
        v2u pk; pk.x = pk2(mv[0], mv[1]); pk.y = pk2(mv[2], mv[3]);
        *(GAS v2u*)(WSP(bf16, WS_PM) + ((size_t)(MP + 4 * b + t) * PW + 4 * q)) = pk;
    }
}
__device__ __forceinline__ void pool_phase(Frame& F, const Args& A) {
    const int q = F.tid & 255, sub = F.tid >> 8;
    for (int bi = F.vcu; bi < 256; bi += F.G) pool_prompt_item(F, 2 * bi + sub, q);
    for (int bi = F.G - 1 - F.vcu; bi < 64; bi += F.G) pool_sample_item(F, A, 2 * bi + sub, q);
    const int gt = F.vcu * (NWAVES * 64) + F.tid, NT = F.G * NWAVES * 64;
    f32x4* o4 = (f32x4*)F.out;
    for (int i = gt; i < NB * 15 * 256; i += NT) { const int qq = i & 255, r = (i >> 8) % 15, b = (i >> 8) / 15;
        o4[O_POOLP / 4 + i] = ((const f32x4*)WSP(float, WS_U))[((size_t)b * SEQ + (SEQ - 15) + r) * 256 + qq]; }
    for (int i = gt; i < DB * 15 * 256; i += NT) { const int qq = i & 255, r = (i >> 8) % 15, b = (i >> 8) / 15;
        o4[O_POOLS / 4 + i] = (r < 11) ? ((const f32x4*)INP(4))[((size_t)b * 15 + r + 4) * 256 + qq] : ((const f32x4*)WSP(float, WS_U))[((size_t)(MP + 4 * b) + (r - 11)) * 256 + qq]; }
}


__global__ void __launch_bounds__(NWAVES * 64, 2) mk_fwd(Args args) {
    extern __shared__ __attribute__((aligned(16))) unsigned char lds[];
    Frame F;
    F.lds = (LAS unsigned char*)lds;
    F.MISC = (volatile LAS unsigned*)(F.lds + MISC_OFF);
    F.tid = threadIdx.x; F.wave = __builtin_amdgcn_readfirstlane(F.tid >> 6);
    F.G = gridDim.x; { const int bx = blockIdx.x; F.vcu = (F.G % 8 == 0) ? (bx % 8) * (F.G / 8) + bx / 8 : bx; }
    unsigned char* ws = args.ws; const Args& A = args;
    F.out = args.out;
    F.ws = ws;
    for (int u = F.tid; u < (LDS_BYTES - LDSCTL_OFF) / 4; u += NWAVES * 64) ((LAS unsigned*)(F.lds + LDSCTL_OFF))[u] = 0u;
    __syncthreads();
    if (!MK_PER_PHASE) (void)xcd_barrier_post((unsigned*)(ws + WS_CTL) + CW_BAR + args.bar_region * XCD_BAR_WORDS, F.MISC + 8);
    const int lo = args.ph_lo, hi = args.ph_hi;
#ifndef PH_MASK
#define PH_MASK 0x7fff
#endif
#define IN(k) (((PH_MASK >> (k)) & 1) && lo <= (k) && (k) < hi)
#ifndef REP_MASK
#define REP_MASK 0
#endif
#define NREP(k) ((((REP_MASK) >> (k)) & 1) ? 2 : 1)
#define SEAM(k) do { if (!MK_PER_PHASE && (IN((k) + 1) || rep_ + 1 < NREP(k))) { XcdBarrier bar_; bar_.bar = (unsigned*)(A.ws + WS_CTL) + CW_BAR + A.bar_region * XCD_BAR_WORDS; bar_.x = xb_xcc_id(); bar_.st = (volatile LAS unsigned*)(F.lds + MISC_OFF) + 8; xcd_barrier(bar_); } } while (0)

    if (IN(0)) for (int rep_ = 0; rep_ < NREP(0); ++rep_) { p0_prologue(F, A); SEAM(0); }
    if (IN(1)) for (int rep_ = 0; rep_ < NREP(1); ++rep_) { p1_adaln(F, A); SEAM(1); }
    if (IN(2)) for (int rep_ = 0; rep_ < NREP(2); ++rep_) { norm_mod(F, INP(0), INP(1), INP(8), 0, WSP(bf16, WS_H), nullptr, 0, nullptr); SEAM(2); }
    if (IN(3)) for (int rep_ = 0; rep_ < NREP(3); ++rep_) {
        pg8::Gemm g{WSP(bf16, WS_H), WSP(bf16, WS_W1), DM, DM, DM, 0, 0}; pg8::StaticOrder S; S.init(MTOK, 2 * DFF, F.G, (int)blockIdx.x);
        pg8::EpiSwiglu E{WSP(bf16, WS_ACT)};
        pg8::gemm_phase<pg8::EpiSwiglu, pg8::StaticOrder, true>(F.lds, g, S, E);
        SEAM(3);
    }
    if (IN(4)) for (int rep_ = 0; rep_ < NREP(4); ++rep_) {
        pg8::Gemm g{WSP(bf16, WS_ACT), WSP(bf16, WS_W1D), DFF, DFF, DFF, 0, KP_DOWN}; pg8::SplitOrder S; S.init(DM, DFF / KP_DOWN, F.G, (int)blockIdx.x);
        pg8::EpiResid E{INP(0), INP(1), WSP(float, WS_X), WSP(float, WS_MODS) + 2 * DM, 0.5f};
        pg8::gemm_phase<pg8::EpiResid, pg8::SplitOrder, true>(F.lds, g, S, E);
        SEAM(4);
    }
    if (IN(5)) for (int rep_ = 0; rep_ < NREP(5); ++rep_) { norm_mod(F, WSP(float, WS_X), INP(1), INP(12), 1, WSP(bf16, WS_H), WSP(float, WS_SLAB), DFF / KP_DOWN, WSP(float, WS_X) + (size_t)MP * DM); SEAM(5); }
    if (IN(6)) for (int rep_ = 0; rep_ < NREP(6); ++rep_) {
        pg8::Gemm g{WSP(bf16, WS_H), WSP(bf16, WS_WIN), DM, DM, DM, 0, 0}; pg8::StaticOrder S; S.init(MTOK, INC, F.G, (int)blockIdx.x);
        pg8::EpiWin E{WSP(float, WS_U), WSP(bf16, WS_QKVG), WSP(float, WS_ROT)};
        pg8::gemm_phase<pg8::EpiWin, pg8::StaticOrder, true>(F.lds, g, S, E);
        SEAM(6);
    }
    if (IN(7)) for (int rep_ = 0; rep_ < NREP(7); ++rep_) {
        for (int u = F.vcu; u < NB * NH * NCH * 2; u += F.G) retA_unit(F, u);
        pool_phase(F, A);
        SEAM(7);
    }
    if (IN(8)) for (int rep_ = 0; rep_ < NREP(8); ++rep_) {
        {
            pg8::Gemm g{WSP(bf16, WS_PM), WSP(bf16, WS_WPOOL), PW, HD, HD, HD, 0}; pg8::StaticOrder S; S.init(MTOK, PW, F.G, (int)blockIdx.x);
            pg8::EpiPool E{WSP(bf16, WS_MIX), INP(15)};
            pg8::gemm_phase<pg8::EpiPool, pg8::StaticOrder, true>(F.lds, g, S, E);
        }
        __syncthreads();
        { int t2 = threadIdx.x; asm volatile("" : "+v"(t2)); F.tid = t2; }
        for (int u = F.vcu; u < DB * NH; u += F.G) retS_unit(F, A, u);
        scan_states(F);
        SEAM(8);
    }
    if (IN(9)) for (int rep_ = 0; rep_ < NREP(9); ++rep_) { for (int u = F.vcu; u < NB * NH * NCH; u += F.G) retC_unit(F, u); SEAM(9); }
    if (IN(10)) for (int rep_ = 0; rep_ < NREP(10); ++rep_) {
        pg8::Gemm g{WSP(bf16, WS_MIX), WSP(bf16, WS_WOUT), DM, DM, DM, 0, KP_OUT}; pg8::SplitOrder S; S.init(DM, DM / KP_OUT, F.G, (int)blockIdx.x);
        pg8::EpiResid E{WSP(float, WS_X), WSP(float, WS_X) + (size_t)MP * DM, WSP(float, WS_X), WSP(float, WS_MODS) + 5 * DM, 1.0f};
        pg8::gemm_phase<pg8::EpiResid, pg8::SplitOrder, true>(F.lds, g, S, E);
        SEAM(10);
    }
    if (IN(11)) for (int rep_ = 0; rep_ < NREP(11); ++rep_) { norm_mod(F, WSP(float, WS_X), WSP(float, WS_X) + (size_t)MP * DM, INP(17), 2, WSP(bf16, WS_H), WSP(float, WS_SLAB), DM / KP_OUT, WSP(float, WS_X) + (size_t)MP * DM); SEAM(11); }
    if (IN(12)) for (int rep_ = 0; rep_ < NREP(12); ++rep_) {
        pg8::Gemm g{WSP(bf16, WS_H), WSP(bf16, WS_W2), DM, DM, DM, 0, 0}; pg8::StaticOrder S; S.init(MTOK, 2 * DFF, F.G, (int)blockIdx.x);
        pg8::EpiSwiglu E{WSP(bf16, WS_ACT)};
        pg8::gemm_phase<pg8::EpiSwiglu, pg8::StaticOrder, true>(F.lds, g, S, E);
        SEAM(12);
    }
    if (IN(13)) for (int rep_ = 0; rep_ < NREP(13); ++rep_) {
        pg8::Gemm g{WSP(bf16, WS_ACT), WSP(bf16, WS_W2D), DFF, DFF, DFF, 0, KP_DOWN}; pg8::SplitOrder S; S.init(DM, DFF / KP_DOWN, F.G, (int)blockIdx.x);
        pg8::EpiResid E{WSP(float, WS_X), WSP(float, WS_X) + (size_t)MP * DM, WSP(float, WS_X), WSP(float, WS_MODS) + 8 * DM, 0.5f};
        pg8::gemm_phase<pg8::EpiResid, pg8::SplitOrder, true>(F.lds, g, S, E);
        SEAM(13);
    }
    if (IN(14)) for (int rep_ = 0; rep_ < NREP(14); ++rep_) { final_norm(F, A, WSP(float, WS_SLAB), DFF / KP_DOWN); if (rep_ + 1 < NREP(14)) { SEAM(14); } }
#undef IN
#undef SEAM
}

extern "C" void kernel_launch(void* const* d_in, const int* in_sizes, int n_in, void* d_out, int out_size, void* d_ws, size_t ws_size, hipStream_t stream) {
    static int grid = 0;
    if (grid == 0) {
        if (n_in != 22 || (size_t)out_size != O_END || ws_size < WS_END) { fprintf(stderr, "kernel_launch: unexpected shapes (n_in %d out %d ws %zu)\n", n_in, out_size, ws_size); grid = -1; return; }
        int dev = 0, cus = 0, per_cu = 0;
        if (hipGetDevice(&dev) != hipSuccess || hipDeviceGetAttribute(&cus, hipDeviceAttributeMultiprocessorCount, dev) != hipSuccess) { grid = -1; return; }
        if (hipFuncSetAttribute((const void*)mk_fwd, hipFuncAttributeMaxDynamicSharedMemorySize, LDS_BYTES) != hipSuccess) { fprintf(stderr, "kernel_launch: hipFuncSetAttribute failed\n"); grid = -1; return; }
        if (hipOccupancyMaxActiveBlocksPerMultiprocessor(&per_cu, (const void*)mk_fwd, NWAVES * 64, LDS_BYTES) != hipSuccess || per_cu < 1) { fprintf(stderr, "kernel_launch: occupancy query says %d blocks/CU\n", per_cu); (void)hipGetLastError(); grid = -1; return; }
        grid = cus;
    }
    if (grid < 0) return;
    (void)hipMemsetAsync((char*)d_ws + WS_CTL, 0, CTL_ZERO_BYTES, stream);
    Args a{};
    for (int i = 0; i < 22; ++i) a.in[i] = (const float*)d_in[i];
    a.out = (float*)d_out; a.ws = (unsigned char*)d_ws;
#if MK_PER_PHASE
    for (int p = 0; p < N_PHASES; ++p) { a.ph_lo = p; a.ph_hi = p + 1; hipLaunchKernelGGL(mk_fwd, dim3(grid), dim3(NWAVES * 64), LDS_BYTES, stream, a); }
#else
    a.ph_lo = 0; a.ph_hi = N_PHASES;
    hipLaunchKernelGGL(mk_fwd, dim3(grid), dim3(NWAVES * 64), LDS_BYTES, stream, a);
#ifdef PROBE_LO
    a.ph_lo = PROBE_LO; a.ph_hi = PROBE_HI; a.bar_region = 1;
    hipLaunchKernelGGL(mk_fwd, dim3(grid), dim3(NWAVES * 64), LDS_BYTES, stream, a);
#endif
#endif
}
```

```cpp
#include <hip/hip_runtime.h>
#include <cstdio>
#include <cstdint>
#include <cmath>

#ifndef MK_PER_PHASE
#define MK_PER_PHASE 0
#endif

constexpr int DM = 2048, DFF = 5632, SEQ = 2048, NB = 4, DB = 128, DS = 4;
constexpr int MP = NB * SEQ;
constexpr int MS = DB * DS;
constexpr int MTOK = MP + MS;
constexpr int NMODROW = NB + DB;
constexpr int NMOD = 9 * DM;
constexpr int PW = 1024, RW = 1024, HD = 256, NH = 4, CH = 128, NCH = SEQ / CH;
constexpr int INC = PW + 4 * RW;
constexpr int PAST = 16384;
constexpr float EPS = 1e-6f;
constexpr int NPOS = SEQ + DS;

constexpr size_t O_YP = 0, O_YS = (size_t)MP * DM, O_POOLP = O_YS + (size_t)MS * DM, O_RETP = O_POOLP + (size_t)NB * 15 * PW,
                 O_POOLS = O_RETP + (size_t)NB * NH * HD * HD, O_RETS = O_POOLS + (size_t)DB * 15 * PW, O_END = O_RETS + (size_t)DB * NH * HD * HD;

constexpr size_t SLAB_MINUS_X = (size_t)(568 - 210) << 20;

namespace pg8 {
#define PG8_LAS __attribute__((address_space(3)))
typedef unsigned short bf16_t;
typedef short bf16x8 __attribute__((ext_vector_type(8)));
typedef float f32x4 __attribute__((ext_vector_type(4)));
typedef unsigned u32x4 __attribute__((ext_vector_type(4)));
typedef unsigned u32x2 __attribute__((ext_vector_type(2)));
constexpr int BM = 256, BK = 64, HALF = 128, HTB = HALF * BK * 2  , STAGE_BYTES = 8 * HTB, NXCD = 8, WGM = 8;

__host__ __device__ __forceinline__ int lds_byte(int r, int c) { const int st = (r >> 4) * 2 + (c >> 5), rr = r & 15, cc = c & 31, ob = rr * 64 + cc * 2; return st * 1024 + (ob ^ (((ob >> 9) & 1) << 5)); }
__host__ __device__ __forceinline__ void stage_rc(int b, int& R, int& C) { const int st = b / 1024, sb = b % 1024, swz = sb ^ (((sb >> 9) & 1) << 5); R = (st >> 1) * 16 + swz / 64; C = (st & 1) * 32 + (swz % 64) / 2; }
__host__ __device__ __forceinline__ int perm32(int rho) { const int n = rho >> 4, i = rho & 15; return 8 * (i >> 2) + 4 * n + (i & 3); }

struct Unit { int pm, pn, kp; };
struct Gemm { const bf16_t* A; const bf16_t* Bt; int lda, ldb, K, acol, kpiece, wscale; };

struct StaticOrder {
    int nM, nN, nwg, G, c;
    __host__ __device__ __forceinline__ void init(int M, int N, int G_, int c_) { nM = M / BM; nN = N / BM; nwg = nM * nN; G = G_; c = c_; }
    __host__ __device__ __forceinline__ bool next(int i, Unit& u) const {
        const long L = (long)i * G + c; if (L >= nwg) return false;
        int wgid = (int)L; { const int q = nwg / NXCD, r = nwg % NXCD, xcd = wgid % NXCD, off = wgid / NXCD; wgid = (xcd < r ? xcd * (q + 1) : r * (q + 1) + (xcd - r) * q) + off; }
        const int nig = WGM * nN, gid = wgid / nig, fm = gid * WGM, gsz = (nM - fm) < WGM ? (nM - fm) : WGM;
        u.pm = fm + ((wgid % nig) % gsz); u.pn = (wgid % nig) / gsz; u.kp = -1; return true;
    }
    __device__ __forceinline__ void a_ready(const Unit&) const {}
    __device__ __forceinline__ void done(const Unit&) const {}
};

struct SplitOrder {
    int nN, nfull, np, G, c;
    __host__ __device__ __forceinline__ void init(int N, int np_, int G_, int c_) { nN = N / BM; nfull = (MP / BM) * nN; np = np_; G = G_; c = c_; }
    __host__ __device__ __forceinline__ bool next(int i, Unit& u) const {
        const int L = i * G + c;
        int pm, pn, kp; bool ok = true;
        if (L < nfull) {
            int wgid = L; { const int q = nfull / NXCD, xcd = wgid % NXCD, off = wgid / NXCD; wgid = xcd * q + off; }
            const int nig = WGM * nN, gid = wgid / nig, fm = gid * WGM;
            pm = fm + ((wgid % nig) % WGM); pn = (wgid % nig) / WGM; kp = -1;
        } else {
            const int j = L - nfull; ok = j < 2 * nN * np;
            const int t = j / np; kp = j - t * np; pm = MP / BM + t / nN; pn = t % nN;
        }
        u.pm = pm; u.pn = pn; u.kp = kp; return ok;
    }
    __device__ __forceinline__ void a_ready(const Unit&) const {}
    __device__ __forceinline__ void done(const Unit&) const {}
};

__device__ __forceinline__ unsigned cvt_pk_bf16(float lo, float hi) { unsigned r; asm volatile("v_cvt_pk_bf16_f32 %0, %1, %2" : "=v"(r) : "v"(lo), "v"(hi)); return r; }
__device__ __forceinline__ float silu_f(float x) { return x * __builtin_amdgcn_rcpf(1.0f + __builtin_amdgcn_exp2f(-1.4426950408889634f * x)); }
__device__ __forceinline__ float clamp448(float x) { return __builtin_fminf(__builtin_fmaxf(x, -448.0f), 448.0f); }
__device__ __forceinline__ unsigned pk4_fp8(float a, float b, float c, float d) {
    int p = 0; p = __builtin_amdgcn_cvt_pk_fp8_f32(clamp448(a), clamp448(b), p, false); p = __builtin_amdgcn_cvt_pk_fp8_f32(clamp448(c), clamp448(d), p, true); return (unsigned)p; }
__device__ __forceinline__ int modrow_of(int row) { return row < MP ? (row >> 11) : NB + ((row - MP) >> 2); }
__device__ __forceinline__ int ptab_of(int row) { return row < MP ? (row & (SEQ - 1)) : SEQ + ((row - MP) & 3); }

struct EpiSwiglu {
    static constexpr bool PERM = true, AFTER_DRAIN = false;
    unsigned char* O;
    __device__ __forceinline__ void operator()(const f32x4 (&acc)[2][2][4][2], const Unit& u, int wr, int wc, int fr, int fq) const {
        const int row0 = u.pm * BM + wr * 64 + fr, col0 = u.pn * HALF + wc * 32 + 8 * fq;
#pragma unroll
        for (int ai = 0; ai < 2; ++ai)
#pragma unroll
            for (int m = 0; m < 4; ++m) {
                unsigned char* rowp = O + (size_t)(row0 + ai * HALF + m * 16) * DFF + col0;
                const f32x4 g0 = acc[ai][0][m][0], g1 = acc[ai][0][m][1], u0 = acc[ai][1][m][0], u1 = acc[ai][1][m][1];
                u32x2 w;
                w.x = pk4_fp8(silu_f(g0[0]) * u0[0], silu_f(g0[1]) * u0[1], silu_f(g0[2]) * u0[2], silu_f(g0[3]) * u0[3]);
                w.y = pk4_fp8(silu_f(g1[0]) * u1[0], silu_f(g1[1]) * u1[1], silu_f(g1[2]) * u1[2], silu_f(g1[3]) * u1[3]);
                *(u32x2*)rowp = w;
            }
    }
};
struct EpiResid {
    static constexpr bool PERM = false, AFTER_DRAIN = false;
    const float* baseP; const float* baseS; float* out; const float* gate; float coef;
    __device__ __forceinline__ void operator()(const f32x4 (&acc)[2][2][4][2], const Unit& u, int wr, int wc, int fr, int fq) const {
        const int row0 = u.pm * BM + wr * 64 + fr, col0 = u.pn * BM + wc * 32 + 4 * fq;
        if (u.kp < 0) {
#pragma unroll
            for (int ai = 0; ai < 2; ++ai)
#pragma unroll
                for (int m = 0; m < 4; ++m) {
                    const int row = row0 + ai * HALF + m * 16;
                    const float* bp = (row < MP ? baseP + (size_t)row * DM : baseS + (size_t)(row - MP) * DM) + col0;
                    const float* gp = gate + (size_t)modrow_of(row) * NMOD + col0;
                    float* op = out + (size_t)row * DM + col0;
#pragma unroll
                    for (int bj = 0; bj < 2; ++bj)
#pragma unroll
                        for (int n = 0; n < 2; ++n) {
                            const f32x4 bs = *(const f32x4*)(bp + bj * HALF + n * 16), gt = *(const f32x4*)(gp + bj * HALF + n * 16);
                            *(f32x4*)(op + bj * HALF + n * 16) = bs + (gt * coef) * acc[ai][bj][m][n];
                        }
                    if (m & 1) asm volatile("" ::: "memory");
                }
        } else {
#pragma unroll
            for (int ai = 0; ai < 2; ++ai)
#pragma unroll
                for (int m = 0; m < 4; ++m) {
                    const int row = row0 + ai * HALF + m * 16;
                    const float* gp = gate + (size_t)modrow_of(row) * NMOD + col0;
                    float* op = (float*)((char*)out + SLAB_MINUS_X) + ((size_t)u.kp * MS + (row - MP)) * DM + col0;
#pragma unroll
                    for (int bj = 0; bj < 2; ++bj)
#pragma unroll
                        for (int n = 0; n < 2; ++n) {
                            const f32x4 gt = *(const f32x4*)(gp + bj * HALF + n * 16);
                            *(f32x4*)(op + bj * HALF + n * 16) = (gt * coef) * acc[ai][bj][m][n];
                        }
                    if (m & 1) asm volatile("" ::: "memory");
                }
        }
    }
};
struct EpiWin {
    static constexpr bool PERM = true, AFTER_DRAIN = false;
    float* U; bf16_t* QKVG; const float* rot;
    __device__ __forceinline__ void operator()(const f32x4 (&acc)[2][2][4][2], const Unit& u, int wr, int wc, int fr, int fq) const {
        const int row0 = u.pm * BM + wr * 64 + fr, cw = wc * 32 + 8 * fq;
        if (u.pn < 4) {
#pragma unroll
            for (int ai = 0; ai < 2; ++ai)
#pragma unroll
                for (int m = 0; m < 4; ++m) {
                    float* rowp = U + (size_t)(row0 + ai * HALF + m * 16) * PW + u.pn * BM + cw;
#pragma unroll
                    for (int bj = 0; bj < 2; ++bj)
#pragma unroll
                        for (int n = 0; n < 2; ++n) *(f32x4*)(rowp + bj * HALF + 4 * n) = acc[ai][bj][m][n];
                }
        } else {
            const int t = (u.pn - 4) >> 2, hd = (u.pn - 4) & 3;
            bf16_t* dst = QKVG + (size_t)t * MTOK * RW + hd * HD + cw;
            if (t < 2) {
                const float sc = (t == 1) ? 0.0625f : 1.0f;
#pragma unroll
                for (int ai = 0; ai < 2; ++ai)
#pragma unroll
                    for (int m = 0; m < 4; ++m) {
                        const int row = row0 + ai * HALF + m * 16;
                        const float* rp = rot + ((size_t)ptab_of(row) * 128 + cw) * 2;
                        u32x4 w1, w2;
#pragma unroll
                        for (int n = 0; n < 2; ++n) {
                            const f32x4 cs0 = *(const f32x4*)(rp + 8 * n), cs1 = *(const f32x4*)(rp + 8 * n + 4);
                            const f32x4 x1 = acc[ai][0][m][n] * sc, x2 = acc[ai][1][m][n] * sc;
                            const float a0 = x1[0] * cs0[0] - x2[0] * cs0[1], b0 = x2[0] * cs0[0] + x1[0] * cs0[1];
                            const float a1 = x1[1] * cs0[2] - x2[1] * cs0[3], b1 = x2[1] * cs0[2] + x1[1] * cs0[3];
                            const float a2 = x1[2] * cs1[0] - x2[2] * cs1[1], b2 = x2[2] * cs1[0] + x1[2] * cs1[1];
                            const float a3 = x1[3] * cs1[2] - x2[3] * cs1[3], b3 = x2[3] * cs1[2] + x1[3] * cs1[3];
                            if (n == 0) { w1.x = cvt_pk_bf16(a0, a1); w1.y = cvt_pk_bf16(a2, a3); w2.x = cvt_pk_bf16(b0, b1); w2.y = cvt_pk_bf16(b2, b3); }
                            else        { w1.z = cvt_pk_bf16(a0, a1); w1.w = cvt_pk_bf16(a2, a3); w2.z = cvt_pk_bf16(b0, b1); w2.w = cvt_pk_bf16(b2, b3); }
                        }
                        bf16_t* rowp = dst + (size_t)row * RW;
                        *(u32x4*)rowp = w1; *(u32x4*)(rowp + HALF) = w2;
                    }
            } else {
#pragma unroll
                for (int ai = 0; ai < 2; ++ai)
#pragma unroll
                    for (int m = 0; m < 4; ++m) {
                        bf16_t* rowp = dst + (size_t)(row0 + ai * HALF + m * 16) * RW;
#pragma unroll
                        for (int bj = 0; bj < 2; ++bj) { const f32x4 v0 = acc[ai][bj][m][0], v1 = acc[ai][bj][m][1]; u32x4 w;
                            w.x = cvt_pk_bf16(v0[0], v0[1]); w.y = cvt_pk_bf16(v0[2], v0[3]); w.z = cvt_pk_bf16(v1[0], v1[1]); w.w = cvt_pk_bf16(v1[2], v1[3]);
                            *(u32x4*)(rowp + bj * HALF) = w; }
                    }
            }
        }
    }
};
struct EpiPool {
    static constexpr bool PERM = true, AFTER_DRAIN = false;
    bf16_t* MIX; const float* pscale;
    __device__ __forceinline__ void operator()(const f32x4 (&acc)[2][2][4][2], const Unit& u, int wr, int wc, int fr, int fq) const {
        const int row0 = u.pm * BM + wr * 64 + fr, col0 = u.pn * BM + wc * 32 + 8 * fq;
#pragma unroll
        for (int ai = 0; ai < 2; ++ai)
#pragma unroll
            for (int m = 0; m < 4; ++m) {
                bf16_t* rowp = MIX + (size_t)(row0 + ai * HALF + m * 16) * DM + col0;
#pragma unroll
                for (int bj = 0; bj < 2; ++bj) { const f32x4 v0 = acc[ai][bj][m][0] * *(const f32x4*)(pscale + col0 + bj * HALF), v1 = acc[ai][bj][m][1] * *(const f32x4*)(pscale + col0 + bj * HALF + 4); u32x4 w;
                    w.x = cvt_pk_bf16(v0[0], v0[1]); w.y = cvt_pk_bf16(v0[2], v0[3]); w.z = cvt_pk_bf16(v1[0], v1[1]); w.w = cvt_pk_bf16(v1[2], v1[3]);
                    *(u32x4*)(rowp + bj * HALF) = w; }
            }
    }
};

template <class Epi, class Sched, bool ALIGN_EPI = false>
__device__ __forceinline__ void gemm_phase(PG8_LAS unsigned char* lds, const Gemm g, const Sched& S, const Epi& E) {
    const int tid = threadIdx.x, wid = __builtin_amdgcn_readfirstlane(tid >> 6), lane = tid & 63, wr = wid >> 2, wc = wid & 3, fr = lane & 15, fq = lane >> 4;
    unsigned voffA[2], voffB[2];
#pragma unroll
    for (int i = 0; i < 2; ++i) { int R, C; stage_rc(tid * 16 + i * 8192, R, C); const int Rb = Epi::PERM ? ((R & ~31) + perm32(R & 31)) : R;
        voffA[i] = (unsigned)(R * g.lda + C) * 2u; voffB[i] = (unsigned)(Rb * g.ldb + C) * 2u; }
    const size_t kstep = (size_t)(BK * 2);
    const size_t hstepA = (size_t)HALF * g.lda * 2, hstepB = (size_t)HALF * g.ldb * 2;
    const size_t tstepA = 2 * hstepA, tstepB = 2 * hstepB;
    const size_t astep = (size_t)g.acol * 2;
    const unsigned ldsw = (unsigned)wid * 1024u;
    const int aoff = lds_byte(wr * 64 + fr, fq * 8), boff = lds_byte(wc * 32 + fr, fq * 8);
#define PG8_SA(b, h) (((b) * 2 + (h)) * HTB)
#define PG8_SB(b, h) ((4 + (b) * 2 + (h)) * HTB)
#define PG8_STAGE(bufoff, gbase, voff) do { _Pragma("unroll") for (int _i = 0; _i < 2; ++_i) \
        __builtin_amdgcn_global_load_lds((const unsigned*)((const char*)(gbase) + (voff)[_i]), (PG8_LAS unsigned*)(lds + (bufoff) + ldsw + _i * 8192), 16, 0, 0); } while (0)
#define PG8_LDA(dst, b, h) do { _Pragma("unroll") for (int m = 0; m < 4; ++m) _Pragma("unroll") for (int k = 0; k < 2; ++k) dst[m][k] = *(const PG8_LAS bf16x8*)(lds + PG8_SA(b, h) + aoff + m * 2048 + k * 1024); } while (0)
#define PG8_LDB(dst, b, h) do { _Pragma("unroll") for (int n = 0; n < 2; ++n) _Pragma("unroll") for (int k = 0; k < 2; ++k) dst[n][k] = *(const PG8_LAS bf16x8*)(lds + PG8_SB(b, h) + boff + n * 2048 + k * 1024); } while (0)
#define PG8_MMA(ai, bj, At, Bt) do { __builtin_amdgcn_s_setprio(1); _Pragma("unroll") for (int m = 0; m < 4; ++m) _Pragma("unroll") for (int n = 0; n < 2; ++n) _Pragma("unroll") for (int k = 0; k < 2; ++k) \
        acc[ai][bj][m][n] = __builtin_amdgcn_mfma_f32_16x16x32_bf16(Bt[n][k], At[m][k], acc[ai][bj][m][n], 0, 0, 0); __builtin_amdgcn_s_setprio(0); } while (0)
#define PG8_WAIT_V(n) asm volatile("s_waitcnt vmcnt(" #n ")" ::: "memory")
#define PG8_WAIT_L(n) asm volatile("s_waitcnt lgkmcnt(" #n ")" ::: "memory")
#define PG8_BAR __builtin_amdgcn_s_barrier()
#define PG8_SCHED __builtin_amdgcn_sched_barrier(0)
    Unit cur, nxt; int ui = 0;
    if (!S.next(0, cur)) return;
    f32x4 acc[2][2][4][2];
#pragma unroll
    for (int a = 0; a < 2; ++a)
#pragma unroll
        for (int b = 0; b < 2; ++b)
#pragma unroll
            for (int m = 0; m < 4; ++m)
#pragma unroll
                for (int n = 0; n < 2; ++n) acc[a][b][m][n] = (f32x4){0.f, 0.f, 0.f, 0.f};
    bf16x8 At[4][2], B0[2][2], B1[2][2];
    const char* cA = (const char*)g.A + (size_t)cur.pm * tstepA + (size_t)cur.pn * astep + (cur.kp > 0 ? (size_t)cur.kp * g.kpiece * 2 : 0); const char* cB = (const char*)g.Bt + (size_t)cur.pn * tstepB + (cur.kp > 0 ? (size_t)cur.kp * g.kpiece * 2 : 0);
    S.a_ready(cur);
    PG8_STAGE(PG8_SB(0, 0), cB, voffB); PG8_STAGE(PG8_SB(0, 1), cB + hstepB, voffB); PG8_STAGE(PG8_SA(0, 0), cA, voffA); PG8_STAGE(PG8_SA(0, 1), cA + hstepA, voffA);
    if (wr == 1) PG8_BAR;
    PG8_WAIT_V(2); PG8_BAR;
    PG8_STAGE(PG8_SB(1, 0), cB + kstep, voffB); PG8_STAGE(PG8_SA(1, 0), cA + kstep, voffA); PG8_STAGE(PG8_SB(1, 1), cB + hstepB + kstep, voffB);
    PG8_WAIT_V(6); PG8_BAR;
    for (;;) {
        const bool has_next = S.next(ui + 1, nxt);
        const size_t nko = (has_next && nxt.kp > 0) ? (size_t)nxt.kp * g.kpiece * 2 : 0;
        const char* nA = has_next ? (const char*)g.A + (size_t)nxt.pm * tstepA + (size_t)nxt.pn * astep + nko : cA; const char* nB = has_next ? (const char*)g.Bt + (size_t)nxt.pn * tstepB + nko : cB;
        const int nt = (cur.kp < 0 ? g.K : g.kpiece) / BK;
        for (int t = 0; t < nt; t += 2) {
            const bool last = (t == nt - 2);
            const char* a1 = cA + (size_t)(t + 1) * kstep;
            const char* a2 = last ? nA : cA + (size_t)(t + 2) * kstep; const char* b2 = last ? nB : cB + (size_t)(t + 2) * kstep;
            const char* a3 = a2 + kstep; const char* b3 = b2 + kstep;
            if (last && has_next) S.a_ready(nxt);
            PG8_LDB(B0, 0, 0); PG8_LDB(B1, 0, 1); PG8_SCHED; PG8_LDA(At, 0, 0); PG8_STAGE(PG8_SA(1, 1), a1 + hstepA, voffA);
            PG8_WAIT_V(8); PG8_WAIT_L(0); PG8_BAR; PG8_MMA(0, 0, At, B0); PG8_MMA(0, 1, At, B1); PG8_BAR; PG8_SCHED;
            PG8_LDA(At, 0, 1); PG8_STAGE(PG8_SB(0, 0), b2, voffB); PG8_STAGE(PG8_SB(0, 1), b2 + hstepB, voffB); PG8_STAGE(PG8_SA(0, 0), a2, voffA);
            PG8_WAIT_V(8); PG8_WAIT_L(0); PG8_BAR; PG8_MMA(1, 0, At, B0); PG8_MMA(1, 1, At, B1); PG8_BAR; PG8_SCHED;
            PG8_LDB(B0, 1, 0); PG8_LDB(B1, 1, 1); PG8_SCHED; PG8_LDA(At, 1, 0); PG8_STAGE(PG8_SA(0, 1), a2 + hstepA, voffA);
            PG8_WAIT_V(8); PG8_WAIT_L(0); PG8_BAR; PG8_MMA(0, 0, At, B0); PG8_MMA(0, 1, At, B1); PG8_BAR; PG8_SCHED;
            PG8_LDA(At, 1, 1); PG8_STAGE(PG8_SB(1, 0), b3, voffB); PG8_STAGE(PG8_SB(1, 1), b3 + hstepB, voffB); PG8_STAGE(PG8_SA(1, 0), a3, voffA);
            PG8_WAIT_V(8); PG8_WAIT_L(0); PG8_BAR; PG8_MMA(1, 0, At, B0); PG8_MMA(1, 1, At, B1); PG8_BAR; PG8_SCHED;
        }
        if constexpr (ALIGN_EPI) { if (wr == 0) PG8_BAR; }
        E(acc, cur, wr, wc, fr, fq); S.done(cur);
        if (!has_next) break;
#pragma unroll
        for (int a = 0; a < 2; ++a)
#pragma unroll
            for (int b = 0; b < 2; ++b)
#pragma unroll
                for (int m = 0; m < 4; ++m)
#pragma unroll
                    for (int n = 0; n < 2; ++n) acc[a][b][m][n] = (f32x4){0.f, 0.f, 0.f, 0.f};
        cur = nxt; cA = nA; cB = nB; ++ui;
        if constexpr (ALIGN_EPI) { if (wr == 1) PG8_BAR; }
    }
    PG8_WAIT_V(0);
    if constexpr (!ALIGN_EPI) { if (wr == 0) PG8_BAR; }
    PG8_BAR;
#undef PG8_SA
#undef PG8_SB
#undef PG8_STAGE
#undef PG8_LDA
#undef PG8_LDB
#undef PG8_MMA
#undef PG8_WAIT_V
#undef PG8_WAIT_L
#undef PG8_BAR
#undef PG8_SCHED
}
__host__ __device__ __forceinline__ int lds_byte8(int r, int cb) { return (r >> 4) * 2048 + (((cb >> 6) * 16 + (r & 15)) * 64) + ((((cb >> 4) & 3) ^ ((r >> 3) & 1)) * 16); }
__host__ __device__ __forceinline__ void stage_rc8(int b, int& R, int& C) { const int g = b >> 11, u = (b >> 6) & 31, h = u >> 4, r = u & 15, q = ((b >> 4) & 3) ^ ((r >> 3) & 1); R = 16 * g + r; C = h * 64 + q * 16; }
typedef int v8i __attribute__((ext_vector_type(8)));
__device__ __forceinline__ v8i cat8(bf16x8 lo, bf16x8 hi) { typedef int v4i __attribute__((ext_vector_type(4))); const v4i a = __builtin_bit_cast(v4i, lo), b = __builtin_bit_cast(v4i, hi); return (v8i){a[0], a[1], a[2], a[3], b[0], b[1], b[2], b[3]}; }
template <class Epi, class Sched, bool ALIGN_EPI = false>
__device__ __forceinline__ void gemm_phase8(PG8_LAS unsigned char* lds, const Gemm g, const Sched& S, const Epi& E) {
    const int tid = threadIdx.x, wid = __builtin_amdgcn_readfirstlane(tid >> 6), lane = tid & 63, wr = wid >> 2, wc = wid & 3, fr = lane & 15, fq = lane >> 4;
    unsigned voffA[2], voffB[2];
#pragma unroll
    for (int i = 0; i < 2; ++i) { int R, C; stage_rc8(tid * 16 + i * 8192, R, C); const int Rb = Epi::PERM ? ((R & ~31) + perm32(R & 31)) : R;
        voffA[i] = (unsigned)(R * g.lda + C); voffB[i] = (unsigned)(Rb * g.ldb + C); }
    const size_t kstep = (size_t)128;
    const size_t hstepA = (size_t)HALF * g.lda, hstepB = (size_t)HALF * g.ldb;
    const size_t tstepA = 2 * hstepA, tstepB = 2 * hstepB;
    const size_t astep = (size_t)g.acol;
    const unsigned ldsw = (unsigned)wid * 1024u;
    const int aoff = lds_byte8(wr * 64 + fr, fq * 32), boff = lds_byte8(wc * 32 + fr, fq * 32);
#define PG8_SA(b, h) (((b) * 2 + (h)) * HTB)
#define PG8_SB(b, h) ((4 + (b) * 2 + (h)) * HTB)
#define PG8_STAGE(bufoff, gbase, voff) do { _Pragma("unroll") for (int _i = 0; _i < 2; ++_i) \
        __builtin_amdgcn_global_load_lds((const unsigned*)((const char*)(gbase) + (voff)[_i]), (PG8_LAS unsigned*)(lds + (bufoff) + ldsw + _i * 8192), 16, 0, 0); } while (0)
#define PG8_LDA(dst, b, h) do { _Pragma("unroll") for (int m = 0; m < 4; ++m) dst[m] = cat8(*(const PG8_LAS bf16x8*)(lds + PG8_SA(b, h) + aoff + m * 2048), *(const PG8_LAS bf16x8*)(lds + PG8_SA(b, h) + (aoff ^ 16) + m * 2048)); } while (0)
#define PG8_LDB(dst, b, h) do { _Pragma("unroll") for (int n = 0; n < 2; ++n) dst[n] = cat8(*(const PG8_LAS bf16x8*)(lds + PG8_SB(b, h) + boff + n * 2048), *(const PG8_LAS bf16x8*)(lds + PG8_SB(b, h) + (boff ^ 16) + n * 2048)); } while (0)
#define PG8_MMA(ai, bj, At, Bt) do { __builtin_amdgcn_s_setprio(1); _Pragma("unroll") for (int m = 0; m < 4; ++m) _Pragma("unroll") for (int n = 0; n < 2; ++n) \
        asm volatile("v_mfma_scale_f32_16x16x128_f8f6f4 %0, %1, %2, %0, %3, %4 op_sel_hi:[0,0,0]" : "+v"(acc[ai][bj][m][n]) : "v"(Bt[n]), "v"(At[m]), "v"(wsc), "v"(asc)); __builtin_amdgcn_s_setprio(0); } while (0)
#define PG8_WAIT_V(n) asm volatile("s_waitcnt vmcnt(" #n ")" ::: "memory")
#define PG8_WAIT_L(n) asm volatile("s_waitcnt lgkmcnt(" #n ")" ::: "memory")
#define PG8_BAR __builtin_amdgcn_s_barrier()
#define PG8_SCHED __builtin_amdgcn_sched_barrier(0)
    Unit cur, nxt; int ui = 0;
    if (!S.next(0, cur)) return;
    f32x4 acc[2][2][4][2];
#pragma unroll
    for (int a = 0; a < 2; ++a)
#pragma unroll
        for (int b = 0; b < 2; ++b)
#pragma unroll
            for (int m = 0; m < 4; ++m)
#pragma unroll
                for (int n = 0; n < 2; ++n) acc[a][b][m][n] = (f32x4){0.f, 0.f, 0.f, 0.f};
    v8i At[4], B0[2], B1[2];
    int wsc = g.wscale, asc = 0x7f7f7f7f;
    asm volatile("" : "+v"(wsc), "+v"(asc));
    const char* cA = (const char*)g.A + (size_t)cur.pm * tstepA + (size_t)cur.pn * astep + (cur.kp > 0 ? (size_t)cur.kp * g.kpiece : 0); const char* cB = (const char*)g.Bt + (size_t)cur.pn * tstepB + (cur.kp > 0 ? (size_t)cur.kp * g.kpiece : 0);
    S.a_ready(cur);
    PG8_STAGE(PG8_SB(0, 0), cB, voffB); PG8_STAGE(PG8_SB(0, 1), cB + hstepB, voffB); PG8_STAGE(PG8_SA(0, 0), cA, voffA); PG8_STAGE(PG8_SA(0, 1), cA + hstepA, voffA);
    if (wr == 1) PG8_BAR;
    PG8_WAIT_V(2); PG8_BAR;
    PG8_STAGE(PG8_SB(1, 0), cB + kstep, voffB); PG8_STAGE(PG8_SA(1, 0), cA + kstep, voffA); PG8_STAGE(PG8_SB(1, 1), cB + hstepB + kstep, voffB);
    PG8_WAIT_V(6); PG8_BAR;
    for (;;) {
        const bool has_next = S.next(ui + 1, nxt);
        const size_t nko = (has_next && nxt.kp > 0) ? (size_t)nxt.kp * g.kpiece : 0;
        const char* nA = has_next ? (const char*)g.A + (size_t)nxt.pm * tstepA + (size_t)nxt.pn * astep + nko : cA; const char* nB = has_next ? (const char*)g.Bt + (size_t)nxt.pn * tstepB + nko : cB;
        const int nt = (cur.kp < 0 ? g.K : g.kpiece) / 128;
        for (int t = 0; t < nt; t += 2) {
            const bool last = (t == nt - 2);
            const char* a1 = cA + (size_t)(t + 1) * kstep;
            const char* a2 = last ? nA : cA + (size_t)(t + 2) * kstep; const char* b2 = last ? nB : cB + (size_t)(t + 2) * kstep;
            const char* a3 = a2 + kstep; const char* b3 = b2 + kstep;
            if (last && has_next) S.a_ready(nxt);
            PG8_LDB(B0, 0, 0); PG8_LDB(B1, 0, 1); PG8_SCHED; PG8_LDA(At, 0, 0); PG8_STAGE(PG8_SA(1, 1), a1 + hstepA, voffA);
            PG8_WAIT_V(8); PG8_WAIT_L(0); PG8_BAR; PG8_MMA(0, 0, At, B0); PG8_MMA(0, 1, At, B1); PG8_BAR; PG8_SCHED;
            PG8_LDA(At, 0, 1); PG8_STAGE(PG8_SB(0, 0), b2, voffB); PG8_STAGE(PG8_SB(0, 1), b2 + hstepB, voffB); PG8_STAGE(PG8_SA(0, 0), a2, voffA);
            PG8_WAIT_V(8); PG8_WAIT_L(0); PG8_BAR; PG8_MMA(1, 0, At, B0); PG8_MMA(1, 1, At, B1); PG8_BAR; PG8_SCHED;
            PG8_LDB(B0, 1, 0); PG8_LDB(B1, 1, 1); PG8_SCHED; PG8_LDA(At, 1, 0); PG8_STAGE(PG8_SA(0, 1), a2 + hstepA, voffA);
            PG8_WAIT_V(8); PG8_WAIT_L(0); PG8_BAR; PG8_MMA(0, 0, At, B0); PG8_MMA(0, 1, At, B1); PG8_BAR; PG8_SCHED;
            PG8_LDA(At, 1, 1); PG8_STAGE(PG8_SB(1, 0), b3, voffB); PG8_STAGE(PG8_SB(1, 1), b3 + hstepB, voffB); PG8_STAGE(PG8_SA(1, 0), a3, voffA);
            PG8_WAIT_V(8); PG8_WAIT_L(0); PG8_BAR; PG8_MMA(1, 0, At, B0); PG8_MMA(1, 1, At, B1); PG8_BAR; PG8_SCHED;
        }
        if constexpr (ALIGN_EPI) { if (wr == 0) PG8_BAR; }
        asm volatile("s_nop 15\n\ts_nop 15" ::: "memory");
        E(acc, cur, wr, wc, fr, fq); S.done(cur);
        if (!has_next) break;
#pragma unroll
        for (int a = 0; a < 2; ++a)
#pragma unroll
            for (int b = 0; b < 2; ++b)
#pragma unroll
                for (int m = 0; m < 4; ++m)
#pragma unroll
                    for (int n = 0; n < 2; ++n) acc[a][b][m][n] = (f32x4){0.f, 0.f, 0.f, 0.f};
        cur = nxt; cA = nA; cB = nB; ++ui;
        if constexpr (ALIGN_EPI) { if (wr == 1) PG8_BAR; }
    }
    PG8_WAIT_V(0);
    if constexpr (!ALIGN_EPI) { if (wr == 0) PG8_BAR; }
    PG8_BAR;
#undef PG8_SA
#undef PG8_SB
#undef PG8_STAGE
#undef PG8_LDA
#undef PG8_LDB
#undef PG8_MMA
#undef PG8_WAIT_V
#undef PG8_WAIT_L
#undef PG8_BAR
#undef PG8_SCHED
}
}

constexpr int NWAVES = 8;
constexpr int N_PHASES = 15;
constexpr size_t MiB = 1u << 20;
constexpr size_t WS_CTL = 0, CTL_ZERO_BYTES = 64 * 1024;
constexpr size_t WS_SC = 1 * MiB;
constexpr size_t WS_ROT = 2 * MiB;
constexpr size_t WS_MODS = 5 * MiB;
constexpr size_t WS_WPOOL = 15 * MiB;
constexpr size_t WS_WOUT = 16 * MiB;
constexpr size_t WS_WIN = 24 * MiB;
constexpr size_t WS_W1 = 44 * MiB;
constexpr size_t WS_W1D = 88 * MiB;
constexpr size_t WS_W2 = 110 * MiB;
constexpr size_t WS_W2D = 154 * MiB;
constexpr size_t WS_H = 176 * MiB;
constexpr size_t WS_X = 210 * MiB;
constexpr size_t WS_ACT = 278 * MiB;
constexpr size_t WS_QKVG = WS_ACT;
constexpr size_t WS_PM = WS_ACT + 68 * MiB;
constexpr size_t WS_U = 372 * MiB;
constexpr size_t WS_MIX = 406 * MiB;
constexpr size_t WS_UT = 440 * MiB;
constexpr size_t WS_OI = 504 * MiB;
constexpr size_t WS_ST = 536 * MiB;
constexpr size_t WS_SLAB = 568 * MiB;
constexpr size_t WS_END = 612 * MiB;
static_assert(WS_SLAB - WS_X == SLAB_MINUS_X, "slab offset");
constexpr int KP_DOWN = 512, KP_OUT = 256;
constexpr float WMUL_UP = 32.0f, WMUL_DOWN = 64.0f; constexpr int WSC_UP = 0x7a7a7a7a, WSC_DOWN = 0x79797979;
static_assert(WS_SC + 160 * 2048 * 2 <= WS_ROT && WS_ROT + (size_t)NPOS * 128 * 8 <= WS_MODS && WS_MODS + (size_t)NMODROW * NMOD * 4 <= WS_WPOOL, "ws map 1");
static_assert(WS_W1 + (size_t)2 * DFF * DM * 2 <= WS_W1D && WS_W1D + (size_t)DM * DFF * 2 <= WS_W2 && WS_W2D + (size_t)DM * DFF * 2 <= WS_H, "ws map 2");
static_assert(WS_H + (size_t)MTOK * DM * 2 <= WS_X && WS_X + (size_t)MTOK * DM * 4 <= WS_ACT && WS_ACT + (size_t)MTOK * DFF * 2 <= WS_U, "ws map 3");
static_assert(WS_PM + (size_t)MTOK * PW * 2 <= WS_U && WS_U + (size_t)MTOK * PW * 4 <= WS_MIX && WS_MIX + (size_t)MTOK * DM * 2 <= WS_UT, "ws map 4");
constexpr int CW_BAR = 1024;

constexpr int RING_BYTES = 131072;
constexpr int LDSCTL_OFF = RING_BYTES, MISC_OFF = LDSCTL_OFF + 320;
constexpr int LDS_BYTES = 147456;

#define GAS __attribute__((address_space(1)))
#define LAS __attribute__((address_space(3)))
typedef unsigned short bf16;
typedef unsigned v4u __attribute__((ext_vector_type(4)));
typedef unsigned v2u __attribute__((ext_vector_type(2)));
typedef float f32x4 __attribute__((ext_vector_type(4)));
typedef float f32x16 __attribute__((ext_vector_type(16)));
typedef short bf16x8 __attribute__((ext_vector_type(8)));
typedef short bf16x4 __attribute__((ext_vector_type(4)));
typedef GAS unsigned gu32;
#define RLX_AGENT __ATOMIC_RELAXED, __HIP_MEMORY_SCOPE_AGENT
#define LDS_WAIT() asm volatile("s_waitcnt lgkmcnt(0)" ::: "memory")
#define VM_WAIT() asm volatile("s_waitcnt vmcnt(0)" ::: "memory")
__device__ __forceinline__ unsigned f2bf(float f) { unsigned u = __builtin_bit_cast(unsigned, f); return (u + 0x7fffu + ((u >> 16) & 1u)) >> 16; }
__device__ __forceinline__ unsigned pk2(float lo, float hi) { return f2bf(lo) | (f2bf(hi) << 16); }
__device__ __forceinline__ float bf2f(unsigned short v) { return __builtin_bit_cast(float, (unsigned)v << 16); }
__device__ __forceinline__ float silu1(float x) { return x / (1.0f + __expf(-x)); }

#define XB_TMO      128
#define XB_XCNT(j)  (256  + 64 * (j))
#define XB_XSUB(j)  (1280 + 64 * (j))
#define XB_XGEN(j)  (2304 + 64 * (j))
#define XB_TOP      3328
#define XB_TOPGEN   3392
#define XCD_BAR_WORDS 3456
#define XB_SPIN_CAP (1u << 20)
static_assert((CW_BAR + 2 * XCD_BAR_WORDS) * 4 <= (int)CTL_ZERO_BYTES, "barrier words inside the memset region");

__device__ __forceinline__ unsigned xb_ld(unsigned* p)              { return __hip_atomic_load(p, __ATOMIC_RELAXED, __HIP_MEMORY_SCOPE_AGENT); }
__device__ __forceinline__ unsigned xb_add(unsigned* p, unsigned v) { return __hip_atomic_fetch_add(p, v, __ATOMIC_RELAXED, __HIP_MEMORY_SCOPE_AGENT); }
__device__ __forceinline__ unsigned xb_xcc_id() { return (unsigned)__builtin_amdgcn_s_getreg((3 << 11) | 20) & 0xFu; }
#define XB_SPIN(cond, bar) do { unsigned _sp = 0; while (cond) { __builtin_amdgcn_s_sleep(1); \
    if ((++_sp & 255u) == 0u) { if (xb_ld(&(bar)[XB_TMO])) break; if (_sp > XB_SPIN_CAP) { atomicAdd(&(bar)[XB_TMO], 1u); break; } } } } while (0)

struct XcdBarrier { unsigned* bar; unsigned x; volatile LAS unsigned* st; };
__device__ __forceinline__ XcdBarrier xcd_barrier_post(unsigned* bar, volatile LAS unsigned* st) {
    XcdBarrier b; b.bar = bar; b.x = xb_xcc_id(); b.st = st;
    if (threadIdx.x == 0) (void)xb_add(&bar[XB_XCNT(b.x)], 1u);
    return b;
}
__device__ __forceinline__ void xcd_barrier_complete(unsigned* bar, unsigned x, unsigned& nloc, unsigned& nx) {
    const unsigned G = gridDim.x * gridDim.y * gridDim.z;
    unsigned sum, cnt, mine, sp = 0u;
    for (;;) {
        sum = 0u; cnt = 0u; mine = 0u;
#pragma unroll
        for (unsigned j = 0; j < 16; ++j) { const unsigned c = xb_ld(&bar[XB_XCNT(j)]); sum += c; cnt += (c > 0u) ? 1u : 0u; mine = (j == x) ? c : mine; }
        if (sum == G) break;
        __builtin_amdgcn_s_sleep(1);
        if ((++sp & 255u) == 0u) { if (xb_ld(&bar[XB_TMO])) break; if (sp > XB_SPIN_CAP) { atomicAdd(&bar[XB_TMO], 1u); break; } }
    }
    nloc = mine > 0u ? mine : 1u; nx = cnt > 0u ? cnt : 1u;
}
__device__ __forceinline__ void xcd_barrier(const XcdBarrier& b) {
    asm volatile("s_waitcnt vmcnt(0)" ::: "memory");
    __syncthreads();
    if (threadIdx.x == 0) {
        unsigned* bar = b.bar;
        __builtin_amdgcn_s_waitcnt(0);
        unsigned nloc = b.st[0], nx = b.st[1];
        if (nloc == 0u) { xcd_barrier_complete(bar, b.x, nloc, nx); b.st[0] = nloc; b.st[1] = nx; }
        const unsigned old = xb_add(&bar[XB_XSUB(b.x)], 1u);
        const unsigned gen = old / nloc;
        if (old + 1u == (gen + 1u) * nloc) {
            __builtin_amdgcn_fence(__ATOMIC_RELEASE, "agent");
            asm volatile("s_waitcnt vmcnt(0)" ::: "memory");
            const unsigned og = xb_add(&bar[XB_TOP], 1u);
            const unsigned tg = og / nx;
            if (og + 1u == (tg + 1u) * nx) xb_add(&bar[XB_TOPGEN], 1u);
            else XB_SPIN(xb_ld(&bar[XB_TOPGEN]) == tg, bar);
            __builtin_amdgcn_fence(__ATOMIC_ACQUIRE, "agent");
            xb_add(&bar[XB_XGEN(b.x)], 1u);
            asm volatile("s_waitcnt vmcnt(0)" ::: "memory");
        } else {
            XB_SPIN(xb_ld(&bar[XB_XGEN(b.x)]) == gen, bar);
            __builtin_amdgcn_fence(__ATOMIC_ACQUIRE, "agent");
            asm volatile("s_waitcnt vmcnt(0)" ::: "memory");
        }
    }
    __syncthreads();
}

struct Args { const float* in[22]; float* out; unsigned char* ws; int ph_lo, ph_hi, bar_region, pad; };
static_assert(sizeof(Args) == 22 * 8 + 8 + 8 + 16, "Args has no padding");
#define INP(i) (A.in[i])
struct Frame {
    LAS unsigned char* lds;
    volatile LAS unsigned* MISC;
    int tid, lane, wave;
    int vcu, G;
    unsigned char* ws;
    float* out;
};
#define WSP(T, off) ((T*)(F.ws + (off)))
__device__ __forceinline__ int lane_of(const Frame& F) { int l = F.tid & 63; asm volatile("" : "+v"(l)); return l; }

__device__ __forceinline__ float wave_sum(float v) {
#pragma unroll
    for (int o = 1; o < 64; o <<= 1) v += __shfl_xor(v, o);
    return v;
}

__device__ __forceinline__ void p0_transpose_item(const float* W, int N, bf16* WT, int ldk, int dst_row0, int k0, int n0, LAS float* scr, int lane) {
    f32x4 t[8];
#pragma unroll
    for (int i = 0; i < 8; ++i) t[i] = *(const f32x4*)(W + (size_t)(k0 + 8 * i + (lane >> 3)) * N + n0 + 4 * (lane & 7));
#pragma unroll
    for (int i = 0; i < 8; ++i) { LAS float* d = scr + (8 * i + (lane >> 3)) * 33 + 4 * (lane & 7); d[0] = t[i][0]; d[1] = t[i][1]; d[2] = t[i][2]; d[3] = t[i][3]; }
    LDS_WAIT(); asm volatile("" ::: "memory");
    const int c = lane & 7;
#pragma unroll
    for (int j = 0; j < 4; ++j) { const int n = (lane >> 3) + 8 * j; const LAS float* s = scr + (8 * c) * 33 + n;
        v4u o; o.x = pk2(s[0 * 33], s[1 * 33]); o.y = pk2(s[2 * 33], s[3 * 33]); o.z = pk2(s[4 * 33], s[5 * 33]); o.w = pk2(s[6 * 33], s[7 * 33]);
        *(GAS v4u*)(WT + (size_t)(dst_row0 + n) * ldk + k0 + 8 * c) = o; }
    LDS_WAIT(); asm volatile("" ::: "memory");
}
__device__ __forceinline__ void p0_transpose_item8(const float* W, int N, unsigned char* WT, int ldk, int dst_row0, int k0, int n0, float mul, LAS float* scr, int lane) {
    f32x4 t[8];
#pragma unroll
    for (int i = 0; i < 8; ++i) t[i] = *(const f32x4*)(W + (size_t)(k0 + 8 * i + (lane >> 3)) * N + n0 + 4 * (lane & 7));
#pragma unroll
    for (int i = 0; i < 8; ++i) { LAS float* d = scr + (8 * i + (lane >> 3)) * 33 + 4 * (lane & 7); d[0] = t[i][0] * mul; d[1] = t[i][1] * mul; d[2] = t[i][2] * mul; d[3] = t[i][3] * mul; }
    LDS_WAIT(); asm volatile("" ::: "memory");
    const int c = lane & 3;
#pragma unroll
    for (int j = 0; j < 2; ++j) { const int n = (lane >> 2) + 16 * j; const LAS float* s = scr + (16 * c) * 33 + n;
        v4u o; o.x = pg8::pk4_fp8(s[0 * 33], s[1 * 33], s[2 * 33], s[3 * 33]); o.y = pg8::pk4_fp8(s[4 * 33], s[5 * 33], s[6 * 33], s[7 * 33]);
        o.z = pg8::pk4_fp8(s[8 * 33], s[9 * 33], s[10 * 33], s[11 * 33]); o.w = pg8::pk4_fp8(s[12 * 33], s[13 * 33], s[14 * 33], s[15 * 33]);
        *(GAS v4u*)(WT + (size_t)(dst_row0 + n) * ldk + k0 + 16 * c) = o; }
    LDS_WAIT(); asm volatile("" ::: "memory");
}
__device__ __forceinline__ void p0_matrix_item(const float* W, int K, int N, bf16* WT, int mode, int item, LAS float* scr, int lane) {
    const int nblk = N / 32, kb = item / nblk, nb = item % nblk, k0 = 64 * kb, n0 = 32 * nb;
    const int dst = (mode == 0) ? n0 : (256 * (n0 >> 7) + (n0 & 127) + (mode == 2 ? 128 : 0));
    p0_transpose_item(W, N, WT, K, dst, k0, n0, scr, lane);
}
__device__ __forceinline__ void p0_matrix_item8(const float* W, int K, int N, unsigned char* WT, int mode, float mul, int item, LAS float* scr, int lane) {
    const int nblk = N / 32, kb = item / nblk, nb = item % nblk, k0 = 64 * kb, n0 = 32 * nb;
    const int dst = (mode == 0) ? n0 : (256 * (n0 >> 7) + (n0 & 127) + (mode == 2 ? 128 : 0));
    p0_transpose_item8(W, N, WT, K, dst, k0, n0, mul, scr, lane);
}
__device__ __forceinline__ void p0_prologue(Frame& F, const Args& A) {
    const int flane = lane_of(F);
    LAS float* scr = (LAS float*)(F.lds + F.wave * 16384);
    const int gw = F.vcu * NWAVES + F.wave, NGW = F.G * NWAVES;
    constexpr int I_F = (DM / 64) * (DFF / 32), I_D = (DFF / 64) * (DM / 32), I_IN = (DM / 64) * (INC / 32), I_OUT = (DM / 64) * (DM / 32), I_P = (HD / 64) * (HD / 32);
    constexpr int NITEMS = 4 * I_F + 2 * I_D + I_IN + I_OUT + 4 * I_P;
    for (int it = gw; it < NITEMS; it += NGW) {
        int r = it;
        if (r < I_F) { p0_matrix_item8(INP(9), DM, DFF, WSP(unsigned char, WS_W1), 1, WMUL_UP, r, scr, flane); continue; } r -= I_F;
        if (r < I_F) { p0_matrix_item8(INP(10), DM, DFF, WSP(unsigned char, WS_W1), 2, WMUL_UP, r, scr, flane); continue; } r -= I_F;
        if (r < I_D) { p0_matrix_item8(INP(11), DFF, DM, WSP(unsigned char, WS_W1D), 0, WMUL_DOWN, r, scr, flane); continue; } r -= I_D;
        if (r < I_IN) { p0_matrix_item(INP(13), DM, INC, WSP(bf16, WS_WIN), 0, r, scr, flane); continue; } r -= I_IN;
        if (r < I_OUT) { p0_matrix_item(INP(16), DM, DM, WSP(bf16, WS_WOUT), 0, r, scr, flane); continue; } r -= I_OUT;
        if (r < 4 * I_P) { const int g = r / I_P; p0_matrix_item(INP(14) + (size_t)g * HD * HD, HD, HD, WSP(bf16, WS_WPOOL) + (size_t)g * HD * HD, 0, r % I_P, scr, flane); continue; } r -= 4 * I_P;
        if (r < I_F) { p0_matrix_item8(INP(18), DM, DFF, WSP(unsigned char, WS_W2), 1, WMUL_UP, r, scr, flane); continue; } r -= I_F;
        if (r < I_F) { p0_matrix_item8(INP(19), DM, DFF, WSP(unsigned char, WS_W2), 2, WMUL_UP, r, scr, flane); continue; } r -= I_F;
        p0_matrix_item8(INP(20), DFF, DM, WSP(unsigned char, WS_W2D), 0, WMUL_DOWN, r, scr, flane);
    }
    const int gt = F.vcu * (NWAVES * 64) + F.tid, NT = F.G * NWAVES * 64;
    for (int i = gt; i < 160 * DM / 4; i += NT) {
        const int m = (4 * i) / DM, k = (4 * i) % DM;
        f32x4 v = (f32x4){0.f, 0.f, 0.f, 0.f};
        if (m < NB) v = *(const f32x4*)(INP(2) + (size_t)m * DM + k); else if (m < NMODROW) v = *(const f32x4*)(INP(3) + (size_t)(m - NB) * DM + k);
        v2u o; o.x = pk2(silu1(v[0]), silu1(v[1])); o.y = pk2(silu1(v[2]), silu1(v[3]));
        *(GAS v2u*)(WSP(bf16, WS_SC) + ((size_t)(((k >> 4) * 5 + (m >> 5)) * 64 + ((k >> 3) & 1) * 32 + (m & 31)) * 8 + (k & 7))) = o;
    }
    for (int i = gt; i < NPOS * 128; i += NT) {
        const int p = i >> 7, fi = i & 127;
        const float pos = (float)(p < SEQ ? p : PAST + (p - SEQ));
        const float inv = (float)exp(-(double)fi * (9.210340371976184 / 128.0));
        const float ang = pos * inv;
        double s, c; sincos((double)ang, &s, &c);
        WSP(float, WS_ROT)[2 * (size_t)i] = (float)c; WSP(float, WS_ROT)[2 * (size_t)i + 1] = (float)s;
    }
}

__device__ __forceinline__ void p1_adaln(Frame& F, const Args& A) {
    const int flane = lane_of(F);
    LAS float* red = (LAS float*)F.lds;
    const int lane = flane, w = F.wave, r = lane & 31, hh = lane >> 5, sl = w & 3, kh = w >> 2;
    for (int u = F.vcu; u < NMOD / 128; u += F.G) {
        const int n0 = (4 * u + sl) * 32;
        f32x16 acc[5];
#pragma unroll
        for (int t = 0; t < 5; ++t)
#pragma unroll
            for (int i = 0; i < 16; ++i) acc[t][i] = 0.f;
        const float* Wp = INP(6) + (size_t)(1024 * kh + 8 * hh) * NMOD + n0 + r;
        const bf16* Sp = WSP(bf16, WS_SC) + ((size_t)(64 * kh) * 5 * 64 + lane) * 8;
#pragma unroll 4
        for (int s = 0; s < 64; ++s) {
            float wv[8];
#pragma unroll
            for (int j = 0; j < 8; ++j) wv[j] = Wp[(size_t)(16 * s + j) * NMOD];
            v4u au; au.x = pk2(wv[0], wv[1]); au.y = pk2(wv[2], wv[3]); au.z = pk2(wv[4], wv[5]); au.w = pk2(wv[6], wv[7]);
            const bf16x8 a = __builtin_bit_cast(bf16x8, au);
#pragma unroll
            for (int t = 0; t < 5; ++t) {
                const bf16x8 b = *(const bf16x8*)(Sp + (size_t)((s * 5 + t) * 64) * 8);
                acc[t] = __builtin_amdgcn_mfma_f32_32x32x16_bf16(a, b, acc[t], 0, 0, 0);
            }
        }
        LAS float* rs = red + sl * (160 * 33);
        if (kh == 1) {
#pragma unroll
            for (int t = 0; t < 5; ++t)
#pragma unroll
                for (int i = 0; i < 16; ++i) rs[(32 * t + r) * 33 + (i & 3) + 8 * (i >> 2) + 4 * hh] = acc[t][i];
        }
        __syncthreads();
        if (kh == 0) {
#pragma unroll
            for (int t = 0; t < 5; ++t)
#pragma unroll
                for (int i = 0; i < 16; ++i) rs[(32 * t + r) * 33 + (i & 3) + 8 * (i >> 2) + 4 * hh] += acc[t][i];
        }
        __syncthreads();
        for (int idx = F.tid; idx < NMODROW * 128; idx += NWAVES * 64) { const int m = idx >> 7, c = idx & 127;
            WSP(float, WS_MODS)[(size_t)m * NMOD + 128 * u + c] = red[(c >> 5) * (160 * 33) + m * 33 + (c & 31)] + INP(7)[128 * u + c]; }
        __syncthreads();
    }
}

template <bool OUT8>
__device__ __forceinline__ void norm_mod(Frame& F, const float* srcP, const float* srcS, const float* gain, int sub, bf16* Hd, const float* slab, int np, float* xs_out) {
    const int flane = lane_of(F);
    const int gw = F.vcu * NWAVES + F.wave, NGW = F.G * NWAVES;
    for (int mi = gw; mi < MTOK; mi += NGW) {
        const int m = (mi + MS) % MTOK;
        const float* xr = (m < MP) ? srcP + (size_t)m * DM : srcS + (size_t)(m - MP) * DM;
        const float* sh = WSP(float, WS_MODS) + (size_t)pg8::modrow_of(m) * NMOD + (size_t)(3 * sub) * DM; const float* sc = sh + DM;
        f32x4 v[8]; float ss = 0.f;
#pragma unroll
        for (int j = 0; j < 8; ++j) v[j] = *(const f32x4*)(xr + 4 * (flane + 64 * j));
        if (m >= MP && np > 0) {
            for (int p = 0; p < np; ++p) { const float* sp = slab + ((size_t)p * MS + (m - MP)) * DM;
#pragma unroll
                for (int j = 0; j < 8; ++j) v[j] += *(const f32x4*)(sp + 4 * (flane + 64 * j)); }
#pragma unroll
            for (int j = 0; j < 8; ++j) *(f32x4*)(xs_out + (size_t)(m - MP) * DM + 4 * (flane + 64 * j)) = v[j];
        }
#pragma unroll
        for (int j = 0; j < 8; ++j) ss += (v[j][0] * v[j][0] + v[j][1] * v[j][1]) + (v[j][2] * v[j][2] + v[j][3] * v[j][3]);
        const float rstd = 1.0f / sqrtf(wave_sum(ss) * (1.0f / DM) + EPS);
#pragma unroll
        for (int j = 0; j < 8; ++j) { const int k = 4 * (flane + 64 * j);
            const f32x4 g4 = *(const f32x4*)(gain + k), s4 = *(const f32x4*)(sc + k), h4 = *(const f32x4*)(sh + k);
            const f32x4 o = (v[j] * rstd) * g4 * (s4 + 1.0f) + h4;
            if (OUT8) { *(GAS unsigned*)((unsigned char*)Hd + (size_t)m * DM + k) = pg8::pk4_fp8(o[0], o[1], o[2], o[3]); }
            else { v2u pk; pk.x = pk2(o[0], o[1]); pk.y = pk2(o[2], o[3]); *(GAS v2u*)(Hd + (size_t)m * DM + k) = pk; } }
    }
}
__device__ __forceinline__ void final_norm(Frame& F, const Args& A, const float* slab, int np) {
    const int flane = lane_of(F);
    const int gw = F.vcu * NWAVES + F.wave, NGW = F.G * NWAVES;
    for (int mi = gw; mi < MTOK; mi += NGW) {
        const int m = (mi + MS) % MTOK;
        const float* xr = WSP(float, WS_X) + (size_t)m * DM;
        float* yr = F.out + ((m < MP) ? O_YP + (size_t)m * DM : O_YS + (size_t)(m - MP) * DM);
        f32x4 v[8]; float ss = 0.f;
#pragma unroll
        for (int j = 0; j < 8; ++j) v[j] = *(const f32x4*)(xr + 4 * (flane + 64 * j));
        if (m >= MP) {
            for (int p = 0; p < np; ++p) { const float* sp = slab + ((size_t)p * MS + (m - MP)) * DM;
#pragma unroll
                for (int j = 0; j < 8; ++j) v[j] += *(const f32x4*)(sp + 4 * (flane + 64 * j)); }
        }
#pragma unroll
        for (int j = 0; j < 8; ++j) ss += (v[j][0] * v[j][0] + v[j][1] * v[j][1]) + (v[j][2] * v[j][2] + v[j][3] * v[j][3]);
        const float rstd = 1.0f / sqrtf(wave_sum(ss) * (1.0f / DM) + EPS);
#pragma unroll
        for (int j = 0; j < 8; ++j) { const int k = 4 * (flane + 64 * j); const f32x4 g4 = *(const f32x4*)(INP(21) + k); *(f32x4*)(yr + k) = (v[j] * rstd) * g4; }
    }
}

#define MFMA16(a, b, c) __builtin_amdgcn_mfma_f32_16x16x32_bf16(a, b, c, 0, 0, 0)
__device__ __forceinline__ float log2_gamma(int h) { return h == 0 ? -0.045803689613124747f : h == 1 ? -0.022720076500083405f : h == 2 ? -0.011315313227834146f : -0.0056465631411130581f; }
constexpr int TP = 136;

__device__ __forceinline__ void retA_unit(Frame& F, int unit) {
    const int flane = lane_of(F);
    const int half = unit & 1, c = (unit >> 1) & 15, bh = unit >> 5, b = bh >> 2, h = bh & 3;
    const int m0 = b * SEQ + c * CH;
    const int tid = F.tid, lane = flane, w = F.wave, fr = lane & 15, fq = lane >> 4;
    LAS bf16* VT = (LAS bf16*)F.lds; LAS bf16* KT = VT + 256 * TP; LAS bf16* PP = KT + 128 * TP;
    const bf16* Qg = WSP(bf16, WS_QKVG) + (size_t)m0 * RW + h * HD;
    const bf16* Kg = Qg + (size_t)MTOK * RW; const bf16* Vg = Kg + (size_t)MTOK * RW;
    const float l2g = log2_gamma(h);
#pragma unroll 4
    for (int it = 0; it < 8; ++it) { const int idx = it * 512 + tid, tok = idx & 127, ch = idx >> 7;
        const bf16x8 v = *(const bf16x8*)(Vg + (size_t)tok * RW + ch * 8);
#pragma unroll
        for (int e = 0; e < 8; ++e) VT[(ch * 8 + e) * TP + tok] = (bf16)v[e]; }
#pragma unroll 4
    for (int it = 0; it < 4; ++it) { const int idx = it * 512 + tid, tok = idx & 127, ch = idx >> 7;
        const bf16x8 k = *(const bf16x8*)(Kg + (size_t)tok * RW + half * 128 + ch * 8);
        const float kd = __builtin_amdgcn_exp2f((float)(127 - tok) * l2g);
#pragma unroll
        for (int e = 0; e < 8; ++e) KT[(ch * 8 + e) * TP + tok] = (bf16)f2bf(bf2f((bf16)k[e]) * kd); }
    {
        f32x4 acc[4];
#pragma unroll
        for (int i = 0; i < 4; ++i) acc[i] = (f32x4){0.f, 0.f, 0.f, 0.f};
        if (16 * w < 64 * half + 64) {
#pragma unroll 2
            for (int s = 0; s < 8; ++s) {
                const bf16x8 bb = *(const bf16x8*)(Kg + (size_t)(16 * w + fr) * RW + 32 * s + 8 * fq);
#pragma unroll
                for (int i = 0; i < 4; ++i) { const bf16x8 aa = *(const bf16x8*)(Qg + (size_t)(64 * half + 16 * i + fr) * RW + 32 * s + 8 * fq); acc[i] = MFMA16(aa, bb, acc[i]); }
            }
        }
#pragma unroll
        for (int i = 0; i < 4; ++i)
#pragma unroll
            for (int r = 0; r < 4; ++r) { const int nl = 16 * i + 4 * fq + r, n = 64 * half + nl, m = 16 * w + fr, dn = n - m;
                const float val = dn >= 0 ? acc[i][r] * __builtin_amdgcn_exp2f((float)dn * l2g) : 0.f;
                PP[nl * TP + m] = (bf16)f2bf(val); }
    }
    __syncthreads();
    {
        f32x4 o[2][4];
#pragma unroll
        for (int j = 0; j < 2; ++j)
#pragma unroll
            for (int i = 0; i < 4; ++i) o[j][i] = (f32x4){0.f, 0.f, 0.f, 0.f};
#pragma unroll
        for (int s = 0; s < 4; ++s) {
            bf16x8 a[4];
#pragma unroll
            for (int i = 0; i < 4; ++i) a[i] = *(const LAS bf16x8*)(PP + (16 * i + fr) * TP + 32 * s + 8 * fq);
#pragma unroll
            for (int j = 0; j < 2; ++j) { const bf16x8 bb = *(const LAS bf16x8*)(VT + (16 * (2 * w + j) + fr) * TP + 32 * s + 8 * fq);
#pragma unroll
                for (int i = 0; i < 4; ++i) o[j][i] = MFMA16(a[i], bb, o[j][i]); }
        }
#pragma unroll
        for (int j = 0; j < 2; ++j)
#pragma unroll
            for (int i = 0; i < 4; ++i)
#pragma unroll
                for (int r = 0; r < 4; ++r) WSP(float, WS_OI)[(size_t)(m0 + 64 * half + 16 * i + 4 * fq + r) * RW + h * HD + 16 * (2 * w + j) + fr] = o[j][i][r];
    }
    {
        f32x4 ua[2][8];
#pragma unroll
        for (int i = 0; i < 2; ++i)
#pragma unroll
            for (int j = 0; j < 8; ++j) ua[i][j] = (f32x4){0.f, 0.f, 0.f, 0.f};
#pragma unroll
        for (int s = 0; s < 4; ++s) {
            bf16x8 a[2];
#pragma unroll
            for (int i = 0; i < 2; ++i) a[i] = *(const LAS bf16x8*)(VT + (16 * (2 * w + i) + fr) * TP + 32 * s + 8 * fq);
#pragma unroll
            for (int j = 0; j < 8; ++j) { const bf16x8 bb = *(const LAS bf16x8*)(KT + (16 * j + fr) * TP + 32 * s + 8 * fq);
#pragma unroll
                for (int i = 0; i < 2; ++i) ua[i][j] = MFMA16(a[i], bb, ua[i][j]); }
        }
        float* UTu = WSP(float, WS_UT) + (size_t)(bh * NCH + c) * HD * HD;
#pragma unroll
        for (int i = 0; i < 2; ++i)
#pragma unroll
            for (int j = 0; j < 8; ++j)
#pragma unroll
                for (int r = 0; r < 4; ++r) UTu[(size_t)(16 * (2 * w + i) + 4 * fq + r) * HD + 128 * half + 16 * j + fr] = ua[i][j][r];
    }
    __syncthreads();
}

__device__ __forceinline__ void retC_unit(Frame& F, int unit) {
    const int flane = lane_of(F);
    const int c = unit & 15, bh = unit >> 4, b = bh >> 2, h = bh & 3;
    const int m0 = b * SEQ + c * CH;
    const int lane = flane, w = F.wave, fr = lane & 15, fq = lane >> 4;
    const bf16* Qg = WSP(bf16, WS_QKVG) + (size_t)m0 * RW + h * HD;
    const bf16* Gg = Qg + (size_t)3 * MTOK * RW;
    const float l2g = log2_gamma(h);
    f32x4 acc[16];
#pragma unroll
    for (int j = 0; j < 16; ++j) acc[j] = (f32x4){0.f, 0.f, 0.f, 0.f};
    if (c > 0) {
        const bf16* STc = WSP(bf16, WS_ST) + (size_t)(bh * NCH + c) * HD * HD;
#pragma unroll 2
        for (int s = 0; s < 8; ++s) {
            const bf16x8 aa = *(const bf16x8*)(Qg + (size_t)(16 * w + fr) * RW + 32 * s + 8 * fq);
#pragma unroll
            for (int j = 0; j < 16; ++j) { const bf16x8 bb = *(const bf16x8*)(STc + (size_t)(16 * j + fr) * HD + 32 * s + 8 * fq); acc[j] = MFMA16(aa, bb, acc[j]); }
        }
    }
#pragma unroll
    for (int r = 0; r < 4; ++r) {
        const int n = 16 * w + 4 * fq + r; const size_t row = (size_t)(m0 + n);
        const float qd = __builtin_amdgcn_exp2f((float)(n + 1) * l2g);
        float ss = 0.f;
#pragma unroll
        for (int j = 0; j < 16; ++j) { const float o = WSP(float, WS_OI)[row * RW + h * HD + 16 * j + fr] + qd * acc[j][r]; acc[j][r] = o; ss += o * o; }
        ss += __shfl_xor(ss, 1); ss += __shfl_xor(ss, 2); ss += __shfl_xor(ss, 4); ss += __shfl_xor(ss, 8);
        const float rs = 1.0f / sqrtf(ss * (1.0f / HD) + EPS);
#pragma unroll
        for (int j = 0; j < 16; ++j) { const float g = bf2f(Gg[(size_t)n * RW + 16 * j + fr]); WSP(bf16, WS_MIX)[row * DM + PW + h * HD + 16 * j + fr] = (bf16)f2bf(silu1(g) * acc[j][r] * rs); }
    }
}

__device__ __forceinline__ void retS_unit(Frame& F, const Args& A, int unit) {
    const int flane = lane_of(F);
    const int b = unit >> 2, h = unit & 3, row0 = MP + 4 * b;
    const int tid = F.tid, lane = flane, w = F.wave;
    LAS float* qs = (LAS float*)F.lds; LAS float* kr = qs + 1024; LAS float* vs = kr + 1024; LAS float* red = vs + 1024; LAS float* dots = red + 8192;
    const bf16* Qg = WSP(bf16, WS_QKVG); const bf16* Kg = Qg + (size_t)MTOK * RW; const bf16* Vg = Kg + (size_t)MTOK * RW; const bf16* Gg = Vg + (size_t)MTOK * RW;
    const float l2g = log2_gamma(h);
    for (int i = tid; i < 1024; i += NWAVES * 64) { const int t = i >> 8, d = i & 255; const size_t off = (size_t)(row0 + t) * RW + h * HD + d;
        qs[i] = bf2f(Qg[off]); kr[i] = bf2f(Kg[off]); vs[i] = bf2f(Vg[off]); }
    __syncthreads();
#pragma unroll
    for (int jj = 0; jj < 2; ++jj) { const int p = 2 * w + jj, t = p >> 2, m = p & 3;
        const f32x4 a = *(const LAS f32x4*)(qs + t * 256 + 4 * lane), k4 = *(const LAS f32x4*)(kr + m * 256 + 4 * lane);
        const float d = wave_sum((a[0] * k4[0] + a[1] * k4[1]) + (a[2] * k4[2] + a[3] * k4[3]));
        if (lane == 0) dots[p] = d; }
    const f32x4* S0 = (const f32x4*)(INP(5) + (size_t)unit * HD * HD);
    f32x4* S1 = (f32x4*)(F.out + O_RETS + (size_t)unit * HD * HD);
    f32x4 v4[4], oq[4];
#pragma unroll
    for (int t = 0; t < 4; ++t) { v4[t] = *(const LAS f32x4*)(vs + t * 256 + 4 * lane); oq[t] = (f32x4){0.f, 0.f, 0.f, 0.f}; }
    const float cdec = __builtin_amdgcn_exp2f(4.0f * l2g);
    const float kd0 = __builtin_amdgcn_exp2f(3.0f * l2g), kd1 = __builtin_amdgcn_exp2f(2.0f * l2g), kd2 = __builtin_amdgcn_exp2f(l2g);
    for (int dk0 = 32 * w; dk0 < 32 * w + 32; dk0 += 8) {
        f32x4 s[8];
#pragma unroll
        for (int u = 0; u < 8; ++u) s[u] = S0[(size_t)(dk0 + u) * 64 + lane];
#pragma unroll
        for (int u = 0; u < 8; ++u) { const int dk = dk0 + u;
            const float q0 = qs[dk], q1 = qs[256 + dk], q2 = qs[512 + dk], q3 = qs[768 + dk];
            const float k0 = kr[dk] * kd0, k1 = kr[256 + dk] * kd1, k2 = kr[512 + dk] * kd2, k3 = kr[768 + dk];
            oq[0] += s[u] * q0; oq[1] += s[u] * q1; oq[2] += s[u] * q2; oq[3] += s[u] * q3;
            S1[(size_t)dk * 64 + lane] = s[u] * cdec + v4[0] * k0 + v4[1] * k1 + v4[2] * k2 + v4[3] * k3; }
    }
#pragma unroll
    for (int t = 0; t < 4; ++t) *(LAS f32x4*)(red + (w * 4 + t) * 256 + 4 * lane) = oq[t];
    __syncthreads();
    if (w < 4) {
        const int t = w;
        f32x4 o = (f32x4){0.f, 0.f, 0.f, 0.f};
#pragma unroll
        for (int ww = 0; ww < 8; ++ww) o += *(const LAS f32x4*)(red + (ww * 4 + t) * 256 + 4 * lane);
        o = o * __builtin_amdgcn_exp2f((float)(t + 1) * l2g);
#pragma unroll
        for (int m = 0; m < 4; ++m) if (m <= t) o += v4[m] * (dots[t * 4 + m] * __builtin_amdgcn_exp2f((float)(t - m) * l2g));
        const float ss = wave_sum((o[0] * o[0] + o[1] * o[1]) + (o[2] * o[2] + o[3] * o[3]));
        const float rs = 1.0f / sqrtf(ss * (1.0f / HD) + EPS);
        const size_t row = (size_t)(row0 + t);
        const v2u gp = *(const v2u*)(Gg + row * RW + h * HD + 4 * lane);
        const float g0 = bf2f((bf16)(gp.x & 0xffffu)), g1 = bf2f((bf16)(gp.x >> 16)), g2 = bf2f((bf16)(gp.y & 0xffffu)), g3 = bf2f((bf16)(gp.y >> 16));
        v2u pk; pk.x = pk2(silu1(g0) * o[0] * rs, silu1(g1) * o[1] * rs); pk.y = pk2(silu1(g2) * o[2] * rs, silu1(g3) * o[3] * rs);
        *(GAS v2u*)(WSP(bf16, WS_MIX) + row * DM + PW + h * HD + 4 * lane) = pk;
    }
    __syncthreads();
}

__device__ __forceinline__ void scan_states(Frame& F) {
    const int gt = F.vcu * (NWAVES * 64) + F.tid, NT = F.G * NWAVES * 64;
    for (int i = gt; i < 16 * 16384; i += NT) {
        const int bh = i >> 14, e4 = i & 16383, h = bh & 3;
        const f32x4* up = (const f32x4*)WSP(float, WS_UT) + (size_t)bh * NCH * 16384 + e4;
        f32x4 uv[16];
#pragma unroll
        for (int c = 0; c < 16; ++c) uv[c] = up[(size_t)c * 16384];
        const float g128 = __builtin_amdgcn_exp2f(128.0f * log2_gamma(h));
        f32x4 S = (f32x4){0.f, 0.f, 0.f, 0.f};
#pragma unroll
        for (int c = 0; c < 16; ++c) {
            S = S * g128 + uv[c];
            if (c < 15) { v2u pk; pk.x = pk2(S[0], S[1]); pk.y = pk2(S[2], S[3]); *(GAS v2u*)(WSP(bf16, WS_ST) + ((size_t)(bh * NCH + c + 1) * 16384 + e4) * 4) = pk; }
        }
        const int dv = (4 * e4) >> 8, dk = (4 * e4) & 255;
        float* rp = F.out + O_RETP + (size_t)bh * HD * HD + dv;
#pragma unroll
        for (int q = 0; q < 4; ++q) rp[(size_t)(dk + q) * HD] = S[q];
    }
}

__device__ __forceinline__ void pool_prompt_item(Frame& F, int item, int q) {
    const int b = item >> 7, t0 = (item & 127) * 16, g = q >> 6, wn = 2 << g;
    const f32x4* U4 = (const f32x4*)(WSP(float, WS_U) + (size_t)b * SEQ * PW) + q;
    f32x4 hv[15], cur[16], old[16];
#pragma unroll
    for (int j = 1; j < 16; ++j) { const int t = t0 - j; const bool ok = (j < wn) && (t >= 0); hv[j - 1] = U4[(size_t)(ok ? t : t0) * 256] * (ok ? 1.0f : 0.0f); }
#pragma unroll
    for (int i = 0; i < 16; ++i) { const int t = t0 + i, to = t - wn; const bool ok = (i >= 1) && (to >= 0);
        cur[i] = U4[(size_t)t * 256]; old[i] = U4[(size_t)(ok ? to : t) * 256] * (ok ? 1.0f : 0.0f); }
    f32x4 sum = (f32x4){0.f, 0.f, 0.f, 0.f};
#pragma unroll
    for (int j = 0; j < 15; ++j) sum += hv[j];
#pragma unroll
    for (int i = 0; i < 16; ++i) {
        const int t = t0 + i;
        sum += cur[i]; sum -= old[i];
        const float cnt = (float)((t + 1 < wn) ? (t + 1) : wn);
        const f32x4 mv = sum / cnt - cur[i];
        v2u pk; pk.x = pk2(mv[0], mv[1]); pk.y = pk2(mv[2], mv[3]);
        *(GAS v2u*)(WSP(bf16, WS_PM) + ((size_t)(b * SEQ + t) * PW + 4 * q)) = pk;
    }
}
__device__ __forceinline__ void pool_sample_item(Frame& F, const Args& A, int b, int q) {
    const int g = q >> 6, wn = 2 << g;
    const f32x4* SP4 = (const f32x4*)(INP(4) + (size_t)b * 15 * PW) + q;
    const f32x4* US4 = (const f32x4*)(WSP(float, WS_U) + (size_t)(MP + 4 * b) * PW) + q;
    for (int t = 0; t < 4; ++t) {
        f32x4 sum = (f32x4){0.f, 0.f, 0.f, 0.f};
        for (int j = 0; j < wn; ++j) { const int i = 15 + t - j; sum += (i < 15) ? SP4[(size_t)i * 256] : US4[(size_t)(i - 15) * 256]; }
        const f32x4 cur = US4[(size_t)t * 256];
        const f32x4 mv = sum / (float)wn - cur;
        v2u pk; pk.x = pk2(mv[0], mv[1]); pk.y = pk2(mv[2], mv[3]);
        *(GAS v2u*)(WSP(bf16, WS_PM) + ((size_t)(MP + 4 * b + t) * PW + 4 * q)) = pk;
    }
}
__device__ __forceinline__ void pool_phase(Frame& F, const Args& A) {
    const int q = F.tid & 255, sub = F.tid >> 8;
    for (int bi = F.vcu; bi < 256; bi += F.G) pool_prompt_item(F, 2 * bi + sub, q);
    for (int bi = F.G - 1 - F.vcu; bi < 64; bi += F.G) pool_sample_item(F, A, 2 * bi + sub, q);
    const int gt = F.vcu * (NWAVES * 64) + F.tid, NT = F.G * NWAVES * 64;
    f32x4* o4 = (f32x4*)F.out;
    for (int i = gt; i < NB * 15 * 256; i += NT) { const int qq = i & 255, r = (i >> 8) % 15, b = (i >> 8) / 15;
        o4[O_POOLP / 4 + i] = ((const f32x4*)WSP(float, WS_U))[((size_t)b * SEQ + (SEQ - 15) + r) * 256 + qq]; }
    for (int i = gt; i < DB * 15 * 256; i += NT) { const int qq = i & 255, r = (i >> 8) % 15, b = (i >> 8) / 15;
        o4[O_POOLS / 4 + i] = (r < 11) ? ((const f32x4*)INP(4))[((size_t)b * 15 + r + 4) * 256 + qq] : ((const f32x4*)WSP(float, WS_U))[((size_t)(MP + 4 * b) + (r - 11)) * 256 + qq]; }
}


__global__ void __launch_bounds__(NWAVES * 64, 2) mk_fwd(Args args) {
    extern __shared__ __attribute__((aligned(16))) unsigned char lds[];
    Frame F;
    F.lds = (LAS unsigned char*)lds;
    F.MISC = (volatile LAS unsigned*)(F.lds + MISC_OFF);
    F.tid = threadIdx.x; F.wave = __builtin_amdgcn_readfirstlane(F.tid >> 6);
    F.G = gridDim.x; { const int bx = blockIdx.x; F.vcu = (F.G % 8 == 0) ? (bx % 8) * (F.G / 8) + bx / 8 : bx; }
    unsigned char* ws = args.ws; const Args& A = args;
    F.out = args.out;
    F.ws = ws;
    for (int u = F.tid; u < (LDS_BYTES - LDSCTL_OFF) / 4; u += NWAVES * 64) ((LAS unsigned*)(F.lds + LDSCTL_OFF))[u] = 0u;
    __syncthreads();
    if (!MK_PER_PHASE) (void)xcd_barrier_post((unsigned*)(ws + WS_CTL) + CW_BAR + args.bar_region * XCD_BAR_WORDS, F.MISC + 8);
    const int lo = args.ph_lo, hi = args.ph_hi;
#ifndef PH_MASK
#define PH_MASK 0x7fff
#endif
#define IN(k) (((PH_MASK >> (k)) & 1) && lo <= (k) && (k) < hi)
#ifndef REP_MASK
#define REP_MASK 0
#endif
#define NREP(k) ((((REP_MASK) >> (k)) & 1) ? 2 : 1)
#define SEAM(k) do { if (!MK_PER_PHASE && (IN((k) + 1) || rep_ + 1 < NREP(k))) { XcdBarrier bar_; bar_.bar = (unsigned*)(A.ws + WS_CTL) + CW_BAR + A.bar_region * XCD_BAR_WORDS; bar_.x = xb_xcc_id(); bar_.st = (volatile LAS unsigned*)(F.lds + MISC_OFF) + 8; xcd_barrier(bar_); } } while (0)

    if (IN(0)) for (int rep_ = 0; rep_ < NREP(0); ++rep_) { p0_prologue(F, A); SEAM(0); }
    if (IN(1)) for (int rep_ = 0; rep_ < NREP(1); ++rep_) { p1_adaln(F, A); SEAM(1); }
    if (IN(2)) for (int rep_ = 0; rep_ < NREP(2); ++rep_) { norm_mod<true>(F, INP(0), INP(1), INP(8), 0, WSP(bf16, WS_H), nullptr, 0, nullptr); SEAM(2); }
    if (IN(3)) for (int rep_ = 0; rep_ < NREP(3); ++rep_) {
        pg8::Gemm g{WSP(bf16, WS_H), WSP(bf16, WS_W1), DM, DM, DM, 0, 0, WSC_UP}; pg8::StaticOrder S; S.init(MTOK, 2 * DFF, F.G, (int)blockIdx.x);
        pg8::EpiSwiglu E{WSP(unsigned char, WS_ACT)};
        pg8::gemm_phase8<pg8::EpiSwiglu, pg8::StaticOrder, true>(F.lds, g, S, E);
        SEAM(3);
    }
    if (IN(4)) for (int rep_ = 0; rep_ < NREP(4); ++rep_) {
        pg8::Gemm g{WSP(bf16, WS_ACT), WSP(bf16, WS_W1D), DFF, DFF, DFF, 0, KP_DOWN, WSC_DOWN}; pg8::SplitOrder S; S.init(DM, DFF / KP_DOWN, F.G, (int)blockIdx.x);
        pg8::EpiResid E{INP(0), INP(1), WSP(float, WS_X), WSP(float, WS_MODS) + 2 * DM, 0.5f};
        pg8::gemm_phase8<pg8::EpiResid, pg8::SplitOrder, true>(F.lds, g, S, E);
        SEAM(4);
    }
    if (IN(5)) for (int rep_ = 0; rep_ < NREP(5); ++rep_) { norm_mod<false>(F, WSP(float, WS_X), INP(1), INP(12), 1, WSP(bf16, WS_H), WSP(float, WS_SLAB), DFF / KP_DOWN, WSP(float, WS_X) + (size_t)MP * DM); SEAM(5); }
    if (IN(6)) for (int rep_ = 0; rep_ < NREP(6); ++rep_) {
        pg8::Gemm g{WSP(bf16, WS_H), WSP(bf16, WS_WIN), DM, DM, DM, 0, 0, 0}; pg8::StaticOrder S; S.init(MTOK, INC, F.G, (int)blockIdx.x);
        pg8::EpiWin E{WSP(float, WS_U), WSP(bf16, WS_QKVG), WSP(float, WS_ROT)};
        pg8::gemm_phase<pg8::EpiWin, pg8::StaticOrder, true>(F.lds, g, S, E);
        SEAM(6);
    }
    if (IN(7)) for (int rep_ = 0; rep_ < NREP(7); ++rep_) {
        for (int u = F.vcu; u < NB * NH * NCH * 2; u += F.G) retA_unit(F, u);
        pool_phase(F, A);
        SEAM(7);
    }
    if (IN(8)) for (int rep_ = 0; rep_ < NREP(8); ++rep_) {
        {
            pg8::Gemm g{WSP(bf16, WS_PM), WSP(bf16, WS_WPOOL), PW, HD, HD, HD, 0, 0}; pg8::StaticOrder S; S.init(MTOK, PW, F.G, (int)blockIdx.x);
            pg8::EpiPool E{WSP(bf16, WS_MIX), INP(15)};
            pg8::gemm_phase<pg8::EpiPool, pg8::StaticOrder, true>(F.lds, g, S, E);
        }
        __syncthreads();
        { int t2 = threadIdx.x; asm volatile("" : "+v"(t2)); F.tid = t2; }
        for (int u = F.vcu; u < DB * NH; u += F.G) retS_unit(F, A, u);
        scan_states(F);
        SEAM(8);
    }
    if (IN(9)) for (int rep_ = 0; rep_ < NREP(9); ++rep_) { for (int u = F.vcu; u < NB * NH * NCH; u += F.G) retC_unit(F, u); SEAM(9); }
    if (IN(10)) for (int rep_ = 0; rep_ < NREP(10); ++rep_) {
        pg8::Gemm g{WSP(bf16, WS_MIX), WSP(bf16, WS_WOUT), DM, DM, DM, 0, KP_OUT, 0}; pg8::SplitOrder S; S.init(DM, DM / KP_OUT, F.G, (int)blockIdx.x);
        pg8::EpiResid E{WSP(float, WS_X), WSP(float, WS_X) + (size_t)MP * DM, WSP(float, WS_X), WSP(float, WS_MODS) + 5 * DM, 1.0f};
        pg8::gemm_phase<pg8::EpiResid, pg8::SplitOrder, true>(F.lds, g, S, E);
        SEAM(10);
    }
    if (IN(11)) for (int rep_ = 0; rep_ < NREP(11); ++rep_) { norm_mod<true>(F, WSP(float, WS_X), WSP(float, WS_X) + (size_t)MP * DM, INP(17), 2, WSP(bf16, WS_H), WSP(float, WS_SLAB), DM / KP_OUT, WSP(float, WS_X) + (size_t)MP * DM); SEAM(11); }
    if (IN(12)) for (int rep_ = 0; rep_ < NREP(12); ++rep_) {
        pg8::Gemm g{WSP(bf16, WS_H), WSP(bf16, WS_W2), DM, DM, DM, 0, 0, WSC_UP}; pg8::StaticOrder S; S.init(MTOK, 2 * DFF, F.G, (int)blockIdx.x);
        pg8::EpiSwiglu E{WSP(unsigned char, WS_ACT)};
        pg8::gemm_phase8<pg8::EpiSwiglu, pg8::StaticOrder, true>(F.lds, g, S, E);
        SEAM(12);
    }
    if (IN(13)) for (int rep_ = 0; rep_ < NREP(13); ++rep_) {
        pg8::Gemm g{WSP(bf16, WS_ACT), WSP(bf16, WS_W2D), DFF, DFF, DFF, 0, KP_DOWN, WSC_DOWN}; pg8::SplitOrder S; S.init(DM, DFF / KP_DOWN, F.G, (int)blockIdx.x);
        pg8::EpiResid E{WSP(float, WS_X), WSP(float, WS_X) + (size_t)MP * DM, WSP(float, WS_X), WSP(float, WS_MODS) + 8 * DM, 0.5f};
        pg8::gemm_phase8<pg8::EpiResid, pg8::SplitOrder, true>(F.lds, g, S, E);
        SEAM(13);
    }
    if (IN(14)) for (int rep_ = 0; rep_ < NREP(14); ++rep_) { final_norm(F, A, WSP(float, WS_SLAB), DFF / KP_DOWN); if (rep_ + 1 < NREP(14)) { SEAM(14); } }
#undef IN
#undef SEAM
}

extern "C" void kernel_launch(void* const* d_in, const int* in_sizes, int n_in, void* d_out, int out_size, void* d_ws, size_t ws_size, hipStream_t stream) {
    static int grid = 0;
    if (grid == 0) {
        if (n_in != 22 || (size_t)out_size != O_END || ws_size < WS_END) { fprintf(stderr, "kernel_launch: unexpected shapes (n_in %d out %d ws %zu)\n", n_in, out_size, ws_size); grid = -1; return; }
        int dev = 0, cus = 0, per_cu = 0;
        if (hipGetDevice(&dev) != hipSuccess || hipDeviceGetAttribute(&cus, hipDeviceAttributeMultiprocessorCount, dev) != hipSuccess) { grid = -1; return; }
        if (hipFuncSetAttribute((const void*)mk_fwd, hipFuncAttributeMaxDynamicSharedMemorySize, LDS_BYTES) != hipSuccess) { fprintf(stderr, "kernel_launch: hipFuncSetAttribute failed\n"); grid = -1; return; }
        if (hipOccupancyMaxActiveBlocksPerMultiprocessor(&per_cu, (const void*)mk_fwd, NWAVES * 64, LDS_BYTES) != hipSuccess || per_cu < 1) { fprintf(stderr, "kernel_launch: occupancy query says %d blocks/CU\n", per_cu); (void)hipGetLastError(); grid = -1; return; }
        grid = cus;
    }
    if (grid < 0) return;
    (void)hipMemsetAsync((char*)d_ws + WS_CTL, 0, CTL_ZERO_BYTES, stream);
    Args a{};
    for (int i = 0; i < 22; ++i) a.in[i] = (const float*)d_in[i];
    a.out = (float*)d_out; a.ws = (unsigned char*)d_ws;
#if MK_PER_PHASE
    for (int p = 0; p < N_PHASES; ++p) { a.ph_lo = p; a.ph_hi = p + 1; hipLaunchKernelGGL(mk_fwd, dim3(grid), dim3(NWAVES * 64), LDS_BYTES, stream, a); }
#else
    a.ph_lo = 0; a.ph_hi = N_PHASES;
    hipLaunchKernelGGL(mk_fwd, dim3(grid), dim3(NWAVES * 64), LDS_BYTES, stream, a);
#ifdef PROBE_LO
    a.ph_lo = PROBE_LO; a.ph_hi = PROBE_HI; a.bar_region = 1;
    hipLaunchKernelGGL(mk_fwd, dim3(grid), dim3(NWAVES * 64), LDS_BYTES, stream, a);
#endif
#endif
}
```

```cpp
#include <hip/hip_runtime.h>
#include <cstdio>
#include <cstdint>
#include <cmath>

#ifndef MK_PER_PHASE
#define MK_PER_PHASE 0
#endif

constexpr int DM = 2048, DFF = 5632, SEQ = 2048, NB = 4, DB = 128, DS = 4;
constexpr int MP = NB * SEQ;
constexpr int MS = DB * DS;
constexpr int MTOK = MP + MS;
constexpr int NMODROW = NB + DB;
constexpr int NMOD = 9 * DM;
constexpr int PW = 1024, RW = 1024, HD = 256, NH = 4, CH = 128, NCH = SEQ / CH;
constexpr int INC = PW + 4 * RW;
constexpr int PAST = 16384;
constexpr float EPS = 1e-6f;
constexpr int NPOS = SEQ + DS;

constexpr size_t O_YP = 0, O_YS = (size_t)MP * DM, O_POOLP = O_YS + (size_t)MS * DM, O_RETP = O_POOLP + (size_t)NB * 15 * PW,
                 O_POOLS = O_RETP + (size_t)NB * NH * HD * HD, O_RETS = O_POOLS + (size_t)DB * 15 * PW, O_END = O_RETS + (size_t)DB * NH * HD * HD;

constexpr size_t SLAB_MINUS_X = (size_t)(568 - 210) << 20;
constexpr size_t MODSB_DELTA = ((size_t)(612 - 5) << 20) / 4;

namespace pg8 {
#define PG8_LAS __attribute__((address_space(3)))
typedef unsigned short bf16_t;
typedef short bf16x8 __attribute__((ext_vector_type(8)));
typedef float f32x4 __attribute__((ext_vector_type(4)));
typedef unsigned u32x4 __attribute__((ext_vector_type(4)));
typedef unsigned u32x2 __attribute__((ext_vector_type(2)));
constexpr int BM = 256, BK = 64, HALF = 128, HTB = HALF * BK * 2  , STAGE_BYTES = 8 * HTB, NXCD = 8, WGM = 8;

__host__ __device__ __forceinline__ int lds_byte(int r, int c) { const int st = (r >> 4) * 2 + (c >> 5), rr = r & 15, cc = c & 31, ob = rr * 64 + cc * 2; return st * 1024 + (ob ^ (((ob >> 9) & 1) << 5)); }
__host__ __device__ __forceinline__ void stage_rc(int b, int& R, int& C) { const int st = b / 1024, sb = b % 1024, swz = sb ^ (((sb >> 9) & 1) << 5); R = (st >> 1) * 16 + swz / 64; C = (st & 1) * 32 + (swz % 64) / 2; }
__host__ __device__ __forceinline__ int perm32(int rho) { const int n = rho >> 4, i = rho & 15; return 8 * (i >> 2) + 4 * n + (i & 3); }

struct Unit { int pm, pn, kp; };
struct Gemm { const bf16_t* A; const bf16_t* Bt; int lda, ldb, K, acol, kpiece, wscale; };

struct StaticOrder {
    int nM, nN, nwg, G, c;
    __host__ __device__ __forceinline__ void init(int M, int N, int G_, int c_) { nM = M / BM; nN = N / BM; nwg = nM * nN; G = G_; c = c_; }
    __host__ __device__ __forceinline__ bool next(int i, Unit& u) const {
        const long L = (long)i * G + c; if (L >= nwg) return false;
        int wgid = (int)L; { const int q = nwg / NXCD, r = nwg % NXCD, xcd = wgid % NXCD, off = wgid / NXCD; wgid = (xcd < r ? xcd * (q + 1) : r * (q + 1) + (xcd - r) * q) + off; }
        const int nig = WGM * nN, gid = wgid / nig, fm = gid * WGM, gsz = (nM - fm) < WGM ? (nM - fm) : WGM;
        u.pm = fm + ((wgid % nig) % gsz); u.pn = (wgid % nig) / gsz; u.kp = -1; return true;
    }
    __device__ __forceinline__ void a_ready(const Unit&) const {}
    __device__ __forceinline__ void done(const Unit&) const {}
};

struct SplitOrder {
    int nN, nfull, np, G, c;
    __host__ __device__ __forceinline__ void init(int N, int np_, int G_, int c_) { nN = N / BM; nfull = (MP / BM) * nN; np = np_; G = G_; c = c_; }
    __host__ __device__ __forceinline__ bool next(int i, Unit& u) const {
        const int L = i * G + c;
        int pm, pn, kp; bool ok = true;
        if (L < nfull) {
            int wgid = L; { const int q = nfull / NXCD, xcd = wgid % NXCD, off = wgid / NXCD; wgid = xcd * q + off; }
            const int nig = WGM * nN, gid = wgid / nig, fm = gid * WGM;
            pm = fm + ((wgid % nig) % WGM); pn = (wgid % nig) / WGM; kp = -1;
        } else {
            const int j = L - nfull; ok = j < 2 * nN * np;
            const int t = j / np; kp = j - t * np; pm = MP / BM + t / nN; pn = t % nN;
        }
        u.pm = pm; u.pn = pn; u.kp = kp; return ok;
    }
    __device__ __forceinline__ void a_ready(const Unit&) const {}
    __device__ __forceinline__ void done(const Unit&) const {}
};

__device__ __forceinline__ unsigned cvt_pk_bf16(float lo, float hi) { unsigned r; asm volatile("v_cvt_pk_bf16_f32 %0, %1, %2" : "=v"(r) : "v"(lo), "v"(hi)); return r; }
__device__ __forceinline__ float silu_f(float x) { return x * __builtin_amdgcn_rcpf(1.0f + __builtin_amdgcn_exp2f(-1.4426950408889634f * x)); }
__device__ __forceinline__ float clamp448(float x) { return __builtin_fminf(__builtin_fmaxf(x, -448.0f), 448.0f); }
__device__ __forceinline__ unsigned pk4_fp8(float a, float b, float c, float d) {
    int p = 0; p = __builtin_amdgcn_cvt_pk_fp8_f32(clamp448(a), clamp448(b), p, false); p = __builtin_amdgcn_cvt_pk_fp8_f32(clamp448(c), clamp448(d), p, true); return (unsigned)p; }
__device__ __forceinline__ int modrow_of(int row) { return row < MP ? (row >> 11) : NB + ((row - MP) >> 2); }
__device__ __forceinline__ int ptab_of(int row) { return row < MP ? (row & (SEQ - 1)) : SEQ + ((row - MP) & 3); }

struct EpiSwiglu {
    static constexpr bool PERM = true, AFTER_DRAIN = false;
    unsigned char* O;
    __device__ __forceinline__ void operator()(const f32x4 (&acc)[2][2][4][2], const Unit& u, int wr, int wc, int fr, int fq) const {
        const int row0 = u.pm * BM + wr * 64 + fr, col0 = u.pn * HALF + wc * 32 + 8 * fq;
#pragma unroll
        for (int ai = 0; ai < 2; ++ai)
#pragma unroll
            for (int m = 0; m < 4; ++m) {
                unsigned char* rowp = O + (size_t)(row0 + ai * HALF + m * 16) * DFF + col0;
                const f32x4 g0 = acc[ai][0][m][0], g1 = acc[ai][0][m][1], u0 = acc[ai][1][m][0], u1 = acc[ai][1][m][1];
                u32x2 w;
                w.x = pk4_fp8(silu_f(g0[0]) * u0[0], silu_f(g0[1]) * u0[1], silu_f(g0[2]) * u0[2], silu_f(g0[3]) * u0[3]);
                w.y = pk4_fp8(silu_f(g1[0]) * u1[0], silu_f(g1[1]) * u1[1], silu_f(g1[2]) * u1[2], silu_f(g1[3]) * u1[3]);
                *(u32x2*)rowp = w;
            }
    }
};
struct EpiResid {
    static constexpr bool PERM = false, AFTER_DRAIN = false;
    const float* baseP; const float* baseS; float* out; const float* gate; float coef;
    __device__ __forceinline__ void operator()(const f32x4 (&acc)[2][2][4][2], const Unit& u, int wr, int wc, int fr, int fq) const {
        const int row0 = u.pm * BM + wr * 64 + fr, col0 = u.pn * BM + wc * 32 + 4 * fq;
        if (u.kp < 0) {
#pragma unroll
            for (int ai = 0; ai < 2; ++ai)
#pragma unroll
                for (int m = 0; m < 4; ++m) {
                    const int row = row0 + ai * HALF + m * 16;
                    const float* bp = (row < MP ? baseP + (size_t)row * DM : baseS + (size_t)(row - MP) * DM) + col0;
                    const float* gp = gate + (size_t)modrow_of(row) * NMOD + col0;
                    float* op = out + (size_t)row * DM + col0;
#pragma unroll
                    for (int bj = 0; bj < 2; ++bj)
#pragma unroll
                        for (int n = 0; n < 2; ++n) {
                            const f32x4 bs = *(const f32x4*)(bp + bj * HALF + n * 16), gt = *(const f32x4*)(gp + bj * HALF + n * 16) + *(const f32x4*)(gp + MODSB_DELTA + bj * HALF + n * 16);
                            *(f32x4*)(op + bj * HALF + n * 16) = bs + (gt * coef) * acc[ai][bj][m][n];
                        }
                    if (m & 1) asm volatile("" ::: "memory");
                }
        } else {
#pragma unroll
            for (int ai = 0; ai < 2; ++ai)
#pragma unroll
                for (int m = 0; m < 4; ++m) {
                    const int row = row0 + ai * HALF + m * 16;
                    const float* gp = gate + (size_t)modrow_of(row) * NMOD + col0;
                    float* op = (float*)((char*)out + SLAB_MINUS_X) + ((size_t)u.kp * MS + (row - MP)) * DM + col0;
#pragma unroll
                    for (int bj = 0; bj < 2; ++bj)
#pragma unroll
                        for (int n = 0; n < 2; ++n) {
                            const f32x4 gt = *(const f32x4*)(gp + bj * HALF + n * 16) + *(const f32x4*)(gp + MODSB_DELTA + bj * HALF + n * 16);
                            *(f32x4*)(op + bj * HALF + n * 16) = (gt * coef) * acc[ai][bj][m][n];
                        }
                    if (m & 1) asm volatile("" ::: "memory");
                }
        }
    }
};
struct EpiWin {
    static constexpr bool PERM = true, AFTER_DRAIN = false;
    float* U; bf16_t* QKVG; const float* rot;
    __device__ __forceinline__ void operator()(const f32x4 (&acc)[2][2][4][2], const Unit& u, int wr, int wc, int fr, int fq) const {
        const int row0 = u.pm * BM + wr * 64 + fr, cw = wc * 32 + 8 * fq;
        if (u.pn < 4) {
#pragma unroll
            for (int ai = 0; ai < 2; ++ai)
#pragma unroll
                for (int m = 0; m < 4; ++m) {
                    float* rowp = U + (size_t)(row0 + ai * HALF + m * 16) * PW + u.pn * BM + cw;
#pragma unroll
                    for (int bj = 0; bj < 2; ++bj)
#pragma unroll
                        for (int n = 0; n < 2; ++n) *(f32x4*)(rowp + bj * HALF + 4 * n) = acc[ai][bj][m][n];
                }
        } else {
            const int t = (u.pn - 4) >> 2, hd = (u.pn - 4) & 3;
            bf16_t* dst = QKVG + (size_t)t * MTOK * RW + hd * HD + cw;
            if (t < 2) {
                const float sc = (t == 1) ? 0.0625f : 1.0f;
#pragma unroll
                for (int ai = 0; ai < 2; ++ai)
#pragma unroll
                    for (int m = 0; m < 4; ++m) {
                        const int row = row0 + ai * HALF + m * 16;
                        const float* rp = rot + ((size_t)ptab_of(row) * 128 + cw) * 2;
                        u32x4 w1, w2;
#pragma unroll
                        for (int n = 0; n < 2; ++n) {
                            const f32x4 cs0 = *(const f32x4*)(rp + 8 * n), cs1 = *(const f32x4*)(rp + 8 * n + 4);
                            const f32x4 x1 = acc[ai][0][m][n] * sc, x2 = acc[ai][1][m][n] * sc;
                            const float a0 = x1[0] * cs0[0] - x2[0] * cs0[1], b0 = x2[0] * cs0[0] + x1[0] * cs0[1];
                            const float a1 = x1[1] * cs0[2] - x2[1] * cs0[3], b1 = x2[1] * cs0[2] + x1[1] * cs0[3];
                            const float a2 = x1[2] * cs1[0] - x2[2] * cs1[1], b2 = x2[2] * cs1[0] + x1[2] * cs1[1];
                            const float a3 = x1[3] * cs1[2] - x2[3] * cs1[3], b3 = x2[3] * cs1[2] + x1[3] * cs1[3];
                            if (n == 0) { w1.x = cvt_pk_bf16(a0, a1); w1.y = cvt_pk_bf16(a2, a3); w2.x = cvt_pk_bf16(b0, b1); w2.y = cvt_pk_bf16(b2, b3); }
                            else        { w1.z = cvt_pk_bf16(a0, a1); w1.w = cvt_pk_bf16(a2, a3); w2.z = cvt_pk_bf16(b0, b1); w2.w = cvt_pk_bf16(b2, b3); }
                        }
                        bf16_t* rowp = dst + (size_t)row * RW;
                        *(u32x4*)rowp = w1; *(u32x4*)(rowp + HALF) = w2;
                    }
            } else {
#pragma unroll
                for (int ai = 0; ai < 2; ++ai)
#pragma unroll
                    for (int m = 0; m < 4; ++m) {
                        bf16_t* rowp = dst + (size_t)(row0 + ai * HALF + m * 16) * RW;
#pragma unroll
                        for (int bj = 0; bj < 2; ++bj) { const f32x4 v0 = acc[ai][bj][m][0], v1 = acc[ai][bj][m][1]; u32x4 w;
                            w.x = cvt_pk_bf16(v0[0], v0[1]); w.y = cvt_pk_bf16(v0[2], v0[3]); w.z = cvt_pk_bf16(v1[0], v1[1]); w.w = cvt_pk_bf16(v1[2], v1[3]);
                            *(u32x4*)(rowp + bj * HALF) = w; }
                    }
            }
        }
    }
};
struct EpiPool {
    static constexpr bool PERM = true, AFTER_DRAIN = false;
    bf16_t* MIX; const float* pscale;
    __device__ __forceinline__ void operator()(const f32x4 (&acc)[2][2][4][2], const Unit& u, int wr, int wc, int fr, int fq) const {
        const int row0 = u.pm * BM + wr * 64 + fr, col0 = u.pn * BM + wc * 32 + 8 * fq;
#pragma unroll
        for (int ai = 0; ai < 2; ++ai)
#pragma unroll
            for (int m = 0; m < 4; ++m) {
                bf16_t* rowp = MIX + (size_t)(row0 + ai * HALF + m * 16) * DM + col0;
#pragma unroll
                for (int bj = 0; bj < 2; ++bj) { const f32x4 v0 = acc[ai][bj][m][0] * *(const f32x4*)(pscale + col0 + bj * HALF), v1 = acc[ai][bj][m][1] * *(const f32x4*)(pscale + col0 + bj * HALF + 4); u32x4 w;
                    w.x = cvt_pk_bf16(v0[0], v0[1]); w.y = cvt_pk_bf16(v0[2], v0[3]); w.z = cvt_pk_bf16(v1[0], v1[1]); w.w = cvt_pk_bf16(v1[2], v1[3]);
                    *(u32x4*)(rowp + bj * HALF) = w; }
            }
    }
};

template <class Epi, class Sched, bool ALIGN_EPI = false>
__device__ __forceinline__ void gemm_phase(PG8_LAS unsigned char* lds, const Gemm g, const Sched& S, const Epi& E) {
    const int tid = threadIdx.x, wid = __builtin_amdgcn_readfirstlane(tid >> 6), lane = tid & 63, wr = wid >> 2, wc = wid & 3, fr = lane & 15, fq = lane >> 4;
    unsigned voffA[2], voffB[2];
#pragma unroll
    for (int i = 0; i < 2; ++i) { int R, C; stage_rc(tid * 16 + i * 8192, R, C); const int Rb = Epi::PERM ? ((R & ~31) + perm32(R & 31)) : R;
        voffA[i] = (unsigned)(R * g.lda + C) * 2u; voffB[i] = (unsigned)(Rb * g.ldb + C) * 2u; }
    const size_t kstep = (size_t)(BK * 2);
    const size_t hstepA = (size_t)HALF * g.lda * 2, hstepB = (size_t)HALF * g.ldb * 2;
    const size_t tstepA = 2 * hstepA, tstepB = 2 * hstepB;
    const size_t astep = (size_t)g.acol * 2;
    const unsigned ldsw = (unsigned)wid * 1024u;
    const int aoff = lds_byte(wr * 64 + fr, fq * 8), boff = lds_byte(wc * 32 + fr, fq * 8);
#define PG8_SA(b, h) (((b) * 2 + (h)) * HTB)
#define PG8_SB(b, h) ((4 + (b) * 2 + (h)) * HTB)
#define PG8_STAGE(bufoff, gbase, voff) do { _Pragma("unroll") for (int _i = 0; _i < 2; ++_i) \
        __builtin_amdgcn_global_load_lds((const unsigned*)((const char*)(gbase) + (voff)[_i]), (PG8_LAS unsigned*)(lds + (bufoff) + ldsw + _i * 8192), 16, 0, 0); } while (0)
#define PG8_LDA(dst, b, h) do { _Pragma("unroll") for (int m = 0; m < 4; ++m) _Pragma("unroll") for (int k = 0; k < 2; ++k) dst[m][k] = *(const PG8_LAS bf16x8*)(lds + PG8_SA(b, h) + aoff + m * 2048 + k * 1024); } while (0)
#define PG8_LDB(dst, b, h) do { _Pragma("unroll") for (int n = 0; n < 2; ++n) _Pragma("unroll") for (int k = 0; k < 2; ++k) dst[n][k] = *(const PG8_LAS bf16x8*)(lds + PG8_SB(b, h) + boff + n * 2048 + k * 1024); } while (0)
#define PG8_MMA(ai, bj, At, Bt) do { __builtin_amdgcn_s_setprio(1); _Pragma("unroll") for (int m = 0; m < 4; ++m) _Pragma("unroll") for (int n = 0; n < 2; ++n) _Pragma("unroll") for (int k = 0; k < 2; ++k) \
        acc[ai][bj][m][n] = __builtin_amdgcn_mfma_f32_16x16x32_bf16(Bt[n][k], At[m][k], acc[ai][bj][m][n], 0, 0, 0); __builtin_amdgcn_s_setprio(0); } while (0)
#define PG8_WAIT_V(n) asm volatile("s_waitcnt vmcnt(" #n ")" ::: "memory")
#define PG8_WAIT_L(n) asm volatile("s_waitcnt lgkmcnt(" #n ")" ::: "memory")
#define PG8_BAR __builtin_amdgcn_s_barrier()
#define PG8_SCHED __builtin_amdgcn_sched_barrier(0)
    Unit cur, nxt; int ui = 0;
    if (!S.next(0, cur)) return;
    f32x4 acc[2][2][4][2];
#pragma unroll
    for (int a = 0; a < 2; ++a)
#pragma unroll
        for (int b = 0; b < 2; ++b)
#pragma unroll
            for (int m = 0; m < 4; ++m)
#pragma unroll
                for (int n = 0; n < 2; ++n) acc[a][b][m][n] = (f32x4){0.f, 0.f, 0.f, 0.f};
    bf16x8 At[4][2], B0[2][2], B1[2][2];
    const char* cA = (const char*)g.A + (size_t)cur.pm * tstepA + (size_t)cur.pn * astep + (cur.kp > 0 ? (size_t)cur.kp * g.kpiece * 2 : 0); const char* cB = (const char*)g.Bt + (size_t)cur.pn * tstepB + (cur.kp > 0 ? (size_t)cur.kp * g.kpiece * 2 : 0);
    S.a_ready(cur);
    PG8_STAGE(PG8_SB(0, 0), cB, voffB); PG8_STAGE(PG8_SB(0, 1), cB + hstepB, voffB); PG8_STAGE(PG8_SA(0, 0), cA, voffA); PG8_STAGE(PG8_SA(0, 1), cA + hstepA, voffA);
    if (wr == 1) PG8_BAR;
    PG8_WAIT_V(2); PG8_BAR;
    PG8_STAGE(PG8_SB(1, 0), cB + kstep, voffB); PG8_STAGE(PG8_SA(1, 0), cA + kstep, voffA); PG8_STAGE(PG8_SB(1, 1), cB + hstepB + kstep, voffB);
    PG8_WAIT_V(6); PG8_BAR;
    for (;;) {
        const bool has_next = S.next(ui + 1, nxt);
        const size_t nko = (has_next && nxt.kp > 0) ? (size_t)nxt.kp * g.kpiece * 2 : 0;
        const char* nA = has_next ? (const char*)g.A + (size_t)nxt.pm * tstepA + (size_t)nxt.pn * astep + nko : cA; const char* nB = has_next ? (const char*)g.Bt + (size_t)nxt.pn * tstepB + nko : cB;
        const int nt = (cur.kp < 0 ? g.K : g.kpiece) / BK;
        for (int t = 0; t < nt; t += 2) {
            const bool last = (t == nt - 2);
            const char* a1 = cA + (size_t)(t + 1) * kstep;
            const char* a2 = last ? nA : cA + (size_t)(t + 2) * kstep; const char* b2 = last ? nB : cB + (size_t)(t + 2) * kstep;
            const char* a3 = a2 + kstep; const char* b3 = b2 + kstep;
            if (last && has_next) S.a_ready(nxt);
            PG8_LDB(B0, 0, 0); PG8_LDB(B1, 0, 1); PG8_SCHED; PG8_LDA(At, 0, 0); PG8_STAGE(PG8_SA(1, 1), a1 + hstepA, voffA);
            PG8_WAIT_V(8); PG8_WAIT_L(0); PG8_BAR; PG8_MMA(0, 0, At, B0); PG8_MMA(0, 1, At, B1); PG8_BAR; PG8_SCHED;
            PG8_LDA(At, 0, 1); PG8_STAGE(PG8_SB(0, 0), b2, voffB); PG8_STAGE(PG8_SB(0, 1), b2 + hstepB, voffB); PG8_STAGE(PG8_SA(0, 0), a2, voffA);
            PG8_WAIT_V(8); PG8_WAIT_L(0); PG8_BAR; PG8_MMA(1, 0, At, B0); PG8_MMA(1, 1, At, B1); PG8_BAR; PG8_SCHED;
            PG8_LDB(B0, 1, 0); PG8_LDB(B1, 1, 1); PG8_SCHED; PG8_LDA(At, 1, 0); PG8_STAGE(PG8_SA(0, 1), a2 + hstepA, voffA);
            PG8_WAIT_V(8); PG8_WAIT_L(0); PG8_BAR; PG8_MMA(0, 0, At, B0); PG8_MMA(0, 1, At, B1); PG8_BAR; PG8_SCHED;
            PG8_LDA(At, 1, 1); PG8_STAGE(PG8_SB(1, 0), b3, voffB); PG8_STAGE(PG8_SB(1, 1), b3 + hstepB, voffB); PG8_STAGE(PG8_SA(1, 0), a3, voffA);
            PG8_WAIT_V(8); PG8_WAIT_L(0); PG8_BAR; PG8_MMA(1, 0, At, B0); PG8_MMA(1, 1, At, B1); PG8_BAR; PG8_SCHED;
        }
        if constexpr (ALIGN_EPI) { if (wr == 0) PG8_BAR; }
        E(acc, cur, wr, wc, fr, fq); S.done(cur);
        if (!has_next) break;
#pragma unroll
        for (int a = 0; a < 2; ++a)
#pragma unroll
            for (int b = 0; b < 2; ++b)
#pragma unroll
                for (int m = 0; m < 4; ++m)
#pragma unroll
                    for (int n = 0; n < 2; ++n) acc[a][b][m][n] = (f32x4){0.f, 0.f, 0.f, 0.f};
        cur = nxt; cA = nA; cB = nB; ++ui;
        if constexpr (ALIGN_EPI) { if (wr == 1) PG8_BAR; }
    }
    PG8_WAIT_V(0);
    if constexpr (!ALIGN_EPI) { if (wr == 0) PG8_BAR; }
    PG8_BAR;
#undef PG8_SA
#undef PG8_SB
#undef PG8_STAGE
#undef PG8_LDA
#undef PG8_LDB
#undef PG8_MMA
#undef PG8_WAIT_V
#undef PG8_WAIT_L
#undef PG8_BAR
#undef PG8_SCHED
}
__host__ __device__ __forceinline__ int lds_byte8(int r, int cb) { return (r >> 4) * 2048 + (((cb >> 6) * 16 + (r & 15)) * 64) + ((((cb >> 4) & 3) ^ ((r >> 3) & 1)) * 16); }
__host__ __device__ __forceinline__ void stage_rc8(int b, int& R, int& C) { const int g = b >> 11, u = (b >> 6) & 31, h = u >> 4, r = u & 15, q = ((b >> 4) & 3) ^ ((r >> 3) & 1); R = 16 * g + r; C = h * 64 + q * 16; }
typedef int v8i __attribute__((ext_vector_type(8)));
__device__ __forceinline__ v8i cat8(bf16x8 lo, bf16x8 hi) { typedef int v4i __attribute__((ext_vector_type(4))); const v4i a = __builtin_bit_cast(v4i, lo), b = __builtin_bit_cast(v4i, hi); return (v8i){a[0], a[1], a[2], a[3], b[0], b[1], b[2], b[3]}; }
template <class Epi, class Sched, bool ALIGN_EPI = false>
__device__ __forceinline__ void gemm_phase8(PG8_LAS unsigned char* lds, const Gemm g, const Sched& S, const Epi& E) {
    const int tid = threadIdx.x, wid = __builtin_amdgcn_readfirstlane(tid >> 6), lane = tid & 63, wr = wid >> 2, wc = wid & 3, fr = lane & 15, fq = lane >> 4;
    unsigned voffA[2], voffB[2];
#pragma unroll
    for (int i = 0; i < 2; ++i) { int R, C; stage_rc8(tid * 16 + i * 8192, R, C); const int Rb = Epi::PERM ? ((R & ~31) + perm32(R & 31)) : R;
        voffA[i] = (unsigned)(R * g.lda + C); voffB[i] = (unsigned)(Rb * g.ldb + C); }
    const size_t kstep = (size_t)128;
    const size_t hstepA = (size_t)HALF * g.lda, hstepB = (size_t)HALF * g.ldb;
    const size_t tstepA = 2 * hstepA, tstepB = 2 * hstepB;
    const size_t astep = (size_t)g.acol;
    const unsigned ldsw = (unsigned)wid * 1024u;
    const int aoff = lds_byte8(wr * 64 + fr, fq * 32), boff = lds_byte8(wc * 32 + fr, fq * 32);
#define PG8_SA(b, h) (((b) * 2 + (h)) * HTB)
#define PG8_SB(b, h) ((4 + (b) * 2 + (h)) * HTB)
#define PG8_STAGE(bufoff, gbase, voff) do { _Pragma("unroll") for (int _i = 0; _i < 2; ++_i) \
        __builtin_amdgcn_global_load_lds((const unsigned*)((const char*)(gbase) + (voff)[_i]), (PG8_LAS unsigned*)(lds + (bufoff) + ldsw + _i * 8192), 16, 0, 0); } while (0)
#define PG8_LDA(dst, b, h) do { _Pragma("unroll") for (int m = 0; m < 4; ++m) dst[m] = cat8(*(const PG8_LAS bf16x8*)(lds + PG8_SA(b, h) + aoff + m * 2048), *(const PG8_LAS bf16x8*)(lds + PG8_SA(b, h) + (aoff ^ 16) + m * 2048)); } while (0)
#define PG8_LDB(dst, b, h) do { _Pragma("unroll") for (int n = 0; n < 2; ++n) dst[n] = cat8(*(const PG8_LAS bf16x8*)(lds + PG8_SB(b, h) + boff + n * 2048), *(const PG8_LAS bf16x8*)(lds + PG8_SB(b, h) + (boff ^ 16) + n * 2048)); } while (0)
#define PG8_MMA(ai, bj, At, Bt) do { __builtin_amdgcn_s_setprio(1); _Pragma("unroll") for (int m = 0; m < 4; ++m) _Pragma("unroll") for (int n = 0; n < 2; ++n) \
        asm volatile("v_mfma_scale_f32_16x16x128_f8f6f4 %0, %1, %2, %0, %3, %4 op_sel_hi:[0,0,0]" : "+v"(acc[ai][bj][m][n]) : "v"(Bt[n]), "v"(At[m]), "v"(wsc), "v"(asc)); __builtin_amdgcn_s_setprio(0); } while (0)
#define PG8_WAIT_V(n) asm volatile("s_waitcnt vmcnt(" #n ")" ::: "memory")
#define PG8_WAIT_L(n) asm volatile("s_waitcnt lgkmcnt(" #n ")" ::: "memory")
#define PG8_BAR __builtin_amdgcn_s_barrier()
#define PG8_SCHED __builtin_amdgcn_sched_barrier(0)
    Unit cur, nxt; int ui = 0;
    if (!S.next(0, cur)) return;
    f32x4 acc[2][2][4][2];
#pragma unroll
    for (int a = 0; a < 2; ++a)
#pragma unroll
        for (int b = 0; b < 2; ++b)
#pragma unroll
            for (int m = 0; m < 4; ++m)
#pragma unroll
                for (int n = 0; n < 2; ++n) acc[a][b][m][n] = (f32x4){0.f, 0.f, 0.f, 0.f};
    v8i At[4], B0[2], B1[2];
    int wsc = g.wscale, asc = 0x7f7f7f7f;
    asm volatile("" : "+v"(wsc), "+v"(asc));
    const char* cA = (const char*)g.A + (size_t)cur.pm * tstepA + (size_t)cur.pn * astep + (cur.kp > 0 ? (size_t)cur.kp * g.kpiece : 0); const char* cB = (const char*)g.Bt + (size_t)cur.pn * tstepB + (cur.kp > 0 ? (size_t)cur.kp * g.kpiece : 0);
    S.a_ready(cur);
    PG8_STAGE(PG8_SB(0, 0), cB, voffB); PG8_STAGE(PG8_SB(0, 1), cB + hstepB, voffB); PG8_STAGE(PG8_SA(0, 0), cA, voffA); PG8_STAGE(PG8_SA(0, 1), cA + hstepA, voffA);
    if (wr == 1) PG8_BAR;
    PG8_WAIT_V(2); PG8_BAR;
    PG8_STAGE(PG8_SB(1, 0), cB + kstep, voffB); PG8_STAGE(PG8_SA(1, 0), cA + kstep, voffA); PG8_STAGE(PG8_SB(1, 1), cB + hstepB + kstep, voffB);
    PG8_WAIT_V(6); PG8_BAR;
    for (;;) {
        const bool has_next = S.next(ui + 1, nxt);
        const size_t nko = (has_next && nxt.kp > 0) ? (size_t)nxt.kp * g.kpiece : 0;
        const char* nA = has_next ? (const char*)g.A + (size_t)nxt.pm * tstepA + (size_t)nxt.pn * astep + nko : cA; const char* nB = has_next ? (const char*)g.Bt + (size_t)nxt.pn * tstepB + nko : cB;
        const int nt = (cur.kp < 0 ? g.K : g.kpiece) / 128;
        for (int t = 0; t < nt; t += 2) {
            const bool last = (t == nt - 2);
            const char* a1 = cA + (size_t)(t + 1) * kstep;
            const char* a2 = last ? nA : cA + (size_t)(t + 2) * kstep; const char* b2 = last ? nB : cB + (size_t)(t + 2) * kstep;
            const char* a3 = a2 + kstep; const char* b3 = b2 + kstep;
            if (last && has_next) S.a_ready(nxt);
            PG8_LDB(B0, 0, 0); PG8_LDB(B1, 0, 1); PG8_SCHED; PG8_LDA(At, 0, 0); PG8_STAGE(PG8_SA(1, 1), a1 + hstepA, voffA);
            PG8_WAIT_V(8); PG8_WAIT_L(0); PG8_BAR; PG8_MMA(0, 0, At, B0); PG8_MMA(0, 1, At, B1); PG8_BAR; PG8_SCHED;
            PG8_LDA(At, 0, 1); PG8_STAGE(PG8_SB(0, 0), b2, voffB); PG8_STAGE(PG8_SB(0, 1), b2 + hstepB, voffB); PG8_STAGE(PG8_SA(0, 0), a2, voffA);
            PG8_WAIT_V(8); PG8_WAIT_L(0); PG8_BAR; PG8_MMA(1, 0, At, B0); PG8_MMA(1, 1, At, B1); PG8_BAR; PG8_SCHED;
            PG8_LDB(B0, 1, 0); PG8_LDB(B1, 1, 1); PG8_SCHED; PG8_LDA(At, 1, 0); PG8_STAGE(PG8_SA(0, 1), a2 + hstepA, voffA);
            PG8_WAIT_V(8); PG8_WAIT_L(0); PG8_BAR; PG8_MMA(0, 0, At, B0); PG8_MMA(0, 1, At, B1); PG8_BAR; PG8_SCHED;
            PG8_LDA(At, 1, 1); PG8_STAGE(PG8_SB(1, 0), b3, voffB); PG8_STAGE(PG8_SB(1, 1), b3 + hstepB, voffB); PG8_STAGE(PG8_SA(1, 0), a3, voffA);
            PG8_WAIT_V(8); PG8_WAIT_L(0); PG8_BAR; PG8_MMA(1, 0, At, B0); PG8_MMA(1, 1, At, B1); PG8_BAR; PG8_SCHED;
        }
        if constexpr (ALIGN_EPI) { if (wr == 0) PG8_BAR; }
        asm volatile("s_nop 15\n\ts_nop 15" ::: "memory");
        E(acc, cur, wr, wc, fr, fq); S.done(cur);
        if (!has_next) break;
#pragma unroll
        for (int a = 0; a < 2; ++a)
#pragma unroll
            for (int b = 0; b < 2; ++b)
#pragma unroll
                for (int m = 0; m < 4; ++m)
#pragma unroll
                    for (int n = 0; n < 2; ++n) acc[a][b][m][n] = (f32x4){0.f, 0.f, 0.f, 0.f};
        cur = nxt; cA = nA; cB = nB; ++ui;
        if constexpr (ALIGN_EPI) { if (wr == 1) PG8_BAR; }
    }
    PG8_WAIT_V(0);
    if constexpr (!ALIGN_EPI) { if (wr == 0) PG8_BAR; }
    PG8_BAR;
#undef PG8_SA
#undef PG8_SB
#undef PG8_STAGE
#undef PG8_LDA
#undef PG8_LDB
#undef PG8_MMA
#undef PG8_WAIT_V
#undef PG8_WAIT_L
#undef PG8_BAR
#undef PG8_SCHED
}
}

constexpr int NWAVES = 8;
constexpr int N_PHASES = 15;
constexpr size_t MiB = 1u << 20;
constexpr size_t WS_CTL = 0, CTL_ZERO_BYTES = 64 * 1024;
constexpr size_t WS_SC = 1 * MiB;
constexpr size_t WS_ROT = 2 * MiB;
constexpr size_t WS_MODS = 5 * MiB;
constexpr size_t WS_WPOOL = 15 * MiB;
constexpr size_t WS_WOUT = 16 * MiB;
constexpr size_t WS_WIN = 24 * MiB;
constexpr size_t WS_W1 = 44 * MiB;
constexpr size_t WS_W1D = 88 * MiB;
constexpr size_t WS_W2 = 110 * MiB;
constexpr size_t WS_W2D = 154 * MiB;
constexpr size_t WS_H = 176 * MiB;
constexpr size_t WS_X = 210 * MiB;
constexpr size_t WS_ACT = 278 * MiB;
constexpr size_t WS_QKVG = WS_ACT;
constexpr size_t WS_PM = WS_ACT + 68 * MiB;
constexpr size_t WS_U = 372 * MiB;
constexpr size_t WS_MIX = 406 * MiB;
constexpr size_t WS_UT = 440 * MiB;
constexpr size_t WS_OI = 504 * MiB;
constexpr size_t WS_ST = 536 * MiB;
constexpr size_t WS_SLAB = 568 * MiB;
constexpr size_t WS_MODSB = 612 * MiB;
constexpr size_t WS_END = 622 * MiB;
static_assert((WS_MODSB - WS_MODS) / 4 == MODSB_DELTA, "mods slab offset");
static_assert(WS_SLAB - WS_X == SLAB_MINUS_X, "slab offset");
constexpr int KP_DOWN = 512, KP_OUT = 256;
constexpr float WMUL_UP = 32.0f, WMUL_DOWN = 64.0f; constexpr int WSC_UP = 0x7a7a7a7a, WSC_DOWN = 0x79797979;
static_assert(WS_SC + 160 * 2048 * 2 <= WS_ROT && WS_ROT + (size_t)NPOS * 128 * 8 <= WS_MODS && WS_MODS + (size_t)NMODROW * NMOD * 4 <= WS_WPOOL, "ws map 1");
static_assert(WS_W1 + (size_t)2 * DFF * DM * 2 <= WS_W1D && WS_W1D + (size_t)DM * DFF * 2 <= WS_W2 && WS_W2D + (size_t)DM * DFF * 2 <= WS_H, "ws map 2");
static_assert(WS_H + (size_t)MTOK * DM * 2 <= WS_X && WS_X + (size_t)MTOK * DM * 4 <= WS_ACT && WS_ACT + (size_t)MTOK * DFF * 2 <= WS_U, "ws map 3");
static_assert(WS_PM + (size_t)MTOK * PW * 2 <= WS_U && WS_U + (size_t)MTOK * PW * 4 <= WS_MIX && WS_MIX + (size_t)MTOK * DM * 2 <= WS_UT, "ws map 4");
constexpr int CW_BAR = 1024;

constexpr int RING_BYTES = 131072;
constexpr int LDSCTL_OFF = RING_BYTES, MISC_OFF = LDSCTL_OFF + 320;
constexpr int LDS_BYTES = 147456;

#define GAS __attribute__((address_space(1)))
#define LAS __attribute__((address_space(3)))
typedef unsigned short bf16;
typedef unsigned v4u __attribute__((ext_vector_type(4)));
typedef unsigned v2u __attribute__((ext_vector_type(2)));
typedef float f32x4 __attribute__((ext_vector_type(4)));
typedef float f32x16 __attribute__((ext_vector_type(16)));
typedef short bf16x8 __attribute__((ext_vector_type(8)));
typedef short bf16x4 __attribute__((ext_vector_type(4)));
typedef GAS unsigned gu32;
#define RLX_AGENT __ATOMIC_RELAXED, __HIP_MEMORY_SCOPE_AGENT
#define LDS_WAIT() asm volatile("s_waitcnt lgkmcnt(0)" ::: "memory")
#define VM_WAIT() asm volatile("s_waitcnt vmcnt(0)" ::: "memory")
__device__ __forceinline__ unsigned f2bf(float f) { unsigned u = __builtin_bit_cast(unsigned, f); return (u + 0x7fffu + ((u >> 16) & 1u)) >> 16; }
__device__ __forceinline__ unsigned pk2(float lo, float hi) { return f2bf(lo) | (f2bf(hi) << 16); }
__device__ __forceinline__ float bf2f(unsigned short v) { return __builtin_bit_cast(float, (unsigned)v << 16); }
__device__ __forceinline__ float silu1(float x) { return x / (1.0f + __expf(-x)); }

#define XB_TMO      128
#define XB_XCNT(j)  (256  + 64 * (j))
#define XB_XSUB(j)  (1280 + 64 * (j))
#define XB_XGEN(j)  (2304 + 64 * (j))
#define XB_TOP      3328
#define XB_TOPGEN   3392
#define XCD_BAR_WORDS 3456
#define XB_SPIN_CAP (1u << 20)
static_assert((CW_BAR + 2 * XCD_BAR_WORDS) * 4 <= (int)CTL_ZERO_BYTES, "barrier words inside the memset region");

__device__ __forceinline__ unsigned xb_ld(unsigned* p)              { return __hip_atomic_load(p, __ATOMIC_RELAXED, __HIP_MEMORY_SCOPE_AGENT); }
__device__ __forceinline__ unsigned xb_add(unsigned* p, unsigned v) { return __hip_atomic_fetch_add(p, v, __ATOMIC_RELAXED, __HIP_MEMORY_SCOPE_AGENT); }
__device__ __forceinline__ unsigned xb_xcc_id() { return (unsigned)__builtin_amdgcn_s_getreg((3 << 11) | 20) & 0xFu; }
#define XB_SPIN(cond, bar) do { unsigned _sp = 0; while (cond) { __builtin_amdgcn_s_sleep(1); \
    if ((++_sp & 255u) == 0u) { if (xb_ld(&(bar)[XB_TMO])) break; if (_sp > XB_SPIN_CAP) { atomicAdd(&(bar)[XB_TMO], 1u); break; } } } } while (0)

struct XcdBarrier { unsigned* bar; unsigned x; volatile LAS unsigned* st; };
__device__ __forceinline__ XcdBarrier xcd_barrier_post(unsigned* bar, volatile LAS unsigned* st) {
    XcdBarrier b; b.bar = bar; b.x = xb_xcc_id(); b.st = st;
    if (threadIdx.x == 0) (void)xb_add(&bar[XB_XCNT(b.x)], 1u);
    return b;
}
__device__ __forceinline__ void xcd_barrier_complete(unsigned* bar, unsigned x, unsigned& nloc, unsigned& nx) {
    const unsigned G = gridDim.x * gridDim.y * gridDim.z;
    unsigned sum, cnt, mine, sp = 0u;
    for (;;) {
        sum = 0u; cnt = 0u; mine = 0u;
#pragma unroll
        for (unsigned j = 0; j < 16; ++j) { const unsigned c = xb_ld(&bar[XB_XCNT(j)]); sum += c; cnt += (c > 0u) ? 1u : 0u; mine = (j == x) ? c : mine; }
        if (sum == G) break;
        __builtin_amdgcn_s_sleep(1);
        if ((++sp & 255u) == 0u) { if (xb_ld(&bar[XB_TMO])) break; if (sp > XB_SPIN_CAP) { atomicAdd(&bar[XB_TMO], 1u); break; } }
    }
    nloc = mine > 0u ? mine : 1u; nx = cnt > 0u ? cnt : 1u;
}
__device__ __forceinline__ void xcd_barrier(const XcdBarrier& b) {
    asm volatile("s_waitcnt vmcnt(0)" ::: "memory");
    __syncthreads();
    if (threadIdx.x == 0) {
        unsigned* bar = b.bar;
        __builtin_amdgcn_s_waitcnt(0);
        unsigned nloc = b.st[0], nx = b.st[1];
        if (nloc == 0u) { xcd_barrier_complete(bar, b.x, nloc, nx); b.st[0] = nloc; b.st[1] = nx; }
        const unsigned old = xb_add(&bar[XB_XSUB(b.x)], 1u);
        const unsigned gen = old / nloc;
        if (old + 1u == (gen + 1u) * nloc) {
            __builtin_amdgcn_fence(__ATOMIC_RELEASE, "agent");
            asm volatile("s_waitcnt vmcnt(0)" ::: "memory");
            const unsigned og = xb_add(&bar[XB_TOP], 1u);
            const unsigned tg = og / nx;
            if (og + 1u == (tg + 1u) * nx) xb_add(&bar[XB_TOPGEN], 1u);
            else XB_SPIN(xb_ld(&bar[XB_TOPGEN]) == tg, bar);
            __builtin_amdgcn_fence(__ATOMIC_ACQUIRE, "agent");
            xb_add(&bar[XB_XGEN(b.x)], 1u);
            asm volatile("s_waitcnt vmcnt(0)" ::: "memory");
        } else {
            XB_SPIN(xb_ld(&bar[XB_XGEN(b.x)]) == gen, bar);
            __builtin_amdgcn_fence(__ATOMIC_ACQUIRE, "agent");
            asm volatile("s_waitcnt vmcnt(0)" ::: "memory");
        }
    }
    __syncthreads();
}

struct Args { const float* in[22]; float* out; unsigned char* ws; int ph_lo, ph_hi, bar_region, pad; };
static_assert(sizeof(Args) == 22 * 8 + 8 + 8 + 16, "Args has no padding");
#define INP(i) (A.in[i])
struct Frame {
    LAS unsigned char* lds;
    volatile LAS unsigned* MISC;
    int tid, lane, wave;
    int vcu, G;
    unsigned char* ws;
    float* out;
};
#define WSP(T, off) ((T*)(F.ws + (off)))
__device__ __forceinline__ int lane_of(const Frame& F) { int l = F.tid & 63; asm volatile("" : "+v"(l)); return l; }

__device__ __forceinline__ float wave_sum(float v) {
#pragma unroll
    for (int o = 1; o < 64; o <<= 1) v += __shfl_xor(v, o);
    return v;
}

__device__ __forceinline__ void p0_transpose_item(const float* W, int N, bf16* WT, int ldk, int dst_row0, int k0, int n0, LAS float* scr, int lane) {
    f32x4 t[8];
#pragma unroll
    for (int i = 0; i < 8; ++i) t[i] = *(const f32x4*)(W + (size_t)(k0 + 8 * i + (lane >> 3)) * N + n0 + 4 * (lane & 7));
#pragma unroll
    for (int i = 0; i < 8; ++i) { LAS float* d = scr + (8 * i + (lane >> 3)) * 33 + 4 * (lane & 7); d[0] = t[i][0]; d[1] = t[i][1]; d[2] = t[i][2]; d[3] = t[i][3]; }
    LDS_WAIT(); asm volatile("" ::: "memory");
    const int c = lane & 7;
#pragma unroll
    for (int j = 0; j < 4; ++j) { const int n = (lane >> 3) + 8 * j; const LAS float* s = scr + (8 * c) * 33 + n;
        v4u o; o.x = pk2(s[0 * 33], s[1 * 33]); o.y = pk2(s[2 * 33], s[3 * 33]); o.z = pk2(s[4 * 33], s[5 * 33]); o.w = pk2(s[6 * 33], s[7 * 33]);
        *(GAS v4u*)(WT + (size_t)(dst_row0 + n) * ldk + k0 + 8 * c) = o; }
    LDS_WAIT(); asm volatile("" ::: "memory");
}
__device__ __forceinline__ void p0_transpose_item8(const float* W, int N, unsigned char* WT, int ldk, int dst_row0, int k0, int n0, float mul, LAS float* scr, int lane) {
    f32x4 t[8];
#pragma unroll
    for (int i = 0; i < 8; ++i) t[i] = *(const f32x4*)(W + (size_t)(k0 + 8 * i + (lane >> 3)) * N + n0 + 4 * (lane & 7));
#pragma unroll
    for (int i = 0; i < 8; ++i) { LAS float* d = scr + (8 * i + (lane >> 3)) * 33 + 4 * (lane & 7); d[0] = t[i][0] * mul; d[1] = t[i][1] * mul; d[2] = t[i][2] * mul; d[3] = t[i][3] * mul; }
    LDS_WAIT(); asm volatile("" ::: "memory");
    const int c = lane & 3;
#pragma unroll
    for (int j = 0; j < 2; ++j) { const int n = (lane >> 2) + 16 * j; const LAS float* s = scr + (16 * c) * 33 + n;
        v4u o; o.x = pg8::pk4_fp8(s[0 * 33], s[1 * 33], s[2 * 33], s[3 * 33]); o.y = pg8::pk4_fp8(s[4 * 33], s[5 * 33], s[6 * 33], s[7 * 33]);
        o.z = pg8::pk4_fp8(s[8 * 33], s[9 * 33], s[10 * 33], s[11 * 33]); o.w = pg8::pk4_fp8(s[12 * 33], s[13 * 33], s[14 * 33], s[15 * 33]);
        *(GAS v4u*)(WT + (size_t)(dst_row0 + n) * ldk + k0 + 16 * c) = o; }
    LDS_WAIT(); asm volatile("" ::: "memory");
}
__device__ __forceinline__ void p0_matrix_item(const float* W, int K, int N, bf16* WT, int mode, int item, LAS float* scr, int lane) {
    const int nblk = N / 32, kb = item / nblk, nb = item % nblk, k0 = 64 * kb, n0 = 32 * nb;
    const int dst = (mode == 0) ? n0 : (256 * (n0 >> 7) + (n0 & 127) + (mode == 2 ? 128 : 0));
    p0_transpose_item(W, N, WT, K, dst, k0, n0, scr, lane);
}
__device__ __forceinline__ void p0_matrix_item8(const float* W, int K, int N, unsigned char* WT, int mode, float mul, int item, LAS float* scr, int lane) {
    const int nblk = N / 32, kb = item / nblk, nb = item % nblk, k0 = 64 * kb, n0 = 32 * nb;
    const int dst = (mode == 0) ? n0 : (256 * (n0 >> 7) + (n0 & 127) + (mode == 2 ? 128 : 0));
    p0_transpose_item8(W, N, WT, K, dst, k0, n0, mul, scr, lane);
}
__device__ __forceinline__ void p0_prologue(Frame& F, const Args& A) {
    const int flane = lane_of(F);
    LAS float* scr = (LAS float*)(F.lds + F.wave * 16384);
    const int gw = F.vcu * NWAVES + F.wave, NGW = F.G * NWAVES;
    constexpr int I_F = (DM / 64) * (DFF / 32), I_D = (DFF / 64) * (DM / 32), I_IN = (DM / 64) * (INC / 32), I_OUT = (DM / 64) * (DM / 32), I_P = (HD / 64) * (HD / 32);
    constexpr int NITEMS = 4 * I_F + 2 * I_D + I_IN + I_OUT + 4 * I_P;
    for (int it = gw; it < NITEMS; it += NGW) {
        int r = it;
        if (r < I_F) { p0_matrix_item8(INP(9), DM, DFF, WSP(unsigned char, WS_W1), 1, WMUL_UP, r, scr, flane); continue; } r -= I_F;
        if (r < I_F) { p0_matrix_item8(INP(10), DM, DFF, WSP(unsigned char, WS_W1), 2, WMUL_UP, r, scr, flane); continue; } r -= I_F;
        if (r < I_D) { p0_matrix_item8(INP(11), DFF, DM, WSP(unsigned char, WS_W1D), 0, WMUL_DOWN, r, scr, flane); continue; } r -= I_D;
        if (r < I_IN) { p0_matrix_item(INP(13), DM, INC, WSP(bf16, WS_WIN), 0, r, scr, flane); continue; } r -= I_IN;
        if (r < I_OUT) { p0_matrix_item(INP(16), DM, DM, WSP(bf16, WS_WOUT), 0, r, scr, flane); continue; } r -= I_OUT;
        if (r < 4 * I_P) { const int g = r / I_P; p0_matrix_item(INP(14) + (size_t)g * HD * HD, HD, HD, WSP(bf16, WS_WPOOL) + (size_t)g * HD * HD, 0, r % I_P, scr, flane); continue; } r -= 4 * I_P;
        if (r < I_F) { p0_matrix_item8(INP(18), DM, DFF, WSP(unsigned char, WS_W2), 1, WMUL_UP, r, scr, flane); continue; } r -= I_F;
        if (r < I_F) { p0_matrix_item8(INP(19), DM, DFF, WSP(unsigned char, WS_W2), 2, WMUL_UP, r, scr, flane); continue; } r -= I_F;
        p0_matrix_item8(INP(20), DFF, DM, WSP(unsigned char, WS_W2D), 0, WMUL_DOWN, r, scr, flane);
    }
    const int gt = F.vcu * (NWAVES * 64) + F.tid, NT = F.G * NWAVES * 64;
    for (int i = gt; i < 160 * DM / 4; i += NT) {
        const int m = (4 * i) / DM, k = (4 * i) % DM;
        f32x4 v = (f32x4){0.f, 0.f, 0.f, 0.f};
        if (m < NB) v = *(const f32x4*)(INP(2) + (size_t)m * DM + k); else if (m < NMODROW) v = *(const f32x4*)(INP(3) + (size_t)(m - NB) * DM + k);
        v2u o; o.x = pk2(silu1(v[0]), silu1(v[1])); o.y = pk2(silu1(v[2]), silu1(v[3]));
        *(GAS v2u*)(WSP(bf16, WS_SC) + ((size_t)(((k >> 4) * 5 + (m >> 5)) * 64 + ((k >> 3) & 1) * 32 + (m & 31)) * 8 + (k & 7))) = o;
    }
    for (int i = gt; i < NPOS * 128; i += NT) {
        const int p = i >> 7, fi = i & 127;
        const float pos = (float)(p < SEQ ? p : PAST + (p - SEQ));
        const float inv = (float)exp(-(double)fi * (9.210340371976184 / 128.0));
        const float ang = pos * inv;
        double s, c; sincos((double)ang, &s, &c);
        WSP(float, WS_ROT)[2 * (size_t)i] = (float)c; WSP(float, WS_ROT)[2 * (size_t)i + 1] = (float)s;
    }
}

__device__ __forceinline__ void p1_adaln(Frame& F, const Args& A) {
    const int flane = lane_of(F);
    LAS float* red = (LAS float*)F.lds;
    const int lane = flane, w = F.wave, r = lane & 31, hh = lane >> 5;
    for (int u = F.vcu; u < 2 * (NMOD / 256); u += F.G) {
        const int cg = u >> 1, kh = u & 1, n0 = (8 * cg + w) * 32;
        f32x16 acc[5];
#pragma unroll
        for (int t = 0; t < 5; ++t)
#pragma unroll
            for (int i = 0; i < 16; ++i) acc[t][i] = 0.f;
        const float* Wp = INP(6) + (size_t)(1024 * kh + 8 * hh) * NMOD + n0 + r;
        const bf16* Sp = WSP(bf16, WS_SC) + ((size_t)(64 * kh) * 5 * 64 + lane) * 8;
#pragma unroll 4
        for (int s = 0; s < 64; ++s) {
            float wv[8];
#pragma unroll
            for (int j = 0; j < 8; ++j) wv[j] = Wp[(size_t)(16 * s + j) * NMOD];
            v4u au; au.x = pk2(wv[0], wv[1]); au.y = pk2(wv[2], wv[3]); au.z = pk2(wv[4], wv[5]); au.w = pk2(wv[6], wv[7]);
            const bf16x8 a = __builtin_bit_cast(bf16x8, au);
#pragma unroll
            for (int t = 0; t < 5; ++t) {
                const bf16x8 b = *(const bf16x8*)(Sp + (size_t)((s * 5 + t) * 64) * 8);
                acc[t] = __builtin_amdgcn_mfma_f32_32x32x16_bf16(a, b, acc[t], 0, 0, 0);
            }
        }
        float* dst = WSP(float, WS_MODS) + (kh ? MODSB_DELTA : (size_t)0);
#pragma unroll
        for (int pass = 0; pass < 2; ++pass) {
            if ((w >> 2) == pass) { LAS float* rs = red + (w & 3) * (160 * 33);
#pragma unroll
                for (int t = 0; t < 5; ++t)
#pragma unroll
                    for (int i = 0; i < 16; ++i) rs[(32 * t + r) * 33 + (i & 3) + 8 * (i >> 2) + 4 * hh] = acc[t][i]; }
            __syncthreads();
            const int c0 = 256 * cg + 128 * pass;
            for (int idx = F.tid; idx < NMODROW * 128; idx += NWAVES * 64) { const int m = idx >> 7, c = idx & 127;
                dst[(size_t)m * NMOD + c0 + c] = red[(c >> 5) * (160 * 33) + m * 33 + (c & 31)] + (kh ? 0.f : INP(7)[c0 + c]); }
            __syncthreads();
        }
    }
}

template <bool OUT8>
__device__ __forceinline__ void norm_mod(Frame& F, const float* srcP, const float* srcS, const float* gain, int sub, bf16* Hd, const float* slab, int np, float* xs_out) {
    const int flane = lane_of(F);
    const int gw = F.vcu * NWAVES + F.wave, NGW = F.G * NWAVES;
    for (int mi = gw; mi < MTOK; mi += NGW) {
        const int m = (mi + MS) % MTOK;
        const float* xr = (m < MP) ? srcP + (size_t)m * DM : srcS + (size_t)(m - MP) * DM;
        const float* sh = WSP(float, WS_MODS) + (size_t)pg8::modrow_of(m) * NMOD + (size_t)(3 * sub) * DM; const float* sc = sh + DM;
        f32x4 v[8]; float ss = 0.f;
#pragma unroll
        for (int j = 0; j < 8; ++j) v[j] = *(const f32x4*)(xr + 4 * (flane + 64 * j));
        if (m >= MP && np > 0) {
            for (int p = 0; p < np; ++p) { const float* sp = slab + ((size_t)p * MS + (m - MP)) * DM;
#pragma unroll
                for (int j = 0; j < 8; ++j) v[j] += *(const f32x4*)(sp + 4 * (flane + 64 * j)); }
#pragma unroll
            for (int j = 0; j < 8; ++j) *(f32x4*)(xs_out + (size_t)(m - MP) * DM + 4 * (flane + 64 * j)) = v[j];
        }
#pragma unroll
        for (int j = 0; j < 8; ++j) ss += (v[j][0] * v[j][0] + v[j][1] * v[j][1]) + (v[j][2] * v[j][2] + v[j][3] * v[j][3]);
        const float rstd = 1.0f / sqrtf(wave_sum(ss) * (1.0f / DM) + EPS);
#pragma unroll
        for (int j = 0; j < 8; ++j) { const int k = 4 * (flane + 64 * j);
            const f32x4 g4 = *(const f32x4*)(gain + k), s4 = *(const f32x4*)(sc + k) + *(const f32x4*)(sc + MODSB_DELTA + k), h4 = *(const f32x4*)(sh + k) + *(const f32x4*)(sh + MODSB_DELTA + k);
            const f32x4 o = (v[j] * rstd) * g4 * (s4 + 1.0f) + h4;
            if (OUT8) { *(GAS unsigned*)((unsigned char*)Hd + (size_t)m * DM + k) = pg8::pk4_fp8(o[0], o[1], o[2], o[3]); }
            else { v2u pk; pk.x = pk2(o[0], o[1]); pk.y = pk2(o[2], o[3]); *(GAS v2u*)(Hd + (size_t)m * DM + k) = pk; } }
    }
}
__device__ __forceinline__ void final_norm(Frame& F, const Args& A, const float* slab, int np) {
    const int flane = lane_of(F);
    const int gw = F.vcu * NWAVES + F.wave, NGW = F.G * NWAVES;
    for (int mi = gw; mi < MTOK; mi += NGW) {
        const int m = (mi + MS) % MTOK;
        const float* xr = WSP(float, WS_X) + (size_t)m * DM;
        float* yr = F.out + ((m < MP) ? O_YP + (size_t)m * DM : O_YS + (size_t)(m - MP) * DM);
        f32x4 v[8]; float ss = 0.f;
#pragma unroll
        for (int j = 0; j < 8; ++j) v[j] = *(const f32x4*)(xr + 4 * (flane + 64 * j));
        if (m >= MP) {
            for (int p = 0; p < np; ++p) { const float* sp = slab + ((size_t)p * MS + (m - MP)) * DM;
#pragma unroll
                for (int j = 0; j < 8; ++j) v[j] += *(const f32x4*)(sp + 4 * (flane + 64 * j)); }
        }
#pragma unroll
        for (int j = 0; j < 8; ++j) ss += (v[j][0] * v[j][0] + v[j][1] * v[j][1]) + (v[j][2] * v[j][2] + v[j][3] * v[j][3]);
        const float rstd = 1.0f / sqrtf(wave_sum(ss) * (1.0f / DM) + EPS);
#pragma unroll
        for (int j = 0; j < 8; ++j) { const int k = 4 * (flane + 64 * j); const f32x4 g4 = *(const f32x4*)(INP(21) + k); *(f32x4*)(yr + k) = (v[j] * rstd) * g4; }
    }
}

#define MFMA16(a, b, c) __builtin_amdgcn_mfma_f32_16x16x32_bf16(a, b, c, 0, 0, 0)
__device__ __forceinline__ float log2_gamma(int h) { return h == 0 ? -0.045803689613124747f : h == 1 ? -0.022720076500083405f : h == 2 ? -0.011315313227834146f : -0.0056465631411130581f; }
constexpr int TP = 136;

__device__ __forceinline__ void retA_unit(Frame& F, int unit) {
    const int flane = lane_of(F);
    const int half = unit & 1, c = (unit >> 1) & 15, bh = unit >> 5, b = bh >> 2, h = bh & 3;
    const int m0 = b * SEQ + c * CH;
    const int tid = F.tid, lane = flane, w = F.wave, fr = lane & 15, fq = lane >> 4;
    LAS bf16* VT = (LAS bf16*)F.lds; LAS bf16* KT = VT + 256 * TP; LAS bf16* PP = KT + 128 * TP;
    const bf16* Qg = WSP(bf16, WS_QKVG) + (size_t)m0 * RW + h * HD;
    const bf16* Kg = Qg + (size_t)MTOK * RW; const bf16* Vg = Kg + (size_t)MTOK * RW;
    const float l2g = log2_gamma(h);
#pragma unroll 4
    for (int it = 0; it < 8; ++it) { const int idx = it * 512 + tid, tok = idx & 127, ch = idx >> 7;
        const bf16x8 v = *(const bf16x8*)(Vg + (size_t)tok * RW + ch * 8);
#pragma unroll
        for (int e = 0; e < 8; ++e) VT[(ch * 8 + e) * TP + tok] = (bf16)v[e]; }
#pragma unroll 4
    for (int it = 0; it < 4; ++it) { const int idx = it * 512 + tid, tok = idx & 127, ch = idx >> 7;
        const bf16x8 k = *(const bf16x8*)(Kg + (size_t)tok * RW + half * 128 + ch * 8);
        const float kd = __builtin_amdgcn_exp2f((float)(127 - tok) * l2g);
#pragma unroll
        for (int e = 0; e < 8; ++e) KT[(ch * 8 + e) * TP + tok] = (bf16)f2bf(bf2f((bf16)k[e]) * kd); }
    {
        f32x4 acc[4];
#pragma unroll
        for (int i = 0; i < 4; ++i) acc[i] = (f32x4){0.f, 0.f, 0.f, 0.f};
        if (16 * w < 64 * half + 64) {
#pragma unroll 2
            for (int s = 0; s < 8; ++s) {
                const bf16x8 bb = *(const bf16x8*)(Kg + (size_t)(16 * w + fr) * RW + 32 * s + 8 * fq);
#pragma unroll
                for (int i = 0; i < 4; ++i) { const bf16x8 aa = *(const bf16x8*)(Qg + (size_t)(64 * half + 16 * i + fr) * RW + 32 * s + 8 * fq); acc[i] = MFMA16(aa, bb, acc[i]); }
            }
        }
#pragma unroll
        for (int i = 0; i < 4; ++i)
#pragma unroll
            for (int r = 0; r < 4; ++r) { const int nl = 16 * i + 4 * fq + r, n = 64 * half + nl, m = 16 * w + fr, dn = n - m;
                const float val = dn >= 0 ? acc[i][r] * __builtin_amdgcn_exp2f((float)dn * l2g) : 0.f;
                PP[nl * TP + m] = (bf16)f2bf(val); }
    }
    __syncthreads();
    {
        f32x4 o[2][4];
#pragma unroll
        for (int j = 0; j < 2; ++j)
#pragma unroll
            for (int i = 0; i < 4; ++i) o[j][i] = (f32x4){0.f, 0.f, 0.f, 0.f};
#pragma unroll
        for (int s = 0; s < 4; ++s) {
            bf16x8 a[4];
#pragma unroll
            for (int i = 0; i < 4; ++i) a[i] = *(const LAS bf16x8*)(PP + (16 * i + fr) * TP + 32 * s + 8 * fq);
#pragma unroll
            for (int j = 0; j < 2; ++j) { const bf16x8 bb = *(const LAS bf16x8*)(VT + (16 * (2 * w + j) + fr) * TP + 32 * s + 8 * fq);
#pragma unroll
                for (int i = 0; i < 4; ++i) o[j][i] = MFMA16(a[i], bb, o[j][i]); }
        }
#pragma unroll
        for (int j = 0; j < 2; ++j)
#pragma unroll
            for (int i = 0; i < 4; ++i)
#pragma unroll
                for (int r = 0; r < 4; ++r) WSP(float, WS_OI)[(size_t)(m0 + 64 * half + 16 * i + 4 * fq + r) * RW + h * HD + 16 * (2 * w + j) + fr] = o[j][i][r];
    }
    {
        f32x4 ua[2][8];
#pragma unroll
        for (int i = 0; i < 2; ++i)
#pragma unroll
            for (int j = 0; j < 8; ++j) ua[i][j] = (f32x4){0.f, 0.f, 0.f, 0.f};
#pragma unroll
        for (int s = 0; s < 4; ++s) {
            bf16x8 a[2];
#pragma unroll
            for (int i = 0; i < 2; ++i) a[i] = *(const LAS bf16x8*)(VT + (16 * (2 * w + i) + fr) * TP + 32 * s + 8 * fq);
#pragma unroll
            for (int j = 0; j < 8; ++j) { const bf16x8 bb = *(const LAS bf16x8*)(KT + (16 * j + fr) * TP + 32 * s + 8 * fq);
#pragma unroll
                for (int i = 0; i < 2; ++i) ua[i][j] = MFMA16(a[i], bb, ua[i][j]); }
        }
        float* UTu = WSP(float, WS_UT) + (size_t)(bh * NCH + c) * HD * HD;
#pragma unroll
        for (int i = 0; i < 2; ++i)
#pragma unroll
            for (int j = 0; j < 8; ++j)
#pragma unroll
                for (int r = 0; r < 4; ++r) UTu[(size_t)(16 * (2 * w + i) + 4 * fq + r) * HD + 128 * half + 16 * j + fr] = ua[i][j][r];
    }
    __syncthreads();
}

__device__ __forceinline__ void retC_unit(Frame& F, int unit) {
    const int flane = lane_of(F);
    const int c = unit & 15, bh = unit >> 4, b = bh >> 2, h = bh & 3;
    const int m0 = b * SEQ + c * CH;
    const int tid = F.tid, lane = flane, w = F.wave, fr = lane & 15, fq = lane >> 4;
    const bf16* Qg = WSP(bf16, WS_QKVG) + (size_t)m0 * RW + h * HD;
    const bf16* Gg = Qg + (size_t)3 * MTOK * RW;
    const float l2g = log2_gamma(h);
    f32x4 acc[16];
#pragma unroll
    for (int j = 0; j < 16; ++j) acc[j] = (f32x4){0.f, 0.f, 0.f, 0.f};
    if (c > 0) {
        const bf16* STc = WSP(bf16, WS_ST) + (size_t)(bh * NCH + c) * HD * HD;
        {
            v4u st[16];
#pragma unroll
            for (int it = 0; it < 16; ++it) st[it] = *(const v4u*)(STc + (size_t)(it * 512 + tid) * 8);
#pragma unroll
            for (int it = 0; it < 16; ++it) { const int idx = it * 512 + tid, row = idx >> 5, ch = idx & 31;
                *(LAS v4u*)(F.lds + row * 512 + ((ch ^ (row & 15)) * 16)) = st[it]; }
        }
        bf16x8 qf[8];
#pragma unroll
        for (int s = 0; s < 8; ++s) qf[s] = *(const bf16x8*)(Qg + (size_t)(16 * w + fr) * RW + 32 * s + 8 * fq);
        __syncthreads();
#pragma unroll
        for (int s = 0; s < 8; ++s) {
#pragma unroll
            for (int j = 0; j < 16; ++j) { const bf16x8 aa = *(const LAS bf16x8*)(F.lds + (16 * j + fr) * 512 + (((4 * s + fq) ^ fr) * 16)); acc[j] = MFMA16(aa, qf[s], acc[j]); }
        }
    }
    {
        const int n = 16 * w + fr; const size_t row = (size_t)(m0 + n);
        const float qd = __builtin_amdgcn_exp2f((float)(n + 1) * l2g);
        const float* oip = WSP(float, WS_OI) + row * RW + h * HD + 4 * fq;
        float ss = 0.f;
#pragma unroll
        for (int j = 0; j < 16; ++j) { const f32x4 o = *(const f32x4*)(oip + 16 * j) + acc[j] * qd; acc[j] = o; ss += (o[0] * o[0] + o[1] * o[1]) + (o[2] * o[2] + o[3] * o[3]); }
        ss += __shfl_xor(ss, 16); ss += __shfl_xor(ss, 32);
        const float rs = 1.0f / sqrtf(ss * (1.0f / HD) + EPS);
        const bf16* gp = Gg + (size_t)n * RW + 4 * fq;
        bf16* mp = WSP(bf16, WS_MIX) + row * DM + PW + h * HD + 4 * fq;
#pragma unroll
        for (int j = 0; j < 16; ++j) { const v2u gv = *(const v2u*)(gp + 16 * j);
            const float g0 = bf2f((bf16)(gv.x & 0xffffu)), g1 = bf2f((bf16)(gv.x >> 16)), g2 = bf2f((bf16)(gv.y & 0xffffu)), g3 = bf2f((bf16)(gv.y >> 16));
            v2u pk; pk.x = pk2(silu1(g0) * acc[j][0] * rs, silu1(g1) * acc[j][1] * rs); pk.y = pk2(silu1(g2) * acc[j][2] * rs, silu1(g3) * acc[j][3] * rs);
            *(GAS v2u*)(mp + 16 * j) = pk; }
    }
    __syncthreads();
}

__device__ __forceinline__ void retS_unit(Frame& F, const Args& A, int unit) {
    const int flane = lane_of(F);
    const int b = unit >> 2, h = unit & 3, row0 = MP + 4 * b;
    const int tid = F.tid, lane = flane, w = F.wave;
    LAS float* qs = (LAS float*)F.lds; LAS float* kr = qs + 1024; LAS float* vs = kr + 1024; LAS float* red = vs + 1024; LAS float* dots = red + 8192;
    const bf16* Qg = WSP(bf16, WS_QKVG); const bf16* Kg = Qg + (size_t)MTOK * RW; const bf16* Vg = Kg + (size_t)MTOK * RW; const bf16* Gg = Vg + (size_t)MTOK * RW;
    const float l2g = log2_gamma(h);
    for (int i = tid; i < 1024; i += NWAVES * 64) { const int t = i >> 8, d = i & 255; const size_t off = (size_t)(row0 + t) * RW + h * HD + d;
        qs[i] = bf2f(Qg[off]); kr[i] = bf2f(Kg[off]); vs[i] = bf2f(Vg[off]); }
    __syncthreads();
#pragma unroll
    for (int jj = 0; jj < 2; ++jj) { const int p = 2 * w + jj, t = p >> 2, m = p & 3;
        const f32x4 a = *(const LAS f32x4*)(qs + t * 256 + 4 * lane), k4 = *(const LAS f32x4*)(kr + m * 256 + 4 * lane);
        const float d = wave_sum((a[0] * k4[0] + a[1] * k4[1]) + (a[2] * k4[2] + a[3] * k4[3]));
        if (lane == 0) dots[p] = d; }
    const f32x4* S0 = (const f32x4*)(INP(5) + (size_t)unit * HD * HD);
    f32x4* S1 = (f32x4*)(F.out + O_RETS + (size_t)unit * HD * HD);
    f32x4 v4[4], oq[4];
#pragma unroll
    for (int t = 0; t < 4; ++t) { v4[t] = *(const LAS f32x4*)(vs + t * 256 + 4 * lane); oq[t] = (f32x4){0.f, 0.f, 0.f, 0.f}; }
    const float cdec = __builtin_amdgcn_exp2f(4.0f * l2g);
    const float kd0 = __builtin_amdgcn_exp2f(3.0f * l2g), kd1 = __builtin_amdgcn_exp2f(2.0f * l2g), kd2 = __builtin_amdgcn_exp2f(l2g);
    for (int dk0 = 32 * w; dk0 < 32 * w + 32; dk0 += 8) {
        f32x4 s[8];
#pragma unroll
        for (int u = 0; u < 8; ++u) s[u] = S0[(size_t)(dk0 + u) * 64 + lane];
#pragma unroll
        for (int u = 0; u < 8; ++u) { const int dk = dk0 + u;
            const float q0 = qs[dk], q1 = qs[256 + dk], q2 = qs[512 + dk], q3 = qs[768 + dk];
            const float k0 = kr[dk] * kd0, k1 = kr[256 + dk] * kd1, k2 = kr[512 + dk] * kd2, k3 = kr[768 + dk];
            oq[0] += s[u] * q0; oq[1] += s[u] * q1; oq[2] += s[u] * q2; oq[3] += s[u] * q3;
            S1[(size_t)dk * 64 + lane] = s[u] * cdec + v4[0] * k0 + v4[1] * k1 + v4[2] * k2 + v4[3] * k3; }
    }
#pragma unroll
    for (int t = 0; t < 4; ++t) *(LAS f32x4*)(red + (w * 4 + t) * 256 + 4 * lane) = oq[t];
    __syncthreads();
    if (w < 4) {
        const int t = w;
        f32x4 o = (f32x4){0.f, 0.f, 0.f, 0.f};
#pragma unroll
        for (int ww = 0; ww < 8; ++ww) o += *(const LAS f32x4*)(red + (ww * 4 + t) * 256 + 4 * lane);
        o = o * __builtin_amdgcn_exp2f((float)(t + 1) * l2g);
#pragma unroll
        for (int m = 0; m < 4; ++m) if (m <= t) o += v4[m] * (dots[t * 4 + m] * __builtin_amdgcn_exp2f((float)(t - m) * l2g));
        const float ss = wave_sum((o[0] * o[0] + o[1] * o[1]) + (o[2] * o[2] + o[3] * o[3]));
        const float rs = 1.0f / sqrtf(ss * (1.0f / HD) + EPS);
        const size_t row = (size_t)(row0 + t);
        const v2u gp = *(const v2u*)(Gg + row * RW + h * HD + 4 * lane);
        const float g0 = bf2f((bf16)(gp.x & 0xffffu)), g1 = bf2f((bf16)(gp.x >> 16)), g2 = bf2f((bf16)(gp.y & 0xffffu)), g3 = bf2f((bf16)(gp.y >> 16));
        v2u pk; pk.x = pk2(silu1(g0) * o[0] * rs, silu1(g1) * o[1] * rs); pk.y = pk2(silu1(g2) * o[2] * rs, silu1(g3) * o[3] * rs);
        *(GAS v2u*)(WSP(bf16, WS_MIX) + row * DM + PW + h * HD + 4 * lane) = pk;
    }
    __syncthreads();
}

__device__ __forceinline__ void scan_states(Frame& F) {
    const int gt = F.vcu * (NWAVES * 64) + F.tid, NT = F.G * NWAVES * 64;
    for (int i = gt; i < 16 * 16384; i += NT) {
        const int bh = i >> 14, e4 = i & 16383, h = bh & 3;
        const f32x4* up = (const f32x4*)WSP(float, WS_UT) + (size_t)bh * NCH * 16384 + e4;
        f32x4 uv[16];
#pragma unroll
        for (int c = 0; c < 16; ++c) uv[c] = up[(size_t)c * 16384];
        const float g128 = __builtin_amdgcn_exp2f(128.0f * log2_gamma(h));
        f32x4 S = (f32x4){0.f, 0.f, 0.f, 0.f};
#pragma unroll
        for (int c = 0; c < 16; ++c) {
            S = S * g128 + uv[c];
            if (c < 15) { v2u pk; pk.x = pk2(S[0], S[1]); pk.y = pk2(S[2], S[3]); *(GAS v2u*)(WSP(bf16, WS_ST) + ((size_t)(bh * NCH + c + 1) * 16384 + e4) * 4) = pk; }
        }
        const int dv = (4 * e4) >> 8, dk = (4 * e4) & 255;
        float* rp = F.out + O_RETP + (size_t)bh * HD * HD + dv;
#pragma unroll
        for (int q = 0; q < 4; ++q) rp[(size_t)(dk + q) * HD] = S[q];
    }
}

__device__ __forceinline__ void pool_prompt_item(Frame& F, int item, int q) {
    const int b = item >> 7, t0 = (item & 127) * 16, g = q >> 6, wn = 2 << g;
    const f32x4* U4 = (const f32x4*)(WSP(float, WS_U) + (size_t)b * SEQ * PW) + q;
    f32x4 hv[15], cur[16], old[16];
#pragma unroll
    for (int j = 1; j < 16; ++j) { const int t = t0 - j; const bool ok = (j < wn) && (t >= 0); hv[j - 1] = U4[(size_t)(ok ? t : t0) * 256] * (ok ? 1.0f : 0.0f); }
#pragma unroll
    for (int i = 0; i < 16; ++i) { const int t = t0 + i, to = t - wn; const bool ok = (i >= 1) && (to >= 0);
        cur[i] = U4[(size_t)t * 256]; old[i] = U4[(size_t)(ok ? to : t) * 256] * (ok ? 1.0f : 0.0f); }
    f32x4 sum = (f32x4){0.f, 0.f, 0.f, 0.f};
#pragma unroll
    for (int j = 0; j < 15; ++j) sum += hv[j];
#pragma unroll
    for (int i = 0; i < 16; ++i) {
        const int t = t0 + i;
        sum += cur[i]; sum -= old[i];
        const float cnt = (float)((t + 1 < wn) ? (t + 1) : wn);
        const f32x4 mv = sum / cnt - cur[i];
        v2u pk; pk.x = pk2(mv[0], mv[1]); pk.y = pk2(mv[2], mv[3]);
        *(GAS v2u*)(WSP(bf16, WS_PM) + ((size_t)(b * SEQ + t) * PW + 4 * q)) = pk;
    }
}
__device__ __forceinline__ void pool_sample_item(Frame& F, const Args& A, int b, int q) {
    const int g = q >> 6, wn = 2 << g;
    const f32x4* SP4 = (const f32x4*)(INP(4) + (size_t)b * 15 * PW) + q;
    const f32x4* US4 = (const f32x4*)(WSP(float, WS_U) + (size_t)(MP + 4 * b) * PW) + q;
    for (int t = 0; t < 4; ++t) {
        f32x4 sum = (f32x4){0.f, 0.f, 0.f, 0.f};
        for (int j = 0; j < wn; ++j) { const int i = 15 + t - j; sum += (i < 15) ? SP4[(size_t)i * 256] : US4[(size_t)(i - 15) * 256]; }
        const f32x4 cur = US4[(size_t)t * 256];
        const f32x4 mv = sum / (float)wn - cur;
        v2u pk; pk.x = pk2(mv[0], mv[1]); pk.y = pk2(mv[2], mv[3]);
        *(GAS v2u*)(WSP(bf16, WS_PM) + ((size_t)(MP + 4 * b + t) * PW + 4 * q)) = pk;
    }
}
__device__ __forceinline__ void pool_phase(Frame& F, const Args& A) {
    const int q = F.tid & 255, sub = F.tid >> 8;
    for (int bi = F.vcu; bi < 256; bi += F.G) pool_prompt_item(F, 2 * bi + sub, q);
    for (int bi = F.G - 1 - F.vcu; bi < 64; bi += F.G) pool_sample_item(F, A, 2 * bi + sub, q);
    const int gt = F.vcu * (NWAVES * 64) + F.tid, NT = F.G * NWAVES * 64;
    f32x4* o4 = (f32x4*)F.out;
    for (int i = gt; i < NB * 15 * 256; i += NT) { const int qq = i & 255, r = (i >> 8) % 15, b = (i >> 8) / 15;
        o4[O_POOLP / 4 + i] = ((const f32x4*)WSP(float, WS_U))[((size_t)b * SEQ + (SEQ - 15) + r) * 256 + qq]; }
    for (int i = gt; i < DB * 15 * 256; i += NT) { const int qq = i & 255, r = (i >> 8) % 15, b = (i >> 8) / 15;
        o4[O_POOLS / 4 + i] = (r < 11) ? ((const f32x4*)INP(4))[((size_t)b * 15 + r + 4) * 256 + qq] : ((const f32x4*)WSP(float, WS_U))[((size_t)(MP + 4 * b) + (r - 11)) * 256 + qq]; }
}


__global__ void __launch_bounds__(NWAVES * 64, 2) mk_fwd(Args args) {
    extern __shared__ __attribute__((aligned(16))) unsigned char lds[];
    Frame F;
    F.lds = (LAS unsigned char*)lds;
    F.MISC = (volatile LAS unsigned*)(F.lds + MISC_OFF);
    F.tid = threadIdx.x; F.wave = __builtin_amdgcn_readfirstlane(F.tid >> 6);
    F.G = gridDim.x; { const int bx = blockIdx.x; F.vcu = (F.G % 8 == 0) ? (bx % 8) * (F.G / 8) + bx / 8 : bx; }
    unsigned char* ws = args.ws; const Args& A = args;
    F.out = args.out;
    F.ws = ws;
    for (int u = F.tid; u < (LDS_BYTES - LDSCTL_OFF) / 4; u += NWAVES * 64) ((LAS unsigned*)(F.lds + LDSCTL_OFF))[u] = 0u;
    __syncthreads();
    if (!MK_PER_PHASE) (void)xcd_barrier_post((unsigned*)(ws + WS_CTL) + CW_BAR + args.bar_region * XCD_BAR_WORDS, F.MISC + 8);
    const int lo = args.ph_lo, hi = args.ph_hi;
#ifndef PH_MASK
#define PH_MASK 0x7fff
#endif
#define IN(k) (((PH_MASK >> (k)) & 1) && lo <= (k) && (k) < hi)
#ifndef REP_MASK
#define REP_MASK 0
#endif
#define NREP(k) ((((REP_MASK) >> (k)) & 1) ? 2 : 1)
#define SEAM(k) do { if (!MK_PER_PHASE && (IN((k) + 1) || rep_ + 1 < NREP(k))) { XcdBarrier bar_; bar_.bar = (unsigned*)(A.ws + WS_CTL) + CW_BAR + A.bar_region * XCD_BAR_WORDS; bar_.x = xb_xcc_id(); bar_.st = (volatile LAS unsigned*)(F.lds + MISC_OFF) + 8; xcd_barrier(bar_); } } while (0)

    if (IN(0)) for (int rep_ = 0; rep_ < NREP(0); ++rep_) { p0_prologue(F, A); SEAM(0); }
    if (IN(1)) for (int rep_ = 0; rep_ < NREP(1); ++rep_) { p1_adaln(F, A); SEAM(1); }
    if (IN(2)) for (int rep_ = 0; rep_ < NREP(2); ++rep_) { norm_mod<true>(F, INP(0), INP(1), INP(8), 0, WSP(bf16, WS_H), nullptr, 0, nullptr); SEAM(2); }
    if (IN(3)) for (int rep_ = 0; rep_ < NREP(3); ++rep_) {
        pg8::Gemm g{WSP(bf16, WS_H), WSP(bf16, WS_W1), DM, DM, DM, 0, 0, WSC_UP}; pg8::StaticOrder S; S.init(MTOK, 2 * DFF, F.G, (int)blockIdx.x);
        pg8::EpiSwiglu E{WSP(unsigned char, WS_ACT)};
        pg8::gemm_phase8<pg8::EpiSwiglu, pg8::StaticOrder, true>(F.lds, g, S, E);
        SEAM(3);
    }
    if (IN(4)) for (int rep_ = 0; rep_ < NREP(4); ++rep_) {
        pg8::Gemm g{WSP(bf16, WS_ACT), WSP(bf16, WS_W1D), DFF, DFF, DFF, 0, KP_DOWN, WSC_DOWN}; pg8::SplitOrder S; S.init(DM, DFF / KP_DOWN, F.G, (int)blockIdx.x);
        pg8::EpiResid E{INP(0), INP(1), WSP(float, WS_X), WSP(float, WS_MODS) + 2 * DM, 0.5f};
        pg8::gemm_phase8<pg8::EpiResid, pg8::SplitOrder, true>(F.lds, g, S, E);
        SEAM(4);
    }
    if (IN(5)) for (int rep_ = 0; rep_ < NREP(5); ++rep_) { norm_mod<false>(F, WSP(float, WS_X), INP(1), INP(12), 1, WSP(bf16, WS_H), WSP(float, WS_SLAB), DFF / KP_DOWN, WSP(float, WS_X) + (size_t)MP * DM); SEAM(5); }
    if (IN(6)) for (int rep_ = 0; rep_ < NREP(6); ++rep_) {
        pg8::Gemm g{WSP(bf16, WS_H), WSP(bf16, WS_WIN), DM, DM, DM, 0, 0, 0}; pg8::StaticOrder S; S.init(MTOK, INC, F.G, (int)blockIdx.x);
        pg8::EpiWin E{WSP(float, WS_U), WSP(bf16, WS_QKVG), WSP(float, WS_ROT)};
        pg8::gemm_phase<pg8::EpiWin, pg8::StaticOrder, true>(F.lds, g, S, E);
        SEAM(6);
    }
    if (IN(7)) for (int rep_ = 0; rep_ < NREP(7); ++rep_) {
        for (int u = F.vcu; u < NB * NH * NCH * 2; u += F.G) retA_unit(F, u);
        pool_phase(F, A);
        SEAM(7);
    }
    if (IN(8)) for (int rep_ = 0; rep_ < NREP(8); ++rep_) {
        {
            pg8::Gemm g{WSP(bf16, WS_PM), WSP(bf16, WS_WPOOL), PW, HD, HD, HD, 0, 0}; pg8::StaticOrder S; S.init(MTOK, PW, F.G, (int)blockIdx.x);
            pg8::EpiPool E{WSP(bf16, WS_MIX), INP(15)};
            pg8::gemm_phase<pg8::EpiPool, pg8::StaticOrder, true>(F.lds, g, S, E);
        }
        __syncthreads();
        { int t2 = threadIdx.x; asm volatile("" : "+v"(t2)); F.tid = t2; }
        for (int u = F.vcu; u < DB * NH; u += F.G) retS_unit(F, A, u);
        scan_states(F);
        SEAM(8);
    }
    if (IN(9)) for (int rep_ = 0; rep_ < NREP(9); ++rep_) { for (int u = F.vcu; u < NB * NH * NCH; u += F.G) retC_unit(F, u); SEAM(9); }
    if (IN(10)) for (int rep_ = 0; rep_ < NREP(10); ++rep_) {
        pg8::Gemm g{WSP(bf16, WS_MIX), WSP(bf16, WS_WOUT), DM, DM, DM, 0, KP_OUT, 0}; pg8::SplitOrder S; S.init(DM, DM / KP_OUT, F.G, (int)blockIdx.x);
        pg8::EpiResid E{WSP(float, WS_X), WSP(float, WS_X) + (size_t)MP * DM, WSP(float, WS_X), WSP(float, WS_MODS) + 5 * DM, 1.0f};
        pg8::gemm_phase<pg8::EpiResid, pg8::SplitOrder, true>(F.lds, g, S, E);
        SEAM(10);
    }
    if (IN(11)) for (int rep_ = 0; rep_ < NREP(11); ++rep_) { norm_mod<true>(F, WSP(float, WS_X), WSP(float, WS_X) + (size_t)MP * DM, INP(17), 2, WSP(bf16, WS_H), WSP(float, WS_SLAB), DM / KP_OUT, WSP(float, WS_X) + (size_t)MP * DM); SEAM(11); }
    if (IN(12)) for (int rep_ = 0; rep_ < NREP(12); ++rep_) {
        pg8::Gemm g{WSP(bf16, WS_H), WSP(bf16, WS_W2), DM, DM, DM, 0, 0, WSC_UP}; pg8::StaticOrder S; S.init(MTOK, 2 * DFF, F.G, (int)blockIdx.x);
        pg8::EpiSwiglu E{WSP(unsigned char, WS_ACT)};
        pg8::gemm_phase8<pg8::EpiSwiglu, pg8::StaticOrder, true>(F.lds, g, S, E);
        SEAM(12);
    }
    if (IN(13)) for (int rep_ = 0; rep_ < NREP(13); ++rep_) {
        pg8::Gemm g{WSP(bf16, WS_ACT), WSP(bf16, WS_W2D), DFF, DFF, DFF, 0, KP_DOWN, WSC_DOWN}; pg8::SplitOrder S; S.init(DM, DFF / KP_DOWN, F.G, (int)blockIdx.x);
        pg8::EpiResid E{WSP(float, WS_X), WSP(float, WS_X) + (size_t)MP * DM, WSP(float, WS_X), WSP(float, WS_MODS) + 8 * DM, 0.5f};
        pg8::gemm_phase8<pg8::EpiResid, pg8::SplitOrder, true>(F.lds, g, S, E);
        SEAM(13);
    }
    if (IN(14)) for (int rep_ = 0; rep_ < NREP(14); ++rep_) { final_norm(F, A, WSP(float, WS_SLAB), DFF / KP_DOWN); if (rep_ + 1 < NREP(14)) { SEAM(14); } }
#undef IN
#undef SEAM
}

extern "C" void kernel_launch(void* const* d_in, const int* in_sizes, int n_in, void* d_out, int out_size, void* d_ws, size_t ws_size, hipStream_t stream) {
    static int grid = 0;
    if (grid == 0) {
        if (n_in != 22 || (size_t)out_size != O_END || ws_size < WS_END) { fprintf(stderr, "kernel_launch: unexpected shapes (n_in %d out %d ws %zu)\n", n_in, out_size, ws_size); grid = -1; return; }
        int dev = 0, cus = 0, per_cu = 0;
        if (hipGetDevice(&dev) != hipSuccess || hipDeviceGetAttribute(&cus, hipDeviceAttributeMultiprocessorCount, dev) != hipSuccess) { grid = -1; return; }
        if (hipFuncSetAttribute((const void*)mk_fwd, hipFuncAttributeMaxDynamicSharedMemorySize, LDS_BYTES) != hipSuccess) { fprintf(stderr, "kernel_launch: hipFuncSetAttribute failed\n"); grid = -1; return; }
        if (hipOccupancyMaxActiveBlocksPerMultiprocessor(&per_cu, (const void*)mk_fwd, NWAVES * 64, LDS_BYTES) != hipSuccess || per_cu < 1) { fprintf(stderr, "kernel_launch: occupancy query says %d blocks/CU\n", per_cu); (void)hipGetLastError(); grid = -1; return; }
        grid = cus;
    }
    if (grid < 0) return;
    (void)hipMemsetAsync((char*)d_ws + WS_CTL, 0, CTL_ZERO_BYTES, stream);
    Args a{};
    for (int i = 0; i < 22; ++i) a.in[i] = (const float*)d_in[i];
    a.out = (float*)d_out; a.ws = (unsigned char*)d_ws;
#if MK_PER_PHASE
    for (int p = 0; p < N_PHASES; ++p) { a.ph_lo = p; a.ph_hi = p + 1; hipLaunchKernelGGL(mk_fwd, dim3(grid), dim3(NWAVES * 64), LDS_BYTES, stream, a); }
#else
    a.ph_lo = 0; a.ph_hi = N_PHASES;
    hipLaunchKernelGGL(mk_fwd, dim3(grid), dim3(NWAVES * 64), LDS_BYTES, stream, a);
#ifdef PROBE_LO
    a.ph_lo = PROBE_LO; a.ph_hi = PROBE_HI; a.bar_region = 1;
    hipLaunchKernelGGL(mk_fwd, dim3(grid), dim3(NWAVES * 64), LDS_BYTES, stream, a);
#endif
#endif
}
```

```cpp
#include <hip/hip_runtime.h>
#include <cstdio>
#include <cstdint>
#include <cmath>

#ifndef MK_PER_PHASE
#define MK_PER_PHASE 0
#endif

constexpr int DM = 2048, DFF = 5632, SEQ = 2048, NB = 4, DB = 128, DS = 4;
constexpr int MP = NB * SEQ;
constexpr int MS = DB * DS;
constexpr int MTOK = MP + MS;
constexpr int NMODROW = NB + DB;
constexpr int NMOD = 9 * DM;
constexpr int PW = 1024, RW = 1024, HD = 256, NH = 4, CH = 128, NCH = SEQ / CH;
constexpr int INC = PW + 4 * RW;
constexpr int PAST = 16384;
constexpr float EPS = 1e-6f;
constexpr int NPOS = SEQ + DS;

constexpr size_t O_YP = 0, O_YS = (size_t)MP * DM, O_POOLP = O_YS + (size_t)MS * DM, O_RETP = O_POOLP + (size_t)NB * 15 * PW,
                 O_POOLS = O_RETP + (size_t)NB * NH * HD * HD, O_RETS = O_POOLS + (size_t)DB * 15 * PW, O_END = O_RETS + (size_t)DB * NH * HD * HD;

constexpr size_t SLAB_MINUS_X = (size_t)(568 - 210) << 20;
constexpr size_t MODSB_DELTA = ((size_t)(612 - 5) << 20) / 4;

namespace pg8 {
#define PG8_LAS __attribute__((address_space(3)))
typedef unsigned short bf16_t;
typedef short bf16x8 __attribute__((ext_vector_type(8)));
typedef float f32x4 __attribute__((ext_vector_type(4)));
typedef unsigned u32x4 __attribute__((ext_vector_type(4)));
typedef unsigned u32x2 __attribute__((ext_vector_type(2)));
constexpr int BM = 256, BK = 64, HALF = 128, HTB = HALF * BK * 2  , STAGE_BYTES = 8 * HTB, NXCD = 8, WGM = 8;

__host__ __device__ __forceinline__ int lds_byte(int r, int c) { const int st = (r >> 4) * 2 + (c >> 5), rr = r & 15, cc = c & 31, ob = rr * 64 + cc * 2; return st * 1024 + (ob ^ (((ob >> 9) & 1) << 5)); }
__host__ __device__ __forceinline__ void stage_rc(int b, int& R, int& C) { const int st = b / 1024, sb = b % 1024, swz = sb ^ (((sb >> 9) & 1) << 5); R = (st >> 1) * 16 + swz / 64; C = (st & 1) * 32 + (swz % 64) / 2; }
__host__ __device__ __forceinline__ int perm32(int rho) { const int n = rho >> 4, i = rho & 15; return 8 * (i >> 2) + 4 * n + (i & 3); }

struct Unit { int pm, pn, kp; };
struct Gemm { const bf16_t* A; const bf16_t* Bt; int lda, ldb, K, acol, kpiece, wscale; };

struct StaticOrder {
    int nM, nN, nwg, G, c;
    __host__ __device__ __forceinline__ void init(int M, int N, int G_, int c_) { nM = M / BM; nN = N / BM; nwg = nM * nN; G = G_; c = c_; }
    __host__ __device__ __forceinline__ bool next(int i, Unit& u) const {
        const long L = (long)i * G + c; if (L >= nwg) return false;
        int wgid = (int)L; { const int q = nwg / NXCD, r = nwg % NXCD, xcd = wgid % NXCD, off = wgid / NXCD; wgid = (xcd < r ? xcd * (q + 1) : r * (q + 1) + (xcd - r) * q) + off; }
        const int nig = WGM * nN, gid = wgid / nig, fm = gid * WGM, gsz = (nM - fm) < WGM ? (nM - fm) : WGM;
        u.pm = fm + ((wgid % nig) % gsz); u.pn = (wgid % nig) / gsz; u.kp = -1; return true;
    }
    __device__ __forceinline__ void a_ready(const Unit&) const {}
    __device__ __forceinline__ void done(const Unit&) const {}
};

struct SplitOrder {
    int nN, nfull, np, G, c;
    __host__ __device__ __forceinline__ void init(int N, int np_, int G_, int c_) { nN = N / BM; nfull = (MP / BM) * nN; np = np_; G = G_; c = c_; }
    __host__ __device__ __forceinline__ bool next(int i, Unit& u) const {
        const int L = i * G + c;
        int pm, pn, kp; bool ok = true;
        if (L < nfull) {
            int wgid = L; { const int q = nfull / NXCD, xcd = wgid % NXCD, off = wgid / NXCD; wgid = xcd * q + off; }
            const int nig = WGM * nN, gid = wgid / nig, fm = gid * WGM;
            pm = fm + ((wgid % nig) % WGM); pn = (wgid % nig) / WGM; kp = -1;
        } else {
            const int j = L - nfull; ok = j < 2 * nN * np;
            const int t = j / np; kp = j - t * np; pm = MP / BM + t / nN; pn = t % nN;
        }
        u.pm = pm; u.pn = pn; u.kp = kp; return ok;
    }
    __device__ __forceinline__ void a_ready(const Unit&) const {}
    __device__ __forceinline__ void done(const Unit&) const {}
};

__device__ __forceinline__ unsigned cvt_pk_bf16(float lo, float hi) { unsigned r; asm volatile("v_cvt_pk_bf16_f32 %0, %1, %2" : "=v"(r) : "v"(lo), "v"(hi)); return r; }
__device__ __forceinline__ float silu_f(float x) { return x * __builtin_amdgcn_rcpf(1.0f + __builtin_amdgcn_exp2f(-1.4426950408889634f * x)); }
__device__ __forceinline__ float clamp448(float x) { return __builtin_fminf(__builtin_fmaxf(x, -448.0f), 448.0f); }
__device__ __forceinline__ unsigned pk4_fp8(float a, float b, float c, float d) {
    int p = 0; p = __builtin_amdgcn_cvt_pk_fp8_f32(clamp448(a), clamp448(b), p, false); p = __builtin_amdgcn_cvt_pk_fp8_f32(clamp448(c), clamp448(d), p, true); return (unsigned)p; }
__device__ __forceinline__ unsigned pk4_fp8_nc(float a, float b, float c, float d) {
    int p = 0; p = __builtin_amdgcn_cvt_pk_fp8_f32(a, b, p, false); p = __builtin_amdgcn_cvt_pk_fp8_f32(c, d, p, true); return (unsigned)p; }
__device__ __forceinline__ int modrow_of(int row) { return row < MP ? (row >> 11) : NB + ((row - MP) >> 2); }
__device__ __forceinline__ int ptab_of(int row) { return row < MP ? (row & (SEQ - 1)) : SEQ + ((row - MP) & 3); }

struct EpiSwiglu {
    static constexpr bool PERM = true, AFTER_DRAIN = false;
    unsigned char* O;
    __device__ __forceinline__ void operator()(const f32x4 (&acc)[2][2][4][2], const Unit& u, int wr, int wc, int fr, int fq) const {
        const int row0 = u.pm * BM + wr * 64 + fr, col0 = u.pn * HALF + wc * 32 + 8 * fq;
#pragma unroll
        for (int ai = 0; ai < 2; ++ai)
#pragma unroll
            for (int m = 0; m < 4; ++m) {
                unsigned char* rowp = O + (size_t)(row0 + ai * HALF + m * 16) * DFF + col0;
                const f32x4 g0 = acc[ai][0][m][0], g1 = acc[ai][0][m][1], u0 = acc[ai][1][m][0], u1 = acc[ai][1][m][1];
                u32x2 w;
                w.x = pk4_fp8_nc(silu_f(g0[0]) * u0[0], silu_f(g0[1]) * u0[1], silu_f(g0[2]) * u0[2], silu_f(g0[3]) * u0[3]);
                w.y = pk4_fp8_nc(silu_f(g1[0]) * u1[0], silu_f(g1[1]) * u1[1], silu_f(g1[2]) * u1[2], silu_f(g1[3]) * u1[3]);
                *(u32x2*)rowp = w;
            }
    }
};
template <bool BASE16> struct EpiResid {
    static constexpr bool PERM = true, AFTER_DRAIN = false;
    const float* base32; bf16_t* X; const float* gate; float coef;
    __device__ __forceinline__ void operator()(const f32x4 (&acc)[2][2][4][2], const Unit& u, int wr, int wc, int fr, int fq) const {
        const int row0 = u.pm * BM + wr * 64 + fr, col0 = u.pn * BM + wc * 32 + 8 * fq;
        if (u.kp < 0) {
            const float* gp = gate + (size_t)(u.pm >> 3) * NMOD + col0;
            f32x4 gg[2][2];
#pragma unroll
            for (int bj = 0; bj < 2; ++bj)
#pragma unroll
                for (int n = 0; n < 2; ++n) gg[bj][n] = (*(const f32x4*)(gp + bj * HALF + 4 * n) + *(const f32x4*)(gp + MODSB_DELTA + bj * HALF + 4 * n)) * coef;
#pragma unroll
            for (int ai = 0; ai < 2; ++ai)
#pragma unroll
                for (int m = 0; m < 4; ++m) {
                    const int row = row0 + ai * HALF + m * 16;
                    bf16_t* xp = X + (size_t)row * DM + col0;
#pragma unroll
                    for (int bj = 0; bj < 2; ++bj) {
                        f32x4 b0, b1;
                        if (BASE16) { const u32x4 bv = *(const u32x4*)(xp + bj * HALF);
                            b0 = (f32x4){__builtin_bit_cast(float, bv.x << 16), __builtin_bit_cast(float, bv.x & 0xffff0000u), __builtin_bit_cast(float, bv.y << 16), __builtin_bit_cast(float, bv.y & 0xffff0000u)};
                            b1 = (f32x4){__builtin_bit_cast(float, bv.z << 16), __builtin_bit_cast(float, bv.z & 0xffff0000u), __builtin_bit_cast(float, bv.w << 16), __builtin_bit_cast(float, bv.w & 0xffff0000u)}; }
                        else { const float* bp = base32 + (size_t)row * DM + col0 + bj * HALF; b0 = __builtin_nontemporal_load((const f32x4*)bp); b1 = __builtin_nontemporal_load((const f32x4*)(bp + 4)); }
                        const f32x4 o0 = b0 + gg[bj][0] * acc[ai][bj][m][0], o1 = b1 + gg[bj][1] * acc[ai][bj][m][1];
                        u32x4 w; w.x = cvt_pk_bf16(o0[0], o0[1]); w.y = cvt_pk_bf16(o0[2], o0[3]); w.z = cvt_pk_bf16(o1[0], o1[1]); w.w = cvt_pk_bf16(o1[2], o1[3]);
                        *(u32x4*)(xp + bj * HALF) = w;
                    }
                    if (m & 1) asm volatile("" ::: "memory");
                }
        } else {
#pragma unroll
            for (int ai = 0; ai < 2; ++ai)
#pragma unroll
                for (int m = 0; m < 4; ++m) {
                    const int row = row0 + ai * HALF + m * 16;
                    const float* gp = gate + (size_t)modrow_of(row) * NMOD + col0;
                    bf16_t* op = (bf16_t*)((char*)X + SLAB_MINUS_X) + ((size_t)u.kp * MS + (row - MP)) * DM + col0;
#pragma unroll
                    for (int bj = 0; bj < 2; ++bj) {
                        const f32x4 g0 = (*(const f32x4*)(gp + bj * HALF) + *(const f32x4*)(gp + MODSB_DELTA + bj * HALF)) * coef, g1 = (*(const f32x4*)(gp + bj * HALF + 4) + *(const f32x4*)(gp + MODSB_DELTA + bj * HALF + 4)) * coef;
                        const f32x4 o0 = g0 * acc[ai][bj][m][0], o1 = g1 * acc[ai][bj][m][1];
                        u32x4 w; w.x = cvt_pk_bf16(o0[0], o0[1]); w.y = cvt_pk_bf16(o0[2], o0[3]); w.z = cvt_pk_bf16(o1[0], o1[1]); w.w = cvt_pk_bf16(o1[2], o1[3]);
                        *(u32x4*)(op + bj * HALF) = w;
                    }
                    if (m & 1) asm volatile("" ::: "memory");
                }
        }
    }
};
struct EpiWin {
    static constexpr bool PERM = true, AFTER_DRAIN = false;
    bf16_t* U; bf16_t* QKVG; const float* rot;
    __device__ __forceinline__ void operator()(const f32x4 (&acc)[2][2][4][2], const Unit& u, int wr, int wc, int fr, int fq) const {
        const int row0 = u.pm * BM + wr * 64 + fr, cw = wc * 32 + 8 * fq;
        if (u.pn < 4) {
#pragma unroll
            for (int ai = 0; ai < 2; ++ai)
#pragma unroll
                for (int m = 0; m < 4; ++m) {
                    bf16_t* rowp = U + (size_t)(row0 + ai * HALF + m * 16) * PW + u.pn * BM + cw;
#pragma unroll
                    for (int bj = 0; bj < 2; ++bj) { const f32x4 v0 = acc[ai][bj][m][0], v1 = acc[ai][bj][m][1]; u32x4 w;
                        w.x = cvt_pk_bf16(v0[0], v0[1]); w.y = cvt_pk_bf16(v0[2], v0[3]); w.z = cvt_pk_bf16(v1[0], v1[1]); w.w = cvt_pk_bf16(v1[2], v1[3]);
                        *(u32x4*)(rowp + bj * HALF) = w; }
                }
        } else {
            const int t = (u.pn - 4) >> 2, hd = (u.pn - 4) & 3;
            bf16_t* dst = QKVG + (size_t)t * MTOK * RW + hd * HD + cw;
            if (t < 2) {
                const float sc = (t == 1) ? 0.0625f : 1.0f;
#pragma unroll
                for (int ai = 0; ai < 2; ++ai)
#pragma unroll
                    for (int m = 0; m < 4; ++m) {
                        const int row = row0 + ai * HALF + m * 16;
                        const float* rp = rot + ((size_t)ptab_of(row) * 128 + cw) * 2;
                        u32x4 w1, w2;
#pragma unroll
                        for (int n = 0; n < 2; ++n) {
                            const f32x4 cs0 = *(const f32x4*)(rp + 8 * n), cs1 = *(const f32x4*)(rp + 8 * n + 4);
                            const f32x4 x1 = acc[ai][0][m][n] * sc, x2 = acc[ai][1][m][n] * sc;
                            const float a0 = x1[0] * cs0[0] - x2[0] * cs0[1], b0 = x2[0] * cs0[0] + x1[0] * cs0[1];
                            const float a1 = x1[1] * cs0[2] - x2[1] * cs0[3], b1 = x2[1] * cs0[2] + x1[1] * cs0[3];
                            const float a2 = x1[2] * cs1[0] - x2[2] * cs1[1], b2 = x2[2] * cs1[0] + x1[2] * cs1[1];
                            const float a3 = x1[3] * cs1[2] - x2[3] * cs1[3], b3 = x2[3] * cs1[2] + x1[3] * cs1[3];
                            if (n == 0) { w1.x = cvt_pk_bf16(a0, a1); w1.y = cvt_pk_bf16(a2, a3); w2.x = cvt_pk_bf16(b0, b1); w2.y = cvt_pk_bf16(b2, b3); }
                            else        { w1.z = cvt_pk_bf16(a0, a1); w1.w = cvt_pk_bf16(a2, a3); w2.z = cvt_pk_bf16(b0, b1); w2.w = cvt_pk_bf16(b2, b3); }
                        }
                        bf16_t* rowp = dst + (size_t)row * RW;
                        *(u32x4*)rowp = w1; *(u32x4*)(rowp + HALF) = w2;
                    }
            } else {
#pragma unroll
                for (int ai = 0; ai < 2; ++ai)
#pragma unroll
                    for (int m = 0; m < 4; ++m) {
                        bf16_t* rowp = dst + (size_t)(row0 + ai * HALF + m * 16) * RW;
#pragma unroll
                        for (int bj = 0; bj < 2; ++bj) { const f32x4 v0 = acc[ai][bj][m][0], v1 = acc[ai][bj][m][1]; u32x4 w;
                            w.x = cvt_pk_bf16(v0[0], v0[1]); w.y = cvt_pk_bf16(v0[2], v0[3]); w.z = cvt_pk_bf16(v1[0], v1[1]); w.w = cvt_pk_bf16(v1[2], v1[3]);
                            *(u32x4*)(rowp + bj * HALF) = w; }
                    }
            }
        }
    }
};
struct EpiPool {
    static constexpr bool PERM = true, AFTER_DRAIN = false;
    unsigned char* MIX; const float* pscale;
    __device__ __forceinline__ void operator()(const f32x4 (&acc)[2][2][4][2], const Unit& u, int wr, int wc, int fr, int fq) const {
        const int row0 = u.pm * BM + wr * 64 + fr, col0 = u.pn * BM + wc * 32 + 8 * fq;
#pragma unroll
        for (int ai = 0; ai < 2; ++ai)
#pragma unroll
            for (int m = 0; m < 4; ++m) {
                unsigned char* rowp = MIX + (size_t)(row0 + ai * HALF + m * 16) * DM + col0;
#pragma unroll
                for (int bj = 0; bj < 2; ++bj) { const f32x4 v0 = acc[ai][bj][m][0] * *(const f32x4*)(pscale + col0 + bj * HALF), v1 = acc[ai][bj][m][1] * *(const f32x4*)(pscale + col0 + bj * HALF + 4); u32x2 w;
                    w.x = pk4_fp8(v0[0], v0[1], v0[2], v0[3]); w.y = pk4_fp8(v1[0], v1[1], v1[2], v1[3]);
                    *(u32x2*)(rowp + bj * HALF) = w; }
            }
    }
};

template <class Epi, class Sched, bool ALIGN_EPI = false>
__device__ __forceinline__ void gemm_phase(PG8_LAS unsigned char* lds, const Gemm g, const Sched& S, const Epi& E) {
    const int tid = threadIdx.x, wid = __builtin_amdgcn_readfirstlane(tid >> 6), lane = tid & 63, wr = wid >> 2, wc = wid & 3, fr = lane & 15, fq = lane >> 4;
    unsigned voffA[2], voffB[2];
#pragma unroll
    for (int i = 0; i < 2; ++i) { int R, C; stage_rc(tid * 16 + i * 8192, R, C); const int Rb = Epi::PERM ? ((R & ~31) + perm32(R & 31)) : R;
        voffA[i] = (unsigned)(R * g.lda + C) * 2u; voffB[i] = (unsigned)(Rb * g.ldb + C) * 2u; }
    const size_t kstep = (size_t)(BK * 2);
    const size_t hstepA = (size_t)HALF * g.lda * 2, hstepB = (size_t)HALF * g.ldb * 2;
    const size_t tstepA = 2 * hstepA, tstepB = 2 * hstepB;
    const size_t astep = (size_t)g.acol * 2;
    const unsigned ldsw = (unsigned)wid * 1024u;
    const int aoff = lds_byte(wr * 64 + fr, fq * 8), boff = lds_byte(wc * 32 + fr, fq * 8);
#define PG8_SA(b, h) (((b) * 2 + (h)) * HTB)
#define PG8_SB(b, h) ((4 + (b) * 2 + (h)) * HTB)
#define PG8_STAGE(bufoff, gbase, voff) do { _Pragma("unroll") for (int _i = 0; _i < 2; ++_i) \
        __builtin_amdgcn_global_load_lds((const unsigned*)((const char*)(gbase) + (voff)[_i]), (PG8_LAS unsigned*)(lds + (bufoff) + ldsw + _i * 8192), 16, 0, 0); } while (0)
#define PG8_LDA(dst, b, h) do { _Pragma("unroll") for (int m = 0; m < 4; ++m) _Pragma("unroll") for (int k = 0; k < 2; ++k) dst[m][k] = *(const PG8_LAS bf16x8*)(lds + PG8_SA(b, h) + aoff + m * 2048 + k * 1024); } while (0)
#define PG8_LDB(dst, b, h) do { _Pragma("unroll") for (int n = 0; n < 2; ++n) _Pragma("unroll") for (int k = 0; k < 2; ++k) dst[n][k] = *(const PG8_LAS bf16x8*)(lds + PG8_SB(b, h) + boff + n * 2048 + k * 1024); } while (0)
#define PG8_MMA(ai, bj, At, Bt) do { __builtin_amdgcn_s_setprio(1); _Pragma("unroll") for (int m = 0; m < 4; ++m) _Pragma("unroll") for (int n = 0; n < 2; ++n) _Pragma("unroll") for (int k = 0; k < 2; ++k) \
        acc[ai][bj][m][n] = __builtin_amdgcn_mfma_f32_16x16x32_bf16(Bt[n][k], At[m][k], acc[ai][bj][m][n], 0, 0, 0); __builtin_amdgcn_s_setprio(0); } while (0)
#define PG8_WAIT_V(n) asm volatile("s_waitcnt vmcnt(" #n ")" ::: "memory")
#define PG8_WAIT_L(n) asm volatile("s_waitcnt lgkmcnt(" #n ")" ::: "memory")
#define PG8_BAR __builtin_amdgcn_s_barrier()
#define PG8_SCHED __builtin_amdgcn_sched_barrier(0)
    Unit cur, nxt; int ui = 0;
    if (!S.next(0, cur)) return;
    f32x4 acc[2][2][4][2];
#pragma unroll
    for (int a = 0; a < 2; ++a)
#pragma unroll
        for (int b = 0; b < 2; ++b)
#pragma unroll
            for (int m = 0; m < 4; ++m)
#pragma unroll
                for (int n = 0; n < 2; ++n) acc[a][b][m][n] = (f32x4){0.f, 0.f, 0.f, 0.f};
    bf16x8 At[4][2], B0[2][2], B1[2][2];
    const char* cA = (const char*)g.A + (size_t)cur.pm * tstepA + (size_t)cur.pn * astep + (cur.kp > 0 ? (size_t)cur.kp * g.kpiece * 2 : 0); const char* cB = (const char*)g.Bt + (size_t)cur.pn * tstepB + (cur.kp > 0 ? (size_t)cur.kp * g.kpiece * 2 : 0);
    S.a_ready(cur);
    PG8_STAGE(PG8_SB(0, 0), cB, voffB); PG8_STAGE(PG8_SB(0, 1), cB + hstepB, voffB); PG8_STAGE(PG8_SA(0, 0), cA, voffA); PG8_STAGE(PG8_SA(0, 1), cA + hstepA, voffA);
    if (wr == 1) PG8_BAR;
    PG8_WAIT_V(2); PG8_BAR;
    PG8_STAGE(PG8_SB(1, 0), cB + kstep, voffB); PG8_STAGE(PG8_SA(1, 0), cA + kstep, voffA); PG8_STAGE(PG8_SB(1, 1), cB + hstepB + kstep, voffB);
    PG8_WAIT_V(6); PG8_BAR;
    for (;;) {
        const bool has_next = S.next(ui + 1, nxt);
        const size_t nko = (has_next && nxt.kp > 0) ? (size_t)nxt.kp * g.kpiece * 2 : 0;
        const char* nA = has_next ? (const char*)g.A + (size_t)nxt.pm * tstepA + (size_t)nxt.pn * astep + nko : cA; const char* nB = has_next ? (const char*)g.Bt + (size_t)nxt.pn * tstepB + nko : cB;
        const int nt = (cur.kp < 0 ? g.K : g.kpiece) / BK;
        for (int t = 0; t < nt; t += 2) {
            const bool last = (t == nt - 2);
            const char* a1 = cA + (size_t)(t + 1) * kstep;
            const char* a2 = last ? nA : cA + (size_t)(t + 2) * kstep; const char* b2 = last ? nB : cB + (size_t)(t + 2) * kstep;
            const char* a3 = a2 + kstep; const char* b3 = b2 + kstep;
            if (last && has_next) S.a_ready(nxt);
            PG8_LDB(B0, 0, 0); PG8_LDB(B1, 0, 1); PG8_SCHED; PG8_LDA(At, 0, 0); PG8_STAGE(PG8_SA(1, 1), a1 + hstepA, voffA);
            PG8_WAIT_V(8); PG8_WAIT_L(0); PG8_BAR; PG8_MMA(0, 0, At, B0); PG8_MMA(0, 1, At, B1); PG8_BAR; PG8_SCHED;
            PG8_LDA(At, 0, 1); PG8_STAGE(PG8_SB(0, 0), b2, voffB); PG8_STAGE(PG8_SB(0, 1), b2 + hstepB, voffB); PG8_STAGE(PG8_SA(0, 0), a2, voffA);
            PG8_WAIT_V(8); PG8_WAIT_L(0); PG8_BAR; PG8_MMA(1, 0, At, B0); PG8_MMA(1, 1, At, B1); PG8_BAR; PG8_SCHED;
            PG8_LDB(B0, 1, 0); PG8_LDB(B1, 1, 1); PG8_SCHED; PG8_LDA(At, 1, 0); PG8_STAGE(PG8_SA(0, 1), a2 + hstepA, voffA);
            PG8_WAIT_V(8); PG8_WAIT_L(0); PG8_BAR; PG8_MMA(0, 0, At, B0); PG8_MMA(0, 1, At, B1); PG8_BAR; PG8_SCHED;
            PG8_LDA(At, 1, 1); PG8_STAGE(PG8_SB(1, 0), b3, voffB); PG8_STAGE(PG8_SB(1, 1), b3 + hstepB, voffB); PG8_STAGE(PG8_SA(1, 0), a3, voffA);
            PG8_WAIT_V(8); PG8_WAIT_L(0); PG8_BAR; PG8_MMA(1, 0, At, B0); PG8_MMA(1, 1, At, B1); PG8_BAR; PG8_SCHED;
        }
        if constexpr (ALIGN_EPI) { if (wr == 0) PG8_BAR; }
        E(acc, cur, wr, wc, fr, fq); S.done(cur);
        if (!has_next) break;
#pragma unroll
        for (int a = 0; a < 2; ++a)
#pragma unroll
            for (int b = 0; b < 2; ++b)
#pragma unroll
                for (int m = 0; m < 4; ++m)
#pragma unroll
                    for (int n = 0; n < 2; ++n) acc[a][b][m][n] = (f32x4){0.f, 0.f, 0.f, 0.f};
        cur = nxt; cA = nA; cB = nB; ++ui;
        if constexpr (ALIGN_EPI) { if (wr == 1) PG8_BAR; }
    }
    PG8_WAIT_V(0);
    if constexpr (!ALIGN_EPI) { if (wr == 0) PG8_BAR; }
    PG8_BAR;
#undef PG8_SA
#undef PG8_SB
#undef PG8_STAGE
#undef PG8_LDA
#undef PG8_LDB
#undef PG8_MMA
#undef PG8_WAIT_V
#undef PG8_WAIT_L
#undef PG8_BAR
#undef PG8_SCHED
}
__host__ __device__ __forceinline__ int lds_byte8(int r, int cb) { return (r >> 4) * 2048 + (((cb >> 6) * 16 + (r & 15)) * 64) + ((((cb >> 4) & 3) ^ ((r >> 3) & 1)) * 16); }
__host__ __device__ __forceinline__ void stage_rc8(int b, int& R, int& C) { const int g = b >> 11, u = (b >> 6) & 31, h = u >> 4, r = u & 15, q = ((b >> 4) & 3) ^ ((r >> 3) & 1); R = 16 * g + r; C = h * 64 + q * 16; }
typedef int v8i __attribute__((ext_vector_type(8)));
__device__ __forceinline__ v8i cat8(bf16x8 lo, bf16x8 hi) { typedef int v4i __attribute__((ext_vector_type(4))); const v4i a = __builtin_bit_cast(v4i, lo), b = __builtin_bit_cast(v4i, hi); return (v8i){a[0], a[1], a[2], a[3], b[0], b[1], b[2], b[3]}; }
template <class Epi, class Sched, bool ALIGN_EPI = false>
__device__ __forceinline__ void gemm_phase8(PG8_LAS unsigned char* lds, const Gemm g, const Sched& S, const Epi& E) {
    const int tid = threadIdx.x, wid = __builtin_amdgcn_readfirstlane(tid >> 6), lane = tid & 63, wr = wid >> 2, wc = wid & 3, fr = lane & 15, fq = lane >> 4;
    unsigned voffA[2], voffB[2];
#pragma unroll
    for (int i = 0; i < 2; ++i) { int R, C; stage_rc8(tid * 16 + i * 8192, R, C); const int Rb = Epi::PERM ? ((R & ~31) + perm32(R & 31)) : R;
        voffA[i] = (unsigned)(R * g.lda + C); voffB[i] = (unsigned)(Rb * g.ldb + C); }
    const size_t kstep = (size_t)128;
    const size_t hstepA = (size_t)HALF * g.lda, hstepB = (size_t)HALF * g.ldb;
    const size_t tstepA = 2 * hstepA, tstepB = 2 * hstepB;
    const size_t astep = (size_t)g.acol;
    const unsigned ldsw = (unsigned)wid * 1024u;
    const int aoff = lds_byte8(wr * 64 + fr, fq * 32), boff = lds_byte8(wc * 32 + fr, fq * 32);
#define PG8_SA(b, h) (((b) * 2 + (h)) * HTB)
#define PG8_SB(b, h) ((4 + (b) * 2 + (h)) * HTB)
#define PG8_STAGE(bufoff, gbase, voff) do { _Pragma("unroll") for (int _i = 0; _i < 2; ++_i) \
        __builtin_amdgcn_global_load_lds((const unsigned*)((const char*)(gbase) + (voff)[_i]), (PG8_LAS unsigned*)(lds + (bufoff) + ldsw + _i * 8192), 16, 0, 0); } while (0)
#define PG8_LDA(dst, b, h) do { _Pragma("unroll") for (int m = 0; m < 4; ++m) dst[m] = cat8(*(const PG8_LAS bf16x8*)(lds + PG8_SA(b, h) + aoff + m * 2048), *(const PG8_LAS bf16x8*)(lds + PG8_SA(b, h) + (aoff ^ 16) + m * 2048)); } while (0)
#define PG8_LDB(dst, b, h) do { _Pragma("unroll") for (int n = 0; n < 2; ++n) dst[n] = cat8(*(const PG8_LAS bf16x8*)(lds + PG8_SB(b, h) + boff + n * 2048), *(const PG8_LAS bf16x8*)(lds + PG8_SB(b, h) + (boff ^ 16) + n * 2048)); } while (0)
#define PG8_MMA(ai, bj, At, Bt) do { __builtin_amdgcn_s_setprio(1); _Pragma("unroll") for (int m = 0; m < 4; ++m) _Pragma("unroll") for (int n = 0; n < 2; ++n) \
        asm volatile("v_mfma_scale_f32_16x16x128_f8f6f4 %0, %1, %2, %0, %3, %4 op_sel_hi:[0,0,0]" : "+v"(acc[ai][bj][m][n]) : "v"(Bt[n]), "v"(At[m]), "v"(wsc), "v"(asc)); __builtin_amdgcn_s_setprio(0); } while (0)
#define PG8_WAIT_V(n) asm volatile("s_waitcnt vmcnt(" #n ")" ::: "memory")
#define PG8_WAIT_L(n) asm volatile("s_waitcnt lgkmcnt(" #n ")" ::: "memory")
#define PG8_BAR __builtin_amdgcn_s_barrier()
#define PG8_SCHED __builtin_amdgcn_sched_barrier(0)
    Unit cur, nxt; int ui = 0;
    if (!S.next(0, cur)) return;
    f32x4 acc[2][2][4][2];
#pragma unroll
    for (int a = 0; a < 2; ++a)
#pragma unroll
        for (int b = 0; b < 2; ++b)
#pragma unroll
            for (int m = 0; m < 4; ++m)
#pragma unroll
                for (int n = 0; n < 2; ++n) acc[a][b][m][n] = (f32x4){0.f, 0.f, 0.f, 0.f};
    v8i At[4], B0[2], B1[2];
    int wsc = g.wscale, asc = 0x7f7f7f7f;
    asm volatile("" : "+v"(wsc), "+v"(asc));
    const char* cA = (const char*)g.A + (size_t)cur.pm * tstepA + (size_t)cur.pn * astep + (cur.kp > 0 ? (size_t)cur.kp * g.kpiece : 0); const char* cB = (const char*)g.Bt + (size_t)cur.pn * tstepB + (cur.kp > 0 ? (size_t)cur.kp * g.kpiece : 0);
    S.a_ready(cur);
    PG8_STAGE(PG8_SB(0, 0), cB, voffB); PG8_STAGE(PG8_SB(0, 1), cB + hstepB, voffB); PG8_STAGE(PG8_SA(0, 0), cA, voffA); PG8_STAGE(PG8_SA(0, 1), cA + hstepA, voffA);
    if (wr == 1) PG8_BAR;
    PG8_WAIT_V(2); PG8_BAR;
    PG8_STAGE(PG8_SB(1, 0), cB + kstep, voffB); PG8_STAGE(PG8_SA(1, 0), cA + kstep, voffA); PG8_STAGE(PG8_SB(1, 1), cB + hstepB + kstep, voffB);
    PG8_WAIT_V(6); PG8_BAR;
    for (;;) {
        const bool has_next = S.next(ui + 1, nxt);
        const size_t nko = (has_next && nxt.kp > 0) ? (size_t)nxt.kp * g.kpiece : 0;
        const char* nA = has_next ? (const char*)g.A + (size_t)nxt.pm * tstepA + (size_t)nxt.pn * astep + nko : cA; const char* nB = has_next ? (const char*)g.Bt + (size_t)nxt.pn * tstepB + nko : cB;
        const int nt = (cur.kp < 0 ? g.K : g.kpiece) / 128;
        for (int t = 0; t < nt; t += 2) {
            const bool last = (t == nt - 2);
            const char* a1 = cA + (size_t)(t + 1) * kstep;
            const char* a2 = last ? nA : cA + (size_t)(t + 2) * kstep; const char* b2 = last ? nB : cB + (size_t)(t + 2) * kstep;
            const char* a3 = a2 + kstep; const char* b3 = b2 + kstep;
            if (last && has_next) S.a_ready(nxt);
            PG8_LDB(B0, 0, 0); PG8_LDB(B1, 0, 1); PG8_SCHED; PG8_LDA(At, 0, 0); PG8_STAGE(PG8_SA(1, 1), a1 + hstepA, voffA);
            PG8_WAIT_V(8); PG8_WAIT_L(0); PG8_BAR; PG8_MMA(0, 0, At, B0); PG8_MMA(0, 1, At, B1); PG8_BAR; PG8_SCHED;
            PG8_LDA(At, 0, 1); PG8_STAGE(PG8_SB(0, 0), b2, voffB); PG8_STAGE(PG8_SB(0, 1), b2 + hstepB, voffB); PG8_STAGE(PG8_SA(0, 0), a2, voffA);
            PG8_WAIT_V(8); PG8_WAIT_L(0); PG8_BAR; PG8_MMA(1, 0, At, B0); PG8_MMA(1, 1, At, B1); PG8_BAR; PG8_SCHED;
            PG8_LDB(B0, 1, 0); PG8_LDB(B1, 1, 1); PG8_SCHED; PG8_LDA(At, 1, 0); PG8_STAGE(PG8_SA(0, 1), a2 + hstepA, voffA);
            PG8_WAIT_V(8); PG8_WAIT_L(0); PG8_BAR; PG8_MMA(0, 0, At, B0); PG8_MMA(0, 1, At, B1); PG8_BAR; PG8_SCHED;
            PG8_LDA(At, 1, 1); PG8_STAGE(PG8_SB(1, 0), b3, voffB); PG8_STAGE(PG8_SB(1, 1), b3 + hstepB, voffB); PG8_STAGE(PG8_SA(1, 0), a3, voffA);
            PG8_WAIT_V(8); PG8_WAIT_L(0); PG8_BAR; PG8_MMA(1, 0, At, B0); PG8_MMA(1, 1, At, B1); PG8_BAR; PG8_SCHED;
        }
        if constexpr (ALIGN_EPI) { if (wr == 0) PG8_BAR; }
        asm volatile("s_nop 15\n\ts_nop 15" ::: "memory");
        E(acc, cur, wr, wc, fr, fq); S.done(cur);
        if (!has_next) break;
#pragma unroll
        for (int a = 0; a < 2; ++a)
#pragma unroll
            for (int b = 0; b < 2; ++b)
#pragma unroll
                for (int m = 0; m < 4; ++m)
#pragma unroll
                    for (int n = 0; n < 2; ++n) acc[a][b][m][n] = (f32x4){0.f, 0.f, 0.f, 0.f};
        cur = nxt; cA = nA; cB = nB; ++ui;
        if constexpr (ALIGN_EPI) { if (wr == 1) PG8_BAR; }
    }
    PG8_WAIT_V(0);
    if constexpr (!ALIGN_EPI) { if (wr == 0) PG8_BAR; }
    PG8_BAR;
#undef PG8_SA
#undef PG8_SB
#undef PG8_STAGE
#undef PG8_LDA
#undef PG8_LDB
#undef PG8_MMA
#undef PG8_WAIT_V
#undef PG8_WAIT_L
#undef PG8_BAR
#undef PG8_SCHED
}
}

constexpr int NWAVES = 8;
constexpr int N_PHASES = 15;
constexpr size_t MiB = 1u << 20;
constexpr size_t WS_CTL = 0, CTL_ZERO_BYTES = 64 * 1024;
constexpr size_t WS_SC = 1 * MiB;
constexpr size_t WS_ROT = 2 * MiB;
constexpr size_t WS_MODS = 5 * MiB;
constexpr size_t WS_WPOOL = 15 * MiB;
constexpr size_t WS_WOUT = 16 * MiB;
constexpr size_t WS_WIN = 24 * MiB;
constexpr size_t WS_W1 = 44 * MiB;
constexpr size_t WS_W1D = 88 * MiB;
constexpr size_t WS_W2 = 110 * MiB;
constexpr size_t WS_W2D = 154 * MiB;
constexpr size_t WS_H = 176 * MiB;
constexpr size_t WS_X = 210 * MiB;
constexpr size_t WS_ACT = 278 * MiB;
constexpr size_t WS_QKVG = WS_ACT;
constexpr size_t WS_PM = WS_ACT + 68 * MiB;
constexpr size_t WS_U = 372 * MiB;
constexpr size_t WS_MIX = 406 * MiB;
constexpr size_t WS_UT = 440 * MiB;
constexpr size_t WS_OI = 504 * MiB;
constexpr size_t WS_ST = 536 * MiB;
constexpr size_t WS_SLAB = 568 * MiB;
constexpr size_t WS_MODSB = 612 * MiB;
constexpr size_t WS_END = 622 * MiB;
static_assert((WS_MODSB - WS_MODS) / 4 == MODSB_DELTA, "mods slab offset");
static_assert(WS_SLAB - WS_X == SLAB_MINUS_X, "slab offset");
constexpr int KP_DOWN = 512, KP_OUT = 512;
constexpr float WMUL_UP = 32.0f, WMUL_DOWN = 64.0f; constexpr int WSC_UP = 0x7a7a7a7a, WSC_DOWN = 0x79797979;
static_assert(WS_SC + 160 * 2048 * 2 <= WS_ROT && WS_ROT + (size_t)NPOS * 128 * 8 <= WS_MODS && WS_MODS + (size_t)NMODROW * NMOD * 4 <= WS_WPOOL, "ws map 1");
static_assert(WS_W1 + (size_t)2 * DFF * DM * 2 <= WS_W1D && WS_W1D + (size_t)DM * DFF * 2 <= WS_W2 && WS_W2D + (size_t)DM * DFF * 2 <= WS_H, "ws map 2");
static_assert(WS_H + (size_t)MTOK * DM * 2 <= WS_X && WS_X + (size_t)MTOK * DM * 4 <= WS_ACT && WS_ACT + (size_t)MTOK * DFF * 2 <= WS_U, "ws map 3");
static_assert(WS_PM + (size_t)MTOK * PW * 2 <= WS_U && WS_U + (size_t)MTOK * PW * 4 <= WS_MIX && WS_MIX + (size_t)MTOK * DM * 2 <= WS_UT, "ws map 4");
constexpr int CW_BAR = 1024;

constexpr int RING_BYTES = 131072;
constexpr int LDSCTL_OFF = 136 * 1024, MISC_OFF = LDSCTL_OFF + 320;
constexpr int LDS_BYTES = 147456;

#define GAS __attribute__((address_space(1)))
#define LAS __attribute__((address_space(3)))
typedef unsigned short bf16;
typedef unsigned v4u __attribute__((ext_vector_type(4)));
typedef unsigned v2u __attribute__((ext_vector_type(2)));
typedef float f32x4 __attribute__((ext_vector_type(4)));
typedef float f32x16 __attribute__((ext_vector_type(16)));
typedef short bf16x8 __attribute__((ext_vector_type(8)));
typedef short bf16x4 __attribute__((ext_vector_type(4)));
typedef GAS unsigned gu32;
#define RLX_AGENT __ATOMIC_RELAXED, __HIP_MEMORY_SCOPE_AGENT
#define LDS_WAIT() asm volatile("s_waitcnt lgkmcnt(0)" ::: "memory")
#define VM_WAIT() asm volatile("s_waitcnt vmcnt(0)" ::: "memory")
__device__ __forceinline__ unsigned f2bf(float f) { unsigned u = __builtin_bit_cast(unsigned, f); return (u + 0x7fffu + ((u >> 16) & 1u)) >> 16; }
__device__ __forceinline__ unsigned pk2(float lo, float hi) { return f2bf(lo) | (f2bf(hi) << 16); }
__device__ __forceinline__ float bf2f(unsigned short v) { return __builtin_bit_cast(float, (unsigned)v << 16); }
__device__ __forceinline__ float silu1(float x) { return x / (1.0f + __expf(-x)); }

#define XB_TMO      128
#define XB_XCNT(j)  (256  + 64 * (j))
#define XB_XSUB(j)  (1280 + 64 * (j))
#define XB_XGEN(j)  (2304 + 64 * (j))
#define XB_TOP      3328
#define XB_TOPGEN   3392
#define XCD_BAR_WORDS 3456
#define XB_SPIN_CAP (1u << 20)
static_assert((CW_BAR + 2 * XCD_BAR_WORDS) * 4 <= (int)CTL_ZERO_BYTES, "barrier words inside the memset region");

__device__ __forceinline__ unsigned xb_ld(unsigned* p)              { return __hip_atomic_load(p, __ATOMIC_RELAXED, __HIP_MEMORY_SCOPE_AGENT); }
__device__ __forceinline__ unsigned xb_add(unsigned* p, unsigned v) { return __hip_atomic_fetch_add(p, v, __ATOMIC_RELAXED, __HIP_MEMORY_SCOPE_AGENT); }
__device__ __forceinline__ unsigned xb_xcc_id() { return (unsigned)__builtin_amdgcn_s_getreg((3 << 11) | 20) & 0xFu; }
#define XB_SPIN(cond, bar) do { unsigned _sp = 0; while (cond) { __builtin_amdgcn_s_sleep(1); \
    if ((++_sp & 255u) == 0u) { if (xb_ld(&(bar)[XB_TMO])) break; if (_sp > XB_SPIN_CAP) { atomicAdd(&(bar)[XB_TMO], 1u); break; } } } } while (0)

struct XcdBarrier { unsigned* bar; unsigned x; volatile LAS unsigned* st; };
__device__ __forceinline__ XcdBarrier xcd_barrier_post(unsigned* bar, volatile LAS unsigned* st) {
    XcdBarrier b; b.bar = bar; b.x = xb_xcc_id(); b.st = st;
    if (threadIdx.x == 0) (void)xb_add(&bar[XB_XCNT(b.x)], 1u);
    return b;
}
__device__ __forceinline__ void xcd_barrier_complete(unsigned* bar, unsigned x, unsigned& nloc, unsigned& nx) {
    const unsigned G = gridDim.x * gridDim.y * gridDim.z;
    unsigned sum, cnt, mine, sp = 0u;
    for (;;) {
        sum = 0u; cnt = 0u; mine = 0u;
#pragma unroll
        for (unsigned j = 0; j < 16; ++j) { const unsigned c = xb_ld(&bar[XB_XCNT(j)]); sum += c; cnt += (c > 0u) ? 1u : 0u; mine = (j == x) ? c : mine; }
        if (sum == G) break;
        __builtin_amdgcn_s_sleep(1);
        if ((++sp & 255u) == 0u) { if (xb_ld(&bar[XB_TMO])) break; if (sp > XB_SPIN_CAP) { atomicAdd(&bar[XB_TMO], 1u); break; } }
    }
    nloc = mine > 0u ? mine : 1u; nx = cnt > 0u ? cnt : 1u;
}
__device__ __forceinline__ void xcd_barrier(const XcdBarrier& b) {
    asm volatile("s_waitcnt vmcnt(0)" ::: "memory");
    __syncthreads();
    if (threadIdx.x == 0) {
        unsigned* bar = b.bar;
        __builtin_amdgcn_s_waitcnt(0);
        unsigned nloc = b.st[0], nx = b.st[1];
        if (nloc == 0u) { xcd_barrier_complete(bar, b.x, nloc, nx); b.st[0] = nloc; b.st[1] = nx; }
        const unsigned old = xb_add(&bar[XB_XSUB(b.x)], 1u);
        const unsigned gen = old / nloc;
        if (old + 1u == (gen + 1u) * nloc) {
            __builtin_amdgcn_fence(__ATOMIC_RELEASE, "agent");
            asm volatile("s_waitcnt vmcnt(0)" ::: "memory");
            const unsigned og = xb_add(&bar[XB_TOP], 1u);
            const unsigned tg = og / nx;
            if (og + 1u == (tg + 1u) * nx) xb_add(&bar[XB_TOPGEN], 1u);
            else XB_SPIN(xb_ld(&bar[XB_TOPGEN]) == tg, bar);
            __builtin_amdgcn_fence(__ATOMIC_ACQUIRE, "agent");
            xb_add(&bar[XB_XGEN(b.x)], 1u);
            asm volatile("s_waitcnt vmcnt(0)" ::: "memory");
        } else {
            XB_SPIN(xb_ld(&bar[XB_XGEN(b.x)]) == gen, bar);
            __builtin_amdgcn_fence(__ATOMIC_ACQUIRE, "agent");
            asm volatile("s_waitcnt vmcnt(0)" ::: "memory");
        }
    }
    __syncthreads();
}

struct Args { const float* in[22]; float* out; unsigned char* ws; int ph_lo, ph_hi, bar_region, pad; };
static_assert(sizeof(Args) == 22 * 8 + 8 + 8 + 16, "Args has no padding");
#define INP(i) (A.in[i])
struct Frame {
    LAS unsigned char* lds;
    volatile LAS unsigned* MISC;
    int tid, lane, wave;
    int vcu, G;
    unsigned char* ws;
    float* out;
};
#define WSP(T, off) ((T*)(F.ws + (off)))
__device__ __forceinline__ int relaunder(Frame& F) { int t2 = threadIdx.x; asm volatile("" : "+v"(t2)); F.tid = t2; unsigned char* w = F.ws; asm volatile("" : "+s"(w)); F.ws = w; float* o = F.out; asm volatile("" : "+s"(o)); F.out = o; return 0; }
__device__ __forceinline__ int lane_of(const Frame& F) { int l = F.tid & 63; asm volatile("" : "+v"(l)); return l; }

__device__ __forceinline__ float wave_sum(float v) {
#pragma unroll
    for (int o = 1; o < 64; o <<= 1) v += __shfl_xor(v, o);
    return v;
}

constexpr int TPITCH = 260;
constexpr int TILE_BYTES = 64 * TPITCH * 4;
static_assert(2 * TILE_BYTES <= LDSCTL_OFF && MISC_OFF + 128 <= LDS_BYTES, "LDS map");
constexpr int P0_NA = 3 * ((DM / 64) * (DFF / 256)) + (DM / 64) * (INC / 256) + (DM / 64) * (DM / 256);
constexpr int P0_NB = 3 * ((DM / 64) * (DFF / 256));
constexpr int P0_NP = 4 * ((HD / 64) * (HD / 256));
static_assert((DFF / 64) * (DM / 256) == (DM / 64) * (DFF / 256), "down and gate/up have the same item count");
constexpr int CW_QUEUE = 64;
struct P0Item { const float* src; unsigned char* dst; int N, ldkb, f8; float mul; };
__device__ __forceinline__ void p0_decode(const Args& A, unsigned char* ws, int it, int w, P0Item& d) {
    constexpr int B_F = (DM / 64) * (DFF / 256), B_D = (DFF / 64) * (DM / 256), B_IN = (DM / 64) * (INC / 256), B_OUT = (DM / 64) * (DM / 256), B_P = (HD / 64) * (HD / 256);
    int r = it; const float* W; int K, Nn, mode = 0, f8 = 1; unsigned char* WT; float mul = WMUL_UP;
    if (r < B_F) { W = INP(9); K = DM; Nn = DFF; WT = ws + WS_W1; mode = 1; }
    else if ((r -= B_F) < B_F) { W = INP(10); K = DM; Nn = DFF; WT = ws + WS_W1; mode = 2; }
    else if ((r -= B_F) < B_D) { W = INP(11); K = DFF; Nn = DM; WT = ws + WS_W1D; mul = WMUL_DOWN; }
    else if ((r -= B_D) < B_IN) { W = INP(13); K = DM; Nn = INC; WT = ws + WS_WIN; f8 = 0; mul = 1.0f; }
    else if ((r -= B_IN) < B_OUT) { W = INP(16); K = DM; Nn = DM; WT = ws + WS_WOUT; }
    else if ((r -= B_OUT) < B_F) { W = INP(18); K = DM; Nn = DFF; WT = ws + WS_W2; mode = 1; }
    else if ((r -= B_F) < B_F) { W = INP(19); K = DM; Nn = DFF; WT = ws + WS_W2; mode = 2; }
    else if ((r -= B_F) < B_D) { W = INP(20); K = DFF; Nn = DM; WT = ws + WS_W2D; mul = WMUL_DOWN; }
    else { r -= B_D; const int g = r / B_P; r -= g * B_P; W = INP(14) + (size_t)g * HD * HD; K = HD; Nn = HD; WT = ws + WS_WPOOL + (size_t)g * HD * HD * 2; f8 = 0; mul = 1.0f; }
    const int nkb = K / 64, ng = r / nkb, kb = r - ng * nkb, k0 = 64 * kb, n0 = 256 * ng + 32 * w;
    const int drow = (mode == 0) ? n0 : (256 * (n0 >> 7) + (n0 & 127) + (mode == 2 ? 128 : 0));
    d.src = W + (size_t)k0 * Nn + 256 * ng; d.N = Nn; d.f8 = f8; d.mul = mul;
    d.ldkb = f8 ? K : 2 * K; d.dst = WT + (size_t)drow * d.ldkb + (f8 ? k0 : 2 * k0);
}
__device__ __forceinline__ void tile_load(const float* src, int N, f32x4 (&t)[8], int w, int lane) {
#pragma unroll
    for (int i = 0; i < 8; ++i) t[i] = __builtin_nontemporal_load((const f32x4*)(src + (size_t)(8 * w + i) * N + 4 * lane));
}
__device__ __forceinline__ void tile_store(LAS float* buf, const f32x4 (&t)[8], float mul, int w, int lane) {
#pragma unroll
    for (int i = 0; i < 8; ++i) *(LAS f32x4*)(buf + (8 * w + i) * TPITCH + 4 * lane) = t[i] * mul;
}
__device__ __forceinline__ void p0_convert(const P0Item& d, const LAS float* buf, int w, int lane, bool NT) {
    if (d.f8) {
        const int c = lane & 3;
#pragma unroll
        for (int j = 0; j < 2; ++j) { const int n = (lane >> 2) + 16 * j; const LAS float* s = buf + (16 * c) * TPITCH + 32 * w + n;
            v4u o; o.x = pg8::pk4_fp8(s[0 * TPITCH], s[1 * TPITCH], s[2 * TPITCH], s[3 * TPITCH]); o.y = pg8::pk4_fp8(s[4 * TPITCH], s[5 * TPITCH], s[6 * TPITCH], s[7 * TPITCH]);
            o.z = pg8::pk4_fp8(s[8 * TPITCH], s[9 * TPITCH], s[10 * TPITCH], s[11 * TPITCH]); o.w = pg8::pk4_fp8(s[12 * TPITCH], s[13 * TPITCH], s[14 * TPITCH], s[15 * TPITCH]);
            if (NT) __builtin_nontemporal_store(o, (v4u*)(d.dst + (size_t)n * d.ldkb + 16 * c)); else *(GAS v4u*)(d.dst + (size_t)n * d.ldkb + 16 * c) = o; }
    } else {
        const int c = lane & 7;
#pragma unroll
        for (int j = 0; j < 4; ++j) { const int n = (lane >> 3) + 8 * j; const LAS float* s = buf + (8 * c) * TPITCH + 32 * w + n;
            v4u o; o.x = pk2(s[0 * TPITCH], s[1 * TPITCH]); o.y = pk2(s[2 * TPITCH], s[3 * TPITCH]); o.z = pk2(s[4 * TPITCH], s[5 * TPITCH]); o.w = pk2(s[6 * TPITCH], s[7 * TPITCH]);
            if (NT) __builtin_nontemporal_store(o, (v4u*)(d.dst + (size_t)n * d.ldkb + 16 * c)); else *(GAS v4u*)(d.dst + (size_t)n * d.ldkb + 16 * c) = o; }
    }
}
__device__ __forceinline__ void p0_prologue(Frame& F, const Args& A) {
    const int flane = lane_of(F);
    const int w = F.wave;
    const int gt = F.vcu * (NWAVES * 64) + F.tid, NT = F.G * NWAVES * 64;
    for (int i = gt; i < 160 * DM / 4; i += NT) {
        const int m = (4 * i) / DM, k = (4 * i) % DM;
        f32x4 v = (f32x4){0.f, 0.f, 0.f, 0.f};
        if (m < NB) v = *(const f32x4*)(INP(2) + (size_t)m * DM + k); else if (m < NMODROW) v = *(const f32x4*)(INP(3) + (size_t)(m - NB) * DM + k);
        v2u o; o.x = pk2(silu1(v[0]), silu1(v[1])); o.y = pk2(silu1(v[2]), silu1(v[3]));
        *(GAS v2u*)(WSP(bf16, WS_SC) + ((size_t)(((k >> 4) * 5 + (m >> 5)) * 64 + ((k >> 3) & 1) * 32 + (m & 31)) * 8 + (k & 7))) = o;
    }
    for (int i = gt; i < NPOS * 128; i += NT) {
        const int p = i >> 7, fi = i & 127;
        const float pos = (float)(p < SEQ ? p : PAST + (p - SEQ));
        const float inv = (float)exp(-(double)fi * (9.210340371976184 / 128.0));
        const float ang = pos * inv;
        double s, c; sincos((double)ang, &s, &c);
        WSP(float, WS_ROT)[2 * (size_t)i] = (float)c; WSP(float, WS_ROT)[2 * (size_t)i + 1] = (float)s;
    }
}

__device__ __forceinline__ void p1_adaln(Frame& F, const Args& A) {
    const int flane = lane_of(F);
    LAS float* red = (LAS float*)F.lds;
    const int lane = flane, w = F.wave, r = lane & 31, hh = lane >> 5;
    for (int u = F.vcu; u < 2 * (NMOD / 256); u += F.G) {
        const int cg = u >> 1, kh = u & 1, n0 = (8 * cg + w) * 32;
        f32x16 acc[5];
#pragma unroll
        for (int t = 0; t < 5; ++t)
#pragma unroll
            for (int i = 0; i < 16; ++i) acc[t][i] = 0.f;
        const float* Wp = INP(6) + (size_t)(1024 * kh + 8 * hh) * NMOD + n0 + r;
        const bf16* Sp = WSP(bf16, WS_SC) + ((size_t)(64 * kh) * 5 * 64 + lane) * 8;
#pragma unroll 4
        for (int s = 0; s < 64; ++s) {
            float wv[8];
#pragma unroll
            for (int j = 0; j < 8; ++j) wv[j] = __builtin_nontemporal_load(Wp + (size_t)(16 * s + j) * NMOD);
            v4u au; au.x = pk2(wv[0], wv[1]); au.y = pk2(wv[2], wv[3]); au.z = pk2(wv[4], wv[5]); au.w = pk2(wv[6], wv[7]);
            const bf16x8 a = __builtin_bit_cast(bf16x8, au);
#pragma unroll
            for (int t = 0; t < 5; ++t) {
                const bf16x8 b = *(const bf16x8*)(Sp + (size_t)((s * 5 + t) * 64) * 8);
                acc[t] = __builtin_amdgcn_mfma_f32_32x32x16_bf16(a, b, acc[t], 0, 0, 0);
            }
        }
        float* dst = WSP(float, WS_MODS) + (kh ? MODSB_DELTA : (size_t)0);
#pragma unroll
        for (int pass = 0; pass < 2; ++pass) {
            if ((w >> 2) == pass) { LAS float* rs = red + (w & 3) * (160 * 33);
#pragma unroll
                for (int t = 0; t < 5; ++t)
#pragma unroll
                    for (int i = 0; i < 16; ++i) rs[(32 * t + r) * 33 + (i & 3) + 8 * (i >> 2) + 4 * hh] = acc[t][i]; }
            __syncthreads();
            const int c0 = 256 * cg + 128 * pass;
            for (int idx = F.tid; idx < NMODROW * 128; idx += NWAVES * 64) { const int m = idx >> 7, c = idx & 127;
                dst[(size_t)m * NMOD + c0 + c] = red[(c >> 5) * (160 * 33) + m * 33 + (c & 31)] + (kh ? 0.f : INP(7)[c0 + c]); }
            __syncthreads();
        }
    }
    {
        const int w8 = F.wave;
        LAS float* buf0 = (LAS float*)F.lds; LAS float* buf1 = (LAS float*)(F.lds + TILE_BYTES);
        volatile LAS int* qslot = (volatile LAS int*)(F.lds + MISC_OFF + 64);
        unsigned* qhead = (unsigned*)(F.ws + WS_CTL) + CW_QUEUE;
        if (F.tid == 0) { qslot[0] = (int)__hip_atomic_fetch_add(qhead, 1u, __ATOMIC_RELAXED, __HIP_MEMORY_SCOPE_AGENT); qslot[1] = (int)__hip_atomic_fetch_add(qhead, 1u, __ATOMIC_RELAXED, __HIP_MEMORY_SCOPE_AGENT); }
        __syncthreads();
        int ic = qslot[0], in = qslot[1];
        __syncthreads();
        constexpr int NALL = P0_NA + P0_NB + P0_NP;
        if (ic < NALL) {
            P0Item cur, nxt; f32x4 t[8];
            p0_decode(A, F.ws, ic, w8, cur); tile_load(cur.src, cur.N, t, w8, flane); tile_store(buf0, t, cur.mul, w8, flane);
            __syncthreads();
            int par = 0;
            for (;;) {
                const bool more = in < NALL;
                if (more) { p0_decode(A, F.ws, in, w8, nxt); tile_load(nxt.src, nxt.N, t, w8, flane); }
                if (F.tid == 0) qslot[0] = (int)__hip_atomic_fetch_add(qhead, 1u, __ATOMIC_RELAXED, __HIP_MEMORY_SCOPE_AGENT);
                p0_convert(cur, par ? buf1 : buf0, w8, flane, ic >= P0_NA && ic < P0_NA + P0_NB);
                if (more) { tile_store(par ? buf0 : buf1, t, nxt.mul, w8, flane); cur = nxt; ic = in; }
                __syncthreads();
                if (!more) break;
                in = qslot[0];
                __syncthreads();
                par ^= 1;
            }
        }
    }
}

__device__ __forceinline__ f32x4 ld4_bf16_nt(const bf16* p) { const v2u v = __builtin_nontemporal_load((const v2u*)p);
    return (f32x4){__builtin_bit_cast(float, v.x << 16), __builtin_bit_cast(float, v.x & 0xffff0000u), __builtin_bit_cast(float, v.y << 16), __builtin_bit_cast(float, v.y & 0xffff0000u)}; }
__device__ __forceinline__ f32x4 ld4_bf16(const bf16* p) { const v2u v = *(const v2u*)p;
    return (f32x4){__builtin_bit_cast(float, v.x << 16), __builtin_bit_cast(float, v.x & 0xffff0000u), __builtin_bit_cast(float, v.y << 16), __builtin_bit_cast(float, v.y & 0xffff0000u)}; }
template <bool OUT8, int NP, bool S16, bool FIN>
__device__ __forceinline__ void norm_sample_rows(Frame& F, const float* srcS32, const float* gain, int sub, bf16* Hd, float* yS) {
    const int flane = lane_of(F);
    const int w = F.wave;
    bf16* X16 = WSP(bf16, WS_X); const bf16* slab = WSP(bf16, WS_SLAB);
    LAS float* part = (LAS float*)F.lds;
    int par = 0;
    for (int hr = F.vcu; hr < MS; hr += F.G) {
        const int m = MP + hr, k = 256 * w + 4 * flane;
        f32x4 v = S16 ? ld4_bf16(X16 + (size_t)m * DM + k) : *(const f32x4*)(srcS32 + (size_t)hr * DM + k);
        if (NP > 0) {
            f32x4 sv[NP > 0 ? NP : 1];
#pragma unroll
            for (int p = 0; p < NP; ++p) sv[p] = ld4_bf16(slab + ((size_t)p * MS + hr) * DM + k);
#pragma unroll
            for (int p = 0; p < NP; ++p) v += sv[p];
            if (!FIN) { v2u pk; pk.x = pk2(v[0], v[1]); pk.y = pk2(v[2], v[3]); *(GAS v2u*)(X16 + (size_t)m * DM + k) = pk; }
        }
        const float ssw = wave_sum((v[0] * v[0] + v[1] * v[1]) + (v[2] * v[2] + v[3] * v[3]));
        if (flane == 0) part[par * 8 + w] = ssw;
        __syncthreads();
        float ss = 0.f;
#pragma unroll
        for (int i = 0; i < 8; ++i) ss += part[par * 8 + i];
        par ^= 1;
        const float rstd = 1.0f / sqrtf(ss * (1.0f / DM) + EPS);
        if (FIN) { const f32x4 g4 = *(const f32x4*)(gain + k); *(f32x4*)(yS + (size_t)hr * DM + k) = (v * rstd) * g4; }
        else {
            const float* sh = WSP(float, WS_MODS) + (size_t)pg8::modrow_of(m) * NMOD + (size_t)(3 * sub) * DM; const float* sc = sh + DM;
            const f32x4 g4 = *(const f32x4*)(gain + k), s4 = *(const f32x4*)(sc + k) + *(const f32x4*)(sc + MODSB_DELTA + k), h4 = *(const f32x4*)(sh + k) + *(const f32x4*)(sh + MODSB_DELTA + k);
            const f32x4 o = (v * rstd) * g4 * (s4 + 1.0f) + h4;
            if (OUT8) { *(GAS unsigned*)((unsigned char*)Hd + (size_t)m * DM + k) = pg8::pk4_fp8(o[0], o[1], o[2], o[3]); }
            else { v2u pk; pk.x = pk2(o[0], o[1]); pk.y = pk2(o[2], o[3]); *(GAS v2u*)(Hd + (size_t)m * DM + k) = pk; }
        }
    }
    __syncthreads();
}
template <bool OUT8, bool P16>
__device__ __forceinline__ void norm_prompt_rows(Frame& F, const float* srcP32, const float* gain, int sub, bf16* Hd) {
    const int flane = lane_of(F);
    const int gw = F.vcu * NWAVES + F.wave, NGW = F.G * NWAVES;
    const bf16* X16 = WSP(bf16, WS_X);
    for (int m = gw; m < MP; m += NGW) {
        const float* sh = WSP(float, WS_MODS) + (size_t)pg8::modrow_of(m) * NMOD + (size_t)(3 * sub) * DM; const float* sc = sh + DM;
        f32x4 v[8]; float ss = 0.f;
#pragma unroll
        for (int j = 0; j < 8; ++j) v[j] = P16 ? ld4_bf16(X16 + (size_t)m * DM + 4 * (flane + 64 * j)) : *(const f32x4*)(srcP32 + (size_t)m * DM + 4 * (flane + 64 * j));
#pragma unroll
        for (int j = 0; j < 8; ++j) ss += (v[j][0] * v[j][0] + v[j][1] * v[j][1]) + (v[j][2] * v[j][2] + v[j][3] * v[j][3]);
        const float rstd = 1.0f / sqrtf(wave_sum(ss) * (1.0f / DM) + EPS);
#pragma unroll
        for (int j = 0; j < 8; ++j) { const int k = 4 * (flane + 64 * j);
            const f32x4 g4 = *(const f32x4*)(gain + k), s4 = *(const f32x4*)(sc + k) + *(const f32x4*)(sc + MODSB_DELTA + k), h4 = *(const f32x4*)(sh + k) + *(const f32x4*)(sh + MODSB_DELTA + k);
            const f32x4 o = (v[j] * rstd) * g4 * (s4 + 1.0f) + h4;
            if (OUT8) { *(GAS unsigned*)((unsigned char*)Hd + (size_t)m * DM + k) = pg8::pk4_fp8(o[0], o[1], o[2], o[3]); }
            else { v2u pk; pk.x = pk2(o[0], o[1]); pk.y = pk2(o[2], o[3]); *(GAS v2u*)(Hd + (size_t)m * DM + k) = pk; } }
    }
}
template <bool OUT8, int NP, bool P16, bool S16>
__device__ __forceinline__ void norm_mod(Frame& F, const float* srcP32, const float* srcS32, const float* gain, int sub, bf16* Hd) {
    norm_sample_rows<OUT8, NP, S16, false>(F, srcS32, gain, sub, Hd, nullptr);
    norm_prompt_rows<OUT8, P16>(F, srcP32, gain, sub, Hd);
}
template <int NP>
__device__ __forceinline__ void final_norm(Frame& F, const Args& A) {
    norm_sample_rows<false, NP, true, true>(F, nullptr, INP(21), 0, nullptr, F.out + O_YS);
    const int flane = lane_of(F);
    const int gw = F.vcu * NWAVES + F.wave, NGW = F.G * NWAVES;
    const bf16* X16 = WSP(bf16, WS_X);
    for (int m = gw; m < MP; m += NGW) {
        float* yr = F.out + O_YP + (size_t)m * DM;
        f32x4 v[8]; float ss = 0.f;
#pragma unroll
        for (int j = 0; j < 8; ++j) v[j] = ld4_bf16_nt(X16 + (size_t)m * DM + 4 * (flane + 64 * j));
#pragma unroll
        for (int j = 0; j < 8; ++j) ss += (v[j][0] * v[j][0] + v[j][1] * v[j][1]) + (v[j][2] * v[j][2] + v[j][3] * v[j][3]);
        const float rstd = 1.0f / sqrtf(wave_sum(ss) * (1.0f / DM) + EPS);
#pragma unroll
        for (int j = 0; j < 8; ++j) { const int k = 4 * (flane + 64 * j); const f32x4 g4 = *(const f32x4*)(INP(21) + k); __builtin_nontemporal_store((v[j] * rstd) * g4, (f32x4*)(yr + k)); }
    }
}

#define MFMA16(a, b, c) __builtin_amdgcn_mfma_f32_16x16x32_bf16(a, b, c, 0, 0, 0)
__device__ __forceinline__ float log2_gamma(int h) { return h == 0 ? -0.045803689613124747f : h == 1 ? -0.022720076500083405f : h == 2 ? -0.011315313227834146f : -0.0056465631411130581f; }
constexpr int TP = 136;

__device__ __forceinline__ void retA_unit(Frame& F, int unit) {
    const int flane = lane_of(F);
    const int half = unit & 1, c = (unit >> 1) & 15, bh = unit >> 5, b = bh >> 2, h = bh & 3;
    const int m0 = b * SEQ + c * CH;
    const int tid = F.tid, lane = flane, w = F.wave, fr = lane & 15, fq = lane >> 4;
    LAS bf16* VT = (LAS bf16*)F.lds; LAS bf16* KT = VT + 256 * TP; LAS bf16* PP = KT + 128 * TP;
    const bf16* Qg = WSP(bf16, WS_QKVG) + (size_t)m0 * RW + h * HD;
    const bf16* Kg = Qg + (size_t)MTOK * RW; const bf16* Vg = Kg + (size_t)MTOK * RW;
    const float l2g = log2_gamma(h);
#pragma unroll 2
    for (int it = 0; it < 8; ++it) { const int idx = it * 512 + tid, tok = idx & 127, ch = idx >> 7;
        const bf16x8 v = *(const bf16x8*)(Vg + (size_t)tok * RW + ch * 8);
#pragma unroll
        for (int e = 0; e < 8; ++e) VT[(ch * 8 + e) * TP + tok] = (bf16)v[e]; }
#pragma unroll 2
    for (int it = 0; it < 4; ++it) { const int idx = it * 512 + tid, tok = idx & 127, ch = idx >> 7;
        const bf16x8 k = *(const bf16x8*)(Kg + (size_t)tok * RW + half * 128 + ch * 8);
        const float kd = __builtin_amdgcn_exp2f((float)(127 - tok) * l2g);
#pragma unroll
        for (int e = 0; e < 8; ++e) KT[(ch * 8 + e) * TP + tok] = (bf16)f2bf(bf2f((bf16)k[e]) * kd); }
    {
        f32x4 acc[4];
#pragma unroll
        for (int i = 0; i < 4; ++i) acc[i] = (f32x4){0.f, 0.f, 0.f, 0.f};
        if (16 * w < 64 * half + 64) {
#pragma unroll 2
            for (int s = 0; s < 8; ++s) {
                const bf16x8 bb = *(const bf16x8*)(Kg + (size_t)(16 * w + fr) * RW + 32 * s + 8 * fq);
#pragma unroll
                for (int i = 0; i < 4; ++i) { const bf16x8 aa = *(const bf16x8*)(Qg + (size_t)(64 * half + 16 * i + fr) * RW + 32 * s + 8 * fq); acc[i] = MFMA16(aa, bb, acc[i]); }
            }
        }
#pragma unroll
        for (int i = 0; i < 4; ++i)
#pragma unroll
            for (int r = 0; r < 4; ++r) { const int nl = 16 * i + 4 * fq + r, n = 64 * half + nl, m = 16 * w + fr, dn = n - m;
                const float val = dn >= 0 ? acc[i][r] * __builtin_amdgcn_exp2f((float)dn * l2g) : 0.f;
                PP[nl * TP + m] = (bf16)f2bf(val); }
    }
    __syncthreads();
    {
        f32x4 o[2][4];
#pragma unroll
        for (int j = 0; j < 2; ++j)
#pragma unroll
            for (int i = 0; i < 4; ++i) o[j][i] = (f32x4){0.f, 0.f, 0.f, 0.f};
#pragma unroll
        for (int s = 0; s < 4; ++s) {
            bf16x8 a[4];
#pragma unroll
            for (int i = 0; i < 4; ++i) a[i] = *(const LAS bf16x8*)(PP + (16 * i + fr) * TP + 32 * s + 8 * fq);
#pragma unroll
            for (int j = 0; j < 2; ++j) { const bf16x8 bb = *(const LAS bf16x8*)(VT + (16 * (2 * w + j) + fr) * TP + 32 * s + 8 * fq);
#pragma unroll
                for (int i = 0; i < 4; ++i) o[j][i] = MFMA16(bb, a[i], o[j][i]); }
        }
#pragma unroll
        for (int j = 0; j < 2; ++j)
#pragma unroll
            for (int i = 0; i < 4; ++i) { v2u pk; pk.x = pk2(o[j][i][0], o[j][i][1]); pk.y = pk2(o[j][i][2], o[j][i][3]);
                *(GAS v2u*)(WSP(bf16, WS_OI) + (size_t)(m0 + 64 * half + 16 * i + fr) * RW + h * HD + 16 * (2 * w + j) + 4 * fq) = pk; }
    }
    {
        f32x4 ua[2][8];
#pragma unroll
        for (int i = 0; i < 2; ++i)
#pragma unroll
            for (int j = 0; j < 8; ++j) ua[i][j] = (f32x4){0.f, 0.f, 0.f, 0.f};
#pragma unroll
        for (int s = 0; s < 4; ++s) {
            bf16x8 a[2];
#pragma unroll
            for (int i = 0; i < 2; ++i) a[i] = *(const LAS bf16x8*)(VT + (16 * (2 * w + i) + fr) * TP + 32 * s + 8 * fq);
#pragma unroll
            for (int j = 0; j < 8; ++j) { const bf16x8 bb = *(const LAS bf16x8*)(KT + (16 * j + fr) * TP + 32 * s + 8 * fq);
#pragma unroll
                for (int i = 0; i < 2; ++i) ua[i][j] = MFMA16(bb, a[i], ua[i][j]); }
        }
        bf16* UTu = WSP(bf16, WS_UT) + (size_t)(bh * NCH + c) * HD * HD;
#pragma unroll
        for (int i = 0; i < 2; ++i)
#pragma unroll
            for (int j = 0; j < 8; ++j) { v2u pk; pk.x = pk2(ua[i][j][0], ua[i][j][1]); pk.y = pk2(ua[i][j][2], ua[i][j][3]);
                *(GAS v2u*)(UTu + (size_t)(16 * (2 * w + i) + fr) * HD + 128 * half + 16 * j + 4 * fq) = pk; }
    }
    __syncthreads();
}

__device__ __forceinline__ void retC_unit(Frame& F, int unit) {
    const int flane = lane_of(F);
    const int c = unit & 15, bh = unit >> 4, b = bh >> 2, h = bh & 3;
    const int m0 = b * SEQ + c * CH;
    const int tid = F.tid, lane = flane, w = F.wave, fr = lane & 15, fq = lane >> 4;
    const bf16* Qg = WSP(bf16, WS_QKVG) + (size_t)m0 * RW + h * HD;
    const bf16* Gg = Qg + (size_t)3 * MTOK * RW;
    const float l2g = log2_gamma(h);
    f32x4 acc[16];
#pragma unroll
    for (int j = 0; j < 16; ++j) acc[j] = (f32x4){0.f, 0.f, 0.f, 0.f};
    if (c > 0) {
        const bf16* STc = WSP(bf16, WS_ST) + (size_t)(bh * NCH + c) * HD * HD;
        {
            v4u st[16];
#pragma unroll
            for (int it = 0; it < 16; ++it) st[it] = *(const v4u*)(STc + (size_t)(it * 512 + tid) * 8);
#pragma unroll
            for (int it = 0; it < 16; ++it) { const int idx = it * 512 + tid, row = idx >> 5, ch = idx & 31;
                *(LAS v4u*)(F.lds + row * 512 + ((ch ^ (row & 15)) * 16)) = st[it]; }
        }
        bf16x8 qf[8];
#pragma unroll
        for (int s = 0; s < 8; ++s) qf[s] = *(const bf16x8*)(Qg + (size_t)(16 * w + fr) * RW + 32 * s + 8 * fq);
        __syncthreads();
#pragma unroll
        for (int s = 0; s < 8; ++s) {
#pragma unroll
            for (int j = 0; j < 16; ++j) { const bf16x8 aa = *(const LAS bf16x8*)(F.lds + (16 * j + fr) * 512 + (((4 * s + fq) ^ fr) * 16)); acc[j] = MFMA16(aa, qf[s], acc[j]); }
        }
    }
    {
        const int n = 16 * w + fr; const size_t row = (size_t)(m0 + n);
        const float qd = __builtin_amdgcn_exp2f((float)(n + 1) * l2g);
        const bf16* oip = WSP(bf16, WS_OI) + row * RW + h * HD + 4 * fq;
        float ss = 0.f;
#pragma unroll
        for (int j = 0; j < 16; ++j) { const f32x4 o = ld4_bf16(oip + 16 * j) + acc[j] * qd; acc[j] = o; ss += (o[0] * o[0] + o[1] * o[1]) + (o[2] * o[2] + o[3] * o[3]); }
        ss += __shfl_xor(ss, 16); ss += __shfl_xor(ss, 32);
        const float rs = 1.0f / sqrtf(ss * (1.0f / HD) + EPS);
        const bf16* gp = Gg + (size_t)n * RW + 4 * fq;
        unsigned char* mp = WSP(unsigned char, WS_MIX) + row * DM + PW + h * HD + 4 * fq;
#pragma unroll
        for (int j = 0; j < 16; ++j) { const v2u gv = *(const v2u*)(gp + 16 * j);
            const float g0 = bf2f((bf16)(gv.x & 0xffffu)), g1 = bf2f((bf16)(gv.x >> 16)), g2 = bf2f((bf16)(gv.y & 0xffffu)), g3 = bf2f((bf16)(gv.y >> 16));
            *(GAS unsigned*)(mp + 16 * j) = pg8::pk4_fp8(silu1(g0) * acc[j][0] * rs, silu1(g1) * acc[j][1] * rs, silu1(g2) * acc[j][2] * rs, silu1(g3) * acc[j][3] * rs); }
    }
    __syncthreads();
}

__device__ __forceinline__ void retS_unit(Frame& F, const Args& A, int unit) {
    const int flane = lane_of(F);
    const int b = unit >> 2, h = unit & 3, row0 = MP + 4 * b;
    const int tid = F.tid, lane = flane, w = F.wave;
    LAS float* qs = (LAS float*)F.lds; LAS float* kr = qs + 1024; LAS float* vs = kr + 1024; LAS float* red = vs + 1024; LAS float* dots = red + 8192;
    const bf16* Qg = WSP(bf16, WS_QKVG); const bf16* Kg = Qg + (size_t)MTOK * RW; const bf16* Vg = Kg + (size_t)MTOK * RW; const bf16* Gg = Vg + (size_t)MTOK * RW;
    const float l2g = log2_gamma(h);
    for (int i = tid; i < 1024; i += NWAVES * 64) { const int t = i >> 8, d = i & 255; const size_t off = (size_t)(row0 + t) * RW + h * HD + d;
        qs[i] = bf2f(Qg[off]); kr[i] = bf2f(Kg[off]); vs[i] = bf2f(Vg[off]); }
    __syncthreads();
#pragma unroll
    for (int jj = 0; jj < 2; ++jj) { const int p = 2 * w + jj, t = p >> 2, m = p & 3;
        const f32x4 a = *(const LAS f32x4*)(qs + t * 256 + 4 * lane), k4 = *(const LAS f32x4*)(kr + m * 256 + 4 * lane);
        const float d = wave_sum((a[0] * k4[0] + a[1] * k4[1]) + (a[2] * k4[2] + a[3] * k4[3]));
        if (lane == 0) dots[p] = d; }
    const f32x4* S0 = (const f32x4*)(INP(5) + (size_t)unit * HD * HD);
    f32x4* S1 = (f32x4*)(F.out + O_RETS + (size_t)unit * HD * HD);
    f32x4 v4[4], oq[4];
#pragma unroll
    for (int t = 0; t < 4; ++t) { v4[t] = *(const LAS f32x4*)(vs + t * 256 + 4 * lane); oq[t] = (f32x4){0.f, 0.f, 0.f, 0.f}; }
    const float cdec = __builtin_amdgcn_exp2f(4.0f * l2g);
    const float kd0 = __builtin_amdgcn_exp2f(3.0f * l2g), kd1 = __builtin_amdgcn_exp2f(2.0f * l2g), kd2 = __builtin_amdgcn_exp2f(l2g);
    f32x4 s[8], sn[8];
#pragma unroll
    for (int u = 0; u < 8; ++u) s[u] = __builtin_nontemporal_load(S0 + (size_t)(32 * w + u) * 64 + lane);
#pragma unroll
    for (int it = 0; it < 4; ++it) {
        const int dk0 = 32 * w + 8 * it;
        if (it < 3) {
#pragma unroll
            for (int u = 0; u < 8; ++u) sn[u] = __builtin_nontemporal_load(S0 + (size_t)(dk0 + 8 + u) * 64 + lane);
        }
#pragma unroll
        for (int u = 0; u < 8; ++u) { const int dk = dk0 + u;
            const float q0 = qs[dk], q1 = qs[256 + dk], q2 = qs[512 + dk], q3 = qs[768 + dk];
            const float k0 = kr[dk] * kd0, k1 = kr[256 + dk] * kd1, k2 = kr[512 + dk] * kd2, k3 = kr[768 + dk];
            oq[0] += s[u] * q0; oq[1] += s[u] * q1; oq[2] += s[u] * q2; oq[3] += s[u] * q3;
            __builtin_nontemporal_store(s[u] * cdec + v4[0] * k0 + v4[1] * k1 + v4[2] * k2 + v4[3] * k3, S1 + (size_t)dk * 64 + lane); }
#pragma unroll
        for (int u = 0; u < 8; ++u) s[u] = sn[u];
    }
#pragma unroll
    for (int t = 0; t < 4; ++t) *(LAS f32x4*)(red + (w * 4 + t) * 256 + 4 * lane) = oq[t];
    __syncthreads();
    if (w < 4) {
        const int t = w;
        f32x4 o = (f32x4){0.f, 0.f, 0.f, 0.f};
#pragma unroll
        for (int ww = 0; ww < 8; ++ww) o += *(const LAS f32x4*)(red + (ww * 4 + t) * 256 + 4 * lane);
        o = o * __builtin_amdgcn_exp2f((float)(t + 1) * l2g);
#pragma unroll
        for (int m = 0; m < 4; ++m) if (m <= t) o += v4[m] * (dots[t * 4 + m] * __builtin_amdgcn_exp2f((float)(t - m) * l2g));
        const float ss = wave_sum((o[0] * o[0] + o[1] * o[1]) + (o[2] * o[2] + o[3] * o[3]));
        const float rs = 1.0f / sqrtf(ss * (1.0f / HD) + EPS);
        const size_t row = (size_t)(row0 + t);
        const v2u gp = *(const v2u*)(Gg + row * RW + h * HD + 4 * lane);
        const float g0 = bf2f((bf16)(gp.x & 0xffffu)), g1 = bf2f((bf16)(gp.x >> 16)), g2 = bf2f((bf16)(gp.y & 0xffffu)), g3 = bf2f((bf16)(gp.y >> 16));
        *(GAS unsigned*)(WSP(unsigned char, WS_MIX) + row * DM + PW + h * HD + 4 * lane) = pg8::pk4_fp8(silu1(g0) * o[0] * rs, silu1(g1) * o[1] * rs, silu1(g2) * o[2] * rs, silu1(g3) * o[3] * rs);
    }
    __syncthreads();
}

__device__ __forceinline__ void scan_states(Frame& F) {
    const int gt = F.vcu * (NWAVES * 64) + F.tid, NT = F.G * NWAVES * 64;
    for (int i = gt; i < 16 * 16384; i += NT) {
        const int bh = i >> 14, e4 = i & 16383, h = bh & 3;
        const bf16* up = WSP(bf16, WS_UT) + ((size_t)bh * NCH * 16384 + e4) * 4;
        f32x4 uv[16];
#pragma unroll
        for (int c = 0; c < 16; ++c) uv[c] = ld4_bf16(up + (size_t)c * 65536);
        const float g128 = __builtin_amdgcn_exp2f(128.0f * log2_gamma(h));
        f32x4 S = (f32x4){0.f, 0.f, 0.f, 0.f};
#pragma unroll
        for (int c = 0; c < 16; ++c) {
            S = S * g128 + uv[c];
            if (c < 15) { v2u pk; pk.x = pk2(S[0], S[1]); pk.y = pk2(S[2], S[3]); *(GAS v2u*)(WSP(bf16, WS_ST) + ((size_t)(bh * NCH + c + 1) * 16384 + e4) * 4) = pk; }
        }
        const int dv = (4 * e4) >> 8, dk = (4 * e4) & 255;
        float* rp = F.out + O_RETP + (size_t)bh * HD * HD + dv;
#pragma unroll
        for (int q = 0; q < 4; ++q) __builtin_nontemporal_store(S[q], rp + (size_t)(dk + q) * HD);
    }
}

__device__ __forceinline__ void pool_prompt_item(Frame& F, int item, int q) {
    const int b = item >> 8, t0 = (item & 255) * 8, g = q >> 6, wn = 2 << g;
    const bf16* U16 = WSP(bf16, WS_U) + (size_t)b * SEQ * PW + 4 * q;
#define U4_AT(t) ld4_bf16(U16 + (size_t)(t) * PW)
    f32x4 hv[15], cur[8], old[8];
#pragma unroll
    for (int j = 1; j < 16; ++j) { const int t = t0 - j; const bool ok = (j < wn) && (t >= 0); hv[j - 1] = U4_AT(ok ? t : t0) * (ok ? 1.0f : 0.0f); }
#pragma unroll
    for (int i = 0; i < 8; ++i) { const int t = t0 + i, to = t - wn; const bool ok = (i >= 1) && (to >= 0);
        cur[i] = U4_AT(t); old[i] = U4_AT(ok ? to : t) * (ok ? 1.0f : 0.0f); }
    f32x4 sum = (f32x4){0.f, 0.f, 0.f, 0.f};
#pragma unroll
    for (int j = 0; j < 15; ++j) sum += hv[j];
#pragma unroll
    for (int i = 0; i < 8; ++i) {
        const int t = t0 + i;
        sum += cur[i]; sum -= old[i];
        const float cnt = (float)((t + 1 < wn) ? (t + 1) : wn);
        const f32x4 mv = sum / cnt - cur[i];
        v2u pk; pk.x = pk2(mv[0], mv[1]); pk.y = pk2(mv[2], mv[3]);
        *(GAS v2u*)(WSP(bf16, WS_PM) + ((size_t)(b * SEQ + t) * PW + 4 * q)) = pk;
    }
}
#undef U4_AT
__device__ __forceinline__ void pool_sample_item(Frame& F, const Args& A, int b, int q) {
    const int g = q >> 6, wn = 2 << g;
    const f32x4* SP4 = (const f32x4*)(INP(4) + (size_t)b * 15 * PW) + q;
    const bf16* US16 = WSP(bf16, WS_U) + (size_t)(MP + 4 * b) * PW + 4 * q;
    for (int t = 0; t < 4; ++t) {
        f32x4 sum = (f32x4){0.f, 0.f, 0.f, 0.f};
        for (int j = 0; j < wn; ++j) { const int i = 15 + t - j; sum += (i < 15) ? SP4[(size_t)i * 256] : ld4_bf16(US16 + (size_t)(i - 15) * PW); }
        const f32x4 cur = ld4_bf16(US16 + (size_t)t * PW);
        const f32x4 mv = sum / (float)wn - cur;
        v2u pk; pk.x = pk2(mv[0], mv[1]); pk.y = pk2(mv[2], mv[3]);
        *(GAS v2u*)(WSP(bf16, WS_PM) + ((size_t)(MP + 4 * b + t) * PW + 4 * q)) = pk;
    }
}
__device__ __forceinline__ void pool_phase(Frame& F, const Args& A) {
    const int q = F.tid & 255, sub = F.tid >> 8;
    for (int bi = F.vcu; bi < 512; bi += F.G) pool_prompt_item(F, 2 * bi + sub, q);
    for (int bi = F.G - 1 - F.vcu; bi < 64; bi += F.G) pool_sample_item(F, A, 2 * bi + sub, q);
    const int gt = F.vcu * (NWAVES * 64) + F.tid, NT = F.G * NWAVES * 64;
    f32x4* o4 = (f32x4*)F.out;
    for (int i = gt; i < NB * 15 * 256; i += NT) { const int qq = i & 255, r = (i >> 8) % 15, b = (i >> 8) / 15;
        __builtin_nontemporal_store(ld4_bf16(WSP(bf16, WS_U) + (((size_t)b * SEQ + (SEQ - 15) + r) * 256 + qq) * 4), o4 + O_POOLP / 4 + i); }
    for (int i = gt; i < DB * 15 * 256; i += NT) { const int qq = i & 255, r = (i >> 8) % 15, b = (i >> 8) / 15;
        __builtin_nontemporal_store((r < 11) ? ((const f32x4*)INP(4))[((size_t)b * 15 + r + 4) * 256 + qq] : ld4_bf16(WSP(bf16, WS_U) + (((size_t)(MP + 4 * b) + (r - 11)) * 256 + qq) * 4), o4 + O_POOLS / 4 + i); }
}


__global__ void __launch_bounds__(NWAVES * 64, 2) mk_fwd(Args args) {
    extern __shared__ __attribute__((aligned(16))) unsigned char lds[];
    Frame F;
    F.lds = (LAS unsigned char*)lds;
    F.MISC = (volatile LAS unsigned*)(F.lds + MISC_OFF);
    F.tid = threadIdx.x; F.wave = __builtin_amdgcn_readfirstlane(F.tid >> 6);
    F.G = gridDim.x; { const int bx = blockIdx.x; F.vcu = (F.G % 8 == 0) ? (bx % 8) * (F.G / 8) + bx / 8 : bx; }
    unsigned char* ws = args.ws; const Args& A = args;
    F.out = args.out;
    F.ws = ws;
    for (int u = F.tid; u < (LDS_BYTES - LDSCTL_OFF) / 4; u += NWAVES * 64) ((LAS unsigned*)(F.lds + LDSCTL_OFF))[u] = 0u;
    __syncthreads();
    if (!MK_PER_PHASE) (void)xcd_barrier_post((unsigned*)(ws + WS_CTL) + CW_BAR + args.bar_region * XCD_BAR_WORDS, F.MISC + 8);
    const int lo = args.ph_lo, hi = args.ph_hi;
#ifdef PROBE_TA
    if (blockIdx.x == 0 && threadIdx.x == 0) ((unsigned long long*)(ws + WS_CTL + 49152))[0] = __builtin_amdgcn_s_memrealtime();
#endif
#ifndef PH_MASK
#define PH_MASK 0x7fff
#endif
#define IN(k) (((PH_MASK >> (k)) & 1) && lo <= (k) && (k) < hi)
#ifndef REP_MASK
#define REP_MASK 0
#endif
#ifdef PROBE_TA
#define STAMP_AFTER(k) do { if (blockIdx.x == 0 && threadIdx.x == 0) ((unsigned long long*)(A.ws + WS_CTL + 49152))[(k) + 1] = __builtin_amdgcn_s_memrealtime(); } while (0)
#else
#define STAMP_AFTER(k) do { } while (0)
#endif
#define NREP(k) ((((REP_MASK) >> (k)) & 1) ? 2 : 1)
#define SEAM(k) do { if (!MK_PER_PHASE && (IN((k) + 1) || rep_ + 1 < NREP(k))) { XcdBarrier bar_; bar_.bar = (unsigned*)(A.ws + WS_CTL) + CW_BAR + A.bar_region * XCD_BAR_WORDS; bar_.x = xb_xcc_id(); bar_.st = (volatile LAS unsigned*)(F.lds + MISC_OFF) + 8; xcd_barrier(bar_); } STAMP_AFTER(k); } while (0)

    if (IN(0)) for (int rep_ = relaunder(F); rep_ < NREP(0); ++rep_) { p0_prologue(F, A); SEAM(0); }
    if (IN(1)) for (int rep_ = relaunder(F); rep_ < NREP(1); ++rep_) { p1_adaln(F, A); SEAM(1); }
    if (IN(2)) for (int rep_ = relaunder(F); rep_ < NREP(2); ++rep_) { norm_mod<true, 0, false, false>(F, INP(0), INP(1), INP(8), 0, WSP(bf16, WS_H)); SEAM(2); }
    if (IN(3)) for (int rep_ = relaunder(F); rep_ < NREP(3); ++rep_) {
        pg8::Gemm g{WSP(bf16, WS_H), WSP(bf16, WS_W1), DM, DM, DM, 0, 0, WSC_UP}; pg8::StaticOrder S; S.init(MTOK, 2 * DFF, F.G, (int)blockIdx.x);
        pg8::EpiSwiglu E{WSP(unsigned char, WS_ACT)};
        pg8::gemm_phase8<pg8::EpiSwiglu, pg8::StaticOrder, true>(F.lds, g, S, E);
        SEAM(3);
    }
    if (IN(4)) for (int rep_ = relaunder(F); rep_ < NREP(4); ++rep_) {
        pg8::Gemm g{WSP(bf16, WS_ACT), WSP(bf16, WS_W1D), DFF, DFF, DFF, 0, KP_DOWN, WSC_DOWN}; pg8::SplitOrder S; S.init(DM, DFF / KP_DOWN, F.G, (int)blockIdx.x);
        pg8::EpiResid<false> E{INP(0), WSP(bf16, WS_X), WSP(float, WS_MODS) + 2 * DM, 0.5f};
        pg8::gemm_phase8<decltype(E), pg8::SplitOrder, true>(F.lds, g, S, E);
        SEAM(4);
    }
    if (IN(5)) for (int rep_ = relaunder(F); rep_ < NREP(5); ++rep_) { norm_mod<false, DFF / KP_DOWN, true, false>(F, nullptr, INP(1), INP(12), 1, WSP(bf16, WS_H)); SEAM(5); }
    if (IN(6)) for (int rep_ = relaunder(F); rep_ < NREP(6); ++rep_) {
        pg8::Gemm g{WSP(bf16, WS_H), WSP(bf16, WS_WIN), DM, DM, DM, 0, 0, 0}; pg8::StaticOrder S; S.init(MTOK, INC, F.G, (int)blockIdx.x);
        pg8::EpiWin E{WSP(bf16, WS_U), WSP(bf16, WS_QKVG), WSP(float, WS_ROT)};
        pg8::gemm_phase<pg8::EpiWin, pg8::StaticOrder, true>(F.lds, g, S, E);
        SEAM(6);
    }
    if (IN(7)) for (int rep_ = relaunder(F); rep_ < NREP(7); ++rep_) {
        for (int u = F.vcu; u < NB * NH * NCH * 2; u += F.G) retA_unit(F, u);
        pool_phase(F, A);
        SEAM(7);
    }
    if (IN(8)) for (int rep_ = relaunder(F); rep_ < NREP(8); ++rep_) {
        {
            pg8::Gemm g{WSP(bf16, WS_PM), WSP(bf16, WS_WPOOL), PW, HD, HD, HD, 0, 0}; pg8::StaticOrder S; S.init(MTOK, PW, F.G, (int)blockIdx.x);
            pg8::EpiPool E{WSP(unsigned char, WS_MIX), INP(15)};
            pg8::gemm_phase<pg8::EpiPool, pg8::StaticOrder, true>(F.lds, g, S, E);
        }
        __syncthreads();
        { int t2 = threadIdx.x; asm volatile("" : "+v"(t2)); F.tid = t2; }
        for (int u = F.vcu; u < DB * NH; u += F.G) retS_unit(F, A, u);
        scan_states(F);
        SEAM(8);
    }
    if (IN(9)) for (int rep_ = relaunder(F); rep_ < NREP(9); ++rep_) { for (int u = F.vcu; u < NB * NH * NCH; u += F.G) retC_unit(F, u); SEAM(9); }
    if (IN(10)) for (int rep_ = relaunder(F); rep_ < NREP(10); ++rep_) {
        pg8::Gemm g{WSP(bf16, WS_MIX), WSP(bf16, WS_WOUT), DM, DM, DM, 0, KP_OUT, WSC_UP}; pg8::SplitOrder S; S.init(DM, DM / KP_OUT, F.G, (int)blockIdx.x);
        pg8::EpiResid<true> E{nullptr, WSP(bf16, WS_X), WSP(float, WS_MODS) + 5 * DM, 1.0f};
        pg8::gemm_phase8<decltype(E), pg8::SplitOrder, true>(F.lds, g, S, E);
        SEAM(10);
    }
    if (IN(11)) for (int rep_ = relaunder(F); rep_ < NREP(11); ++rep_) { norm_mod<true, DM / KP_OUT, true, true>(F, nullptr, nullptr, INP(17), 2, WSP(bf16, WS_H)); SEAM(11); }
    if (IN(12)) for (int rep_ = relaunder(F); rep_ < NREP(12); ++rep_) {
        pg8::Gemm g{WSP(bf16, WS_H), WSP(bf16, WS_W2), DM, DM, DM, 0, 0, WSC_UP}; pg8::StaticOrder S; S.init(MTOK, 2 * DFF, F.G, (int)blockIdx.x);
        pg8::EpiSwiglu E{WSP(unsigned char, WS_ACT)};
        pg8::gemm_phase8<pg8::EpiSwiglu, pg8::StaticOrder, true>(F.lds, g, S, E);
        SEAM(12);
    }
    if (IN(13)) for (int rep_ = relaunder(F); rep_ < NREP(13); ++rep_) {
        pg8::Gemm g{WSP(bf16, WS_ACT), WSP(bf16, WS_W2D), DFF, DFF, DFF, 0, KP_DOWN, WSC_DOWN}; pg8::SplitOrder S; S.init(DM, DFF / KP_DOWN, F.G, (int)blockIdx.x);
        pg8::EpiResid<true> E{nullptr, WSP(bf16, WS_X), WSP(float, WS_MODS) + 8 * DM, 0.5f};
        pg8::gemm_phase8<decltype(E), pg8::SplitOrder, true>(F.lds, g, S, E);
        SEAM(13);
    }
    if (IN(14)) for (int rep_ = relaunder(F); rep_ < NREP(14); ++rep_) { final_norm<DFF / KP_DOWN>(F, A); if (rep_ + 1 < NREP(14)) { SEAM(14); } }
#ifdef PROBE_TA
    if (blockIdx.x == 0 && threadIdx.x == 0) {
        unsigned long long* ts = (unsigned long long*)(ws + WS_CTL + 49152);
        const unsigned long long now = __builtin_amdgcn_s_memrealtime(); ts[15] = now;
        unsigned long long qa = (ts[PROBE_TA + 1] - ts[PROBE_TA]) / 400ull, qb = (ts[PROBE_TB + 1] - ts[PROBE_TB]) / 400ull;
        if (qa > 99ull) qa = 99ull; if (qb > 99ull) qb = 99ull;
        const unsigned long long until = now + qa * 2000ull + qb * 200000ull;
        while (__builtin_amdgcn_s_memrealtime() < until) __builtin_amdgcn_s_sleep(64);
    }
#endif
#undef IN
#undef SEAM
}

extern "C" void kernel_launch(void* const* d_in, const int* in_sizes, int n_in, void* d_out, int out_size, void* d_ws, size_t ws_size, hipStream_t stream) {
    static int grid = 0;
    if (grid == 0) {
        if (n_in != 22 || (size_t)out_size != O_END || ws_size < WS_END) { fprintf(stderr, "kernel_launch: unexpected shapes (n_in %d out %d ws %zu)\n", n_in, out_size, ws_size); grid = -1; return; }
        int dev = 0, cus = 0, per_cu = 0;
        if (hipGetDevice(&dev) != hipSuccess || hipDeviceGetAttribute(&cus, hipDeviceAttributeMultiprocessorCount, dev) != hipSuccess) { grid = -1; return; }
        if (hipFuncSetAttribute((const void*)mk_fwd, hipFuncAttributeMaxDynamicSharedMemorySize, LDS_BYTES) != hipSuccess) { fprintf(stderr, "kernel_launch: hipFuncSetAttribute failed\n"); grid = -1; return; }
        if (hipOccupancyMaxActiveBlocksPerMultiprocessor(&per_cu, (const void*)mk_fwd, NWAVES * 64, LDS_BYTES) != hipSuccess || per_cu < 1) { fprintf(stderr, "kernel_launch: occupancy query says %d blocks/CU\n", per_cu); (void)hipGetLastError(); grid = -1; return; }
        grid = cus;
    }
    if (grid < 0) return;
    (void)hipMemsetAsync((char*)d_ws + WS_CTL, 0, CTL_ZERO_BYTES, stream);
    Args a{};
    for (int i = 0; i < 22; ++i) a.in[i] = (const float*)d_in[i];
    a.out = (float*)d_out; a.ws = (unsigned char*)d_ws;
#if MK_PER_PHASE
    for (int p = 0; p < N_PHASES; ++p) { a.ph_lo = p; a.ph_hi = p + 1; hipLaunchKernelGGL(mk_fwd, dim3(grid), dim3(NWAVES * 64), LDS_BYTES, stream, a); }
#else
    a.ph_lo = 0; a.ph_hi = N_PHASES;
    hipLaunchKernelGGL(mk_fwd, dim3(grid), dim3(NWAVES * 64), LDS_BYTES, stream, a);
#ifdef PROBE_LO
    a.ph_lo = PROBE_LO; a.ph_hi = PROBE_HI; a.bar_region = 1;
    hipLaunchKernelGGL(mk_fwd, dim3(grid), dim3(NWAVES * 64), LDS_BYTES, stream, a);
#endif
#endif
}
```

```cpp
#include <hip/hip_runtime.h>
#include <cstdio>
#include <cstdint>
#include <cmath>

#ifndef MK_PER_PHASE
#define MK_PER_PHASE 0
#endif

constexpr int DM = 2048, DFF = 5632, SEQ = 2048, NB = 4, DB = 128, DS = 4;
constexpr int MP = NB * SEQ;
constexpr int MS = DB * DS;
constexpr int MTOK = MP + MS;
constexpr int NMODROW = NB + DB;
constexpr int NMOD = 9 * DM;
constexpr int PW = 1024, RW = 1024, HD = 256, NH = 4, CH = 128, NCH = SEQ / CH;
constexpr int INC = PW + 4 * RW;
constexpr int PAST = 16384;
constexpr float EPS = 1e-6f;
constexpr int NPOS = SEQ + DS;

constexpr size_t O_YP = 0, O_YS = (size_t)MP * DM, O_POOLP = O_YS + (size_t)MS * DM, O_RETP = O_POOLP + (size_t)NB * 15 * PW,
                 O_POOLS = O_RETP + (size_t)NB * NH * HD * HD, O_RETS = O_POOLS + (size_t)DB * 15 * PW, O_END = O_RETS + (size_t)DB * NH * HD * HD;

constexpr size_t SLAB_MINUS_X = (size_t)(568 - 210) << 20;
constexpr size_t MODSB_DELTA = ((size_t)(612 - 5) << 20) / 4;

namespace pg8 {
#define PG8_LAS __attribute__((address_space(3)))
typedef unsigned short bf16_t;
typedef short bf16x8 __attribute__((ext_vector_type(8)));
typedef float f32x4 __attribute__((ext_vector_type(4)));
typedef unsigned u32x4 __attribute__((ext_vector_type(4)));
typedef unsigned u32x2 __attribute__((ext_vector_type(2)));
constexpr int BM = 256, BK = 64, HALF = 128, HTB = HALF * BK * 2  , STAGE_BYTES = 8 * HTB, NXCD = 8, WGM = 8;

__host__ __device__ __forceinline__ int lds_byte(int r, int c) { const int st = (r >> 4) * 2 + (c >> 5), rr = r & 15, cc = c & 31, ob = rr * 64 + cc * 2; return st * 1024 + (ob ^ (((ob >> 9) & 1) << 5)); }
__host__ __device__ __forceinline__ void stage_rc(int b, int& R, int& C) { const int st = b / 1024, sb = b % 1024, swz = sb ^ (((sb >> 9) & 1) << 5); R = (st >> 1) * 16 + swz / 64; C = (st & 1) * 32 + (swz % 64) / 2; }
__host__ __device__ __forceinline__ int perm32(int rho) { const int n = rho >> 4, i = rho & 15; return 8 * (i >> 2) + 4 * n + (i & 3); }

struct Unit { int pm, pn, kp; };
struct Gemm { const bf16_t* A; const bf16_t* Bt; int lda, ldb, K, acol, kpiece, wscale; };

struct StaticOrder {
    int nM, nN, nwg, G, c;
    __host__ __device__ __forceinline__ void init(int M, int N, int G_, int c_) { nM = M / BM; nN = N / BM; nwg = nM * nN; G = G_; c = c_; }
    __host__ __device__ __forceinline__ bool next(int i, Unit& u) const {
        const long L = (long)i * G + c; if (L >= nwg) return false;
        int wgid = (int)L; { const int q = nwg / NXCD, r = nwg % NXCD, xcd = wgid % NXCD, off = wgid / NXCD; wgid = (xcd < r ? xcd * (q + 1) : r * (q + 1) + (xcd - r) * q) + off; }
        const int nig = WGM * nN, gid = wgid / nig, fm = gid * WGM, gsz = (nM - fm) < WGM ? (nM - fm) : WGM;
        u.pm = fm + ((wgid % nig) % gsz); u.pn = (wgid % nig) / gsz; u.kp = -1; return true;
    }
    __device__ __forceinline__ void a_ready(const Unit&) const {}
    __device__ __forceinline__ void done(const Unit&) const {}
};

struct SplitOrder {
    int nN, nfull, np, G, c;
    __host__ __device__ __forceinline__ void init(int N, int np_, int G_, int c_) { nN = N / BM; nfull = (MP / BM) * nN; np = np_; G = G_; c = c_; }
    __host__ __device__ __forceinline__ bool next(int i, Unit& u) const {
        const int L = i * G + c;
        int pm, pn, kp; bool ok = true;
        if (L < nfull) {
            int wgid = L; { const int q = nfull / NXCD, xcd = wgid % NXCD, off = wgid / NXCD; wgid = xcd * q + off; }
            const int nig = WGM * nN, gid = wgid / nig, fm = gid * WGM;
            pm = fm + ((wgid % nig) % WGM); pn = (wgid % nig) / WGM; kp = -1;
        } else {
            const int j = L - nfull; ok = j < 2 * nN * np;
            const int t = j / np; kp = j - t * np; pm = MP / BM + t / nN; pn = t % nN;
        }
        u.pm = pm; u.pn = pn; u.kp = kp; return ok;
    }
    __device__ __forceinline__ void a_ready(const Unit&) const {}
    __device__ __forceinline__ void done(const Unit&) const {}
};

__device__ __forceinline__ unsigned cvt_pk_bf16(float lo, float hi) { unsigned r; asm volatile("v_cvt_pk_bf16_f32 %0, %1, %2" : "=v"(r) : "v"(lo), "v"(hi)); return r; }
__device__ __forceinline__ float silu_f(float x) { return x * __builtin_amdgcn_rcpf(1.0f + __builtin_amdgcn_exp2f(-1.4426950408889634f * x)); }
__device__ __forceinline__ float clamp448(float x) { return __builtin_fminf(__builtin_fmaxf(x, -448.0f), 448.0f); }
__device__ __forceinline__ unsigned pk4_fp8(float a, float b, float c, float d) {
    int p = 0; p = __builtin_amdgcn_cvt_pk_fp8_f32(clamp448(a), clamp448(b), p, false); p = __builtin_amdgcn_cvt_pk_fp8_f32(clamp448(c), clamp448(d), p, true); return (unsigned)p; }
__device__ __forceinline__ unsigned pk4_fp8_nc(float a, float b, float c, float d) {
    int p = 0; p = __builtin_amdgcn_cvt_pk_fp8_f32(a, b, p, false); p = __builtin_amdgcn_cvt_pk_fp8_f32(c, d, p, true); return (unsigned)p; }
__device__ __forceinline__ int modrow_of(int row) { return row < MP ? (row >> 11) : NB + ((row - MP) >> 2); }
__device__ __forceinline__ int ptab_of(int row) { return row < MP ? (row & (SEQ - 1)) : SEQ + ((row - MP) & 3); }

struct EpiSwiglu {
    static constexpr bool PERM = true, AFTER_DRAIN = false;
    unsigned char* O;
    __device__ __forceinline__ void operator()(const f32x4 (&acc)[2][2][4][2], const Unit& u, int wr, int wc, int fr, int fq) const {
        const int row0 = u.pm * BM + wr * 64 + fr, col0 = u.pn * HALF + wc * 32 + 8 * fq;
#pragma unroll
        for (int ai = 0; ai < 2; ++ai)
#pragma unroll
            for (int m = 0; m < 4; ++m) {
                unsigned char* rowp = O + (size_t)(row0 + ai * HALF + m * 16) * DFF + col0;
                const f32x4 g0 = acc[ai][0][m][0], g1 = acc[ai][0][m][1], u0 = acc[ai][1][m][0], u1 = acc[ai][1][m][1];
                u32x2 w;
                w.x = pk4_fp8_nc(silu_f(g0[0]) * u0[0], silu_f(g0[1]) * u0[1], silu_f(g0[2]) * u0[2], silu_f(g0[3]) * u0[3]);
                w.y = pk4_fp8_nc(silu_f(g1[0]) * u1[0], silu_f(g1[1]) * u1[1], silu_f(g1[2]) * u1[2], silu_f(g1[3]) * u1[3]);
                *(u32x2*)rowp = w;
            }
    }
};
template <bool BASE16> struct EpiResid {
    static constexpr bool PERM = true, AFTER_DRAIN = false;
    const float* base32; bf16_t* X; const float* gate; float coef;
    __device__ __forceinline__ void operator()(const f32x4 (&acc)[2][2][4][2], const Unit& u, int wr, int wc, int fr, int fq) const {
        const int row0 = u.pm * BM + wr * 64 + fr, col0 = u.pn * BM + wc * 32 + 8 * fq;
        if (u.kp < 0) {
            const float* gp = gate + (size_t)(u.pm >> 3) * NMOD + col0;
            f32x4 gg[2][2];
#pragma unroll
            for (int bj = 0; bj < 2; ++bj)
#pragma unroll
                for (int n = 0; n < 2; ++n) gg[bj][n] = (*(const f32x4*)(gp + bj * HALF + 4 * n) + *(const f32x4*)(gp + MODSB_DELTA + bj * HALF + 4 * n)) * coef;
#pragma unroll
            for (int ai = 0; ai < 2; ++ai)
#pragma unroll
                for (int m = 0; m < 4; ++m) {
                    const int row = row0 + ai * HALF + m * 16;
                    bf16_t* xp = X + (size_t)row * DM + col0;
#pragma unroll
                    for (int bj = 0; bj < 2; ++bj) {
                        f32x4 b0, b1;
                        if (BASE16) { const u32x4 bv = *(const u32x4*)(xp + bj * HALF);
                            b0 = (f32x4){__builtin_bit_cast(float, bv.x << 16), __builtin_bit_cast(float, bv.x & 0xffff0000u), __builtin_bit_cast(float, bv.y << 16), __builtin_bit_cast(float, bv.y & 0xffff0000u)};
                            b1 = (f32x4){__builtin_bit_cast(float, bv.z << 16), __builtin_bit_cast(float, bv.z & 0xffff0000u), __builtin_bit_cast(float, bv.w << 16), __builtin_bit_cast(float, bv.w & 0xffff0000u)}; }
                        else { const float* bp = base32 + (size_t)row * DM + col0 + bj * HALF; b0 = __builtin_nontemporal_load((const f32x4*)bp); b1 = __builtin_nontemporal_load((const f32x4*)(bp + 4)); }
                        const f32x4 o0 = b0 + gg[bj][0] * acc[ai][bj][m][0], o1 = b1 + gg[bj][1] * acc[ai][bj][m][1];
                        u32x4 w; w.x = cvt_pk_bf16(o0[0], o0[1]); w.y = cvt_pk_bf16(o0[2], o0[3]); w.z = cvt_pk_bf16(o1[0], o1[1]); w.w = cvt_pk_bf16(o1[2], o1[3]);
                        *(u32x4*)(xp + bj * HALF) = w;
                    }
                    if (m & 1) asm volatile("" ::: "memory");
                }
        } else {
#pragma unroll
            for (int ai = 0; ai < 2; ++ai)
#pragma unroll
                for (int m = 0; m < 4; ++m) {
                    const int row = row0 + ai * HALF + m * 16;
                    const float* gp = gate + (size_t)modrow_of(row) * NMOD + col0;
                    bf16_t* op = (bf16_t*)((char*)X + SLAB_MINUS_X) + ((size_t)u.kp * MS + (row - MP)) * DM + col0;
#pragma unroll
                    for (int bj = 0; bj < 2; ++bj) {
                        const f32x4 g0 = (*(const f32x4*)(gp + bj * HALF) + *(const f32x4*)(gp + MODSB_DELTA + bj * HALF)) * coef, g1 = (*(const f32x4*)(gp + bj * HALF + 4) + *(const f32x4*)(gp + MODSB_DELTA + bj * HALF + 4)) * coef;
                        const f32x4 o0 = g0 * acc[ai][bj][m][0], o1 = g1 * acc[ai][bj][m][1];
                        u32x4 w; w.x = cvt_pk_bf16(o0[0], o0[1]); w.y = cvt_pk_bf16(o0[2], o0[3]); w.z = cvt_pk_bf16(o1[0], o1[1]); w.w = cvt_pk_bf16(o1[2], o1[3]);
                        *(u32x4*)(op + bj * HALF) = w;
                    }
                    if (m & 1) asm volatile("" ::: "memory");
                }
        }
    }
};
struct EpiWin {
    static constexpr bool PERM = true, AFTER_DRAIN = false;
    bf16_t* U; bf16_t* QKVG; const float* rot;
    __device__ __forceinline__ void operator()(const f32x4 (&acc)[2][2][4][2], const Unit& u, int wr, int wc, int fr, int fq) const {
        const int row0 = u.pm * BM + wr * 64 + fr, cw = wc * 32 + 8 * fq;
        if (u.pn < 4) {
#pragma unroll
            for (int ai = 0; ai < 2; ++ai)
#pragma unroll
                for (int m = 0; m < 4; ++m) {
                    bf16_t* rowp = U + (size_t)(row0 + ai * HALF + m * 16) * PW + u.pn * BM + cw;
#pragma unroll
                    for (int bj = 0; bj < 2; ++bj) { const f32x4 v0 = acc[ai][bj][m][0], v1 = acc[ai][bj][m][1]; u32x4 w;
                        w.x = cvt_pk_bf16(v0[0], v0[1]); w.y = cvt_pk_bf16(v0[2], v0[3]); w.z = cvt_pk_bf16(v1[0], v1[1]); w.w = cvt_pk_bf16(v1[2], v1[3]);
                        *(u32x4*)(rowp + bj * HALF) = w; }
                }
        } else {
            const int t = (u.pn - 4) >> 2, hd = (u.pn - 4) & 3;
            bf16_t* dst = QKVG + (size_t)t * MTOK * RW + hd * HD + cw;
            if (t < 2) {
                const float sc = (t == 1) ? 0.0625f : 1.0f;
#pragma unroll
                for (int ai = 0; ai < 2; ++ai)
#pragma unroll
                    for (int m = 0; m < 4; ++m) {
                        const int row = row0 + ai * HALF + m * 16;
                        const float* rp = rot + ((size_t)ptab_of(row) * 128 + cw) * 2;
                        u32x4 w1, w2;
#pragma unroll
                        for (int n = 0; n < 2; ++n) {
                            const f32x4 cs0 = *(const f32x4*)(rp + 8 * n), cs1 = *(const f32x4*)(rp + 8 * n + 4);
                            const f32x4 x1 = acc[ai][0][m][n] * sc, x2 = acc[ai][1][m][n] * sc;
                            const float a0 = x1[0] * cs0[0] - x2[0] * cs0[1], b0 = x2[0] * cs0[0] + x1[0] * cs0[1];
                            const float a1 = x1[1] * cs0[2] - x2[1] * cs0[3], b1 = x2[1] * cs0[2] + x1[1] * cs0[3];
                            const float a2 = x1[2] * cs1[0] - x2[2] * cs1[1], b2 = x2[2] * cs1[0] + x1[2] * cs1[1];
                            const float a3 = x1[3] * cs1[2] - x2[3] * cs1[3], b3 = x2[3] * cs1[2] + x1[3] * cs1[3];
                            if (n == 0) { w1.x = cvt_pk_bf16(a0, a1); w1.y = cvt_pk_bf16(a2, a3); w2.x = cvt_pk_bf16(b0, b1); w2.y = cvt_pk_bf16(b2, b3); }
                            else        { w1.z = cvt_pk_bf16(a0, a1); w1.w = cvt_pk_bf16(a2, a3); w2.z = cvt_pk_bf16(b0, b1); w2.w = cvt_pk_bf16(b2, b3); }
                        }
                        bf16_t* rowp = dst + (size_t)row * RW;
                        *(u32x4*)rowp = w1; *(u32x4*)(rowp + HALF) = w2;
                    }
            } else {
#pragma unroll
                for (int ai = 0; ai < 2; ++ai)
#pragma unroll
                    for (int m = 0; m < 4; ++m) {
                        bf16_t* rowp = dst + (size_t)(row0 + ai * HALF + m * 16) * RW;
#pragma unroll
                        for (int bj = 0; bj < 2; ++bj) { const f32x4 v0 = acc[ai][bj][m][0], v1 = acc[ai][bj][m][1]; u32x4 w;
                            w.x = cvt_pk_bf16(v0[0], v0[1]); w.y = cvt_pk_bf16(v0[2], v0[3]); w.z = cvt_pk_bf16(v1[0], v1[1]); w.w = cvt_pk_bf16(v1[2], v1[3]);
                            *(u32x4*)(rowp + bj * HALF) = w; }
                    }
            }
        }
    }
};
struct EpiPool {
    static constexpr bool PERM = true, AFTER_DRAIN = false;
    unsigned char* MIX; const float* pscale;
    __device__ __forceinline__ void operator()(const f32x4 (&acc)[2][2][4][2], const Unit& u, int wr, int wc, int fr, int fq) const {
        const int row0 = u.pm * BM + wr * 64 + fr, col0 = u.pn * BM + wc * 32 + 8 * fq;
#pragma unroll
        for (int ai = 0; ai < 2; ++ai)
#pragma unroll
            for (int m = 0; m < 4; ++m) {
                unsigned char* rowp = MIX + (size_t)(row0 + ai * HALF + m * 16) * DM + col0;
#pragma unroll
                for (int bj = 0; bj < 2; ++bj) { const f32x4 v0 = acc[ai][bj][m][0] * *(const f32x4*)(pscale + col0 + bj * HALF), v1 = acc[ai][bj][m][1] * *(const f32x4*)(pscale + col0 + bj * HALF + 4); u32x2 w;
                    w.x = pk4_fp8(v0[0], v0[1], v0[2], v0[3]); w.y = pk4_fp8(v1[0], v1[1], v1[2], v1[3]);
                    *(u32x2*)(rowp + bj * HALF) = w; }
            }
    }
};

template <class Epi, class Sched, bool ALIGN_EPI = false>
__device__ __forceinline__ void gemm_phase(PG8_LAS unsigned char* lds, const Gemm g, const Sched& S, const Epi& E) {
    const int tid = threadIdx.x, wid = __builtin_amdgcn_readfirstlane(tid >> 6), lane = tid & 63, wr = wid >> 2, wc = wid & 3, fr = lane & 15, fq = lane >> 4;
    unsigned voffA[2], voffB[2];
#pragma unroll
    for (int i = 0; i < 2; ++i) { int R, C; stage_rc(tid * 16 + i * 8192, R, C); const int Rb = Epi::PERM ? ((R & ~31) + perm32(R & 31)) : R;
        voffA[i] = (unsigned)(R * g.lda + C) * 2u; voffB[i] = (unsigned)(Rb * g.ldb + C) * 2u; }
    const size_t kstep = (size_t)(BK * 2);
    const size_t hstepA = (size_t)HALF * g.lda * 2, hstepB = (size_t)HALF * g.ldb * 2;
    const size_t tstepA = 2 * hstepA, tstepB = 2 * hstepB;
    const size_t astep = (size_t)g.acol * 2;
    const unsigned ldsw = (unsigned)wid * 1024u;
    const int aoff = lds_byte(wr * 64 + fr, fq * 8), boff = lds_byte(wc * 32 + fr, fq * 8);
#define PG8_SA(b, h) (((b) * 2 + (h)) * HTB)
#define PG8_SB(b, h) ((4 + (b) * 2 + (h)) * HTB)
#define PG8_STAGE(bufoff, gbase, voff) do { _Pragma("unroll") for (int _i = 0; _i < 2; ++_i) \
        __builtin_amdgcn_global_load_lds((const unsigned*)((const char*)(gbase) + (voff)[_i]), (PG8_LAS unsigned*)(lds + (bufoff) + ldsw + _i * 8192), 16, 0, 0); } while (0)
#define PG8_LDA(dst, b, h) do { _Pragma("unroll") for (int m = 0; m < 4; ++m) _Pragma("unroll") for (int k = 0; k < 2; ++k) dst[m][k] = *(const PG8_LAS bf16x8*)(lds + PG8_SA(b, h) + aoff + m * 2048 + k * 1024); } while (0)
#define PG8_LDB(dst, b, h) do { _Pragma("unroll") for (int n = 0; n < 2; ++n) _Pragma("unroll") for (int k = 0; k < 2; ++k) dst[n][k] = *(const PG8_LAS bf16x8*)(lds + PG8_SB(b, h) + boff + n * 2048 + k * 1024); } while (0)
#define PG8_MMA(ai, bj, At, Bt) do { __builtin_amdgcn_s_setprio(1); _Pragma("unroll") for (int m = 0; m < 4; ++m) _Pragma("unroll") for (int n = 0; n < 2; ++n) _Pragma("unroll") for (int k = 0; k < 2; ++k) \
        acc[ai][bj][m][n] = __builtin_amdgcn_mfma_f32_16x16x32_bf16(Bt[n][k], At[m][k], acc[ai][bj][m][n], 0, 0, 0); __builtin_amdgcn_s_setprio(0); } while (0)
#define PG8_WAIT_V(n) asm volatile("s_waitcnt vmcnt(" #n ")" ::: "memory")
#define PG8_WAIT_L(n) asm volatile("s_waitcnt lgkmcnt(" #n ")" ::: "memory")
#define PG8_BAR __builtin_amdgcn_s_barrier()
#define PG8_SCHED __builtin_amdgcn_sched_barrier(0)
    Unit cur, nxt; int ui = 0;
    if (!S.next(0, cur)) return;
    f32x4 acc[2][2][4][2];
#pragma unroll
    for (int a = 0; a < 2; ++a)
#pragma unroll
        for (int b = 0; b < 2; ++b)
#pragma unroll
            for (int m = 0; m < 4; ++m)
#pragma unroll
                for (int n = 0; n < 2; ++n) acc[a][b][m][n] = (f32x4){0.f, 0.f, 0.f, 0.f};
    bf16x8 At[4][2], B0[2][2], B1[2][2];
    const char* cA = (const char*)g.A + (size_t)cur.pm * tstepA + (size_t)cur.pn * astep + (cur.kp > 0 ? (size_t)cur.kp * g.kpiece * 2 : 0); const char* cB = (const char*)g.Bt + (size_t)cur.pn * tstepB + (cur.kp > 0 ? (size_t)cur.kp * g.kpiece * 2 : 0);
    S.a_ready(cur);
    PG8_STAGE(PG8_SB(0, 0), cB, voffB); PG8_STAGE(PG8_SB(0, 1), cB + hstepB, voffB); PG8_STAGE(PG8_SA(0, 0), cA, voffA); PG8_STAGE(PG8_SA(0, 1), cA + hstepA, voffA);
    if (wr == 1) PG8_BAR;
    PG8_WAIT_V(2); PG8_BAR;
    PG8_STAGE(PG8_SB(1, 0), cB + kstep, voffB); PG8_STAGE(PG8_SA(1, 0), cA + kstep, voffA); PG8_STAGE(PG8_SB(1, 1), cB + hstepB + kstep, voffB);
    PG8_WAIT_V(6); PG8_BAR;
    for (;;) {
        const bool has_next = S.next(ui + 1, nxt);
        const size_t nko = (has_next && nxt.kp > 0) ? (size_t)nxt.kp * g.kpiece * 2 : 0;
        const char* nA = has_next ? (const char*)g.A + (size_t)nxt.pm * tstepA + (size_t)nxt.pn * astep + nko : cA; const char* nB = has_next ? (const char*)g.Bt + (size_t)nxt.pn * tstepB + nko : cB;
        const int nt = (cur.kp < 0 ? g.K : g.kpiece) / BK;
        for (int t = 0; t < nt; t += 2) {
            const bool last = (t == nt - 2);
            const char* a1 = cA + (size_t)(t + 1) * kstep;
            const char* a2 = last ? nA : cA + (size_t)(t + 2) * kstep; const char* b2 = last ? nB : cB + (size_t)(t + 2) * kstep;
            const char* a3 = a2 + kstep; const char* b3 = b2 + kstep;
            if (last && has_next) S.a_ready(nxt);
            PG8_LDB(B0, 0, 0); PG8_LDB(B1, 0, 1); PG8_SCHED; PG8_LDA(At, 0, 0); PG8_STAGE(PG8_SA(1, 1), a1 + hstepA, voffA);
            PG8_WAIT_V(8); PG8_WAIT_L(0); PG8_BAR; PG8_MMA(0, 0, At, B0); PG8_MMA(0, 1, At, B1); PG8_BAR; PG8_SCHED;
            PG8_LDA(At, 0, 1); PG8_STAGE(PG8_SB(0, 0), b2, voffB); PG8_STAGE(PG8_SB(0, 1), b2 + hstepB, voffB); PG8_STAGE(PG8_SA(0, 0), a2, voffA);
            PG8_WAIT_V(8); PG8_WAIT_L(0); PG8_BAR; PG8_MMA(1, 0, At, B0); PG8_MMA(1, 1, At, B1); PG8_BAR; PG8_SCHED;
            PG8_LDB(B0, 1, 0); PG8_LDB(B1, 1, 1); PG8_SCHED; PG8_LDA(At, 1, 0); PG8_STAGE(PG8_SA(0, 1), a2 + hstepA, voffA);
            PG8_WAIT_V(8); PG8_WAIT_L(0); PG8_BAR; PG8_MMA(0, 0, At, B0); PG8_MMA(0, 1, At, B1); PG8_BAR; PG8_SCHED;
            PG8_LDA(At, 1, 1); PG8_STAGE(PG8_SB(1, 0), b3, voffB); PG8_STAGE(PG8_SB(1, 1), b3 + hstepB, voffB); PG8_STAGE(PG8_SA(1, 0), a3, voffA);
            PG8_WAIT_V(8); PG8_WAIT_L(0); PG8_BAR; PG8_MMA(1, 0, At, B0); PG8_MMA(1, 1, At, B1); PG8_BAR; PG8_SCHED;
        }
        if constexpr (ALIGN_EPI) { if (wr == 0) PG8_BAR; }
        E(acc, cur, wr, wc, fr, fq); S.done(cur);
        if (!has_next) break;
#pragma unroll
        for (int a = 0; a < 2; ++a)
#pragma unroll
            for (int b = 0; b < 2; ++b)
#pragma unroll
                for (int m = 0; m < 4; ++m)
#pragma unroll
                    for (int n = 0; n < 2; ++n) acc[a][b][m][n] = (f32x4){0.f, 0.f, 0.f, 0.f};
        cur = nxt; cA = nA; cB = nB; ++ui;
        if constexpr (ALIGN_EPI) { if (wr == 1) PG8_BAR; }
    }
    PG8_WAIT_V(0);
    if constexpr (!ALIGN_EPI) { if (wr == 0) PG8_BAR; }
    PG8_BAR;
#undef PG8_SA
#undef PG8_SB
#undef PG8_STAGE
#undef PG8_LDA
#undef PG8_LDB
#undef PG8_MMA
#undef PG8_WAIT_V
#undef PG8_WAIT_L
#undef PG8_BAR
#undef PG8_SCHED
}
__host__ __device__ __forceinline__ int lds_byte8(int r, int cb) { return (r >> 4) * 2048 + (((cb >> 6) * 16 + (r & 15)) * 64) + ((((cb >> 4) & 3) ^ ((r >> 3) & 1)) * 16); }
__host__ __device__ __forceinline__ void stage_rc8(int b, int& R, int& C) { const int g = b >> 11, u = (b >> 6) & 31, h = u >> 4, r = u & 15, q = ((b >> 4) & 3) ^ ((r >> 3) & 1); R = 16 * g + r; C = h * 64 + q * 16; }
typedef int v8i __attribute__((ext_vector_type(8)));
__device__ __forceinline__ v8i cat8(bf16x8 lo, bf16x8 hi) { typedef int v4i __attribute__((ext_vector_type(4))); const v4i a = __builtin_bit_cast(v4i, lo), b = __builtin_bit_cast(v4i, hi); return (v8i){a[0], a[1], a[2], a[3], b[0], b[1], b[2], b[3]}; }
template <class Epi, class Sched, bool ALIGN_EPI = false>
__device__ __forceinline__ void gemm_phase8(PG8_LAS unsigned char* lds, const Gemm g, const Sched& S, const Epi& E) {
    const int tid = threadIdx.x, wid = __builtin_amdgcn_readfirstlane(tid >> 6), lane = tid & 63, wr = wid >> 2, wc = wid & 3, fr = lane & 15, fq = lane >> 4;
    unsigned voffA[2], voffB[2];
#pragma unroll
    for (int i = 0; i < 2; ++i) { int R, C; stage_rc8(tid * 16 + i * 8192, R, C); const int Rb = Epi::PERM ? ((R & ~31) + perm32(R & 31)) : R;
        voffA[i] = (unsigned)(R * g.lda + C); voffB[i] = (unsigned)(Rb * g.ldb + C); }
    const size_t kstep = (size_t)128;
    const size_t hstepA = (size_t)HALF * g.lda, hstepB = (size_t)HALF * g.ldb;
    const size_t tstepA = 2 * hstepA, tstepB = 2 * hstepB;
    const size_t astep = (size_t)g.acol;
    const unsigned ldsw = (unsigned)wid * 1024u;
    const int aoff = lds_byte8(wr * 64 + fr, fq * 32), boff = lds_byte8(wc * 32 + fr, fq * 32);
#define PG8_SA(b, h) (((b) * 2 + (h)) * HTB)
#define PG8_SB(b, h) ((4 + (b) * 2 + (h)) * HTB)
#define PG8_STAGE(bufoff, gbase, voff) do { _Pragma("unroll") for (int _i = 0; _i < 2; ++_i) \
        __builtin_amdgcn_global_load_lds((const unsigned*)((const char*)(gbase) + (voff)[_i]), (PG8_LAS unsigned*)(lds + (bufoff) + ldsw + _i * 8192), 16, 0, 0); } while (0)
#define PG8_LDA(dst, b, h) do { _Pragma("unroll") for (int m = 0; m < 4; ++m) dst[m] = cat8(*(const PG8_LAS bf16x8*)(lds + PG8_SA(b, h) + aoff + m * 2048), *(const PG8_LAS bf16x8*)(lds + PG8_SA(b, h) + (aoff ^ 16) + m * 2048)); } while (0)
#define PG8_LDB(dst, b, h) do { _Pragma("unroll") for (int n = 0; n < 2; ++n) dst[n] = cat8(*(const PG8_LAS bf16x8*)(lds + PG8_SB(b, h) + boff + n * 2048), *(const PG8_LAS bf16x8*)(lds + PG8_SB(b, h) + (boff ^ 16) + n * 2048)); } while (0)
#define PG8_MMA(ai, bj, At, Bt) do { __builtin_amdgcn_s_setprio(1); _Pragma("unroll") for (int m = 0; m < 4; ++m) _Pragma("unroll") for (int n = 0; n < 2; ++n) \
        asm volatile("v_mfma_scale_f32_16x16x128_f8f6f4 %0, %1, %2, %0, %3, %4 op_sel_hi:[0,0,0]" : "+v"(acc[ai][bj][m][n]) : "v"(Bt[n]), "v"(At[m]), "v"(wsc), "v"(asc)); __builtin_amdgcn_s_setprio(0); } while (0)
#define PG8_WAIT_V(n) asm volatile("s_waitcnt vmcnt(" #n ")" ::: "memory")
#define PG8_WAIT_L(n) asm volatile("s_waitcnt lgkmcnt(" #n ")" ::: "memory")
#define PG8_BAR __builtin_amdgcn_s_barrier()
#define PG8_SCHED __builtin_amdgcn_sched_barrier(0)
    Unit cur, nxt; int ui = 0;
    if (!S.next(0, cur)) return;
    f32x4 acc[2][2][4][2];
#pragma unroll
    for (int a = 0; a < 2; ++a)
#pragma unroll
        for (int b = 0; b < 2; ++b)
#pragma unroll
            for (int m = 0; m < 4; ++m)
#pragma unroll
                for (int n = 0; n < 2; ++n) acc[a][b][m][n] = (f32x4){0.f, 0.f, 0.f, 0.f};
    v8i At[4], B0[2], B1[2];
    int wsc = g.wscale, asc = 0x7f7f7f7f;
    asm volatile("" : "+v"(wsc), "+v"(asc));
    const char* cA = (const char*)g.A + (size_t)cur.pm * tstepA + (size_t)cur.pn * astep + (cur.kp > 0 ? (size_t)cur.kp * g.kpiece : 0); const char* cB = (const char*)g.Bt + (size_t)cur.pn * tstepB + (cur.kp > 0 ? (size_t)cur.kp * g.kpiece : 0);
    S.a_ready(cur);
    PG8_STAGE(PG8_SB(0, 0), cB, voffB); PG8_STAGE(PG8_SB(0, 1), cB + hstepB, voffB); PG8_STAGE(PG8_SA(0, 0), cA, voffA); PG8_STAGE(PG8_SA(0, 1), cA + hstepA, voffA);
    if (wr == 1) PG8_BAR;
    PG8_WAIT_V(2); PG8_BAR;
    PG8_STAGE(PG8_SB(1, 0), cB + kstep, voffB); PG8_STAGE(PG8_SA(1, 0), cA + kstep, voffA); PG8_STAGE(PG8_SB(1, 1), cB + hstepB + kstep, voffB);
    PG8_WAIT_V(6); PG8_BAR;
    for (;;) {
        const bool has_next = S.next(ui + 1, nxt);
        const size_t nko = (has_next && nxt.kp > 0) ? (size_t)nxt.kp * g.kpiece : 0;
        const char* nA = has_next ? (const char*)g.A + (size_t)nxt.pm * tstepA + (size_t)nxt.pn * astep + nko : cA; const char* nB = has_next ? (const char*)g.Bt + (size_t)nxt.pn * tstepB + nko : cB;
        const int nt = (cur.kp < 0 ? g.K : g.kpiece) / 128;
        for (int t = 0; t < nt; t += 2) {
            const bool last = (t == nt - 2);
            const char* a1 = cA + (size_t)(t + 1) * kstep;
            const char* a2 = last ? nA : cA + (size_t)(t + 2) * kstep; const char* b2 = last ? nB : cB + (size_t)(t + 2) * kstep;
            const char* a3 = a2 + kstep; const char* b3 = b2 + kstep;
            if (last && has_next) S.a_ready(nxt);
            PG8_LDB(B0, 0, 0); PG8_LDB(B1, 0, 1); PG8_SCHED; PG8_LDA(At, 0, 0); PG8_STAGE(PG8_SA(1, 1), a1 + hstepA, voffA);
            PG8_WAIT_V(8); PG8_WAIT_L(0); PG8_BAR; PG8_MMA(0, 0, At, B0); PG8_MMA(0, 1, At, B1); PG8_BAR; PG8_SCHED;
            PG8_LDA(At, 0, 1); PG8_STAGE(PG8_SB(0, 0), b2, voffB); PG8_STAGE(PG8_SB(0, 1), b2 + hstepB, voffB); PG8_STAGE(PG8_SA(0, 0), a2, voffA);
            PG8_WAIT_V(8); PG8_WAIT_L(0); PG8_BAR; PG8_MMA(1, 0, At, B0); PG8_MMA(1, 1, At, B1); PG8_BAR; PG8_SCHED;
            PG8_LDB(B0, 1, 0); PG8_LDB(B1, 1, 1); PG8_SCHED; PG8_LDA(At, 1, 0); PG8_STAGE(PG8_SA(0, 1), a2 + hstepA, voffA);
            PG8_WAIT_V(8); PG8_WAIT_L(0); PG8_BAR; PG8_MMA(0, 0, At, B0); PG8_MMA(0, 1, At, B1); PG8_BAR; PG8_SCHED;
            PG8_LDA(At, 1, 1); PG8_STAGE(PG8_SB(1, 0), b3, voffB); PG8_STAGE(PG8_SB(1, 1), b3 + hstepB, voffB); PG8_STAGE(PG8_SA(1, 0), a3, voffA);
            PG8_WAIT_V(8); PG8_WAIT_L(0); PG8_BAR; PG8_MMA(1, 0, At, B0); PG8_MMA(1, 1, At, B1); PG8_BAR; PG8_SCHED;
        }
        if constexpr (ALIGN_EPI) { if (wr == 0) PG8_BAR; }
        asm volatile("s_nop 15\n\ts_nop 15" ::: "memory");
        E(acc, cur, wr, wc, fr, fq); S.done(cur);
        if (!has_next) break;
#pragma unroll
        for (int a = 0; a < 2; ++a)
#pragma unroll
            for (int b = 0; b < 2; ++b)
#pragma unroll
                for (int m = 0; m < 4; ++m)
#pragma unroll
                    for (int n = 0; n < 2; ++n) acc[a][b][m][n] = (f32x4){0.f, 0.f, 0.f, 0.f};
        cur = nxt; cA = nA; cB = nB; ++ui;
        if constexpr (ALIGN_EPI) { if (wr == 1) PG8_BAR; }
    }
    PG8_WAIT_V(0);
    if constexpr (!ALIGN_EPI) { if (wr == 0) PG8_BAR; }
    PG8_BAR;
#undef PG8_SA
#undef PG8_SB
#undef PG8_STAGE
#undef PG8_LDA
#undef PG8_LDB
#undef PG8_MMA
#undef PG8_WAIT_V
#undef PG8_WAIT_L
#undef PG8_BAR
#undef PG8_SCHED
}
}

constexpr int NWAVES = 8;
constexpr int N_PHASES = 15;
constexpr size_t MiB = 1u << 20;
constexpr size_t WS_CTL = 0, CTL_ZERO_BYTES = 64 * 1024;
constexpr size_t WS_SC = 1 * MiB;
constexpr size_t WS_ROT = 2 * MiB;
constexpr size_t WS_MODS = 5 * MiB;
constexpr size_t WS_WPOOL = 15 * MiB;
constexpr size_t WS_WOUT = 16 * MiB;
constexpr size_t WS_WIN = 24 * MiB;
constexpr size_t WS_W1 = 44 * MiB;
constexpr size_t WS_W1D = 88 * MiB;
constexpr size_t WS_W2 = 110 * MiB;
constexpr size_t WS_W2D = 154 * MiB;
constexpr size_t WS_H = 176 * MiB;
constexpr size_t WS_X = 210 * MiB;
constexpr size_t WS_ACT = 278 * MiB;
constexpr size_t WS_QKVG = WS_ACT;
constexpr size_t WS_PM = WS_ACT + 68 * MiB;
constexpr size_t WS_U = 372 * MiB;
constexpr size_t WS_MIX = 406 * MiB;
constexpr size_t WS_UT = 440 * MiB;
constexpr size_t WS_OI = 504 * MiB;
constexpr size_t WS_ST = 536 * MiB;
constexpr size_t WS_SLAB = 568 * MiB;
constexpr size_t WS_MODSB = 612 * MiB;
constexpr size_t WS_END = 622 * MiB;
static_assert((WS_MODSB - WS_MODS) / 4 == MODSB_DELTA, "mods slab offset");
static_assert(WS_SLAB - WS_X == SLAB_MINUS_X, "slab offset");
constexpr int KP_DOWN = 512, KP_OUT = 512;
constexpr float WMUL_UP = 32.0f, WMUL_DOWN = 64.0f; constexpr int WSC_UP = 0x7a7a7a7a, WSC_DOWN = 0x79797979;
static_assert(WS_SC + 160 * 2048 * 2 <= WS_ROT && WS_ROT + (size_t)NPOS * 128 * 8 <= WS_MODS && WS_MODS + (size_t)NMODROW * NMOD * 4 <= WS_WPOOL, "ws map 1");
static_assert(WS_W1 + (size_t)2 * DFF * DM * 2 <= WS_W1D && WS_W1D + (size_t)DM * DFF * 2 <= WS_W2 && WS_W2D + (size_t)DM * DFF * 2 <= WS_H, "ws map 2");
static_assert(WS_H + (size_t)MTOK * DM * 2 <= WS_X && WS_X + (size_t)MTOK * DM * 4 <= WS_ACT && WS_ACT + (size_t)MTOK * DFF * 2 <= WS_U, "ws map 3");
static_assert(WS_PM + (size_t)MTOK * PW * 2 <= WS_U && WS_U + (size_t)MTOK * PW * 4 <= WS_MIX && WS_MIX + (size_t)MTOK * DM * 2 <= WS_UT, "ws map 4");
constexpr int CW_BAR = 1024;

constexpr int RING_BYTES = 131072;
constexpr int LDSCTL_OFF = 136 * 1024, MISC_OFF = LDSCTL_OFF + 320;
constexpr int LDS_BYTES = 147456;

#define GAS __attribute__((address_space(1)))
#define LAS __attribute__((address_space(3)))
typedef unsigned short bf16;
typedef unsigned v4u __attribute__((ext_vector_type(4)));
typedef unsigned v2u __attribute__((ext_vector_type(2)));
typedef float f32x4 __attribute__((ext_vector_type(4)));
typedef float f32x16 __attribute__((ext_vector_type(16)));
typedef short bf16x8 __attribute__((ext_vector_type(8)));
typedef short bf16x4 __attribute__((ext_vector_type(4)));
typedef GAS unsigned gu32;
#define RLX_AGENT __ATOMIC_RELAXED, __HIP_MEMORY_SCOPE_AGENT
#define LDS_WAIT() asm volatile("s_waitcnt lgkmcnt(0)" ::: "memory")
#define VM_WAIT() asm volatile("s_waitcnt vmcnt(0)" ::: "memory")
__device__ __forceinline__ unsigned f2bf(float f) { unsigned u = __builtin_bit_cast(unsigned, f); return (u + 0x7fffu + ((u >> 16) & 1u)) >> 16; }
__device__ __forceinline__ unsigned pk2(float lo, float hi) { return f2bf(lo) | (f2bf(hi) << 16); }
__device__ __forceinline__ float bf2f(unsigned short v) { return __builtin_bit_cast(float, (unsigned)v << 16); }
__device__ __forceinline__ float silu1(float x) { return x / (1.0f + __expf(-x)); }

#define XB_TMO      128
#define XB_XCNT(j)  (256  + 64 * (j))
#define XB_XSUB(j)  (1280 + 64 * (j))
#define XB_XGEN(j)  (2304 + 64 * (j))
#define XB_TOP      3328
#define XB_TOPGEN   3392
#define XCD_BAR_WORDS 3456
#define XB_SPIN_CAP (1u << 20)
static_assert((CW_BAR + 2 * XCD_BAR_WORDS) * 4 <= (int)CTL_ZERO_BYTES, "barrier words inside the memset region");

__device__ __forceinline__ unsigned xb_ld(unsigned* p)              { return __hip_atomic_load(p, __ATOMIC_RELAXED, __HIP_MEMORY_SCOPE_AGENT); }
__device__ __forceinline__ unsigned xb_add(unsigned* p, unsigned v) { return __hip_atomic_fetch_add(p, v, __ATOMIC_RELAXED, __HIP_MEMORY_SCOPE_AGENT); }
__device__ __forceinline__ unsigned xb_xcc_id() { return (unsigned)__builtin_amdgcn_s_getreg((3 << 11) | 20) & 0xFu; }
#define XB_SPIN(cond, bar) do { unsigned _sp = 0; while (cond) { __builtin_amdgcn_s_sleep(1); \
    if ((++_sp & 255u) == 0u) { if (xb_ld(&(bar)[XB_TMO])) break; if (_sp > XB_SPIN_CAP) { atomicAdd(&(bar)[XB_TMO], 1u); break; } } } } while (0)

struct XcdBarrier { unsigned* bar; unsigned x; volatile LAS unsigned* st; };
__device__ __forceinline__ XcdBarrier xcd_barrier_post(unsigned* bar, volatile LAS unsigned* st) {
    XcdBarrier b; b.bar = bar; b.x = xb_xcc_id(); b.st = st;
    if (threadIdx.x == 0) (void)xb_add(&bar[XB_XCNT(b.x)], 1u);
    return b;
}
__device__ __forceinline__ void xcd_barrier_complete(unsigned* bar, unsigned x, unsigned& nloc, unsigned& nx) {
    const unsigned G = gridDim.x * gridDim.y * gridDim.z;
    unsigned sum, cnt, mine, sp = 0u;
    for (;;) {
        sum = 0u; cnt = 0u; mine = 0u;
#pragma unroll
        for (unsigned j = 0; j < 16; ++j) { const unsigned c = xb_ld(&bar[XB_XCNT(j)]); sum += c; cnt += (c > 0u) ? 1u : 0u; mine = (j == x) ? c : mine; }
        if (sum == G) break;
        __builtin_amdgcn_s_sleep(1);
        if ((++sp & 255u) == 0u) { if (xb_ld(&bar[XB_TMO])) break; if (sp > XB_SPIN_CAP) { atomicAdd(&bar[XB_TMO], 1u); break; } }
    }
    nloc = mine > 0u ? mine : 1u; nx = cnt > 0u ? cnt : 1u;
}
__device__ __forceinline__ void xcd_barrier(const XcdBarrier& b) {
    asm volatile("s_waitcnt vmcnt(0)" ::: "memory");
    __syncthreads();
    if (threadIdx.x == 0) {
        unsigned* bar = b.bar;
        __builtin_amdgcn_s_waitcnt(0);
        unsigned nloc = b.st[0], nx = b.st[1];
        if (nloc == 0u) { xcd_barrier_complete(bar, b.x, nloc, nx); b.st[0] = nloc; b.st[1] = nx; }
        const unsigned old = xb_add(&bar[XB_XSUB(b.x)], 1u);
        const unsigned gen = old / nloc;
        if (old + 1u == (gen + 1u) * nloc) {
            __builtin_amdgcn_fence(__ATOMIC_RELEASE, "agent");
            asm volatile("s_waitcnt vmcnt(0)" ::: "memory");
            const unsigned og = xb_add(&bar[XB_TOP], 1u);
            const unsigned tg = og / nx;
            if (og + 1u == (tg + 1u) * nx) xb_add(&bar[XB_TOPGEN], 1u);
            else XB_SPIN(xb_ld(&bar[XB_TOPGEN]) == tg, bar);
            __builtin_amdgcn_fence(__ATOMIC_ACQUIRE, "agent");
            xb_add(&bar[XB_XGEN(b.x)], 1u);
            asm volatile("s_waitcnt vmcnt(0)" ::: "memory");
        } else {
            XB_SPIN(xb_ld(&bar[XB_XGEN(b.x)]) == gen, bar);
            __builtin_amdgcn_fence(__ATOMIC_ACQUIRE, "agent");
            asm volatile("s_waitcnt vmcnt(0)" ::: "memory");
        }
    }
    __syncthreads();
}

struct Args { const float* in[22]; float* out; unsigned char* ws; int ph_lo, ph_hi, bar_region, pad; };
static_assert(sizeof(Args) == 22 * 8 + 8 + 8 + 16, "Args has no padding");
#define INP(i) (A.in[i])
struct Frame {
    LAS unsigned char* lds;
    volatile LAS unsigned* MISC;
    int tid, lane, wave;
    int vcu, G;
    unsigned char* ws;
    float* out;
};
#define WSP(T, off) ((T*)(F.ws + (off)))
__device__ __forceinline__ int relaunder(Frame& F) { int t2 = threadIdx.x; asm volatile("" : "+v"(t2)); F.tid = t2; unsigned char* w = F.ws; asm volatile("" : "+s"(w)); F.ws = w; float* o = F.out; asm volatile("" : "+s"(o)); F.out = o; return 0; }
__device__ __forceinline__ int lane_of(const Frame& F) { int l = F.tid & 63; asm volatile("" : "+v"(l)); return l; }

__device__ __forceinline__ float wave_sum(float v) {
#pragma unroll
    for (int o = 1; o < 64; o <<= 1) v += __shfl_xor(v, o);
    return v;
}

constexpr int TPITCH = 260;
constexpr int TILE_BYTES = 64 * TPITCH * 4;
static_assert(2 * TILE_BYTES <= LDSCTL_OFF && MISC_OFF + 128 <= LDS_BYTES, "LDS map");
constexpr int P0_NA = 3 * ((DM / 64) * (DFF / 256)) + (DM / 64) * (INC / 256) + (DM / 64) * (DM / 256);
constexpr int P0_NB = 3 * ((DM / 64) * (DFF / 256));
constexpr int P0_NP = 4 * ((HD / 64) * (HD / 256));
static_assert((DFF / 64) * (DM / 256) == (DM / 64) * (DFF / 256), "down and gate/up have the same item count");
constexpr int CW_QUEUE = 64;
struct P0Item { const float* src; unsigned char* dst; int N, ldkb, f8; float mul; };
__device__ __forceinline__ void p0_decode(const Args& A, unsigned char* ws, int it, int w, P0Item& d) {
    constexpr int B_F = (DM / 64) * (DFF / 256), B_D = (DFF / 64) * (DM / 256), B_IN = (DM / 64) * (INC / 256), B_OUT = (DM / 64) * (DM / 256), B_P = (HD / 64) * (HD / 256);
    int r = it; const float* W; int K, Nn, mode = 0, f8 = 1; unsigned char* WT; float mul = WMUL_UP;
    if (r < B_F) { W = INP(9); K = DM; Nn = DFF; WT = ws + WS_W1; mode = 1; }
    else if ((r -= B_F) < B_F) { W = INP(10); K = DM; Nn = DFF; WT = ws + WS_W1; mode = 2; }
    else if ((r -= B_F) < B_D) { W = INP(11); K = DFF; Nn = DM; WT = ws + WS_W1D; mul = WMUL_DOWN; }
    else if ((r -= B_D) < B_IN) { W = INP(13); K = DM; Nn = INC; WT = ws + WS_WIN; f8 = 0; mul = 1.0f; }
    else if ((r -= B_IN) < B_OUT) { W = INP(16); K = DM; Nn = DM; WT = ws + WS_WOUT; }
    else if ((r -= B_OUT) < B_F) { W = INP(18); K = DM; Nn = DFF; WT = ws + WS_W2; mode = 1; }
    else if ((r -= B_F) < B_F) { W = INP(19); K = DM; Nn = DFF; WT = ws + WS_W2; mode = 2; }
    else if ((r -= B_F) < B_D) { W = INP(20); K = DFF; Nn = DM; WT = ws + WS_W2D; mul = WMUL_DOWN; }
    else { r -= B_D; const int g = r / B_P; r -= g * B_P; W = INP(14) + (size_t)g * HD * HD; K = HD; Nn = HD; WT = ws + WS_WPOOL + (size_t)g * HD * HD * 2; f8 = 0; mul = 1.0f; }
    const int nkb = K / 64, ng = r / nkb, kb = r - ng * nkb, k0 = 64 * kb, n0 = 256 * ng + 32 * w;
    const int drow = (mode == 0) ? n0 : (256 * (n0 >> 7) + (n0 & 127) + (mode == 2 ? 128 : 0));
    d.src = W + (size_t)k0 * Nn + 256 * ng; d.N = Nn; d.f8 = f8; d.mul = mul;
    d.ldkb = f8 ? K : 2 * K; d.dst = WT + (size_t)drow * d.ldkb + (f8 ? k0 : 2 * k0);
}
__device__ __forceinline__ void tile_load(const float* src, int N, f32x4 (&t)[8], int w, int lane) {
#pragma unroll
    for (int i = 0; i < 8; ++i) t[i] = __builtin_nontemporal_load((const f32x4*)(src + (size_t)(8 * w + i) * N + 4 * lane));
}
__device__ __forceinline__ void tile_store(LAS float* buf, const f32x4 (&t)[8], float mul, int w, int lane) {
#pragma unroll
    for (int i = 0; i < 8; ++i) *(LAS f32x4*)(buf + (8 * w + i) * TPITCH + 4 * lane) = t[i] * mul;
}
__device__ __forceinline__ void p0_convert(const P0Item& d, const LAS float* buf, int w, int lane, bool NT) {
    if (d.f8) {
        const int c = lane & 3;
#pragma unroll
        for (int j = 0; j < 2; ++j) { const int n = (lane >> 2) + 16 * j; const LAS float* s = buf + (16 * c) * TPITCH + 32 * w + n;
            v4u o; o.x = pg8::pk4_fp8(s[0 * TPITCH], s[1 * TPITCH], s[2 * TPITCH], s[3 * TPITCH]); o.y = pg8::pk4_fp8(s[4 * TPITCH], s[5 * TPITCH], s[6 * TPITCH], s[7 * TPITCH]);
            o.z = pg8::pk4_fp8(s[8 * TPITCH], s[9 * TPITCH], s[10 * TPITCH], s[11 * TPITCH]); o.w = pg8::pk4_fp8(s[12 * TPITCH], s[13 * TPITCH], s[14 * TPITCH], s[15 * TPITCH]);
            if (NT) __builtin_nontemporal_store(o, (v4u*)(d.dst + (size_t)n * d.ldkb + 16 * c)); else *(GAS v4u*)(d.dst + (size_t)n * d.ldkb + 16 * c) = o; }
    } else {
        const int c = lane & 7;
#pragma unroll
        for (int j = 0; j < 4; ++j) { const int n = (lane >> 3) + 8 * j; const LAS float* s = buf + (8 * c) * TPITCH + 32 * w + n;
            v4u o; o.x = pk2(s[0 * TPITCH], s[1 * TPITCH]); o.y = pk2(s[2 * TPITCH], s[3 * TPITCH]); o.z = pk2(s[4 * TPITCH], s[5 * TPITCH]); o.w = pk2(s[6 * TPITCH], s[7 * TPITCH]);
            if (NT) __builtin_nontemporal_store(o, (v4u*)(d.dst + (size_t)n * d.ldkb + 16 * c)); else *(GAS v4u*)(d.dst + (size_t)n * d.ldkb + 16 * c) = o; }
    }
}
__device__ __forceinline__ void p0_prologue(Frame& F, const Args& A) {
    const int flane = lane_of(F);
    const int w = F.wave;
    const int gt = F.vcu * (NWAVES * 64) + F.tid, NT = F.G * NWAVES * 64;
    for (int i = gt; i < 160 * DM / 4; i += NT) {
        const int m = (4 * i) / DM, k = (4 * i) % DM;
        f32x4 v = (f32x4){0.f, 0.f, 0.f, 0.f};
        if (m < NB) v = *(const f32x4*)(INP(2) + (size_t)m * DM + k); else if (m < NMODROW) v = *(const f32x4*)(INP(3) + (size_t)(m - NB) * DM + k);
        v2u o; o.x = pk2(silu1(v[0]), silu1(v[1])); o.y = pk2(silu1(v[2]), silu1(v[3]));
        *(GAS v2u*)(WSP(bf16, WS_SC) + ((size_t)(((k >> 4) * 5 + (m >> 5)) * 64 + ((k >> 3) & 1) * 32 + (m & 31)) * 8 + (k & 7))) = o;
    }
    for (int i = gt; i < NPOS * 128; i += NT) {
        const int p = i >> 7, fi = i & 127;
        const float pos = (float)(p < SEQ ? p : PAST + (p - SEQ));
        const float inv = (float)exp(-(double)fi * (9.210340371976184 / 128.0));
        const float ang = pos * inv;
        double s, c; sincos((double)ang, &s, &c);
        WSP(float, WS_ROT)[2 * (size_t)i] = (float)c; WSP(float, WS_ROT)[2 * (size_t)i + 1] = (float)s;
    }
}

__device__ __forceinline__ void p1_adaln(Frame& F, const Args& A) {
    const int flane = lane_of(F);
    LAS float* red = (LAS float*)F.lds;
    const int lane = flane, w = F.wave, r = lane & 31, hh = lane >> 5;
    for (int u = F.vcu; u < 2 * (NMOD / 256); u += F.G) {
        const int cg = u >> 1, kh = u & 1, n0 = (8 * cg + w) * 32;
        f32x16 acc[5];
#pragma unroll
        for (int t = 0; t < 5; ++t)
#pragma unroll
            for (int i = 0; i < 16; ++i) acc[t][i] = 0.f;
        const float* Wp = INP(6) + (size_t)(1024 * kh + 8 * hh) * NMOD + n0 + r;
        const bf16* Sp = WSP(bf16, WS_SC) + ((size_t)(64 * kh) * 5 * 64 + lane) * 8;
#pragma unroll 4
        for (int s = 0; s < 64; ++s) {
            float wv[8];
#pragma unroll
            for (int j = 0; j < 8; ++j) wv[j] = __builtin_nontemporal_load(Wp + (size_t)(16 * s + j) * NMOD);
            v4u au; au.x = pk2(wv[0], wv[1]); au.y = pk2(wv[2], wv[3]); au.z = pk2(wv[4], wv[5]); au.w = pk2(wv[6], wv[7]);
            const bf16x8 a = __builtin_bit_cast(bf16x8, au);
#pragma unroll
            for (int t = 0; t < 5; ++t) {
                const bf16x8 b = *(const bf16x8*)(Sp + (size_t)((s * 5 + t) * 64) * 8);
                acc[t] = __builtin_amdgcn_mfma_f32_32x32x16_bf16(a, b, acc[t], 0, 0, 0);
            }
        }
        float* dst = WSP(float, WS_MODS) + (kh ? MODSB_DELTA : (size_t)0);
#pragma unroll
        for (int pass = 0; pass < 2; ++pass) {
            if ((w >> 2) == pass) { LAS float* rs = red + (w & 3) * (160 * 33);
#pragma unroll
                for (int t = 0; t < 5; ++t)
#pragma unroll
                    for (int i = 0; i < 16; ++i) rs[(32 * t + r) * 33 + (i & 3) + 8 * (i >> 2) + 4 * hh] = acc[t][i]; }
            __syncthreads();
            const int c0 = 256 * cg + 128 * pass;
            for (int idx = F.tid; idx < NMODROW * 128; idx += NWAVES * 64) { const int m = idx >> 7, c = idx & 127;
                dst[(size_t)m * NMOD + c0 + c] = red[(c >> 5) * (160 * 33) + m * 33 + (c & 31)] + (kh ? 0.f : INP(7)[c0 + c]); }
            __syncthreads();
        }
    }
    {
        const int w8 = F.wave;
        LAS float* buf0 = (LAS float*)F.lds; LAS float* buf1 = (LAS float*)(F.lds + TILE_BYTES);
        volatile LAS int* qslot = (volatile LAS int*)(F.lds + MISC_OFF + 64);
        unsigned* qhead = (unsigned*)(F.ws + WS_CTL) + CW_QUEUE;
        if (F.tid == 0) { qslot[0] = (int)__hip_atomic_fetch_add(qhead, 1u, __ATOMIC_RELAXED, __HIP_MEMORY_SCOPE_AGENT); qslot[1] = (int)__hip_atomic_fetch_add(qhead, 1u, __ATOMIC_RELAXED, __HIP_MEMORY_SCOPE_AGENT); }
        __syncthreads();
        int ic = qslot[0], in = qslot[1];
        __syncthreads();
        constexpr int NALL = P0_NA + P0_NB + P0_NP;
        if (ic < NALL) {
            P0Item cur, nxt; f32x4 t[8];
            p0_decode(A, F.ws, ic, w8, cur); tile_load(cur.src, cur.N, t, w8, flane); tile_store(buf0, t, cur.mul, w8, flane);
            __syncthreads();
            int par = 0;
            for (;;) {
                const bool more = in < NALL;
                if (more) { p0_decode(A, F.ws, in, w8, nxt); tile_load(nxt.src, nxt.N, t, w8, flane); }
                if (F.tid == 0) qslot[0] = (int)__hip_atomic_fetch_add(qhead, 1u, __ATOMIC_RELAXED, __HIP_MEMORY_SCOPE_AGENT);
                p0_convert(cur, par ? buf1 : buf0, w8, flane, ic >= P0_NA && ic < P0_NA + P0_NB);
                if (more) { tile_store(par ? buf0 : buf1, t, nxt.mul, w8, flane); cur = nxt; ic = in; }
                __syncthreads();
                if (!more) break;
                in = qslot[0];
                __syncthreads();
                par ^= 1;
            }
        }
    }
}

__device__ __forceinline__ f32x4 ld4_bf16(const bf16* p) { const v2u v = *(const v2u*)p;
    return (f32x4){__builtin_bit_cast(float, v.x << 16), __builtin_bit_cast(float, v.x & 0xffff0000u), __builtin_bit_cast(float, v.y << 16), __builtin_bit_cast(float, v.y & 0xffff0000u)}; }
template <bool OUT8, int NP, bool S16, bool FIN>
__device__ __forceinline__ void norm_sample_rows(Frame& F, const float* srcS32, const float* gain, int sub, bf16* Hd, float* yS) {
    const int flane = lane_of(F);
    const int w = F.wave;
    bf16* X16 = WSP(bf16, WS_X); const bf16* slab = WSP(bf16, WS_SLAB);
    LAS float* part = (LAS float*)F.lds;
    int par = 0;
    for (int hr = F.vcu; hr < MS; hr += F.G) {
        const int m = MP + hr, k = 256 * w + 4 * flane;
        f32x4 v = S16 ? ld4_bf16(X16 + (size_t)m * DM + k) : *(const f32x4*)(srcS32 + (size_t)hr * DM + k);
        if (NP > 0) {
            f32x4 sv[NP > 0 ? NP : 1];
#pragma unroll
            for (int p = 0; p < NP; ++p) sv[p] = ld4_bf16(slab + ((size_t)p * MS + hr) * DM + k);
#pragma unroll
            for (int p = 0; p < NP; ++p) v += sv[p];
            if (!FIN) { v2u pk; pk.x = pk2(v[0], v[1]); pk.y = pk2(v[2], v[3]); *(GAS v2u*)(X16 + (size_t)m * DM + k) = pk; }
        }
        const float ssw = wave_sum((v[0] * v[0] + v[1] * v[1]) + (v[2] * v[2] + v[3] * v[3]));
        if (flane == 0) part[par * 8 + w] = ssw;
        __syncthreads();
        float ss = 0.f;
#pragma unroll
        for (int i = 0; i < 8; ++i) ss += part[par * 8 + i];
        par ^= 1;
        const float rstd = 1.0f / sqrtf(ss * (1.0f / DM) + EPS);
        if (FIN) { const f32x4 g4 = *(const f32x4*)(gain + k); *(f32x4*)(yS + (size_t)hr * DM + k) = (v * rstd) * g4; }
        else {
            const float* sh = WSP(float, WS_MODS) + (size_t)pg8::modrow_of(m) * NMOD + (size_t)(3 * sub) * DM; const float* sc = sh + DM;
            const f32x4 g4 = *(const f32x4*)(gain + k), s4 = *(const f32x4*)(sc + k) + *(const f32x4*)(sc + MODSB_DELTA + k), h4 = *(const f32x4*)(sh + k) + *(const f32x4*)(sh + MODSB_DELTA + k);
            const f32x4 o = (v * rstd) * g4 * (s4 + 1.0f) + h4;
            if (OUT8) { *(GAS unsigned*)((unsigned char*)Hd + (size_t)m * DM + k) = pg8::pk4_fp8(o[0], o[1], o[2], o[3]); }
            else { v2u pk; pk.x = pk2(o[0], o[1]); pk.y = pk2(o[2], o[3]); *(GAS v2u*)(Hd + (size_t)m * DM + k) = pk; }
        }
    }
    __syncthreads();
}
template <bool OUT8, bool P16>
__device__ __forceinline__ void norm_prompt_rows(Frame& F, const float* srcP32, const float* gain, int sub, bf16* Hd) {
    const int flane = lane_of(F);
    const int gw = F.vcu * NWAVES + F.wave, NGW = F.G * NWAVES;
    const bf16* X16 = WSP(bf16, WS_X);
    for (int m = gw; m < MP; m += NGW) {
        const float* sh = WSP(float, WS_MODS) + (size_t)pg8::modrow_of(m) * NMOD + (size_t)(3 * sub) * DM; const float* sc = sh + DM;
        f32x4 v[8]; float ss = 0.f;
#pragma unroll
        for (int j = 0; j < 8; ++j) v[j] = P16 ? ld4_bf16(X16 + (size_t)m * DM + 4 * (flane + 64 * j)) : *(const f32x4*)(srcP32 + (size_t)m * DM + 4 * (flane + 64 * j));
#pragma unroll
        for (int j = 0; j < 8; ++j) ss += (v[j][0] * v[j][0] + v[j][1] * v[j][1]) + (v[j][2] * v[j][2] + v[j][3] * v[j][3]);
        const float rstd = 1.0f / sqrtf(wave_sum(ss) * (1.0f / DM) + EPS);
#pragma unroll
        for (int j = 0; j < 8; ++j) { const int k = 4 * (flane + 64 * j);
            const f32x4 g4 = *(const f32x4*)(gain + k), s4 = *(const f32x4*)(sc + k) + *(const f32x4*)(sc + MODSB_DELTA + k), h4 = *(const f32x4*)(sh + k) + *(const f32x4*)(sh + MODSB_DELTA + k);
            const f32x4 o = (v[j] * rstd) * g4 * (s4 + 1.0f) + h4;
            if (OUT8) { *(GAS unsigned*)((unsigned char*)Hd + (size_t)m * DM + k) = pg8::pk4_fp8(o[0], o[1], o[2], o[3]); }
            else { v2u pk; pk.x = pk2(o[0], o[1]); pk.y = pk2(o[2], o[3]); *(GAS v2u*)(Hd + (size_t)m * DM + k) = pk; } }
    }
}
template <bool OUT8, int NP, bool P16, bool S16>
__device__ __forceinline__ void norm_mod(Frame& F, const float* srcP32, const float* srcS32, const float* gain, int sub, bf16* Hd) {
    norm_sample_rows<OUT8, NP, S16, false>(F, srcS32, gain, sub, Hd, nullptr);
    norm_prompt_rows<OUT8, P16>(F, srcP32, gain, sub, Hd);
}
template <int NP>
__device__ __forceinline__ void final_norm(Frame& F, const Args& A) {
    norm_sample_rows<false, NP, true, true>(F, nullptr, INP(21), 0, nullptr, F.out + O_YS);
    const int flane = lane_of(F);
    const int gw = F.vcu * NWAVES + F.wave, NGW = F.G * NWAVES;
    const bf16* X16 = WSP(bf16, WS_X);
    for (int m = gw; m < MP; m += NGW) {
        float* yr = F.out + O_YP + (size_t)m * DM;
        f32x4 v[8]; float ss = 0.f;
#pragma unroll
        for (int j = 0; j < 8; ++j) v[j] = ld4_bf16(X16 + (size_t)m * DM + 4 * (flane + 64 * j));
#pragma unroll
        for (int j = 0; j < 8; ++j) ss += (v[j][0] * v[j][0] + v[j][1] * v[j][1]) + (v[j][2] * v[j][2] + v[j][3] * v[j][3]);
        const float rstd = 1.0f / sqrtf(wave_sum(ss) * (1.0f / DM) + EPS);
#pragma unroll
        for (int j = 0; j < 8; ++j) { const int k = 4 * (flane + 64 * j); const f32x4 g4 = *(const f32x4*)(INP(21) + k); __builtin_nontemporal_store((v[j] * rstd) * g4, (f32x4*)(yr + k)); }
    }
}

#define MFMA16(a, b, c) __builtin_amdgcn_mfma_f32_16x16x32_bf16(a, b, c, 0, 0, 0)
__device__ __forceinline__ float log2_gamma(int h) { return h == 0 ? -0.045803689613124747f : h == 1 ? -0.022720076500083405f : h == 2 ? -0.011315313227834146f : -0.0056465631411130581f; }
constexpr int TP = 136;

__device__ __forceinline__ void retA_unit(Frame& F, int unit) {
    const int flane = lane_of(F);
    const int half = unit & 1, c = (unit >> 1) & 15, bh = unit >> 5, b = bh >> 2, h = bh & 3;
    const int m0 = b * SEQ + c * CH;
    const int tid = F.tid, lane = flane, w = F.wave, fr = lane & 15, fq = lane >> 4;
    LAS bf16* VT = (LAS bf16*)F.lds; LAS bf16* KT = VT + 256 * TP; LAS bf16* PP = KT + 128 * TP;
    const bf16* Qg = WSP(bf16, WS_QKVG) + (size_t)m0 * RW + h * HD;
    const bf16* Kg = Qg + (size_t)MTOK * RW; const bf16* Vg = Kg + (size_t)MTOK * RW;
    const float l2g = log2_gamma(h);
#pragma unroll 2
    for (int it = 0; it < 8; ++it) { const int idx = it * 512 + tid, tok = idx & 127, ch = idx >> 7;
        const bf16x8 v = *(const bf16x8*)(Vg + (size_t)tok * RW + ch * 8);
#pragma unroll
        for (int e = 0; e < 8; ++e) VT[(ch * 8 + e) * TP + tok] = (bf16)v[e]; }
#pragma unroll 2
    for (int it = 0; it < 4; ++it) { const int idx = it * 512 + tid, tok = idx & 127, ch = idx >> 7;
        const bf16x8 k = *(const bf16x8*)(Kg + (size_t)tok * RW + half * 128 + ch * 8);
        const float kd = __builtin_amdgcn_exp2f((float)(127 - tok) * l2g);
#pragma unroll
        for (int e = 0; e < 8; ++e) KT[(ch * 8 + e) * TP + tok] = (bf16)f2bf(bf2f((bf16)k[e]) * kd); }
    {
        f32x4 acc[4];
#pragma unroll
        for (int i = 0; i < 4; ++i) acc[i] = (f32x4){0.f, 0.f, 0.f, 0.f};
        if (16 * w < 64 * half + 64) {
#pragma unroll 2
            for (int s = 0; s < 8; ++s) {
                const bf16x8 bb = *(const bf16x8*)(Kg + (size_t)(16 * w + fr) * RW + 32 * s + 8 * fq);
#pragma unroll
                for (int i = 0; i < 4; ++i) { const bf16x8 aa = *(const bf16x8*)(Qg + (size_t)(64 * half + 16 * i + fr) * RW + 32 * s + 8 * fq); acc[i] = MFMA16(aa, bb, acc[i]); }
            }
        }
#pragma unroll
        for (int i = 0; i < 4; ++i)
#pragma unroll
            for (int r = 0; r < 4; ++r) { const int nl = 16 * i + 4 * fq + r, n = 64 * half + nl, m = 16 * w + fr, dn = n - m;
                const float val = dn >= 0 ? acc[i][r] * __builtin_amdgcn_exp2f((float)dn * l2g) : 0.f;
                PP[nl * TP + m] = (bf16)f2bf(val); }
    }
    __syncthreads();
    {
        f32x4 o[2][4];
#pragma unroll
        for (int j = 0; j < 2; ++j)
#pragma unroll
            for (int i = 0; i < 4; ++i) o[j][i] = (f32x4){0.f, 0.f, 0.f, 0.f};
#pragma unroll
        for (int s = 0; s < 4; ++s) {
            bf16x8 a[4];
#pragma unroll
            for (int i = 0; i < 4; ++i) a[i] = *(const LAS bf16x8*)(PP + (16 * i + fr) * TP + 32 * s + 8 * fq);
#pragma unroll
            for (int j = 0; j < 2; ++j) { const bf16x8 bb = *(const LAS bf16x8*)(VT + (16 * (2 * w + j) + fr) * TP + 32 * s + 8 * fq);
#pragma unroll
                for (int i = 0; i < 4; ++i) o[j][i] = MFMA16(bb, a[i], o[j][i]); }
        }
#pragma unroll
        for (int j = 0; j < 2; ++j)
#pragma unroll
            for (int i = 0; i < 4; ++i) { v2u pk; pk.x = pk2(o[j][i][0], o[j][i][1]); pk.y = pk2(o[j][i][2], o[j][i][3]);
                *(GAS v2u*)(WSP(bf16, WS_OI) + (size_t)(m0 + 64 * half + 16 * i + fr) * RW + h * HD + 16 * (2 * w + j) + 4 * fq) = pk; }
    }
    {
        f32x4 ua[2][8];
#pragma unroll
        for (int i = 0; i < 2; ++i)
#pragma unroll
            for (int j = 0; j < 8; ++j) ua[i][j] = (f32x4){0.f, 0.f, 0.f, 0.f};
#pragma unroll
        for (int s = 0; s < 4; ++s) {
            bf16x8 a[2];
#pragma unroll
            for (int i = 0; i < 2; ++i) a[i] = *(const LAS bf16x8*)(VT + (16 * (2 * w + i) + fr) * TP + 32 * s + 8 * fq);
#pragma unroll
            for (int j = 0; j < 8; ++j) { const bf16x8 bb = *(const LAS bf16x8*)(KT + (16 * j + fr) * TP + 32 * s + 8 * fq);
#pragma unroll
                for (int i = 0; i < 2; ++i) ua[i][j] = MFMA16(bb, a[i], ua[i][j]); }
        }
        bf16* UTu = WSP(bf16, WS_UT) + (size_t)(bh * NCH + c) * HD * HD;
#pragma unroll
        for (int i = 0; i < 2; ++i)
#pragma unroll
            for (int j = 0; j < 8; ++j) { v2u pk; pk.x = pk2(ua[i][j][0], ua[i][j][1]); pk.y = pk2(ua[i][j][2], ua[i][j][3]);
                *(GAS v2u*)(UTu + (size_t)(16 * (2 * w + i) + fr) * HD + 128 * half + 16 * j + 4 * fq) = pk; }
    }
    __syncthreads();
}

__device__ __forceinline__ void retC_unit(Frame& F, int unit) {
    const int flane = lane_of(F);
    const int c = unit & 15, bh = unit >> 4, b = bh >> 2, h = bh & 3;
    const int m0 = b * SEQ + c * CH;
    const int tid = F.tid, lane = flane, w = F.wave, fr = lane & 15, fq = lane >> 4;
    const bf16* Qg = WSP(bf16, WS_QKVG) + (size_t)m0 * RW + h * HD;
    const bf16* Gg = Qg + (size_t)3 * MTOK * RW;
    const float l2g = log2_gamma(h);
    f32x4 acc[16];
#pragma unroll
    for (int j = 0; j < 16; ++j) acc[j] = (f32x4){0.f, 0.f, 0.f, 0.f};
    if (c > 0) {
        const bf16* STc = WSP(bf16, WS_ST) + (size_t)(bh * NCH + c) * HD * HD;
        {
            v4u st[16];
#pragma unroll
            for (int it = 0; it < 16; ++it) st[it] = *(const v4u*)(STc + (size_t)(it * 512 + tid) * 8);
#pragma unroll
            for (int it = 0; it < 16; ++it) { const int idx = it * 512 + tid, row = idx >> 5, ch = idx & 31;
                *(LAS v4u*)(F.lds + row * 512 + ((ch ^ (row & 15)) * 16)) = st[it]; }
        }
        bf16x8 qf[8];
#pragma unroll
        for (int s = 0; s < 8; ++s) qf[s] = *(const bf16x8*)(Qg + (size_t)(16 * w + fr) * RW + 32 * s + 8 * fq);
        __syncthreads();
#pragma unroll
        for (int s = 0; s < 8; ++s) {
#pragma unroll
            for (int j = 0; j < 16; ++j) { const bf16x8 aa = *(const LAS bf16x8*)(F.lds + (16 * j + fr) * 512 + (((4 * s + fq) ^ fr) * 16)); acc[j] = MFMA16(aa, qf[s], acc[j]); }
        }
    }
    {
        const int n = 16 * w + fr; const size_t row = (size_t)(m0 + n);
        const float qd = __builtin_amdgcn_exp2f((float)(n + 1) * l2g);
        const bf16* oip = WSP(bf16, WS_OI) + row * RW + h * HD + 4 * fq;
        float ss = 0.f;
#pragma unroll
        for (int j = 0; j < 16; ++j) { const f32x4 o = ld4_bf16(oip + 16 * j) + acc[j] * qd; acc[j] = o; ss += (o[0] * o[0] + o[1] * o[1]) + (o[2] * o[2] + o[3] * o[3]); }
        ss += __shfl_xor(ss, 16); ss += __shfl_xor(ss, 32);
        const float rs = 1.0f / sqrtf(ss * (1.0f / HD) + EPS);
        const bf16* gp = Gg + (size_t)n * RW + 4 * fq;
        unsigned char* mp = WSP(unsigned char, WS_MIX) + row * DM + PW + h * HD + 4 * fq;
#pragma unroll
        for (int j = 0; j < 16; ++j) { const v2u gv = *(const v2u*)(gp + 16 * j);
            const float g0 = bf2f((bf16)(gv.x & 0xffffu)), g1 = bf2f((bf16)(gv.x >> 16)), g2 = bf2f((bf16)(gv.y & 0xffffu)), g3 = bf2f((bf16)(gv.y >> 16));
            *(GAS unsigned*)(mp + 16 * j) = pg8::pk4_fp8(silu1(g0) * acc[j][0] * rs, silu1(g1) * acc[j][1] * rs, silu1(g2) * acc[j][2] * rs, silu1(g3) * acc[j][3] * rs); }
    }
    __syncthreads();
}

__device__ __forceinline__ void retS_unit(Frame& F, const Args& A, int unit) {
    const int flane = lane_of(F);
    const int b = unit >> 2, h = unit & 3, row0 = MP + 4 * b;
    const int tid = F.tid, lane = flane, w = F.wave;
    LAS float* qs = (LAS float*)F.lds; LAS float* kr = qs + 1024; LAS float* vs = kr + 1024; LAS float* red = vs + 1024; LAS float* dots = red + 8192;
    const bf16* Qg = WSP(bf16, WS_QKVG); const bf16* Kg = Qg + (size_t)MTOK * RW; const bf16* Vg = Kg + (size_t)MTOK * RW; const bf16* Gg = Vg + (size_t)MTOK * RW;
    const float l2g = log2_gamma(h);
    for (int i = tid; i < 1024; i += NWAVES * 64) { const int t = i >> 8, d = i & 255; const size_t off = (size_t)(row0 + t) * RW + h * HD + d;
        qs[i] = bf2f(Qg[off]); kr[i] = bf2f(Kg[off]); vs[i] = bf2f(Vg[off]); }
    __syncthreads();
#pragma unroll
    for (int jj = 0; jj < 2; ++jj) { const int p = 2 * w + jj, t = p >> 2, m = p & 3;
        const f32x4 a = *(const LAS f32x4*)(qs + t * 256 + 4 * lane), k4 = *(const LAS f32x4*)(kr + m * 256 + 4 * lane);
        const float d = wave_sum((a[0] * k4[0] + a[1] * k4[1]) + (a[2] * k4[2] + a[3] * k4[3]));
        if (lane == 0) dots[p] = d; }
    const f32x4* S0 = (const f32x4*)(INP(5) + (size_t)unit * HD * HD);
    f32x4* S1 = (f32x4*)(F.out + O_RETS + (size_t)unit * HD * HD);
    f32x4 v4[4], oq[4];
#pragma unroll
    for (int t = 0; t < 4; ++t) { v4[t] = *(const LAS f32x4*)(vs + t * 256 + 4 * lane); oq[t] = (f32x4){0.f, 0.f, 0.f, 0.f}; }
    const float cdec = __builtin_amdgcn_exp2f(4.0f * l2g);
    const float kd0 = __builtin_amdgcn_exp2f(3.0f * l2g), kd1 = __builtin_amdgcn_exp2f(2.0f * l2g), kd2 = __builtin_amdgcn_exp2f(l2g);
    f32x4 s[8], sn[8];
#pragma unroll
    for (int u = 0; u < 8; ++u) s[u] = __builtin_nontemporal_load(S0 + (size_t)(32 * w + u) * 64 + lane);
#pragma unroll
    for (int it = 0; it < 4; ++it) {
        const int dk0 = 32 * w + 8 * it;
        if (it < 3) {
#pragma unroll
            for (int u = 0; u < 8; ++u) sn[u] = __builtin_nontemporal_load(S0 + (size_t)(dk0 + 8 + u) * 64 + lane);
        }
#pragma unroll
        for (int u = 0; u < 8; ++u) { const int dk = dk0 + u;
            const float q0 = qs[dk], q1 = qs[256 + dk], q2 = qs[512 + dk], q3 = qs[768 + dk];
            const float k0 = kr[dk] * kd0, k1 = kr[256 + dk] * kd1, k2 = kr[512 + dk] * kd2, k3 = kr[768 + dk];
            oq[0] += s[u] * q0; oq[1] += s[u] * q1; oq[2] += s[u] * q2; oq[3] += s[u] * q3;
            __builtin_nontemporal_store(s[u] * cdec + v4[0] * k0 + v4[1] * k1 + v4[2] * k2 + v4[3] * k3, S1 + (size_t)dk * 64 + lane); }
#pragma unroll
        for (int u = 0; u < 8; ++u) s[u] = sn[u];
    }
#pragma unroll
    for (int t = 0; t < 4; ++t) *(LAS f32x4*)(red + (w * 4 + t) * 256 + 4 * lane) = oq[t];
    __syncthreads();
    if (w < 4) {
        const int t = w;
        f32x4 o = (f32x4){0.f, 0.f, 0.f, 0.f};
#pragma unroll
        for (int ww = 0; ww < 8; ++ww) o += *(const LAS f32x4*)(red + (ww * 4 + t) * 256 + 4 * lane);
        o = o * __builtin_amdgcn_exp2f((float)(t + 1) * l2g);
#pragma unroll
        for (int m = 0; m < 4; ++m) if (m <= t) o += v4[m] * (dots[t * 4 + m] * __builtin_amdgcn_exp2f((float)(t - m) * l2g));
        const float ss = wave_sum((o[0] * o[0] + o[1] * o[1]) + (o[2] * o[2] + o[3] * o[3]));
        const float rs = 1.0f / sqrtf(ss * (1.0f / HD) + EPS);
        const size_t row = (size_t)(row0 + t);
        const v2u gp = *(const v2u*)(Gg + row * RW + h * HD + 4 * lane);
        const float g0 = bf2f((bf16)(gp.x & 0xffffu)), g1 = bf2f((bf16)(gp.x >> 16)), g2 = bf2f((bf16)(gp.y & 0xffffu)), g3 = bf2f((bf16)(gp.y >> 16));
        *(GAS unsigned*)(WSP(unsigned char, WS_MIX) + row * DM + PW + h * HD + 4 * lane) = pg8::pk4_fp8(silu1(g0) * o[0] * rs, silu1(g1) * o[1] * rs, silu1(g2) * o[2] * rs, silu1(g3) * o[3] * rs);
    }
    __syncthreads();
}

__device__ __forceinline__ void scan_states(Frame& F) {
    const int gt = F.vcu * (NWAVES * 64) + F.tid, NT = F.G * NWAVES * 64;
    for (int i = gt; i < 16 * 16384; i += NT) {
        const int bh = i >> 14, e4 = i & 16383, h = bh & 3;
        const bf16* up = WSP(bf16, WS_UT) + ((size_t)bh * NCH * 16384 + e4) * 4;
        f32x4 uv[16];
#pragma unroll
        for (int c = 0; c < 16; ++c) uv[c] = ld4_bf16(up + (size_t)c * 65536);
        const float g128 = __builtin_amdgcn_exp2f(128.0f * log2_gamma(h));
        f32x4 S = (f32x4){0.f, 0.f, 0.f, 0.f};
#pragma unroll
        for (int c = 0; c < 16; ++c) {
            S = S * g128 + uv[c];
            if (c < 15) { v2u pk; pk.x = pk2(S[0], S[1]); pk.y = pk2(S[2], S[3]); *(GAS v2u*)(WSP(bf16, WS_ST) + ((size_t)(bh * NCH + c + 1) * 16384 + e4) * 4) = pk; }
        }
        const int dv = (4 * e4) >> 8, dk = (4 * e4) & 255;
        float* rp = F.out + O_RETP + (size_t)bh * HD * HD + dv;
#pragma unroll
        for (int q = 0; q < 4; ++q) rp[(size_t)(dk + q) * HD] = S[q];
    }
}

__device__ __forceinline__ void pool_prompt_item(Frame& F, int item, int q) {
    const int b = item >> 8, t0 = (item & 255) * 8, g = q >> 6, wn = 2 << g;
    const bf16* U16 = WSP(bf16, WS_U) + (size_t)b * SEQ * PW + 4 * q;
#define U4_AT(t) ld4_bf16(U16 + (size_t)(t) * PW)
    f32x4 hv[15], cur[8], old[8];
#pragma unroll
    for (int j = 1; j < 16; ++j) { const int t = t0 - j; const bool ok = (j < wn) && (t >= 0); hv[j - 1] = U4_AT(ok ? t : t0) * (ok ? 1.0f : 0.0f); }
#pragma unroll
    for (int i = 0; i < 8; ++i) { const int t = t0 + i, to = t - wn; const bool ok = (i >= 1) && (to >= 0);
        cur[i] = U4_AT(t); old[i] = U4_AT(ok ? to : t) * (ok ? 1.0f : 0.0f); }
    f32x4 sum = (f32x4){0.f, 0.f, 0.f, 0.f};
#pragma unroll
    for (int j = 0; j < 15; ++j) sum += hv[j];
#pragma unroll
    for (int i = 0; i < 8; ++i) {
        const int t = t0 + i;
        sum += cur[i]; sum -= old[i];
        const float cnt = (float)((t + 1 < wn) ? (t + 1) : wn);
        const f32x4 mv = sum / cnt - cur[i];
        v2u pk; pk.x = pk2(mv[0], mv[1]); pk.y = pk2(mv[2], mv[3]);
        *(GAS v2u*)(WSP(bf16, WS_PM) + ((size_t)(b * SEQ + t) * PW + 4 * q)) = pk;
    }
}
#undef U4_AT
__device__ __forceinline__ void pool_sample_item(Frame& F, const Args& A, int b, int q) {
    const int g = q >> 6, wn = 2 << g;
    const f32x4* SP4 = (const f32x4*)(INP(4) + (size_t)b * 15 * PW) + q;
    const bf16* US16 = WSP(bf16, WS_U) + (size_t)(MP + 4 * b) * PW + 4 * q;
    f32x4 ue[19];
#pragma unroll
    for (int i = 0; i < 15; ++i) ue[i] = SP4[(size_t)i * 256];
#pragma unroll
    for (int t = 0; t < 4; ++t) ue[15 + t] = ld4_bf16(US16 + (size_t)t * PW);
#pragma unroll
    for (int t = 0; t < 4; ++t) {
        f32x4 sum = (f32x4){0.f, 0.f, 0.f, 0.f};
#pragma unroll
        for (int j = 0; j < 16; ++j) sum += ue[15 + t - j] * ((j < wn) ? 1.0f : 0.0f);
        const f32x4 mv = sum / (float)wn - ue[15 + t];
        v2u pk; pk.x = pk2(mv[0], mv[1]); pk.y = pk2(mv[2], mv[3]);
        *(GAS v2u*)(WSP(bf16, WS_PM) + ((size_t)(MP + 4 * b + t) * PW + 4 * q)) = pk;
    }
}
__device__ __forceinline__ void pool_phase(Frame& F, const Args& A) {
    const int q = F.tid & 255, sub = F.tid >> 8;
    for (int bi = F.vcu; bi < 512; bi += F.G) pool_prompt_item(F, 2 * bi + sub, q);
    for (int bi = F.G - 1 - F.vcu; bi < 64; bi += F.G) pool_sample_item(F, A, 2 * bi + sub, q);
    const int gt = F.vcu * (NWAVES * 64) + F.tid, NT = F.G * NWAVES * 64;
    f32x4* o4 = (f32x4*)F.out;
    for (int i = gt; i < NB * 15 * 256; i += NT) { const int qq = i & 255, r = (i >> 8) % 15, b = (i >> 8) / 15;
        o4[O_POOLP / 4 + i] = ld4_bf16(WSP(bf16, WS_U) + (((size_t)b * SEQ + (SEQ - 15) + r) * 256 + qq) * 4); }
    for (int i = gt; i < DB * 15 * 256; i += NT) { const int qq = i & 255, r = (i >> 8) % 15, b = (i >> 8) / 15;
        o4[O_POOLS / 4 + i] = (r < 11) ? ((const f32x4*)INP(4))[((size_t)b * 15 + r + 4) * 256 + qq] : ld4_bf16(WSP(bf16, WS_U) + (((size_t)(MP + 4 * b) + (r - 11)) * 256 + qq) * 4); }
}


__global__ void __launch_bounds__(NWAVES * 64, 2) mk_fwd(Args args) {
    extern __shared__ __attribute__((aligned(16))) unsigned char lds[];
    Frame F;
    F.lds = (LAS unsigned char*)lds;
    F.MISC = (volatile LAS unsigned*)(F.lds + MISC_OFF);
    F.tid = threadIdx.x; F.wave = __builtin_amdgcn_readfirstlane(F.tid >> 6);
    F.G = gridDim.x; { const int bx = blockIdx.x; F.vcu = (F.G % 8 == 0) ? (bx % 8) * (F.G / 8) + bx / 8 : bx; }
    unsigned char* ws = args.ws; const Args& A = args;
    F.out = args.out;
    F.ws = ws;
    for (int u = F.tid; u < (LDS_BYTES - LDSCTL_OFF) / 4; u += NWAVES * 64) ((LAS unsigned*)(F.lds + LDSCTL_OFF))[u] = 0u;
    __syncthreads();
    if (!MK_PER_PHASE) (void)xcd_barrier_post((unsigned*)(ws + WS_CTL) + CW_BAR + args.bar_region * XCD_BAR_WORDS, F.MISC + 8);
    const int lo = args.ph_lo, hi = args.ph_hi;
#ifdef PROBE_TA
    if (blockIdx.x == 0 && threadIdx.x == 0) ((unsigned long long*)(ws + WS_CTL + 49152))[0] = __builtin_amdgcn_s_memrealtime();
#endif
#ifndef PH_MASK
#define PH_MASK 0x7fff
#endif
#define IN(k) (((PH_MASK >> (k)) & 1) && lo <= (k) && (k) < hi)
#ifndef REP_MASK
#define REP_MASK 0
#endif
#ifdef PROBE_TA
#define STAMP_AFTER(k) do { if (blockIdx.x == 0 && threadIdx.x == 0) ((unsigned long long*)(A.ws + WS_CTL + 49152))[(k) + 1] = __builtin_amdgcn_s_memrealtime(); } while (0)
#else
#define STAMP_AFTER(k) do { } while (0)
#endif
#define NREP(k) ((((REP_MASK) >> (k)) & 1) ? 2 : 1)
#define SEAM(k) do { if (!MK_PER_PHASE && (IN((k) + 1) || rep_ + 1 < NREP(k))) { XcdBarrier bar_; bar_.bar = (unsigned*)(A.ws + WS_CTL) + CW_BAR + A.bar_region * XCD_BAR_WORDS; bar_.x = xb_xcc_id(); bar_.st = (volatile LAS unsigned*)(F.lds + MISC_OFF) + 8; xcd_barrier(bar_); } STAMP_AFTER(k); } while (0)

    if (IN(0)) for (int rep_ = relaunder(F); rep_ < NREP(0); ++rep_) { p0_prologue(F, A); SEAM(0); }
    if (IN(1)) for (int rep_ = relaunder(F); rep_ < NREP(1); ++rep_) { p1_adaln(F, A); SEAM(1); }
    if (IN(2)) for (int rep_ = relaunder(F); rep_ < NREP(2); ++rep_) { norm_mod<true, 0, false, false>(F, INP(0), INP(1), INP(8), 0, WSP(bf16, WS_H)); SEAM(2); }
    if (IN(3)) for (int rep_ = relaunder(F); rep_ < NREP(3); ++rep_) {
        pg8::Gemm g{WSP(bf16, WS_H), WSP(bf16, WS_W1), DM, DM, DM, 0, 0, WSC_UP}; pg8::StaticOrder S; S.init(MTOK, 2 * DFF, F.G, (int)blockIdx.x);
        pg8::EpiSwiglu E{WSP(unsigned char, WS_ACT)};
        pg8::gemm_phase8<pg8::EpiSwiglu, pg8::StaticOrder, true>(F.lds, g, S, E);
        SEAM(3);
    }
    if (IN(4)) for (int rep_ = relaunder(F); rep_ < NREP(4); ++rep_) {
        pg8::Gemm g{WSP(bf16, WS_ACT), WSP(bf16, WS_W1D), DFF, DFF, DFF, 0, KP_DOWN, WSC_DOWN}; pg8::SplitOrder S; S.init(DM, DFF / KP_DOWN, F.G, (int)blockIdx.x);
        pg8::EpiResid<false> E{INP(0), WSP(bf16, WS_X), WSP(float, WS_MODS) + 2 * DM, 0.5f};
        pg8::gemm_phase8<decltype(E), pg8::SplitOrder, true>(F.lds, g, S, E);
        SEAM(4);
    }
    if (IN(5)) for (int rep_ = relaunder(F); rep_ < NREP(5); ++rep_) { norm_mod<false, DFF / KP_DOWN, true, false>(F, nullptr, INP(1), INP(12), 1, WSP(bf16, WS_H)); SEAM(5); }
    if (IN(6)) for (int rep_ = relaunder(F); rep_ < NREP(6); ++rep_) {
        pg8::Gemm g{WSP(bf16, WS_H), WSP(bf16, WS_WIN), DM, DM, DM, 0, 0, 0}; pg8::StaticOrder S; S.init(MTOK, INC, F.G, (int)blockIdx.x);
        pg8::EpiWin E{WSP(bf16, WS_U), WSP(bf16, WS_QKVG), WSP(float, WS_ROT)};
        pg8::gemm_phase<pg8::EpiWin, pg8::StaticOrder, true>(F.lds, g, S, E);
        SEAM(6);
    }
    if (IN(7)) for (int rep_ = relaunder(F); rep_ < NREP(7); ++rep_) {
        for (int u = F.vcu; u < NB * NH * NCH * 2; u += F.G) retA_unit(F, u);
        pool_phase(F, A);
        SEAM(7);
    }
    if (IN(8)) for (int rep_ = relaunder(F); rep_ < NREP(8); ++rep_) {
        {
            pg8::Gemm g{WSP(bf16, WS_PM), WSP(bf16, WS_WPOOL), PW, HD, HD, HD, 0, 0}; pg8::StaticOrder S; S.init(MTOK, PW, F.G, (int)blockIdx.x);
            pg8::EpiPool E{WSP(unsigned char, WS_MIX), INP(15)};
            pg8::gemm_phase<pg8::EpiPool, pg8::StaticOrder, true>(F.lds, g, S, E);
        }
        __syncthreads();
        { int t2 = threadIdx.x; asm volatile("" : "+v"(t2)); F.tid = t2; }
        for (int u = F.vcu; u < DB * NH; u += F.G) retS_unit(F, A, u);
        scan_states(F);
        SEAM(8);
    }
    if (IN(9)) for (int rep_ = relaunder(F); rep_ < NREP(9); ++rep_) { for (int u = F.vcu; u < NB * NH * NCH; u += F.G) retC_unit(F, u); SEAM(9); }
    if (IN(10)) for (int rep_ = relaunder(F); rep_ < NREP(10); ++rep_) {
        pg8::Gemm g{WSP(bf16, WS_MIX), WSP(bf16, WS_WOUT), DM, DM, DM, 0, KP_OUT, WSC_UP}; pg8::SplitOrder S; S.init(DM, DM / KP_OUT, F.G, (int)blockIdx.x);
        pg8::EpiResid<true> E{nullptr, WSP(bf16, WS_X), WSP(float, WS_MODS) + 5 * DM, 1.0f};
        pg8::gemm_phase8<decltype(E), pg8::SplitOrder, true>(F.lds, g, S, E);
        SEAM(10);
    }
    if (IN(11)) for (int rep_ = relaunder(F); rep_ < NREP(11); ++rep_) { norm_mod<true, DM / KP_OUT, true, true>(F, nullptr, nullptr, INP(17), 2, WSP(bf16, WS_H)); SEAM(11); }
    if (IN(12)) for (int rep_ = relaunder(F); rep_ < NREP(12); ++rep_) {
        pg8::Gemm g{WSP(bf16, WS_H), WSP(bf16, WS_W2), DM, DM, DM, 0, 0, WSC_UP}; pg8::StaticOrder S; S.init(MTOK, 2 * DFF, F.G, (int)blockIdx.x);
        pg8::EpiSwiglu E{WSP(unsigned char, WS_ACT)};
        pg8::gemm_phase8<pg8::EpiSwiglu, pg8::StaticOrder, true>(F.lds, g, S, E);
        SEAM(12);
    }
    if (IN(13)) for (int rep_ = relaunder(F); rep_ < NREP(13); ++rep_) {
        pg8::Gemm g{WSP(bf16, WS_ACT), WSP(bf16, WS_W2D), DFF, DFF, DFF, 0, KP_DOWN, WSC_DOWN}; pg8::SplitOrder S; S.init(DM, DFF / KP_DOWN, F.G, (int)blockIdx.x);
        pg8::EpiResid<true> E{nullptr, WSP(bf16, WS_X), WSP(float, WS_MODS) + 8 * DM, 0.5f};
        pg8::gemm_phase8<decltype(E), pg8::SplitOrder, true>(F.lds, g, S, E);
        SEAM(13);
    }
    if (IN(14)) for (int rep_ = relaunder(F); rep_ < NREP(14); ++rep_) { final_norm<DFF / KP_DOWN>(F, A); if (rep_ + 1 < NREP(14)) { SEAM(14); } }
#ifdef PROBE_TA
    if (blockIdx.x == 0 && threadIdx.x == 0) {
        unsigned long long* ts = (unsigned long long*)(ws + WS_CTL + 49152);
        const unsigned long long now = __builtin_amdgcn_s_memrealtime(); ts[15] = now;
        unsigned long long qa = (ts[PROBE_TA + 1] - ts[PROBE_TA]) / 400ull, qb = (ts[PROBE_TB + 1] - ts[PROBE_TB]) / 400ull;
        if (qa > 99ull) qa = 99ull; if (qb > 99ull) qb = 99ull;
        const unsigned long long until = now + qa * 2000ull + qb * 200000ull;
        while (__builtin_amdgcn_s_memrealtime() < until) __builtin_amdgcn_s_sleep(64);
    }
#endif
#undef IN
#undef SEAM
}

extern "C" void kernel_launch(void* const* d_in, const int* in_sizes, int n_in, void* d_out, int out_size, void* d_ws, size_t ws_size, hipStream_t stream) {
    static int grid = 0;
    if (grid == 0) {
        if (n_in != 22 || (size_t)out_size != O_END || ws_size < WS_END) { fprintf(stderr, "kernel_launch: unexpected shapes (n_in %d out %d ws %zu)\n", n_in, out_size, ws_size); grid = -1; return; }
        int dev = 0, cus = 0, per_cu = 0;
        if (hipGetDevice(&dev) != hipSuccess || hipDeviceGetAttribute(&cus, hipDeviceAttributeMultiprocessorCount, dev) != hipSuccess) { grid = -1; return; }
        if (hipFuncSetAttribute((const void*)mk_fwd, hipFuncAttributeMaxDynamicSharedMemorySize, LDS_BYTES) != hipSuccess) { fprintf(stderr, "kernel_launch: hipFuncSetAttribute failed\n"); grid = -1; return; }
        if (hipOccupancyMaxActiveBlocksPerMultiprocessor(&per_cu, (const void*)mk_fwd, NWAVES * 64, LDS_BYTES) != hipSuccess || per_cu < 1) { fprintf(stderr, "kernel_launch: occupancy query says %d blocks/CU\n", per_cu); (void)hipGetLastError(); grid = -1; return; }
        grid = cus;
    }
    if (grid < 0) return;
    (void)hipMemsetAsync((char*)d_ws + WS_CTL, 0, CTL_ZERO_BYTES, stream);
    Args a{};
    for (int i = 0; i < 22; ++i) a.in[i] = (const float*)d_in[i];
    a.out = (float*)d_out; a.ws = (unsigned char*)d_ws;
#if MK_PER_PHASE
    for (int p = 0; p < N_PHASES; ++p) { a.ph_lo = p; a.ph_hi = p + 1; hipLaunchKernelGGL(mk_fwd, dim3(grid), dim3(NWAVES * 64), LDS_BYTES, stream, a); }
#else
    a.ph_lo = 0; a.ph_hi = N_PHASES;
    hipLaunchKernelGGL(mk_fwd, dim3(grid), dim3(NWAVES * 64), LDS_BYTES, stream, a);
#ifdef PROBE_LO
    a.ph_lo = PROBE_LO; a.ph_hi = PROBE_HI; a.bar_region = 1;
    hipLaunchKernelGGL(mk_fwd, dim3(grid), dim3(NWAVES * 64), LDS_BYTES, stream, a);
#endif
#endif
}
```

```cpp
#include <hip/hip_runtime.h>
#include <cstdio>
#include <cstdint>
#include <cmath>

#ifndef MK_PER_PHASE
#define MK_PER_PHASE 0
#endif

constexpr int DM = 2048, DFF = 5632, SEQ = 2048, NB = 4, DB = 128, DS = 4;
constexpr int MP = NB * SEQ;
constexpr int MS = DB * DS;
constexpr int MTOK = MP + MS;
constexpr int NMODROW = NB + DB;
constexpr int NMOD = 9 * DM;
constexpr int PW = 1024, RW = 1024, HD = 256, NH = 4, CH = 128, NCH = SEQ / CH;
constexpr int INC = PW + 4 * RW;
constexpr int PAST = 16384;
constexpr float EPS = 1e-6f;
constexpr int NPOS = SEQ + DS;

constexpr size_t O_YP = 0, O_YS = (size_t)MP * DM, O_POOLP = O_YS + (size_t)MS * DM, O_RETP = O_POOLP + (size_t)NB * 15 * PW,
                 O_POOLS = O_RETP + (size_t)NB * NH * HD * HD, O_RETS = O_POOLS + (size_t)DB * 15 * PW, O_END = O_RETS + (size_t)DB * NH * HD * HD;

constexpr size_t SLAB_MINUS_X = (size_t)(568 - 210) << 20;
constexpr size_t MODSB_DELTA = ((size_t)(612 - 5) << 20) / 4;

namespace pg8 {
#define PG8_LAS __attribute__((address_space(3)))
typedef unsigned short bf16_t;
typedef short bf16x8 __attribute__((ext_vector_type(8)));
typedef float f32x4 __attribute__((ext_vector_type(4)));
typedef unsigned u32x4 __attribute__((ext_vector_type(4)));
typedef unsigned u32x2 __attribute__((ext_vector_type(2)));
constexpr int BM = 256, BK = 64, HALF = 128, HTB = HALF * BK * 2  , STAGE_BYTES = 8 * HTB, NXCD = 8, WGM = 8;

__host__ __device__ __forceinline__ int lds_byte(int r, int c) { const int st = (r >> 4) * 2 + (c >> 5), rr = r & 15, cc = c & 31, ob = rr * 64 + cc * 2; return st * 1024 + (ob ^ (((ob >> 9) & 1) << 5)); }
__host__ __device__ __forceinline__ void stage_rc(int b, int& R, int& C) { const int st = b / 1024, sb = b % 1024, swz = sb ^ (((sb >> 9) & 1) << 5); R = (st >> 1) * 16 + swz / 64; C = (st & 1) * 32 + (swz % 64) / 2; }
__host__ __device__ __forceinline__ int perm32(int rho) { const int n = rho >> 4, i = rho & 15; return 8 * (i >> 2) + 4 * n + (i & 3); }

struct Unit { int pm, pn, kp; };
struct Gemm { const bf16_t* A; const bf16_t* Bt; int lda, ldb, K, acol, kpiece, wscale; };

struct StaticOrder {
    int nM, nN, nwg, G, c;
    __host__ __device__ __forceinline__ void init(int M, int N, int G_, int c_) { nM = M / BM; nN = N / BM; nwg = nM * nN; G = G_; c = c_; }
    __host__ __device__ __forceinline__ bool next(int i, Unit& u) const {
        const long L = (long)i * G + c; if (L >= nwg) return false;
        int wgid = (int)L; { const int q = nwg / NXCD, r = nwg % NXCD, xcd = wgid % NXCD, off = wgid / NXCD; wgid = (xcd < r ? xcd * (q + 1) : r * (q + 1) + (xcd - r) * q) + off; }
        const int nig = WGM * nN, gid = wgid / nig, fm = gid * WGM, gsz = (nM - fm) < WGM ? (nM - fm) : WGM;
        u.pm = fm + ((wgid % nig) % gsz); u.pn = (wgid % nig) / gsz; u.kp = -1; return true;
    }
    __device__ __forceinline__ void a_ready(const Unit&) const {}
    __device__ __forceinline__ void done(const Unit&) const {}
};

struct SplitOrder {
    int nN, nfull, np, G, c;
    __host__ __device__ __forceinline__ void init(int N, int np_, int G_, int c_) { nN = N / BM; nfull = (MP / BM) * nN; np = np_; G = G_; c = c_; }
    __host__ __device__ __forceinline__ bool next(int i, Unit& u) const {
        const int L = i * G + c;
        int pm, pn, kp; bool ok = true;
        if (L < nfull) {
            int wgid = L; { const int q = nfull / NXCD, xcd = wgid % NXCD, off = wgid / NXCD; wgid = xcd * q + off; }
            const int nig = WGM * nN, gid = wgid / nig, fm = gid * WGM;
            pm = fm + ((wgid % nig) % WGM); pn = (wgid % nig) / WGM; kp = -1;
        } else {
            const int j = L - nfull; ok = j < 2 * nN * np;
            const int t = j / np; kp = j - t * np; pm = MP / BM + t / nN; pn = t % nN;
        }
        u.pm = pm; u.pn = pn; u.kp = kp; return ok;
    }
    __device__ __forceinline__ void a_ready(const Unit&) const {}
    __device__ __forceinline__ void done(const Unit&) const {}
};

__device__ __forceinline__ unsigned cvt_pk_bf16(float lo, float hi) { unsigned r; asm volatile("v_cvt_pk_bf16_f32 %0, %1, %2" : "=v"(r) : "v"(lo), "v"(hi)); return r; }
__device__ __forceinline__ float silu_f(float x) { return x * __builtin_amdgcn_rcpf(1.0f + __builtin_amdgcn_exp2f(-1.4426950408889634f * x)); }
__device__ __forceinline__ float clamp448(float x) { return __builtin_fminf(__builtin_fmaxf(x, -448.0f), 448.0f); }
__device__ __forceinline__ unsigned pk4_fp8(float a, float b, float c, float d) {
    int p = 0; p = __builtin_amdgcn_cvt_pk_fp8_f32(clamp448(a), clamp448(b), p, false); p = __builtin_amdgcn_cvt_pk_fp8_f32(clamp448(c), clamp448(d), p, true); return (unsigned)p; }
__device__ __forceinline__ unsigned pk4_fp8_nc(float a, float b, float c, float d) {
    int p = 0; p = __builtin_amdgcn_cvt_pk_fp8_f32(a, b, p, false); p = __builtin_amdgcn_cvt_pk_fp8_f32(c, d, p, true); return (unsigned)p; }
__device__ __forceinline__ int modrow_of(int row) { return row < MP ? (row >> 11) : NB + ((row - MP) >> 2); }
__device__ __forceinline__ int ptab_of(int row) { return row < MP ? (row & (SEQ - 1)) : SEQ + ((row - MP) & 3); }

struct EpiSwiglu {
    static constexpr bool PERM = true, AFTER_DRAIN = false;
    unsigned char* O;
    __device__ __forceinline__ void operator()(const f32x4 (&acc)[2][2][4][2], const Unit& u, int wr, int wc, int fr, int fq) const {
        const int row0 = u.pm * BM + wr * 64 + fr, col0 = u.pn * HALF + wc * 32 + 8 * fq;
#pragma unroll
        for (int ai = 0; ai < 2; ++ai)
#pragma unroll
            for (int m = 0; m < 4; ++m) {
                unsigned char* rowp = O + (size_t)(row0 + ai * HALF + m * 16) * DFF + col0;
                const f32x4 g0 = acc[ai][0][m][0], g1 = acc[ai][0][m][1], u0 = acc[ai][1][m][0], u1 = acc[ai][1][m][1];
                u32x2 w;
                w.x = pk4_fp8_nc(silu_f(g0[0]) * u0[0], silu_f(g0[1]) * u0[1], silu_f(g0[2]) * u0[2], silu_f(g0[3]) * u0[3]);
                w.y = pk4_fp8_nc(silu_f(g1[0]) * u1[0], silu_f(g1[1]) * u1[1], silu_f(g1[2]) * u1[2], silu_f(g1[3]) * u1[3]);
                *(u32x2*)rowp = w;
            }
    }
};
template <bool BASE16> struct EpiResid {
    static constexpr bool PERM = true, AFTER_DRAIN = false;
    const float* base32; bf16_t* X; const float* gate; float coef;
    __device__ __forceinline__ void operator()(const f32x4 (&acc)[2][2][4][2], const Unit& u, int wr, int wc, int fr, int fq) const {
        const int row0 = u.pm * BM + wr * 64 + fr, col0 = u.pn * BM + wc * 32 + 8 * fq;
        if (u.kp < 0) {
            const float* gp = gate + (size_t)(u.pm >> 3) * NMOD + col0;
            f32x4 gg[2][2];
#pragma unroll
            for (int bj = 0; bj < 2; ++bj)
#pragma unroll
                for (int n = 0; n < 2; ++n) gg[bj][n] = (*(const f32x4*)(gp + bj * HALF + 4 * n) + *(const f32x4*)(gp + MODSB_DELTA + bj * HALF + 4 * n)) * coef;
#pragma unroll
            for (int ai = 0; ai < 2; ++ai)
#pragma unroll
                for (int m = 0; m < 4; ++m) {
                    const int row = row0 + ai * HALF + m * 16;
                    bf16_t* xp = X + (size_t)row * DM + col0;
#pragma unroll
                    for (int bj = 0; bj < 2; ++bj) {
                        f32x4 b0, b1;
                        if (BASE16) { const u32x4 bv = *(const u32x4*)(xp + bj * HALF);
                            b0 = (f32x4){__builtin_bit_cast(float, bv.x << 16), __builtin_bit_cast(float, bv.x & 0xffff0000u), __builtin_bit_cast(float, bv.y << 16), __builtin_bit_cast(float, bv.y & 0xffff0000u)};
                            b1 = (f32x4){__builtin_bit_cast(float, bv.z << 16), __builtin_bit_cast(float, bv.z & 0xffff0000u), __builtin_bit_cast(float, bv.w << 16), __builtin_bit_cast(float, bv.w & 0xffff0000u)}; }
                        else { const float* bp = base32 + (size_t)row * DM + col0 + bj * HALF; b0 = __builtin_nontemporal_load((const f32x4*)bp); b1 = __builtin_nontemporal_load((const f32x4*)(bp + 4)); }
                        const f32x4 o0 = b0 + gg[bj][0] * acc[ai][bj][m][0], o1 = b1 + gg[bj][1] * acc[ai][bj][m][1];
                        u32x4 w; w.x = cvt_pk_bf16(o0[0], o0[1]); w.y = cvt_pk_bf16(o0[2], o0[3]); w.z = cvt_pk_bf16(o1[0], o1[1]); w.w = cvt_pk_bf16(o1[2], o1[3]);
                        *(u32x4*)(xp + bj * HALF) = w;
                    }
                    if (m & 1) asm volatile("" ::: "memory");
                }
        } else {
#pragma unroll
            for (int ai = 0; ai < 2; ++ai)
#pragma unroll
                for (int m = 0; m < 4; ++m) {
                    const int row = row0 + ai * HALF + m * 16;
                    const float* gp = gate + (size_t)modrow_of(row) * NMOD + col0;
                    bf16_t* op = (bf16_t*)((char*)X + SLAB_MINUS_X) + ((size_t)u.kp * MS + (row - MP)) * DM + col0;
#pragma unroll
                    for (int bj = 0; bj < 2; ++bj) {
                        const f32x4 g0 = (*(const f32x4*)(gp + bj * HALF) + *(const f32x4*)(gp + MODSB_DELTA + bj * HALF)) * coef, g1 = (*(const f32x4*)(gp + bj * HALF + 4) + *(const f32x4*)(gp + MODSB_DELTA + bj * HALF + 4)) * coef;
                        const f32x4 o0 = g0 * acc[ai][bj][m][0], o1 = g1 * acc[ai][bj][m][1];
                        u32x4 w; w.x = cvt_pk_bf16(o0[0], o0[1]); w.y = cvt_pk_bf16(o0[2], o0[3]); w.z = cvt_pk_bf16(o1[0], o1[1]); w.w = cvt_pk_bf16(o1[2], o1[3]);
                        *(u32x4*)(op + bj * HALF) = w;
                    }
                    if (m & 1) asm volatile("" ::: "memory");
                }
        }
    }
};
struct EpiWin {
    static constexpr bool PERM = true, AFTER_DRAIN = false;
    bf16_t* U; bf16_t* QKVG; const float* rot;
    __device__ __forceinline__ void operator()(const f32x4 (&acc)[2][2][4][2], const Unit& u, int wr, int wc, int fr, int fq) const {
        const int row0 = u.pm * BM + wr * 64 + fr, cw = wc * 32 + 8 * fq;
        if (u.pn < 4) {
#pragma unroll
            for (int ai = 0; ai < 2; ++ai)
#pragma unroll
                for (int m = 0; m < 4; ++m) {
                    bf16_t* rowp = U + (size_t)(row0 + ai * HALF + m * 16) * PW + u.pn * BM + cw;
#pragma unroll
                    for (int bj = 0; bj < 2; ++bj) { const f32x4 v0 = acc[ai][bj][m][0], v1 = acc[ai][bj][m][1]; u32x4 w;
                        w.x = cvt_pk_bf16(v0[0], v0[1]); w.y = cvt_pk_bf16(v0[2], v0[3]); w.z = cvt_pk_bf16(v1[0], v1[1]); w.w = cvt_pk_bf16(v1[2], v1[3]);
                        *(u32x4*)(rowp + bj * HALF) = w; }
                }
        } else {
            const int t = (u.pn - 4) >> 2, hd = (u.pn - 4) & 3;
            bf16_t* dst = QKVG + (size_t)t * MTOK * RW + hd * HD + cw;
            if (t < 2) {
                const float sc = (t == 1) ? 0.0625f : 1.0f;
#pragma unroll
                for (int ai = 0; ai < 2; ++ai)
#pragma unroll
                    for (int m = 0; m < 4; ++m) {
                        const int row = row0 + ai * HALF + m * 16;
                        const float* rp = rot + ((size_t)ptab_of(row) * 128 + cw) * 2;
                        u32x4 w1, w2;
#pragma unroll
                        for (int n = 0; n < 2; ++n) {
                            const f32x4 cs0 = *(const f32x4*)(rp + 8 * n), cs1 = *(const f32x4*)(rp + 8 * n + 4);
                            const f32x4 x1 = acc[ai][0][m][n] * sc, x2 = acc[ai][1][m][n] * sc;
                            const float a0 = x1[0] * cs0[0] - x2[0] * cs0[1], b0 = x2[0] * cs0[0] + x1[0] * cs0[1];
                            const float a1 = x1[1] * cs0[2] - x2[1] * cs0[3], b1 = x2[1] * cs0[2] + x1[1] * cs0[3];
                            const float a2 = x1[2] * cs1[0] - x2[2] * cs1[1], b2 = x2[2] * cs1[0] + x1[2] * cs1[1];
                            const float a3 = x1[3] * cs1[2] - x2[3] * cs1[3], b3 = x2[3] * cs1[2] + x1[3] * cs1[3];
                            if (n == 0) { w1.x = cvt_pk_bf16(a0, a1); w1.y = cvt_pk_bf16(a2, a3); w2.x = cvt_pk_bf16(b0, b1); w2.y = cvt_pk_bf16(b2, b3); }
                            else        { w1.z = cvt_pk_bf16(a0, a1); w1.w = cvt_pk_bf16(a2, a3); w2.z = cvt_pk_bf16(b0, b1); w2.w = cvt_pk_bf16(b2, b3); }
                        }
                        bf16_t* rowp = dst + (size_t)row * RW;
                        *(u32x4*)rowp = w1; *(u32x4*)(rowp + HALF) = w2;
                    }
            } else {
#pragma unroll
                for (int ai = 0; ai < 2; ++ai)
#pragma unroll
                    for (int m = 0; m < 4; ++m) {
                        bf16_t* rowp = dst + (size_t)(row0 + ai * HALF + m * 16) * RW;
#pragma unroll
                        for (int bj = 0; bj < 2; ++bj) { const f32x4 v0 = acc[ai][bj][m][0], v1 = acc[ai][bj][m][1]; u32x4 w;
                            w.x = cvt_pk_bf16(v0[0], v0[1]); w.y = cvt_pk_bf16(v0[2], v0[3]); w.z = cvt_pk_bf16(v1[0], v1[1]); w.w = cvt_pk_bf16(v1[2], v1[3]);
                            *(u32x4*)(rowp + bj * HALF) = w; }
                    }
            }
        }
    }
};
struct EpiPool {
    static constexpr bool PERM = true, AFTER_DRAIN = false;
    unsigned char* MIX; const float* pscale;
    __device__ __forceinline__ void operator()(const f32x4 (&acc)[2][2][4][2], const Unit& u, int wr, int wc, int fr, int fq) const {
        const int row0 = u.pm * BM + wr * 64 + fr, col0 = u.pn * BM + wc * 32 + 8 * fq;
#pragma unroll
        for (int ai = 0; ai < 2; ++ai)
#pragma unroll
            for (int m = 0; m < 4; ++m) {
                unsigned char* rowp = MIX + (size_t)(row0 + ai * HALF + m * 16) * DM + col0;
#pragma unroll
                for (int bj = 0; bj < 2; ++bj) { const f32x4 v0 = acc[ai][bj][m][0] * *(const f32x4*)(pscale + col0 + bj * HALF), v1 = acc[ai][bj][m][1] * *(const f32x4*)(pscale + col0 + bj * HALF + 4); u32x2 w;
                    w.x = pk4_fp8(v0[0], v0[1], v0[2], v0[3]); w.y = pk4_fp8(v1[0], v1[1], v1[2], v1[3]);
                    *(u32x2*)(rowp + bj * HALF) = w; }
            }
    }
};

template <class Epi, class Sched, bool ALIGN_EPI = false>
__device__ __forceinline__ void gemm_phase(PG8_LAS unsigned char* lds, const Gemm g, const Sched& S, const Epi& E) {
    const int tid = threadIdx.x, wid = __builtin_amdgcn_readfirstlane(tid >> 6), lane = tid & 63, wr = wid >> 2, wc = wid & 3, fr = lane & 15, fq = lane >> 4;
    unsigned voffA[2], voffB[2];
#pragma unroll
    for (int i = 0; i < 2; ++i) { int R, C; stage_rc(tid * 16 + i * 8192, R, C); const int Rb = Epi::PERM ? ((R & ~31) + perm32(R & 31)) : R;
        voffA[i] = (unsigned)(R * g.lda + C) * 2u; voffB[i] = (unsigned)(Rb * g.ldb + C) * 2u; }
    const size_t kstep = (size_t)(BK * 2);
    const size_t hstepA = (size_t)HALF * g.lda * 2, hstepB = (size_t)HALF * g.ldb * 2;
    const size_t tstepA = 2 * hstepA, tstepB = 2 * hstepB;
    const size_t astep = (size_t)g.acol * 2;
    const unsigned ldsw = (unsigned)wid * 1024u;
    const int aoff = lds_byte(wr * 64 + fr, fq * 8), boff = lds_byte(wc * 32 + fr, fq * 8);
#define PG8_SA(b, h) (((b) * 2 + (h)) * HTB)
#define PG8_SB(b, h) ((4 + (b) * 2 + (h)) * HTB)
#define PG8_STAGE(bufoff, gbase, voff) do { _Pragma("unroll") for (int _i = 0; _i < 2; ++_i) \
        __builtin_amdgcn_global_load_lds((const unsigned*)((const char*)(gbase) + (voff)[_i]), (PG8_LAS unsigned*)(lds + (bufoff) + ldsw + _i * 8192), 16, 0, 0); } while (0)
#define PG8_LDA(dst, b, h) do { _Pragma("unroll") for (int m = 0; m < 4; ++m) _Pragma("unroll") for (int k = 0; k < 2; ++k) dst[m][k] = *(const PG8_LAS bf16x8*)(lds + PG8_SA(b, h) + aoff + m * 2048 + k * 1024); } while (0)
#define PG8_LDB(dst, b, h) do { _Pragma("unroll") for (int n = 0; n < 2; ++n) _Pragma("unroll") for (int k = 0; k < 2; ++k) dst[n][k] = *(const PG8_LAS bf16x8*)(lds + PG8_SB(b, h) + boff + n * 2048 + k * 1024); } while (0)
#define PG8_MMA(ai, bj, At, Bt) do { __builtin_amdgcn_s_setprio(1); _Pragma("unroll") for (int m = 0; m < 4; ++m) _Pragma("unroll") for (int n = 0; n < 2; ++n) _Pragma("unroll") for (int k = 0; k < 2; ++k) \
        acc[ai][bj][m][n] = __builtin_amdgcn_mfma_f32_16x16x32_bf16(Bt[n][k], At[m][k], acc[ai][bj][m][n], 0, 0, 0); __builtin_amdgcn_s_setprio(0); } while (0)
#define PG8_WAIT_V(n) asm volatile("s_waitcnt vmcnt(" #n ")" ::: "memory")
#define PG8_WAIT_L(n) asm volatile("s_waitcnt lgkmcnt(" #n ")" ::: "memory")
#define PG8_BAR __builtin_amdgcn_s_barrier()
#define PG8_SCHED __builtin_amdgcn_sched_barrier(0)
    Unit cur, nxt; int ui = 0;
    if (!S.next(0, cur)) return;
    f32x4 acc[2][2][4][2];
#pragma unroll
    for (int a = 0; a < 2; ++a)
#pragma unroll
        for (int b = 0; b < 2; ++b)
#pragma unroll
            for (int m = 0; m < 4; ++m)
#pragma unroll
                for (int n = 0; n < 2; ++n) acc[a][b][m][n] = (f32x4){0.f, 0.f, 0.f, 0.f};
    bf16x8 At[4][2], B0[2][2], B1[2][2];
    const char* cA = (const char*)g.A + (size_t)cur.pm * tstepA + (size_t)cur.pn * astep + (cur.kp > 0 ? (size_t)cur.kp * g.kpiece * 2 : 0); const char* cB = (const char*)g.Bt + (size_t)cur.pn * tstepB + (cur.kp > 0 ? (size_t)cur.kp * g.kpiece * 2 : 0);
    S.a_ready(cur);
    PG8_STAGE(PG8_SB(0, 0), cB, voffB); PG8_STAGE(PG8_SB(0, 1), cB + hstepB, voffB); PG8_STAGE(PG8_SA(0, 0), cA, voffA); PG8_STAGE(PG8_SA(0, 1), cA + hstepA, voffA);
    if (wr == 1) PG8_BAR;
    PG8_WAIT_V(2); PG8_BAR;
    PG8_STAGE(PG8_SB(1, 0), cB + kstep, voffB); PG8_STAGE(PG8_SA(1, 0), cA + kstep, voffA); PG8_STAGE(PG8_SB(1, 1), cB + hstepB + kstep, voffB);
    PG8_WAIT_V(6); PG8_BAR;
    for (;;) {
        const bool has_next = S.next(ui + 1, nxt);
        const size_t nko = (has_next && nxt.kp > 0) ? (size_t)nxt.kp * g.kpiece * 2 : 0;
        const char* nA = has_next ? (const char*)g.A + (size_t)nxt.pm * tstepA + (size_t)nxt.pn * astep + nko : cA; const char* nB = has_next ? (const char*)g.Bt + (size_t)nxt.pn * tstepB + nko : cB;
        const int nt = (cur.kp < 0 ? g.K : g.kpiece) / BK;
        for (int t = 0; t < nt; t += 2) {
            const bool last = (t == nt - 2);
            const char* a1 = cA + (size_t)(t + 1) * kstep;
            const char* a2 = last ? nA : cA + (size_t)(t + 2) * kstep; const char* b2 = last ? nB : cB + (size_t)(t + 2) * kstep;
            const char* a3 = a2 + kstep; const char* b3 = b2 + kstep;
            if (last && has_next) S.a_ready(nxt);
            PG8_LDB(B0, 0, 0); PG8_LDB(B1, 0, 1); PG8_SCHED; PG8_LDA(At, 0, 0); PG8_STAGE(PG8_SA(1, 1), a1 + hstepA, voffA);
            PG8_WAIT_V(8); PG8_WAIT_L(0); PG8_BAR; PG8_MMA(0, 0, At, B0); PG8_MMA(0, 1, At, B1); PG8_BAR; PG8_SCHED;
            PG8_LDA(At, 0, 1); PG8_STAGE(PG8_SB(0, 0), b2, voffB); PG8_STAGE(PG8_SB(0, 1), b2 + hstepB, voffB); PG8_STAGE(PG8_SA(0, 0), a2, voffA);
            PG8_WAIT_V(8); PG8_WAIT_L(0); PG8_BAR; PG8_MMA(1, 0, At, B0); PG8_MMA(1, 1, At, B1); PG8_BAR; PG8_SCHED;
            PG8_LDB(B0, 1, 0); PG8_LDB(B1, 1, 1); PG8_SCHED; PG8_LDA(At, 1, 0); PG8_STAGE(PG8_SA(0, 1), a2 + hstepA, voffA);
            PG8_WAIT_V(8); PG8_WAIT_L(0); PG8_BAR; PG8_MMA(0, 0, At, B0); PG8_MMA(0, 1, At, B1); PG8_BAR; PG8_SCHED;
            PG8_LDA(At, 1, 1); PG8_STAGE(PG8_SB(1, 0), b3, voffB); PG8_STAGE(PG8_SB(1, 1), b3 + hstepB, voffB); PG8_STAGE(PG8_SA(1, 0), a3, voffA);
            PG8_WAIT_V(8); PG8_WAIT_L(0); PG8_BAR; PG8_MMA(1, 0, At, B0); PG8_MMA(1, 1, At, B1); PG8_BAR; PG8_SCHED;
        }
        if constexpr (ALIGN_EPI) { if (wr == 0) PG8_BAR; }
        E(acc, cur, wr, wc, fr, fq); S.done(cur);
        if (!has_next) break;
#pragma unroll
        for (int a = 0; a < 2; ++a)
#pragma unroll
            for (int b = 0; b < 2; ++b)
#pragma unroll
                for (int m = 0; m < 4; ++m)
#pragma unroll
                    for (int n = 0; n < 2; ++n) acc[a][b][m][n] = (f32x4){0.f, 0.f, 0.f, 0.f};
        cur = nxt; cA = nA; cB = nB; ++ui;
        if constexpr (ALIGN_EPI) { if (wr == 1) PG8_BAR; }
    }
    PG8_WAIT_V(0);
    if constexpr (!ALIGN_EPI) { if (wr == 0) PG8_BAR; }
    PG8_BAR;
#undef PG8_SA
#undef PG8_SB
#undef PG8_STAGE
#undef PG8_LDA
#undef PG8_LDB
#undef PG8_MMA
#undef PG8_WAIT_V
#undef PG8_WAIT_L
#undef PG8_BAR
#undef PG8_SCHED
}
__host__ __device__ __forceinline__ int lds_byte8(int r, int cb) { return (r >> 4) * 2048 + (((cb >> 6) * 16 + (r & 15)) * 64) + ((((cb >> 4) & 3) ^ ((r >> 3) & 1)) * 16); }
__host__ __device__ __forceinline__ void stage_rc8(int b, int& R, int& C) { const int g = b >> 11, u = (b >> 6) & 31, h = u >> 4, r = u & 15, q = ((b >> 4) & 3) ^ ((r >> 3) & 1); R = 16 * g + r; C = h * 64 + q * 16; }
typedef int v8i __attribute__((ext_vector_type(8)));
__device__ __forceinline__ v8i cat8(bf16x8 lo, bf16x8 hi) { typedef int v4i __attribute__((ext_vector_type(4))); const v4i a = __builtin_bit_cast(v4i, lo), b = __builtin_bit_cast(v4i, hi); return (v8i){a[0], a[1], a[2], a[3], b[0], b[1], b[2], b[3]}; }
template <class Epi, class Sched, bool ALIGN_EPI = false>
__device__ __forceinline__ void gemm_phase8(PG8_LAS unsigned char* lds, const Gemm g, const Sched& S, const Epi& E) {
    const int tid = threadIdx.x, wid = __builtin_amdgcn_readfirstlane(tid >> 6), lane = tid & 63, wr = wid >> 2, wc = wid & 3, fr = lane & 15, fq = lane >> 4;
    unsigned voffA[2], voffB[2];
#pragma unroll
    for (int i = 0; i < 2; ++i) { int R, C; stage_rc8(tid * 16 + i * 8192, R, C); const int Rb = Epi::PERM ? ((R & ~31) + perm32(R & 31)) : R;
        voffA[i] = (unsigned)(R * g.lda + C); voffB[i] = (unsigned)(Rb * g.ldb + C); }
    const size_t kstep = (size_t)128;
    const size_t hstepA = (size_t)HALF * g.lda, hstepB = (size_t)HALF * g.ldb;
    const size_t tstepA = 2 * hstepA, tstepB = 2 * hstepB;
    const size_t astep = (size_t)g.acol;
    const unsigned ldsw = (unsigned)wid * 1024u;
    const int aoff = lds_byte8(wr * 64 + fr, fq * 32), boff = lds_byte8(wc * 32 + fr, fq * 32);
#define PG8_SA(b, h) (((b) * 2 + (h)) * HTB)
#define PG8_SB(b, h) ((4 + (b) * 2 + (h)) * HTB)
#define PG8_STAGE(bufoff, gbase, voff) do { _Pragma("unroll") for (int _i = 0; _i < 2; ++_i) \
        __builtin_amdgcn_global_load_lds((const unsigned*)((const char*)(gbase) + (voff)[_i]), (PG8_LAS unsigned*)(lds + (bufoff) + ldsw + _i * 8192), 16, 0, 0); } while (0)
#define PG8_LDA(dst, b, h) do { _Pragma("unroll") for (int m = 0; m < 4; ++m) dst[m] = cat8(*(const PG8_LAS bf16x8*)(lds + PG8_SA(b, h) + aoff + m * 2048), *(const PG8_LAS bf16x8*)(lds + PG8_SA(b, h) + (aoff ^ 16) + m * 2048)); } while (0)
#define PG8_LDB(dst, b, h) do { _Pragma("unroll") for (int n = 0; n < 2; ++n) dst[n] = cat8(*(const PG8_LAS bf16x8*)(lds + PG8_SB(b, h) + boff + n * 2048), *(const PG8_LAS bf16x8*)(lds + PG8_SB(b, h) + (boff ^ 16) + n * 2048)); } while (0)
#define PG8_MMA(ai, bj, At, Bt) do { __builtin_amdgcn_s_setprio(1); _Pragma("unroll") for (int m = 0; m < 4; ++m) _Pragma("unroll") for (int n = 0; n < 2; ++n) \
        asm volatile("v_mfma_scale_f32_16x16x128_f8f6f4 %0, %1, %2, %0, %3, %4 op_sel_hi:[0,0,0]" : "+v"(acc[ai][bj][m][n]) : "v"(Bt[n]), "v"(At[m]), "v"(wsc), "v"(asc)); __builtin_amdgcn_s_setprio(0); } while (0)
#define PG8_WAIT_V(n) asm volatile("s_waitcnt vmcnt(" #n ")" ::: "memory")
#define PG8_WAIT_L(n) asm volatile("s_waitcnt lgkmcnt(" #n ")" ::: "memory")
#define PG8_BAR __builtin_amdgcn_s_barrier()
#define PG8_SCHED __builtin_amdgcn_sched_barrier(0)
    Unit cur, nxt; int ui = 0;
    if (!S.next(0, cur)) return;
    f32x4 acc[2][2][4][2];
#pragma unroll
    for (int a = 0; a < 2; ++a)
#pragma unroll
        for (int b = 0; b < 2; ++b)
#pragma unroll
            for (int m = 0; m < 4; ++m)
#pragma unroll
                for (int n = 0; n < 2; ++n) acc[a][b][m][n] = (f32x4){0.f, 0.f, 0.f, 0.f};
    v8i At[4], B0[2], B1[2];
    int wsc = g.wscale, asc = 0x7f7f7f7f;
    asm volatile("" : "+v"(wsc), "+v"(asc));
    const char* cA = (const char*)g.A + (size_t)cur.pm * tstepA + (size_t)cur.pn * astep + (cur.kp > 0 ? (size_t)cur.kp * g.kpiece : 0); const char* cB = (const char*)g.Bt + (size_t)cur.pn * tstepB + (cur.kp > 0 ? (size_t)cur.kp * g.kpiece : 0);
    S.a_ready(cur);
    PG8_STAGE(PG8_SB(0, 0), cB, voffB); PG8_STAGE(PG8_SB(0, 1), cB + hstepB, voffB); PG8_STAGE(PG8_SA(0, 0), cA, voffA); PG8_STAGE(PG8_SA(0, 1), cA + hstepA, voffA);
    if (wr == 1) PG8_BAR;
    PG8_WAIT_V(2); PG8_BAR;
    PG8_STAGE(PG8_SB(1, 0), cB + kstep, voffB); PG8_STAGE(PG8_SA(1, 0), cA + kstep, voffA); PG8_STAGE(PG8_SB(1, 1), cB + hstepB + kstep, voffB);
    PG8_WAIT_V(6); PG8_BAR;
    for (;;) {
        const bool has_next = S.next(ui + 1, nxt);
        const size_t nko = (has_next && nxt.kp > 0) ? (size_t)nxt.kp * g.kpiece : 0;
        const char* nA = has_next ? (const char*)g.A + (size_t)nxt.pm * tstepA + (size_t)nxt.pn * astep + nko : cA; const char* nB = has_next ? (const char*)g.Bt + (size_t)nxt.pn * tstepB + nko : cB;
        const int nt = (cur.kp < 0 ? g.K : g.kpiece) / 128;
        for (int t = 0; t < nt; t += 2) {
            const bool last = (t == nt - 2);
            const char* a1 = cA + (size_t)(t + 1) * kstep;
            const char* a2 = last ? nA : cA + (size_t)(t + 2) * kstep; const char* b2 = last ? nB : cB + (size_t)(t + 2) * kstep;
            const char* a3 = a2 + kstep; const char* b3 = b2 + kstep;
            if (last && has_next) S.a_ready(nxt);
            PG8_LDB(B0, 0, 0); PG8_LDB(B1, 0, 1); PG8_SCHED; PG8_LDA(At, 0, 0); PG8_STAGE(PG8_SA(1, 1), a1 + hstepA, voffA);
            PG8_WAIT_V(8); PG8_WAIT_L(0); PG8_BAR; PG8_MMA(0, 0, At, B0); PG8_MMA(0, 1, At, B1); PG8_BAR; PG8_SCHED;
            PG8_LDA(At, 0, 1); PG8_STAGE(PG8_SB(0, 0), b2, voffB); PG8_STAGE(PG8_SB(0, 1), b2 + hstepB, voffB); PG8_STAGE(PG8_SA(0, 0), a2, voffA);
            PG8_WAIT_V(8); PG8_WAIT_L(0); PG8_BAR; PG8_MMA(1, 0, At, B0); PG8_MMA(1, 1, At, B1); PG8_BAR; PG8_SCHED;
            PG8_LDB(B0, 1, 0); PG8_LDB(B1, 1, 1); PG8_SCHED; PG8_LDA(At, 1, 0); PG8_STAGE(PG8_SA(0, 1), a2 + hstepA, voffA);
            PG8_WAIT_V(8); PG8_WAIT_L(0); PG8_BAR; PG8_MMA(0, 0, At, B0); PG8_MMA(0, 1, At, B1); PG8_BAR; PG8_SCHED;
            PG8_LDA(At, 1, 1); PG8_STAGE(PG8_SB(1, 0), b3, voffB); PG8_STAGE(PG8_SB(1, 1), b3 + hstepB, voffB); PG8_STAGE(PG8_SA(1, 0), a3, voffA);
            PG8_WAIT_V(8); PG8_WAIT_L(0); PG8_BAR; PG8_MMA(1, 0, At, B0); PG8_MMA(1, 1, At, B1); PG8_BAR; PG8_SCHED;
        }
        if constexpr (ALIGN_EPI) { if (wr == 0) PG8_BAR; }
        asm volatile("s_nop 15\n\ts_nop 15" ::: "memory");
        E(acc, cur, wr, wc, fr, fq); S.done(cur);
        if (!has_next) break;
#pragma unroll
        for (int a = 0; a < 2; ++a)
#pragma unroll
            for (int b = 0; b < 2; ++b)
#pragma unroll
                for (int m = 0; m < 4; ++m)
#pragma unroll
                    for (int n = 0; n < 2; ++n) acc[a][b][m][n] = (f32x4){0.f, 0.f, 0.f, 0.f};
        cur = nxt; cA = nA; cB = nB; ++ui;
        if constexpr (ALIGN_EPI) { if (wr == 1) PG8_BAR; }
    }
    PG8_WAIT_V(0);
    if constexpr (!ALIGN_EPI) { if (wr == 0) PG8_BAR; }
    PG8_BAR;
#undef PG8_SA
#undef PG8_SB
#undef PG8_STAGE
#undef PG8_LDA
#undef PG8_LDB
#undef PG8_MMA
#undef PG8_WAIT_V
#undef PG8_WAIT_L
#undef PG8_BAR
#undef PG8_SCHED
}
}

constexpr int NWAVES = 8;
constexpr int N_PHASES = 15;
constexpr size_t MiB = 1u << 20;
constexpr size_t WS_CTL = 0, CTL_ZERO_BYTES = 64 * 1024;
constexpr size_t WS_SC = 1 * MiB;
constexpr size_t WS_ROT = 2 * MiB;
constexpr size_t WS_MODS = 5 * MiB;
constexpr size_t WS_WPOOL = 15 * MiB;
constexpr size_t WS_WOUT = 16 * MiB;
constexpr size_t WS_WIN = 24 * MiB;
constexpr size_t WS_W1 = 44 * MiB;
constexpr size_t WS_W1D = 88 * MiB;
constexpr size_t WS_W2 = 110 * MiB;
constexpr size_t WS_W2D = 154 * MiB;
constexpr size_t WS_H = 176 * MiB;
constexpr size_t WS_X = 210 * MiB;
constexpr size_t WS_ACT = 278 * MiB;
constexpr size_t WS_QKVG = WS_ACT;
constexpr size_t WS_PM = WS_ACT + 68 * MiB;
constexpr size_t WS_U = 372 * MiB;
constexpr size_t WS_MIX = 406 * MiB;
constexpr size_t WS_UT = 440 * MiB;
constexpr size_t WS_OI = 504 * MiB;
constexpr size_t WS_ST = 536 * MiB;
constexpr size_t WS_SLAB = 568 * MiB;
constexpr size_t WS_MODSB = 612 * MiB;
constexpr size_t WS_END = 622 * MiB;
static_assert((WS_MODSB - WS_MODS) / 4 == MODSB_DELTA, "mods slab offset");
static_assert(WS_SLAB - WS_X == SLAB_MINUS_X, "slab offset");
constexpr int KP_DOWN = 512, KP_OUT = 512;
constexpr float WMUL_UP = 32.0f, WMUL_DOWN = 64.0f; constexpr int WSC_UP = 0x7a7a7a7a, WSC_DOWN = 0x79797979;
static_assert(WS_SC + 160 * 2048 * 2 <= WS_ROT && WS_ROT + (size_t)NPOS * 128 * 8 <= WS_MODS && WS_MODS + (size_t)NMODROW * NMOD * 4 <= WS_WPOOL, "ws map 1");
static_assert(WS_W1 + (size_t)2 * DFF * DM * 2 <= WS_W1D && WS_W1D + (size_t)DM * DFF * 2 <= WS_W2 && WS_W2D + (size_t)DM * DFF * 2 <= WS_H, "ws map 2");
static_assert(WS_H + (size_t)MTOK * DM * 2 <= WS_X && WS_X + (size_t)MTOK * DM * 4 <= WS_ACT && WS_ACT + (size_t)MTOK * DFF * 2 <= WS_U, "ws map 3");
static_assert(WS_PM + (size_t)MTOK * PW * 2 <= WS_U && WS_U + (size_t)MTOK * PW * 4 <= WS_MIX && WS_MIX + (size_t)MTOK * DM * 2 <= WS_UT, "ws map 4");
constexpr int CW_BAR = 1024;

constexpr int RING_BYTES = 131072;
constexpr int LDSCTL_OFF = 136 * 1024, MISC_OFF = LDSCTL_OFF + 320;
constexpr int LDS_BYTES = 147456;

#define GAS __attribute__((address_space(1)))
#define LAS __attribute__((address_space(3)))
typedef unsigned short bf16;
typedef unsigned v4u __attribute__((ext_vector_type(4)));
typedef unsigned v2u __attribute__((ext_vector_type(2)));
typedef float f32x4 __attribute__((ext_vector_type(4)));
typedef float f32x16 __attribute__((ext_vector_type(16)));
typedef short bf16x8 __attribute__((ext_vector_type(8)));
typedef short bf16x4 __attribute__((ext_vector_type(4)));
typedef GAS unsigned gu32;
#define RLX_AGENT __ATOMIC_RELAXED, __HIP_MEMORY_SCOPE_AGENT
#define LDS_WAIT() asm volatile("s_waitcnt lgkmcnt(0)" ::: "memory")
#define VM_WAIT() asm volatile("s_waitcnt vmcnt(0)" ::: "memory")
__device__ __forceinline__ unsigned f2bf(float f) { unsigned u = __builtin_bit_cast(unsigned, f); return (u + 0x7fffu + ((u >> 16) & 1u)) >> 16; }
__device__ __forceinline__ unsigned pk2(float lo, float hi) { return f2bf(lo) | (f2bf(hi) << 16); }
__device__ __forceinline__ float bf2f(unsigned short v) { return __builtin_bit_cast(float, (unsigned)v << 16); }
__device__ __forceinline__ float silu1(float x) { return x / (1.0f + __expf(-x)); }

#define XB_TMO      128
#define XB_XCNT(j)  (256  + 64 * (j))
#define XB_XSUB(j)  (1280 + 64 * (j))
#define XB_XGEN(j)  (2304 + 64 * (j))
#define XB_TOP      3328
#define XB_TOPGEN   3392
#define XCD_BAR_WORDS 3456
#define XB_SPIN_CAP (1u << 20)
static_assert((CW_BAR + 2 * XCD_BAR_WORDS) * 4 <= (int)CTL_ZERO_BYTES, "barrier words inside the memset region");

__device__ __forceinline__ unsigned xb_ld(unsigned* p)              { return __hip_atomic_load(p, __ATOMIC_RELAXED, __HIP_MEMORY_SCOPE_AGENT); }
__device__ __forceinline__ unsigned xb_add(unsigned* p, unsigned v) { return __hip_atomic_fetch_add(p, v, __ATOMIC_RELAXED, __HIP_MEMORY_SCOPE_AGENT); }
__device__ __forceinline__ unsigned xb_xcc_id() { return (unsigned)__builtin_amdgcn_s_getreg((3 << 11) | 20) & 0xFu; }
#define XB_SPIN(cond, bar) do { unsigned _sp = 0; while (cond) { __builtin_amdgcn_s_sleep(1); \
    if ((++_sp & 255u) == 0u) { if (xb_ld(&(bar)[XB_TMO])) break; if (_sp > XB_SPIN_CAP) { atomicAdd(&(bar)[XB_TMO], 1u); break; } } } } while (0)

struct XcdBarrier { unsigned* bar; unsigned x; volatile LAS unsigned* st; };
__device__ __forceinline__ XcdBarrier xcd_barrier_post(unsigned* bar, volatile LAS unsigned* st) {
    XcdBarrier b; b.bar = bar; b.x = xb_xcc_id(); b.st = st;
    if (threadIdx.x == 0) (void)xb_add(&bar[XB_XCNT(b.x)], 1u);
    return b;
}
__device__ __forceinline__ void xcd_barrier_complete(unsigned* bar, unsigned x, unsigned& nloc, unsigned& nx) {
    const unsigned G = gridDim.x * gridDim.y * gridDim.z;
    unsigned sum, cnt, mine, sp = 0u;
    for (;;) {
        sum = 0u; cnt = 0u; mine = 0u;
#pragma unroll
        for (unsigned j = 0; j < 16; ++j) { const unsigned c = xb_ld(&bar[XB_XCNT(j)]); sum += c; cnt += (c > 0u) ? 1u : 0u; mine = (j == x) ? c : mine; }
        if (sum == G) break;
        __builtin_amdgcn_s_sleep(1);
        if ((++sp & 255u) == 0u) { if (xb_ld(&bar[XB_TMO])) break; if (sp > XB_SPIN_CAP) { atomicAdd(&bar[XB_TMO], 1u); break; } }
    }
    nloc = mine > 0u ? mine : 1u; nx = cnt > 0u ? cnt : 1u;
}
__device__ __forceinline__ void xcd_barrier(const XcdBarrier& b) {
    asm volatile("s_waitcnt vmcnt(0)" ::: "memory");
    __syncthreads();
    if (threadIdx.x == 0) {
        unsigned* bar = b.bar;
        __builtin_amdgcn_s_waitcnt(0);
        unsigned nloc = b.st[0], nx = b.st[1];
        if (nloc == 0u) { xcd_barrier_complete(bar, b.x, nloc, nx); b.st[0] = nloc; b.st[1] = nx; }
        const unsigned old = xb_add(&bar[XB_XSUB(b.x)], 1u);
        const unsigned gen = old / nloc;
        if (old + 1u == (gen + 1u) * nloc) {
            __builtin_amdgcn_fence(__ATOMIC_RELEASE, "agent");
            asm volatile("s_waitcnt vmcnt(0)" ::: "memory");
            const unsigned og = xb_add(&bar[XB_TOP], 1u);
            const unsigned tg = og / nx;
            if (og + 1u == (tg + 1u) * nx) xb_add(&bar[XB_TOPGEN], 1u);
            else XB_SPIN(xb_ld(&bar[XB_TOPGEN]) == tg, bar);
            __builtin_amdgcn_fence(__ATOMIC_ACQUIRE, "agent");
            xb_add(&bar[XB_XGEN(b.x)], 1u);
            asm volatile("s_waitcnt vmcnt(0)" ::: "memory");
        } else {
            XB_SPIN(xb_ld(&bar[XB_XGEN(b.x)]) == gen, bar);
            __builtin_amdgcn_fence(__ATOMIC_ACQUIRE, "agent");
            asm volatile("s_waitcnt vmcnt(0)" ::: "memory");
        }
    }
    __syncthreads();
}

struct Args { const float* in[22]; float* out; unsigned char* ws; int ph_lo, ph_hi, bar_region, pad; };
static_assert(sizeof(Args) == 22 * 8 + 8 + 8 + 16, "Args has no padding");
#define INP(i) (A.in[i])
struct Frame {
    LAS unsigned char* lds;
    volatile LAS unsigned* MISC;
    int tid, lane, wave;
    int vcu, G;
    unsigned char* ws;
    float* out;
};
#define WSP(T, off) ((T*)(F.ws + (off)))
__device__ __forceinline__ int relaunder(Frame& F) { int t2 = threadIdx.x; asm volatile("" : "+v"(t2)); F.tid = t2; unsigned char* w = F.ws; asm volatile("" : "+s"(w)); F.ws = w; float* o = F.out; asm volatile("" : "+s"(o)); F.out = o; return 0; }
__device__ __forceinline__ int lane_of(const Frame& F) { int l = F.tid & 63; asm volatile("" : "+v"(l)); return l; }

__device__ __forceinline__ float wave_sum(float v) {
#pragma unroll
    for (int o = 1; o < 64; o <<= 1) v += __shfl_xor(v, o);
    return v;
}

constexpr int TPITCH = 260;
constexpr int TILE_BYTES = 64 * TPITCH * 4;
static_assert(2 * TILE_BYTES <= LDSCTL_OFF && MISC_OFF + 128 <= LDS_BYTES, "LDS map");
constexpr int P0_NA = 3 * ((DM / 64) * (DFF / 256)) + (DM / 64) * (INC / 256) + (DM / 64) * (DM / 256);
constexpr int P0_NB = 3 * ((DM / 64) * (DFF / 256));
constexpr int P0_NP = 4 * ((HD / 64) * (HD / 256));
static_assert((DFF / 64) * (DM / 256) == (DM / 64) * (DFF / 256), "down and gate/up have the same item count");
constexpr int CW_QUEUE = 64;
struct P0Item { const float* src; unsigned char* dst; int N, ldkb, f8; float mul; };
__device__ __forceinline__ void p0_decode(const Args& A, unsigned char* ws, int it, int w, P0Item& d) {
    constexpr int B_F = (DM / 64) * (DFF / 256), B_D = (DFF / 64) * (DM / 256), B_IN = (DM / 64) * (INC / 256), B_OUT = (DM / 64) * (DM / 256), B_P = (HD / 64) * (HD / 256);
    int r = it; const float* W; int K, Nn, mode = 0, f8 = 1; unsigned char* WT; float mul = WMUL_UP;
    if (r < B_F) { W = INP(9); K = DM; Nn = DFF; WT = ws + WS_W1; mode = 1; }
    else if ((r -= B_F) < B_F) { W = INP(10); K = DM; Nn = DFF; WT = ws + WS_W1; mode = 2; }
    else if ((r -= B_F) < B_D) { W = INP(11); K = DFF; Nn = DM; WT = ws + WS_W1D; mul = WMUL_DOWN; }
    else if ((r -= B_D) < B_IN) { W = INP(13); K = DM; Nn = INC; WT = ws + WS_WIN; f8 = 0; mul = 1.0f; }
    else if ((r -= B_IN) < B_OUT) { W = INP(16); K = DM; Nn = DM; WT = ws + WS_WOUT; }
    else if ((r -= B_OUT) < B_F) { W = INP(18); K = DM; Nn = DFF; WT = ws + WS_W2; mode = 1; }
    else if ((r -= B_F) < B_F) { W = INP(19); K = DM; Nn = DFF; WT = ws + WS_W2; mode = 2; }
    else if ((r -= B_F) < B_D) { W = INP(20); K = DFF; Nn = DM; WT = ws + WS_W2D; mul = WMUL_DOWN; }
    else { r -= B_D; const int g = r / B_P; r -= g * B_P; W = INP(14) + (size_t)g * HD * HD; K = HD; Nn = HD; WT = ws + WS_WPOOL + (size_t)g * HD * HD * 2; f8 = 0; mul = 1.0f; }
    const int nkb = K / 64, ng = r / nkb, kb = r - ng * nkb, k0 = 64 * kb, n0 = 256 * ng + 32 * w;
    const int drow = (mode == 0) ? n0 : (256 * (n0 >> 7) + (n0 & 127) + (mode == 2 ? 128 : 0));
    d.src = W + (size_t)k0 * Nn + 256 * ng; d.N = Nn; d.f8 = f8; d.mul = mul;
    d.ldkb = f8 ? K : 2 * K; d.dst = WT + (size_t)drow * d.ldkb + (f8 ? k0 : 2 * k0);
}
__device__ __forceinline__ void tile_load(const float* src, int N, f32x4 (&t)[8], int w, int lane) {
#pragma unroll
    for (int i = 0; i < 8; ++i) t[i] = __builtin_nontemporal_load((const f32x4*)(src + (size_t)(8 * w + i) * N + 4 * lane));
}
__device__ __forceinline__ void tile_store(LAS float* buf, const f32x4 (&t)[8], float mul, int w, int lane) {
#pragma unroll
    for (int i = 0; i < 8; ++i) *(LAS f32x4*)(buf + (8 * w + i) * TPITCH + 4 * lane) = t[i] * mul;
}
__device__ __forceinline__ void p0_convert(const P0Item& d, const LAS float* buf, int w, int lane, bool NT) {
    if (d.f8) {
        const int c = lane & 3;
#pragma unroll
        for (int j = 0; j < 2; ++j) { const int n = (lane >> 2) + 16 * j; const LAS float* s = buf + (16 * c) * TPITCH + 32 * w + n;
            v4u o; o.x = pg8::pk4_fp8(s[0 * TPITCH], s[1 * TPITCH], s[2 * TPITCH], s[3 * TPITCH]); o.y = pg8::pk4_fp8(s[4 * TPITCH], s[5 * TPITCH], s[6 * TPITCH], s[7 * TPITCH]);
            o.z = pg8::pk4_fp8(s[8 * TPITCH], s[9 * TPITCH], s[10 * TPITCH], s[11 * TPITCH]); o.w = pg8::pk4_fp8(s[12 * TPITCH], s[13 * TPITCH], s[14 * TPITCH], s[15 * TPITCH]);
            if (NT) __builtin_nontemporal_store(o, (v4u*)(d.dst + (size_t)n * d.ldkb + 16 * c)); else *(GAS v4u*)(d.dst + (size_t)n * d.ldkb + 16 * c) = o; }
    } else {
        const int c = lane & 7;
#pragma unroll
        for (int j = 0; j < 4; ++j) { const int n = (lane >> 3) + 8 * j; const LAS float* s = buf + (8 * c) * TPITCH + 32 * w + n;
            v4u o; o.x = pk2(s[0 * TPITCH], s[1 * TPITCH]); o.y = pk2(s[2 * TPITCH], s[3 * TPITCH]); o.z = pk2(s[4 * TPITCH], s[5 * TPITCH]); o.w = pk2(s[6 * TPITCH], s[7 * TPITCH]);
            if (NT) __builtin_nontemporal_store(o, (v4u*)(d.dst + (size_t)n * d.ldkb + 16 * c)); else *(GAS v4u*)(d.dst + (size_t)n * d.ldkb + 16 * c) = o; }
    }
}
__device__ __forceinline__ void p0_prologue(Frame& F, const Args& A) {
    const int flane = lane_of(F);
    const int w = F.wave;
    const int gt = F.vcu * (NWAVES * 64) + F.tid, NT = F.G * NWAVES * 64;
    for (int i = gt; i < 160 * DM / 4; i += NT) {
        const int m = (4 * i) / DM, k = (4 * i) % DM;
        f32x4 v = (f32x4){0.f, 0.f, 0.f, 0.f};
        if (m < NB) v = *(const f32x4*)(INP(2) + (size_t)m * DM + k); else if (m < NMODROW) v = *(const f32x4*)(INP(3) + (size_t)(m - NB) * DM + k);
        v2u o; o.x = pk2(silu1(v[0]), silu1(v[1])); o.y = pk2(silu1(v[2]), silu1(v[3]));
        *(GAS v2u*)(WSP(bf16, WS_SC) + ((size_t)(((k >> 4) * 5 + (m >> 5)) * 64 + ((k >> 3) & 1) * 32 + (m & 31)) * 8 + (k & 7))) = o;
    }
    for (int i = gt; i < NPOS * 128; i += NT) {
        const int p = i >> 7, fi = i & 127;
        const float pos = (float)(p < SEQ ? p : PAST + (p - SEQ));
        const float inv = (float)exp(-(double)fi * (9.210340371976184 / 128.0));
        const float ang = pos * inv;
        double s, c; sincos((double)ang, &s, &c);
        WSP(float, WS_ROT)[2 * (size_t)i] = (float)c; WSP(float, WS_ROT)[2 * (size_t)i + 1] = (float)s;
    }
}

__device__ __forceinline__ void p1_adaln(Frame& F, const Args& A) {
    const int flane = lane_of(F);
    LAS float* red = (LAS float*)F.lds;
    const int lane = flane, w = F.wave, r = lane & 31, hh = lane >> 5;
    for (int u = F.vcu; u < 2 * (NMOD / 256); u += F.G) {
        const int cg = u >> 1, kh = u & 1, n0 = (8 * cg + w) * 32;
        f32x16 acc[5];
#pragma unroll
        for (int t = 0; t < 5; ++t)
#pragma unroll
            for (int i = 0; i < 16; ++i) acc[t][i] = 0.f;
        const float* Wp = INP(6) + (size_t)(1024 * kh + 8 * hh) * NMOD + n0 + r;
        const bf16* Sp = WSP(bf16, WS_SC) + ((size_t)(64 * kh) * 5 * 64 + lane) * 8;
#pragma unroll 4
        for (int s = 0; s < 64; ++s) {
            float wv[8];
#pragma unroll
            for (int j = 0; j < 8; ++j) wv[j] = __builtin_nontemporal_load(Wp + (size_t)(16 * s + j) * NMOD);
            v4u au; au.x = pk2(wv[0], wv[1]); au.y = pk2(wv[2], wv[3]); au.z = pk2(wv[4], wv[5]); au.w = pk2(wv[6], wv[7]);
            const bf16x8 a = __builtin_bit_cast(bf16x8, au);
#pragma unroll
            for (int t = 0; t < 5; ++t) {
                const bf16x8 b = *(const bf16x8*)(Sp + (size_t)((s * 5 + t) * 64) * 8);
                acc[t] = __builtin_amdgcn_mfma_f32_32x32x16_bf16(a, b, acc[t], 0, 0, 0);
            }
        }
        float* dst = WSP(float, WS_MODS) + (kh ? MODSB_DELTA : (size_t)0);
#pragma unroll
        for (int pass = 0; pass < 2; ++pass) {
            if ((w >> 2) == pass) { LAS float* rs = red + (w & 3) * (160 * 33);
#pragma unroll
                for (int t = 0; t < 5; ++t)
#pragma unroll
                    for (int i = 0; i < 16; ++i) rs[(32 * t + r) * 33 + (i & 3) + 8 * (i >> 2) + 4 * hh] = acc[t][i]; }
            __syncthreads();
            const int c0 = 256 * cg + 128 * pass;
            for (int idx = F.tid; idx < NMODROW * 128; idx += NWAVES * 64) { const int m = idx >> 7, c = idx & 127;
                dst[(size_t)m * NMOD + c0 + c] = red[(c >> 5) * (160 * 33) + m * 33 + (c & 31)] + (kh ? 0.f : INP(7)[c0 + c]); }
            __syncthreads();
        }
    }
    {
        const int w8 = F.wave;
        LAS float* buf0 = (LAS float*)F.lds; LAS float* buf1 = (LAS float*)(F.lds + TILE_BYTES);
        volatile LAS int* qslot = (volatile LAS int*)(F.lds + MISC_OFF + 64);
        unsigned* qhead = (unsigned*)(F.ws + WS_CTL) + CW_QUEUE;
        if (F.tid == 0) { qslot[0] = (int)__hip_atomic_fetch_add(qhead, 1u, __ATOMIC_RELAXED, __HIP_MEMORY_SCOPE_AGENT); qslot[1] = (int)__hip_atomic_fetch_add(qhead, 1u, __ATOMIC_RELAXED, __HIP_MEMORY_SCOPE_AGENT); }
        __syncthreads();
        int ic = qslot[0], in = qslot[1];
        __syncthreads();
        constexpr int NALL = P0_NA + P0_NB + P0_NP;
        if (ic < NALL) {
            P0Item cur, nxt; f32x4 t[8];
            p0_decode(A, F.ws, ic, w8, cur); tile_load(cur.src, cur.N, t, w8, flane); tile_store(buf0, t, cur.mul, w8, flane);
            __syncthreads();
            int par = 0;
            for (;;) {
                const bool more = in < NALL;
                if (more) { p0_decode(A, F.ws, in, w8, nxt); tile_load(nxt.src, nxt.N, t, w8, flane); }
                if (F.tid == 0) qslot[0] = (int)__hip_atomic_fetch_add(qhead, 1u, __ATOMIC_RELAXED, __HIP_MEMORY_SCOPE_AGENT);
                p0_convert(cur, par ? buf1 : buf0, w8, flane, ic >= P0_NA && ic < P0_NA + P0_NB);
                if (more) { tile_store(par ? buf0 : buf1, t, nxt.mul, w8, flane); cur = nxt; ic = in; }
                __syncthreads();
                if (!more) break;
                in = qslot[0];
                __syncthreads();
                par ^= 1;
            }
        }
    }
}

__device__ __forceinline__ f32x4 ld4_bf16(const bf16* p) { const v2u v = *(const v2u*)p;
    return (f32x4){__builtin_bit_cast(float, v.x << 16), __builtin_bit_cast(float, v.x & 0xffff0000u), __builtin_bit_cast(float, v.y << 16), __builtin_bit_cast(float, v.y & 0xffff0000u)}; }
template <bool OUT8, int NP, bool S16, bool FIN>
__device__ __forceinline__ void norm_sample_rows(Frame& F, const float* srcS32, const float* gain, int sub, bf16* Hd, float* yS) {
    const int flane = lane_of(F);
    const int w = F.wave;
    bf16* X16 = WSP(bf16, WS_X); const bf16* slab = WSP(bf16, WS_SLAB);
    LAS float* part = (LAS float*)F.lds;
    int par = 0;
    for (int hr = F.vcu; hr < MS; hr += F.G) {
        const int m = MP + hr, k = 256 * w + 4 * flane;
        f32x4 v = S16 ? ld4_bf16(X16 + (size_t)m * DM + k) : *(const f32x4*)(srcS32 + (size_t)hr * DM + k);
        if (NP > 0) {
            f32x4 sv[NP > 0 ? NP : 1];
#pragma unroll
            for (int p = 0; p < NP; ++p) sv[p] = ld4_bf16(slab + ((size_t)p * MS + hr) * DM + k);
#pragma unroll
            for (int p = 0; p < NP; ++p) v += sv[p];
            if (!FIN) { v2u pk; pk.x = pk2(v[0], v[1]); pk.y = pk2(v[2], v[3]); *(GAS v2u*)(X16 + (size_t)m * DM + k) = pk; }
        }
        const float ssw = wave_sum((v[0] * v[0] + v[1] * v[1]) + (v[2] * v[2] + v[3] * v[3]));
        if (flane == 0) part[par * 8 + w] = ssw;
        __syncthreads();
        float ss = 0.f;
#pragma unroll
        for (int i = 0; i < 8; ++i) ss += part[par * 8 + i];
        par ^= 1;
        const float rstd = 1.0f / sqrtf(ss * (1.0f / DM) + EPS);
        if (FIN) { const f32x4 g4 = *(const f32x4*)(gain + k); *(f32x4*)(yS + (size_t)hr * DM + k) = (v * rstd) * g4; }
        else {
            const float* sh = WSP(float, WS_MODS) + (size_t)pg8::modrow_of(m) * NMOD + (size_t)(3 * sub) * DM; const float* sc = sh + DM;
            const f32x4 g4 = *(const f32x4*)(gain + k), s4 = *(const f32x4*)(sc + k) + *(const f32x4*)(sc + MODSB_DELTA + k), h4 = *(const f32x4*)(sh + k) + *(const f32x4*)(sh + MODSB_DELTA + k);
            const f32x4 o = (v * rstd) * g4 * (s4 + 1.0f) + h4;
            if (OUT8) { *(GAS unsigned*)((unsigned char*)Hd + (size_t)m * DM + k) = pg8::pk4_fp8(o[0], o[1], o[2], o[3]); }
            else { v2u pk; pk.x = pk2(o[0], o[1]); pk.y = pk2(o[2], o[3]); *(GAS v2u*)(Hd + (size_t)m * DM + k) = pk; }
        }
    }
    __syncthreads();
}
template <bool OUT8, bool P16>
__device__ __forceinline__ void norm_prompt_rows(Frame& F, const float* srcP32, const float* gain, int sub, bf16* Hd) {
    const int flane = lane_of(F);
    const int gw = F.vcu * NWAVES + F.wave, NGW = F.G * NWAVES;
    const bf16* X16 = WSP(bf16, WS_X);
    for (int m = gw; m < MP; m += NGW) {
        const float* sh = WSP(float, WS_MODS) + (size_t)pg8::modrow_of(m) * NMOD + (size_t)(3 * sub) * DM; const float* sc = sh + DM;
        f32x4 v[8]; float ss = 0.f;
#pragma unroll
        for (int j = 0; j < 8; ++j) v[j] = P16 ? ld4_bf16(X16 + (size_t)m * DM + 4 * (flane + 64 * j)) : *(const f32x4*)(srcP32 + (size_t)m * DM + 4 * (flane + 64 * j));
#pragma unroll
        for (int j = 0; j < 8; ++j) ss += (v[j][0] * v[j][0] + v[j][1] * v[j][1]) + (v[j][2] * v[j][2] + v[j][3] * v[j][3]);
        const float rstd = 1.0f / sqrtf(wave_sum(ss) * (1.0f / DM) + EPS);
#pragma unroll
        for (int j = 0; j < 8; ++j) { const int k = 4 * (flane + 64 * j);
            const f32x4 g4 = *(const f32x4*)(gain + k), s4 = *(const f32x4*)(sc + k) + *(const f32x4*)(sc + MODSB_DELTA + k), h4 = *(const f32x4*)(sh + k) + *(const f32x4*)(sh + MODSB_DELTA + k);
            const f32x4 o = (v[j] * rstd) * g4 * (s4 + 1.0f) + h4;
            if (OUT8) { *(GAS unsigned*)((unsigned char*)Hd + (size_t)m * DM + k) = pg8::pk4_fp8(o[0], o[1], o[2], o[3]); }
            else { v2u pk; pk.x = pk2(o[0], o[1]); pk.y = pk2(o[2], o[3]); *(GAS v2u*)(Hd + (size_t)m * DM + k) = pk; } }
    }
}
template <bool OUT8, int NP, bool P16, bool S16>
__device__ __forceinline__ void norm_mod(Frame& F, const float* srcP32, const float* srcS32, const float* gain, int sub, bf16* Hd) {
    norm_sample_rows<OUT8, NP, S16, false>(F, srcS32, gain, sub, Hd, nullptr);
    norm_prompt_rows<OUT8, P16>(F, srcP32, gain, sub, Hd);
}
template <int NP>
__device__ __forceinline__ void final_norm(Frame& F, const Args& A) {
    norm_sample_rows<false, NP, true, true>(F, nullptr, INP(21), 0, nullptr, F.out + O_YS);
    const int flane = lane_of(F);
    const int gw = F.vcu * NWAVES + F.wave, NGW = F.G * NWAVES;
    const bf16* X16 = WSP(bf16, WS_X);
    for (int m = gw; m < MP; m += NGW) {
        float* yr = F.out + O_YP + (size_t)m * DM;
        f32x4 v[8]; float ss = 0.f;
#pragma unroll
        for (int j = 0; j < 8; ++j) v[j] = ld4_bf16(X16 + (size_t)m * DM + 4 * (flane + 64 * j));
#pragma unroll
        for (int j = 0; j < 8; ++j) ss += (v[j][0] * v[j][0] + v[j][1] * v[j][1]) + (v[j][2] * v[j][2] + v[j][3] * v[j][3]);
        const float rstd = 1.0f / sqrtf(wave_sum(ss) * (1.0f / DM) + EPS);
#pragma unroll
        for (int j = 0; j < 8; ++j) { const int k = 4 * (flane + 64 * j); const f32x4 g4 = *(const f32x4*)(INP(21) + k); __builtin_nontemporal_store((v[j] * rstd) * g4, (f32x4*)(yr + k)); }
    }
}

#define MFMA16(a, b, c) __builtin_amdgcn_mfma_f32_16x16x32_bf16(a, b, c, 0, 0, 0)
__device__ __forceinline__ float log2_gamma(int h) { return h == 0 ? -0.045803689613124747f : h == 1 ? -0.022720076500083405f : h == 2 ? -0.011315313227834146f : -0.0056465631411130581f; }
constexpr int TP = 136;

__device__ __forceinline__ void retA_unit(Frame& F, int unit) {
    const int flane = lane_of(F);
    const int half = unit & 1, c = (unit >> 1) & 15, bh = unit >> 5, b = bh >> 2, h = bh & 3;
    const int m0 = b * SEQ + c * CH;
    const int tid = F.tid, lane = flane, w = F.wave, fr = lane & 15, fq = lane >> 4;
    LAS bf16* VT = (LAS bf16*)F.lds; LAS bf16* KT = VT + 256 * TP; LAS bf16* PP = KT + 128 * TP;
    const bf16* Qg = WSP(bf16, WS_QKVG) + (size_t)m0 * RW + h * HD;
    const bf16* Kg = Qg + (size_t)MTOK * RW; const bf16* Vg = Kg + (size_t)MTOK * RW;
    const float l2g = log2_gamma(h);
#pragma unroll 2
    for (int it = 0; it < 8; ++it) { const int idx = it * 512 + tid, tok = idx & 127, ch = idx >> 7;
        const bf16x8 v = *(const bf16x8*)(Vg + (size_t)tok * RW + ch * 8);
#pragma unroll
        for (int e = 0; e < 8; ++e) VT[(ch * 8 + e) * TP + tok] = (bf16)v[e]; }
#pragma unroll 2
    for (int it = 0; it < 4; ++it) { const int idx = it * 512 + tid, tok = idx & 127, ch = idx >> 7;
        const bf16x8 k = *(const bf16x8*)(Kg + (size_t)tok * RW + half * 128 + ch * 8);
        const float kd = __builtin_amdgcn_exp2f((float)(127 - tok) * l2g);
#pragma unroll
        for (int e = 0; e < 8; ++e) KT[(ch * 8 + e) * TP + tok] = (bf16)f2bf(bf2f((bf16)k[e]) * kd); }
    {
        f32x4 acc[4];
#pragma unroll
        for (int i = 0; i < 4; ++i) acc[i] = (f32x4){0.f, 0.f, 0.f, 0.f};
        if (16 * w < 64 * half + 64) {
#pragma unroll 2
            for (int s = 0; s < 8; ++s) {
                const bf16x8 bb = *(const bf16x8*)(Kg + (size_t)(16 * w + fr) * RW + 32 * s + 8 * fq);
#pragma unroll
                for (int i = 0; i < 4; ++i) { const bf16x8 aa = *(const bf16x8*)(Qg + (size_t)(64 * half + 16 * i + fr) * RW + 32 * s + 8 * fq); acc[i] = MFMA16(aa, bb, acc[i]); }
            }
        }
#pragma unroll
        for (int i = 0; i < 4; ++i)
#pragma unroll
            for (int r = 0; r < 4; ++r) { const int nl = 16 * i + 4 * fq + r, n = 64 * half + nl, m = 16 * w + fr, dn = n - m;
                const float val = dn >= 0 ? acc[i][r] * __builtin_amdgcn_exp2f((float)dn * l2g) : 0.f;
                PP[nl * TP + m] = (bf16)f2bf(val); }
    }
    __syncthreads();
    {
        f32x4 o[2][4];
#pragma unroll
        for (int j = 0; j < 2; ++j)
#pragma unroll
            for (int i = 0; i < 4; ++i) o[j][i] = (f32x4){0.f, 0.f, 0.f, 0.f};
#pragma unroll
        for (int s = 0; s < 4; ++s) {
            bf16x8 a[4];
#pragma unroll
            for (int i = 0; i < 4; ++i) a[i] = *(const LAS bf16x8*)(PP + (16 * i + fr) * TP + 32 * s + 8 * fq);
#pragma unroll
            for (int j = 0; j < 2; ++j) { const bf16x8 bb = *(const LAS bf16x8*)(VT + (16 * (2 * w + j) + fr) * TP + 32 * s + 8 * fq);
#pragma unroll
                for (int i = 0; i < 4; ++i) o[j][i] = MFMA16(bb, a[i], o[j][i]); }
        }
#pragma unroll
        for (int j = 0; j < 2; ++j)
#pragma unroll
            for (int i = 0; i < 4; ++i) { v2u pk; pk.x = pk2(o[j][i][0], o[j][i][1]); pk.y = pk2(o[j][i][2], o[j][i][3]);
                *(GAS v2u*)(WSP(bf16, WS_OI) + (size_t)(m0 + 64 * half + 16 * i + fr) * RW + h * HD + 16 * (2 * w + j) + 4 * fq) = pk; }
    }
    {
        f32x4 ua[2][8];
#pragma unroll
        for (int i = 0; i < 2; ++i)
#pragma unroll
            for (int j = 0; j < 8; ++j) ua[i][j] = (f32x4){0.f, 0.f, 0.f, 0.f};
#pragma unroll
        for (int s = 0; s < 4; ++s) {
            bf16x8 a[2];
#pragma unroll
            for (int i = 0; i < 2; ++i) a[i] = *(const LAS bf16x8*)(VT + (16 * (2 * w + i) + fr) * TP + 32 * s + 8 * fq);
#pragma unroll
            for (int j = 0; j < 8; ++j) { const bf16x8 bb = *(const LAS bf16x8*)(KT + (16 * j + fr) * TP + 32 * s + 8 * fq);
#pragma unroll
                for (int i = 0; i < 2; ++i) ua[i][j] = MFMA16(bb, a[i], ua[i][j]); }
        }
        bf16* UTu = WSP(bf16, WS_UT) + (size_t)(bh * NCH + c) * HD * HD;
#pragma unroll
        for (int i = 0; i < 2; ++i)
#pragma unroll
            for (int j = 0; j < 8; ++j) { v2u pk; pk.x = pk2(ua[i][j][0], ua[i][j][1]); pk.y = pk2(ua[i][j][2], ua[i][j][3]);
                *(GAS v2u*)(UTu + (size_t)(16 * (2 * w + i) + fr) * HD + 128 * half + 16 * j + 4 * fq) = pk; }
    }
    __syncthreads();
}

__device__ __forceinline__ void retC_unit(Frame& F, int unit) {
    const int flane = lane_of(F);
    const int c = unit & 15, bh = unit >> 4, b = bh >> 2, h = bh & 3;
    const int m0 = b * SEQ + c * CH;
    const int tid = F.tid, lane = flane, w = F.wave, fr = lane & 15, fq = lane >> 4;
    const bf16* Qg = WSP(bf16, WS_QKVG) + (size_t)m0 * RW + h * HD;
    const bf16* Gg = Qg + (size_t)3 * MTOK * RW;
    const float l2g = log2_gamma(h);
    f32x4 acc[16];
#pragma unroll
    for (int j = 0; j < 16; ++j) acc[j] = (f32x4){0.f, 0.f, 0.f, 0.f};
    if (c > 0) {
        const bf16* STc = WSP(bf16, WS_ST) + (size_t)(bh * NCH + c) * HD * HD;
        {
            v4u st[16];
#pragma unroll
            for (int it = 0; it < 16; ++it) st[it] = *(const v4u*)(STc + (size_t)(it * 512 + tid) * 8);
#pragma unroll
            for (int it = 0; it < 16; ++it) { const int idx = it * 512 + tid, row = idx >> 5, ch = idx & 31;
                *(LAS v4u*)(F.lds + row * 512 + ((ch ^ (row & 15)) * 16)) = st[it]; }
        }
        bf16x8 qf[8];
#pragma unroll
        for (int s = 0; s < 8; ++s) qf[s] = *(const bf16x8*)(Qg + (size_t)(16 * w + fr) * RW + 32 * s + 8 * fq);
        __syncthreads();
#pragma unroll
        for (int s = 0; s < 8; ++s) {
#pragma unroll
            for (int j = 0; j < 16; ++j) { const bf16x8 aa = *(const LAS bf16x8*)(F.lds + (16 * j + fr) * 512 + (((4 * s + fq) ^ fr) * 16)); acc[j] = MFMA16(aa, qf[s], acc[j]); }
        }
    }
    {
        const int n = 16 * w + fr; const size_t row = (size_t)(m0 + n);
        const float qd = __builtin_amdgcn_exp2f((float)(n + 1) * l2g);
        const bf16* oip = WSP(bf16, WS_OI) + row * RW + h * HD + 4 * fq;
        float ss = 0.f;
#pragma unroll
        for (int j = 0; j < 16; ++j) { const f32x4 o = ld4_bf16(oip + 16 * j) + acc[j] * qd; acc[j] = o; ss += (o[0] * o[0] + o[1] * o[1]) + (o[2] * o[2] + o[3] * o[3]); }
        ss += __shfl_xor(ss, 16); ss += __shfl_xor(ss, 32);
        const float rs = 1.0f / sqrtf(ss * (1.0f / HD) + EPS);
        const bf16* gp = Gg + (size_t)n * RW + 4 * fq;
        unsigned char* mp = WSP(unsigned char, WS_MIX) + row * DM + PW + h * HD + 4 * fq;
#pragma unroll
        for (int j = 0; j < 16; ++j) { const v2u gv = *(const v2u*)(gp + 16 * j);
            const float g0 = bf2f((bf16)(gv.x & 0xffffu)), g1 = bf2f((bf16)(gv.x >> 16)), g2 = bf2f((bf16)(gv.y & 0xffffu)), g3 = bf2f((bf16)(gv.y >> 16));
            *(GAS unsigned*)(mp + 16 * j) = pg8::pk4_fp8(silu1(g0) * acc[j][0] * rs, silu1(g1) * acc[j][1] * rs, silu1(g2) * acc[j][2] * rs, silu1(g3) * acc[j][3] * rs); }
    }
    __syncthreads();
}

__device__ __forceinline__ void retS_unit(Frame& F, const Args& A, int unit) {
    const int flane = lane_of(F);
    const int b = unit >> 2, h = unit & 3, row0 = MP + 4 * b;
    const int tid = F.tid, lane = flane, w = F.wave;
    LAS float* qs = (LAS float*)F.lds; LAS float* kr = qs + 1024; LAS float* vs = kr + 1024; LAS float* red = vs + 1024; LAS float* dots = red + 8192;
    const bf16* Qg = WSP(bf16, WS_QKVG); const bf16* Kg = Qg + (size_t)MTOK * RW; const bf16* Vg = Kg + (size_t)MTOK * RW; const bf16* Gg = Vg + (size_t)MTOK * RW;
    const float l2g = log2_gamma(h);
    for (int i = tid; i < 1024; i += NWAVES * 64) { const int t = i >> 8, d = i & 255; const size_t off = (size_t)(row0 + t) * RW + h * HD + d;
        qs[i] = bf2f(Qg[off]); kr[i] = bf2f(Kg[off]); vs[i] = bf2f(Vg[off]); }
    __syncthreads();
#pragma unroll
    for (int jj = 0; jj < 2; ++jj) { const int p = 2 * w + jj, t = p >> 2, m = p & 3;
        const f32x4 a = *(const LAS f32x4*)(qs + t * 256 + 4 * lane), k4 = *(const LAS f32x4*)(kr + m * 256 + 4 * lane);
        const float d = wave_sum((a[0] * k4[0] + a[1] * k4[1]) + (a[2] * k4[2] + a[3] * k4[3]));
        if (lane == 0) dots[p] = d; }
    const f32x4* S0 = (const f32x4*)(INP(5) + (size_t)unit * HD * HD);
    f32x4* S1 = (f32x4*)(F.out + O_RETS + (size_t)unit * HD * HD);
    f32x4 v4[4], oq[4];
#pragma unroll
    for (int t = 0; t < 4; ++t) { v4[t] = *(const LAS f32x4*)(vs + t * 256 + 4 * lane); oq[t] = (f32x4){0.f, 0.f, 0.f, 0.f}; }
    const float cdec = __builtin_amdgcn_exp2f(4.0f * l2g);
    const float kd0 = __builtin_amdgcn_exp2f(3.0f * l2g), kd1 = __builtin_amdgcn_exp2f(2.0f * l2g), kd2 = __builtin_amdgcn_exp2f(l2g);
    f32x4 s[8], sn[8];
#pragma unroll
    for (int u = 0; u < 8; ++u) s[u] = __builtin_nontemporal_load(S0 + (size_t)(32 * w + u) * 64 + lane);
#pragma unroll
    for (int it = 0; it < 4; ++it) {
        const int dk0 = 32 * w + 8 * it;
        if (it < 3) {
#pragma unroll
            for (int u = 0; u < 8; ++u) sn[u] = __builtin_nontemporal_load(S0 + (size_t)(dk0 + 8 + u) * 64 + lane);
        }
#pragma unroll
        for (int u = 0; u < 8; ++u) { const int dk = dk0 + u;
            const float q0 = qs[dk], q1 = qs[256 + dk], q2 = qs[512 + dk], q3 = qs[768 + dk];
            const float k0 = kr[dk] * kd0, k1 = kr[256 + dk] * kd1, k2 = kr[512 + dk] * kd2, k3 = kr[768 + dk];
            oq[0] += s[u] * q0; oq[1] += s[u] * q1; oq[2] += s[u] * q2; oq[3] += s[u] * q3;
            __builtin_nontemporal_store(s[u] * cdec + v4[0] * k0 + v4[1] * k1 + v4[2] * k2 + v4[3] * k3, S1 + (size_t)dk * 64 + lane); }
#pragma unroll
        for (int u = 0; u < 8; ++u) s[u] = sn[u];
    }
#pragma unroll
    for (int t = 0; t < 4; ++t) *(LAS f32x4*)(red + (w * 4 + t) * 256 + 4 * lane) = oq[t];
    __syncthreads();
    if (w < 4) {
        const int t = w;
        f32x4 o = (f32x4){0.f, 0.f, 0.f, 0.f};
#pragma unroll
        for (int ww = 0; ww < 8; ++ww) o += *(const LAS f32x4*)(red + (ww * 4 + t) * 256 + 4 * lane);
        o = o * __builtin_amdgcn_exp2f((float)(t + 1) * l2g);
#pragma unroll
        for (int m = 0; m < 4; ++m) if (m <= t) o += v4[m] * (dots[t * 4 + m] * __builtin_amdgcn_exp2f((float)(t - m) * l2g));
        const float ss = wave_sum((o[0] * o[0] + o[1] * o[1]) + (o[2] * o[2] + o[3] * o[3]));
        const float rs = 1.0f / sqrtf(ss * (1.0f / HD) + EPS);
        const size_t row = (size_t)(row0 + t);
        const v2u gp = *(const v2u*)(Gg + row * RW + h * HD + 4 * lane);
        const float g0 = bf2f((bf16)(gp.x & 0xffffu)), g1 = bf2f((bf16)(gp.x >> 16)), g2 = bf2f((bf16)(gp.y & 0xffffu)), g3 = bf2f((bf16)(gp.y >> 16));
        *(GAS unsigned*)(WSP(unsigned char, WS_MIX) + row * DM + PW + h * HD + 4 * lane) = pg8::pk4_fp8(silu1(g0) * o[0] * rs, silu1(g1) * o[1] * rs, silu1(g2) * o[2] * rs, silu1(g3) * o[3] * rs);
    }
    __syncthreads();
}

__device__ __forceinline__ void scan_states(Frame& F) {
    const int bx = (int)blockIdx.x; const bool bal = (F.G == 256), heavy = bx < 136;
    const int i0 = bal ? (heavy ? bx * 544 : 136 * 544 + (bx - 136) * 1568) + F.tid : F.vcu * (NWAVES * 64) + F.tid;
    const int i1 = bal ? (heavy ? (bx + 1) * 544 : 136 * 544 + (bx - 135) * 1568) : 16 * 16384;
    const int istep = bal ? NWAVES * 64 : F.G * NWAVES * 64;
    for (int i = i0; i < i1; i += istep) {
        const int bh = i >> 14, e4 = i & 16383, h = bh & 3;
        const bf16* up = WSP(bf16, WS_UT) + ((size_t)bh * NCH * 16384 + e4) * 4;
        f32x4 uv[16];
#pragma unroll
        for (int c = 0; c < 16; ++c) uv[c] = ld4_bf16(up + (size_t)c * 65536);
        const float g128 = __builtin_amdgcn_exp2f(128.0f * log2_gamma(h));
        f32x4 S = (f32x4){0.f, 0.f, 0.f, 0.f};
#pragma unroll
        for (int c = 0; c < 16; ++c) {
            S = S * g128 + uv[c];
            if (c < 15) { v2u pk; pk.x = pk2(S[0], S[1]); pk.y = pk2(S[2], S[3]); *(GAS v2u*)(WSP(bf16, WS_ST) + ((size_t)(bh * NCH + c + 1) * 16384 + e4) * 4) = pk; }
        }
        const int dv = (4 * e4) >> 8, dk = (4 * e4) & 255;
        float* rp = F.out + O_RETP + (size_t)bh * HD * HD + dv;
#pragma unroll
        for (int q = 0; q < 4; ++q) rp[(size_t)(dk + q) * HD] = S[q];
    }
}

__device__ __forceinline__ void pool_prompt_item(Frame& F, int item, int q) {
    const int b = item >> 8, t0 = (item & 255) * 8, g = q >> 6, wn = 2 << g;
    const bf16* U16 = WSP(bf16, WS_U) + (size_t)b * SEQ * PW + 4 * q;
#define U4_AT(t) ld4_bf16(U16 + (size_t)(t) * PW)
    f32x4 hv[15], cur[8], old[8];
#pragma unroll
    for (int j = 1; j < 16; ++j) { const int t = t0 - j; const bool ok = (j < wn) && (t >= 0); hv[j - 1] = U4_AT(ok ? t : t0) * (ok ? 1.0f : 0.0f); }
#pragma unroll
    for (int i = 0; i < 8; ++i) { const int t = t0 + i, to = t - wn; const bool ok = (i >= 1) && (to >= 0);
        cur[i] = U4_AT(t); old[i] = U4_AT(ok ? to : t) * (ok ? 1.0f : 0.0f); }
    f32x4 sum = (f32x4){0.f, 0.f, 0.f, 0.f};
#pragma unroll
    for (int j = 0; j < 15; ++j) sum += hv[j];
#pragma unroll
    for (int i = 0; i < 8; ++i) {
        const int t = t0 + i;
        sum += cur[i]; sum -= old[i];
        const float cnt = (float)((t + 1 < wn) ? (t + 1) : wn);
        const f32x4 mv = sum / cnt - cur[i];
        v2u pk; pk.x = pk2(mv[0], mv[1]); pk.y = pk2(mv[2], mv[3]);
        *(GAS v2u*)(WSP(bf16, WS_PM) + ((size_t)(b * SEQ + t) * PW + 4 * q)) = pk;
    }
}
#undef U4_AT
__device__ __forceinline__ void pool_sample_item(Frame& F, const Args& A, int b, int q) {
    const int g = q >> 6, wn = 2 << g;
    const f32x4* SP4 = (const f32x4*)(INP(4) + (size_t)b * 15 * PW) + q;
    const bf16* US16 = WSP(bf16, WS_U) + (size_t)(MP + 4 * b) * PW + 4 * q;
    f32x4 ue[19];
#pragma unroll
    for (int i = 0; i < 15; ++i) ue[i] = SP4[(size_t)i * 256];
#pragma unroll
    for (int t = 0; t < 4; ++t) ue[15 + t] = ld4_bf16(US16 + (size_t)t * PW);
#pragma unroll
    for (int t = 0; t < 4; ++t) {
        f32x4 sum = (f32x4){0.f, 0.f, 0.f, 0.f};
#pragma unroll
        for (int j = 0; j < 16; ++j) sum += ue[15 + t - j] * ((j < wn) ? 1.0f : 0.0f);
        const f32x4 mv = sum / (float)wn - ue[15 + t];
        v2u pk; pk.x = pk2(mv[0], mv[1]); pk.y = pk2(mv[2], mv[3]);
        *(GAS v2u*)(WSP(bf16, WS_PM) + ((size_t)(MP + 4 * b + t) * PW + 4 * q)) = pk;
    }
}
__device__ __forceinline__ void pool_phase(Frame& F, const Args& A) {
    const int q = F.tid & 255, sub = F.tid >> 8;
    for (int bi = F.vcu; bi < 512; bi += F.G) pool_prompt_item(F, 2 * bi + sub, q);
    for (int bi = F.G - 1 - F.vcu; bi < 64; bi += F.G) pool_sample_item(F, A, 2 * bi + sub, q);
    const int gt = F.vcu * (NWAVES * 64) + F.tid, NT = F.G * NWAVES * 64;
    f32x4* o4 = (f32x4*)F.out;
    for (int i = gt; i < NB * 15 * 256; i += NT) { const int qq = i & 255, r = (i >> 8) % 15, b = (i >> 8) / 15;
        o4[O_POOLP / 4 + i] = ld4_bf16(WSP(bf16, WS_U) + (((size_t)b * SEQ + (SEQ - 15) + r) * 256 + qq) * 4); }
    for (int i = gt; i < DB * 15 * 256; i += NT) { const int qq = i & 255, r = (i >> 8) % 15, b = (i >> 8) / 15;
        o4[O_POOLS / 4 + i] = (r < 11) ? ((const f32x4*)INP(4))[((size_t)b * 15 + r + 4) * 256 + qq] : ld4_bf16(WSP(bf16, WS_U) + (((size_t)(MP + 4 * b) + (r - 11)) * 256 + qq) * 4); }
}


__global__ void __launch_bounds__(NWAVES * 64, 2) mk_fwd(Args args) {
    extern __shared__ __attribute__((aligned(16))) unsigned char lds[];
    Frame F;
    F.lds = (LAS unsigned char*)lds;
    F.MISC = (volatile LAS unsigned*)(F.lds + MISC_OFF);
    F.tid = threadIdx.x; F.wave = __builtin_amdgcn_readfirstlane(F.tid >> 6);
    F.G = gridDim.x; { const int bx = blockIdx.x; F.vcu = (F.G % 8 == 0) ? (bx % 8) * (F.G / 8) + bx / 8 : bx; }
    unsigned char* ws = args.ws; const Args& A = args;
    F.out = args.out;
    F.ws = ws;
    for (int u = F.tid; u < (LDS_BYTES - LDSCTL_OFF) / 4; u += NWAVES * 64) ((LAS unsigned*)(F.lds + LDSCTL_OFF))[u] = 0u;
    __syncthreads();
    if (!MK_PER_PHASE) (void)xcd_barrier_post((unsigned*)(ws + WS_CTL) + CW_BAR + args.bar_region * XCD_BAR_WORDS, F.MISC + 8);
    const int lo = args.ph_lo, hi = args.ph_hi;
#ifdef PROBE_TA
    if (blockIdx.x == 0 && threadIdx.x == 0) ((unsigned long long*)(ws + WS_CTL + 49152))[0] = __builtin_amdgcn_s_memrealtime();
#endif
#ifndef PH_MASK
#define PH_MASK 0x7fff
#endif
#define IN(k) (((PH_MASK >> (k)) & 1) && lo <= (k) && (k) < hi)
#ifndef REP_MASK
#define REP_MASK 0
#endif
#ifdef PROBE_TA
#define STAMP_AFTER(k) do { if (blockIdx.x == 0 && threadIdx.x == 0) ((unsigned long long*)(A.ws + WS_CTL + 49152))[(k) + 1] = __builtin_amdgcn_s_memrealtime(); } while (0)
#else
#define STAMP_AFTER(k) do { } while (0)
#endif
#define NREP(k) ((((REP_MASK) >> (k)) & 1) ? 2 : 1)
#define SEAM(k) do { if (!MK_PER_PHASE && (IN((k) + 1) || rep_ + 1 < NREP(k))) { XcdBarrier bar_; bar_.bar = (unsigned*)(A.ws + WS_CTL) + CW_BAR + A.bar_region * XCD_BAR_WORDS; bar_.x = xb_xcc_id(); bar_.st = (volatile LAS unsigned*)(F.lds + MISC_OFF) + 8; xcd_barrier(bar_); } STAMP_AFTER(k); } while (0)

    if (IN(0)) for (int rep_ = relaunder(F); rep_ < NREP(0); ++rep_) { p0_prologue(F, A); SEAM(0); }
    if (IN(1)) for (int rep_ = relaunder(F); rep_ < NREP(1); ++rep_) { p1_adaln(F, A); SEAM(1); }
    if (IN(2)) for (int rep_ = relaunder(F); rep_ < NREP(2); ++rep_) { norm_mod<true, 0, false, false>(F, INP(0), INP(1), INP(8), 0, WSP(bf16, WS_H)); SEAM(2); }
    if (IN(3)) for (int rep_ = relaunder(F); rep_ < NREP(3); ++rep_) {
        pg8::Gemm g{WSP(bf16, WS_H), WSP(bf16, WS_W1), DM, DM, DM, 0, 0, WSC_UP}; pg8::StaticOrder S; S.init(MTOK, 2 * DFF, F.G, (int)blockIdx.x);
        pg8::EpiSwiglu E{WSP(unsigned char, WS_ACT)};
        pg8::gemm_phase8<pg8::EpiSwiglu, pg8::StaticOrder, true>(F.lds, g, S, E);
        SEAM(3);
    }
    if (IN(4)) for (int rep_ = relaunder(F); rep_ < NREP(4); ++rep_) {
        pg8::Gemm g{WSP(bf16, WS_ACT), WSP(bf16, WS_W1D), DFF, DFF, DFF, 0, KP_DOWN, WSC_DOWN}; pg8::SplitOrder S; S.init(DM, DFF / KP_DOWN, F.G, (int)blockIdx.x);
        pg8::EpiResid<false> E{INP(0), WSP(bf16, WS_X), WSP(float, WS_MODS) + 2 * DM, 0.5f};
        pg8::gemm_phase8<decltype(E), pg8::SplitOrder, true>(F.lds, g, S, E);
        SEAM(4);
    }
    if (IN(5)) for (int rep_ = relaunder(F); rep_ < NREP(5); ++rep_) { norm_mod<false, DFF / KP_DOWN, true, false>(F, nullptr, INP(1), INP(12), 1, WSP(bf16, WS_H)); SEAM(5); }
    if (IN(6)) for (int rep_ = relaunder(F); rep_ < NREP(6); ++rep_) {
        pg8::Gemm g{WSP(bf16, WS_H), WSP(bf16, WS_WIN), DM, DM, DM, 0, 0, 0}; pg8::StaticOrder S; S.init(MTOK, INC, F.G, (int)blockIdx.x);
        pg8::EpiWin E{WSP(bf16, WS_U), WSP(bf16, WS_QKVG), WSP(float, WS_ROT)};
        pg8::gemm_phase<pg8::EpiWin, pg8::StaticOrder, true>(F.lds, g, S, E);
        SEAM(6);
    }
    if (IN(7)) for (int rep_ = relaunder(F); rep_ < NREP(7); ++rep_) {
        for (int u = F.vcu; u < NB * NH * NCH * 2; u += F.G) retA_unit(F, u);
        pool_phase(F, A);
        SEAM(7);
    }
    if (IN(8)) for (int rep_ = relaunder(F); rep_ < NREP(8); ++rep_) {
        {
            pg8::Gemm g{WSP(bf16, WS_PM), WSP(bf16, WS_WPOOL), PW, HD, HD, HD, 0, 0}; pg8::StaticOrder S; S.init(MTOK, PW, F.G, (int)blockIdx.x);
            pg8::EpiPool E{WSP(unsigned char, WS_MIX), INP(15)};
            pg8::gemm_phase<pg8::EpiPool, pg8::StaticOrder, true>(F.lds, g, S, E);
        }
        __syncthreads();
        { int t2 = threadIdx.x; asm volatile("" : "+v"(t2)); F.tid = t2; }
        for (int u = F.vcu; u < DB * NH; u += F.G) retS_unit(F, A, u);
        scan_states(F);
        SEAM(8);
    }
    if (IN(9)) for (int rep_ = relaunder(F); rep_ < NREP(9); ++rep_) { for (int u = F.vcu; u < NB * NH * NCH; u += F.G) retC_unit(F, u); SEAM(9); }
    if (IN(10)) for (int rep_ = relaunder(F); rep_ < NREP(10); ++rep_) {
        pg8::Gemm g{WSP(bf16, WS_MIX), WSP(bf16, WS_WOUT), DM, DM, DM, 0, KP_OUT, WSC_UP}; pg8::SplitOrder S; S.init(DM, DM / KP_OUT, F.G, (int)blockIdx.x);
        pg8::EpiResid<true> E{nullptr, WSP(bf16, WS_X), WSP(float, WS_MODS) + 5 * DM, 1.0f};
        pg8::gemm_phase8<decltype(E), pg8::SplitOrder, true>(F.lds, g, S, E);
        SEAM(10);
    }
    if (IN(11)) for (int rep_ = relaunder(F); rep_ < NREP(11); ++rep_) { norm_mod<true, DM / KP_OUT, true, true>(F, nullptr, nullptr, INP(17), 2, WSP(bf16, WS_H)); SEAM(11); }
    if (IN(12)) for (int rep_ = relaunder(F); rep_ < NREP(12); ++rep_) {
        pg8::Gemm g{WSP(bf16, WS_H), WSP(bf16, WS_W2), DM, DM, DM, 0, 0, WSC_UP}; pg8::StaticOrder S; S.init(MTOK, 2 * DFF, F.G, (int)blockIdx.x);
        pg8::EpiSwiglu E{WSP(unsigned char, WS_ACT)};
        pg8::gemm_phase8<pg8::EpiSwiglu, pg8::StaticOrder, true>(F.lds, g, S, E);
        SEAM(12);
    }
    if (IN(13)) for (int rep_ = relaunder(F); rep_ < NREP(13); ++rep_) {
        pg8::Gemm g{WSP(bf16, WS_ACT), WSP(bf16, WS_W2D), DFF, DFF, DFF, 0, KP_DOWN, WSC_DOWN}; pg8::SplitOrder S; S.init(DM, DFF / KP_DOWN, F.G, (int)blockIdx.x);
        pg8::EpiResid<true> E{nullptr, WSP(bf16, WS_X), WSP(float, WS_MODS) + 8 * DM, 0.5f};
        pg8::gemm_phase8<decltype(E), pg8::SplitOrder, true>(F.lds, g, S, E);
        SEAM(13);
    }
    if (IN(14)) for (int rep_ = relaunder(F); rep_ < NREP(14); ++rep_) { final_norm<DFF / KP_DOWN>(F, A); if (rep_ + 1 < NREP(14)) { SEAM(14); } }
#ifdef PROBE_TA
    if (blockIdx.x == 0 && threadIdx.x == 0) {
        unsigned long long* ts = (unsigned long long*)(ws + WS_CTL + 49152);
        const unsigned long long now = __builtin_amdgcn_s_memrealtime(); ts[15] = now;
        unsigned long long qa = (ts[PROBE_TA + 1] - ts[PROBE_TA]) / 400ull, qb = (ts[PROBE_TB + 1] - ts[PROBE_TB]) / 400ull;
        if (qa > 99ull) qa = 99ull; if (qb > 99ull) qb = 99ull;
        const unsigned long long until = now + qa * 2000ull + qb * 200000ull;
        while (__builtin_amdgcn_s_memrealtime() < until) __builtin_amdgcn_s_sleep(64);
    }
#endif
#undef IN
#undef SEAM
}

extern "C" void kernel_launch(void* const* d_in, const int* in_sizes, int n_in, void* d_out, int out_size, void* d_ws, size_t ws_size, hipStream_t stream) {
    static int grid = 0;
    if (grid == 0) {
        if (n_in != 22 || (size_t)out_size != O_END || ws_size < WS_END) { fprintf(stderr, "kernel_launch: unexpected shapes (n_in %d out %d ws %zu)\n", n_in, out_size, ws_size); grid = -1; return; }
        int dev = 0, cus = 0, per_cu = 0;
        if (hipGetDevice(&dev) != hipSuccess || hipDeviceGetAttribute(&cus, hipDeviceAttributeMultiprocessorCount, dev) != hipSuccess) { grid = -1; return; }
        if (hipFuncSetAttribute((const void*)mk_fwd, hipFuncAttributeMaxDynamicSharedMemorySize, LDS_BYTES) != hipSuccess) { fprintf(stderr, "kernel_launch: hipFuncSetAttribute failed\n"); grid = -1; return; }
        if (hipOccupancyMaxActiveBlocksPerMultiprocessor(&per_cu, (const void*)mk_fwd, NWAVES * 64, LDS_BYTES) != hipSuccess || per_cu < 1) { fprintf(stderr, "kernel_launch: occupancy query says %d blocks/CU\n", per_cu); (void)hipGetLastError(); grid = -1; return; }
        grid = cus;
    }
    if (grid < 0) return;
    (void)hipMemsetAsync((char*)d_ws + WS_CTL, 0, CTL_ZERO_BYTES, stream);
    Args a{};
    for (int i = 0; i < 22; ++i) a.in[i] = (const float*)d_in[i];
    a.out = (float*)d_out; a.ws = (unsigned char*)d_ws;
#if MK_PER_PHASE
    for (int p = 0; p < N_PHASES; ++p) { a.ph_lo = p; a.ph_hi = p + 1; hipLaunchKernelGGL(mk_fwd, dim3(grid), dim3(NWAVES * 64), LDS_BYTES, stream, a); }
#else
    a.ph_lo = 0; a.ph_hi = N_PHASES;
    hipLaunchKernelGGL(mk_fwd, dim3(grid), dim3(NWAVES * 64), LDS_BYTES, stream, a);
#ifdef PROBE_LO
    a.ph_lo = PROBE_LO; a.ph_hi = PROBE_HI; a.bar_region = 1;
    hipLaunchKernelGGL(mk_fwd, dim3(grid), dim3(NWAVES * 64), LDS_BYTES, stream, a);
#endif
#endif
}
```

```cpp
#include <hip/hip_runtime.h>
#include <cstdio>
#include <cstdint>
#include <cmath>

#ifndef MK_PER_PHASE
#define MK_PER_PHASE 0
#endif

constexpr int DM = 2048, DFF = 5632, SEQ = 2048, NB = 4, DB = 128, DS = 4;
constexpr int MP = NB * SEQ;
constexpr int MS = DB * DS;
constexpr int MTOK = MP + MS;
constexpr int NMODROW = NB + DB;
constexpr int NMOD = 9 * DM;
constexpr int PW = 1024, RW = 1024, HD = 256, NH = 4, CH = 128, NCH = SEQ / CH;
constexpr int INC = PW + 4 * RW;
constexpr int PAST = 16384;
constexpr float EPS = 1e-6f;
constexpr int NPOS = SEQ + DS;

constexpr size_t O_YP = 0, O_YS = (size_t)MP * DM, O_POOLP = O_YS + (size_t)MS * DM, O_RETP = O_POOLP + (size_t)NB * 15 * PW,
                 O_POOLS = O_RETP + (size_t)NB * NH * HD * HD, O_RETS = O_POOLS + (size_t)DB * 15 * PW, O_END = O_RETS + (size_t)DB * NH * HD * HD;

constexpr size_t SLAB_MINUS_X = (size_t)(568 - 210) << 20;
constexpr size_t MODSB_DELTA = ((size_t)(612 - 5) << 20) / 4;

namespace pg8 {
#define PG8_LAS __attribute__((address_space(3)))
typedef unsigned short bf16_t;
typedef short bf16x8 __attribute__((ext_vector_type(8)));
typedef float f32x4 __attribute__((ext_vector_type(4)));
typedef unsigned u32x4 __attribute__((ext_vector_type(4)));
typedef unsigned u32x2 __attribute__((ext_vector_type(2)));
constexpr int BM = 256, BK = 64, HALF = 128, HTB = HALF * BK * 2  , STAGE_BYTES = 8 * HTB, NXCD = 8, WGM = 8;

__host__ __device__ __forceinline__ int lds_byte(int r, int c) { const int st = (r >> 4) * 2 + (c >> 5), rr = r & 15, cc = c & 31, ob = rr * 64 + cc * 2; return st * 1024 + (ob ^ (((ob >> 9) & 1) << 5)); }
__host__ __device__ __forceinline__ void stage_rc(int b, int& R, int& C) { const int st = b / 1024, sb = b % 1024, swz = sb ^ (((sb >> 9) & 1) << 5); R = (st >> 1) * 16 + swz / 64; C = (st & 1) * 32 + (swz % 64) / 2; }
__host__ __device__ __forceinline__ int perm32(int rho) { const int n = rho >> 4, i = rho & 15; return 8 * (i >> 2) + 4 * n + (i & 3); }

struct Unit { int pm, pn, kp; };
struct Gemm { const bf16_t* A; const bf16_t* Bt; int lda, ldb, K, acol, kpiece, wscale; };

struct StaticOrder {
    int nM, nN, nwg, G, c;
    __host__ __device__ __forceinline__ void init(int M, int N, int G_, int c_) { nM = M / BM; nN = N / BM; nwg = nM * nN; G = G_; c = c_; }
    __host__ __device__ __forceinline__ bool next(int i, Unit& u) const {
        const long L = (long)i * G + c; if (L >= nwg) return false;
        int wgid = (int)L; { const int q = nwg / NXCD, r = nwg % NXCD, xcd = wgid % NXCD, off = wgid / NXCD; wgid = (xcd < r ? xcd * (q + 1) : r * (q + 1) + (xcd - r) * q) + off; }
        const int nig = WGM * nN, gid = wgid / nig, fm = gid * WGM, gsz = (nM - fm) < WGM ? (nM - fm) : WGM;
        u.pm = fm + ((wgid % nig) % gsz); u.pn = (wgid % nig) / gsz; u.kp = -1; return true;
    }
    __device__ __forceinline__ void a_ready(const Unit&) const {}
    __device__ __forceinline__ void done(const Unit&) const {}
};

struct SplitOrder {
    int nN, nfull, np, G, c;
    __host__ __device__ __forceinline__ void init(int N, int np_, int G_, int c_) { nN = N / BM; nfull = (MP / BM) * nN; np = np_; G = G_; c = c_; }
    __host__ __device__ __forceinline__ bool next(int i, Unit& u) const {
        const int L = i * G + c;
        int pm, pn, kp; bool ok = true;
        if (L < nfull) {
            int wgid = L; { const int q = nfull / NXCD, xcd = wgid % NXCD, off = wgid / NXCD; wgid = xcd * q + off; }
            const int nig = WGM * nN, gid = wgid / nig, fm = gid * WGM;
            pm = fm + ((wgid % nig) % WGM); pn = (wgid % nig) / WGM; kp = -1;
        } else {
            const int j = L - nfull; ok = j < 2 * nN * np;
            const int t = j / np; kp = j - t * np; pm = MP / BM + t / nN; pn = t % nN;
        }
        u.pm = pm; u.pn = pn; u.kp = kp; return ok;
    }
    __device__ __forceinline__ void a_ready(const Unit&) const {}
    __device__ __forceinline__ void done(const Unit&) const {}
};

__device__ __forceinline__ unsigned cvt_pk_bf16(float lo, float hi) { unsigned r; asm volatile("v_cvt_pk_bf16_f32 %0, %1, %2" : "=v"(r) : "v"(lo), "v"(hi)); return r; }
__device__ __forceinline__ float silu_f(float x) { return x * __builtin_amdgcn_rcpf(1.0f + __builtin_amdgcn_exp2f(-1.4426950408889634f * x)); }
__device__ __forceinline__ float clamp448(float x) { return __builtin_fminf(__builtin_fmaxf(x, -448.0f), 448.0f); }
__device__ __forceinline__ unsigned pk4_fp8(float a, float b, float c, float d) {
    int p = 0; p = __builtin_amdgcn_cvt_pk_fp8_f32(clamp448(a), clamp448(b), p, false); p = __builtin_amdgcn_cvt_pk_fp8_f32(clamp448(c), clamp448(d), p, true); return (unsigned)p; }
__device__ __forceinline__ unsigned pk4_fp8_nc(float a, float b, float c, float d) {
    int p = 0; p = __builtin_amdgcn_cvt_pk_fp8_f32(a, b, p, false); p = __builtin_amdgcn_cvt_pk_fp8_f32(c, d, p, true); return (unsigned)p; }
__device__ __forceinline__ int modrow_of(int row) { return row < MP ? (row >> 11) : NB + ((row - MP) >> 2); }
__device__ __forceinline__ int ptab_of(int row) { return row < MP ? (row & (SEQ - 1)) : SEQ + ((row - MP) & 3); }

struct EpiSwiglu {
    static constexpr bool PERM = true, AFTER_DRAIN = false;
    unsigned char* O;
    __device__ __forceinline__ void operator()(const f32x4 (&acc)[2][2][4][2], const Unit& u, int wr, int wc, int fr, int fq) const {
        const int row0 = u.pm * BM + wr * 64 + fr, col0 = u.pn * HALF + wc * 32 + 8 * fq;
#pragma unroll
        for (int ai = 0; ai < 2; ++ai)
#pragma unroll
            for (int m = 0; m < 4; ++m) {
                unsigned char* rowp = O + (size_t)(row0 + ai * HALF + m * 16) * DFF + col0;
                const f32x4 g0 = acc[ai][0][m][0], g1 = acc[ai][0][m][1], u0 = acc[ai][1][m][0], u1 = acc[ai][1][m][1];
                u32x2 w;
                w.x = pk4_fp8_nc(silu_f(g0[0]) * u0[0], silu_f(g0[1]) * u0[1], silu_f(g0[2]) * u0[2], silu_f(g0[3]) * u0[3]);
                w.y = pk4_fp8_nc(silu_f(g1[0]) * u1[0], silu_f(g1[1]) * u1[1], silu_f(g1[2]) * u1[2], silu_f(g1[3]) * u1[3]);
                *(u32x2*)rowp = w;
            }
    }
};
template <bool BASE16> struct EpiResid {
    static constexpr bool PERM = true, AFTER_DRAIN = false;
    const float* base32; bf16_t* X; const float* gate; float coef;
    __device__ __forceinline__ void operator()(const f32x4 (&acc)[2][2][4][2], const Unit& u, int wr, int wc, int fr, int fq) const {
        const int row0 = u.pm * BM + wr * 64 + fr, col0 = u.pn * BM + wc * 32 + 8 * fq;
        if (u.kp < 0) {
            const float* gp = gate + (size_t)(u.pm >> 3) * NMOD + col0;
            f32x4 gg[2][2];
#pragma unroll
            for (int bj = 0; bj < 2; ++bj)
#pragma unroll
                for (int n = 0; n < 2; ++n) gg[bj][n] = (*(const f32x4*)(gp + bj * HALF + 4 * n) + *(const f32x4*)(gp + MODSB_DELTA + bj * HALF + 4 * n)) * coef;
#pragma unroll
            for (int ai = 0; ai < 2; ++ai)
#pragma unroll
                for (int m = 0; m < 4; ++m) {
                    const int row = row0 + ai * HALF + m * 16;
                    bf16_t* xp = X + (size_t)row * DM + col0;
#pragma unroll
                    for (int bj = 0; bj < 2; ++bj) {
                        f32x4 b0, b1;
                        if (BASE16) { const u32x4 bv = *(const u32x4*)(xp + bj * HALF);
                            b0 = (f32x4){__builtin_bit_cast(float, bv.x << 16), __builtin_bit_cast(float, bv.x & 0xffff0000u), __builtin_bit_cast(float, bv.y << 16), __builtin_bit_cast(float, bv.y & 0xffff0000u)};
                            b1 = (f32x4){__builtin_bit_cast(float, bv.z << 16), __builtin_bit_cast(float, bv.z & 0xffff0000u), __builtin_bit_cast(float, bv.w << 16), __builtin_bit_cast(float, bv.w & 0xffff0000u)}; }
                        else { const float* bp = base32 + (size_t)row * DM + col0 + bj * HALF; b0 = __builtin_nontemporal_load((const f32x4*)bp); b1 = __builtin_nontemporal_load((const f32x4*)(bp + 4)); }
                        const f32x4 o0 = b0 + gg[bj][0] * acc[ai][bj][m][0], o1 = b1 + gg[bj][1] * acc[ai][bj][m][1];
                        u32x4 w; w.x = cvt_pk_bf16(o0[0], o0[1]); w.y = cvt_pk_bf16(o0[2], o0[3]); w.z = cvt_pk_bf16(o1[0], o1[1]); w.w = cvt_pk_bf16(o1[2], o1[3]);
                        *(u32x4*)(xp + bj * HALF) = w;
                    }
                    if (m & 1) asm volatile("" ::: "memory");
                }
        } else {
#pragma unroll
            for (int ai = 0; ai < 2; ++ai)
#pragma unroll
                for (int m = 0; m < 4; ++m) {
                    const int row = row0 + ai * HALF + m * 16;
                    const float* gp = gate + (size_t)modrow_of(row) * NMOD + col0;
                    bf16_t* op = (bf16_t*)((char*)X + SLAB_MINUS_X) + ((size_t)u.kp * MS + (row - MP)) * DM + col0;
#pragma unroll
                    for (int bj = 0; bj < 2; ++bj) {
                        const f32x4 g0 = (*(const f32x4*)(gp + bj * HALF) + *(const f32x4*)(gp + MODSB_DELTA + bj * HALF)) * coef, g1 = (*(const f32x4*)(gp + bj * HALF + 4) + *(const f32x4*)(gp + MODSB_DELTA + bj * HALF + 4)) * coef;
                        const f32x4 o0 = g0 * acc[ai][bj][m][0], o1 = g1 * acc[ai][bj][m][1];
                        u32x4 w; w.x = cvt_pk_bf16(o0[0], o0[1]); w.y = cvt_pk_bf16(o0[2], o0[3]); w.z = cvt_pk_bf16(o1[0], o1[1]); w.w = cvt_pk_bf16(o1[2], o1[3]);
                        *(u32x4*)(op + bj * HALF) = w;
                    }
                    if (m & 1) asm volatile("" ::: "memory");
                }
        }
    }
};
struct EpiWin {
    static constexpr bool PERM = true, AFTER_DRAIN = false;
    bf16_t* U; bf16_t* QKVG; const float* rot;
    __device__ __forceinline__ void operator()(const f32x4 (&acc)[2][2][4][2], const Unit& u, int wr, int wc, int fr, int fq) const {
        const int row0 = u.pm * BM + wr * 64 + fr, cw = wc * 32 + 8 * fq;
        if (u.pn < 4) {
#pragma unroll
            for (int ai = 0; ai < 2; ++ai)
#pragma unroll
                for (int m = 0; m < 4; ++m) {
                    bf16_t* rowp = U + (size_t)(row0 + ai * HALF + m * 16) * PW + u.pn * BM + cw;
#pragma unroll
                    for (int bj = 0; bj < 2; ++bj) { const f32x4 v0 = acc[ai][bj][m][0], v1 = acc[ai][bj][m][1]; u32x4 w;
                        w.x = cvt_pk_bf16(v0[0], v0[1]); w.y = cvt_pk_bf16(v0[2], v0[3]); w.z = cvt_pk_bf16(v1[0], v1[1]); w.w = cvt_pk_bf16(v1[2], v1[3]);
                        *(u32x4*)(rowp + bj * HALF) = w; }
                }
        } else {
            const int t = (u.pn - 4) >> 2, hd = (u.pn - 4) & 3;
            bf16_t* dst = QKVG + (size_t)t * MTOK * RW + hd * HD + cw;
            if (t < 2) {
                const float sc = (t == 1) ? 0.0625f : 1.0f;
#pragma unroll
                for (int ai = 0; ai < 2; ++ai)
#pragma unroll
                    for (int m = 0; m < 4; ++m) {
                        const int row = row0 + ai * HALF + m * 16;
                        const float* rp = rot + ((size_t)ptab_of(row) * 128 + cw) * 2;
                        u32x4 w1, w2;
#pragma unroll
                        for (int n = 0; n < 2; ++n) {
                            const f32x4 cs0 = *(const f32x4*)(rp + 8 * n), cs1 = *(const f32x4*)(rp + 8 * n + 4);
                            const f32x4 x1 = acc[ai][0][m][n] * sc, x2 = acc[ai][1][m][n] * sc;
                            const float a0 = x1[0] * cs0[0] - x2[0] * cs0[1], b0 = x2[0] * cs0[0] + x1[0] * cs0[1];
                            const float a1 = x1[1] * cs0[2] - x2[1] * cs0[3], b1 = x2[1] * cs0[2] + x1[1] * cs0[3];
                            const float a2 = x1[2] * cs1[0] - x2[2] * cs1[1], b2 = x2[2] * cs1[0] + x1[2] * cs1[1];
                            const float a3 = x1[3] * cs1[2] - x2[3] * cs1[3], b3 = x2[3] * cs1[2] + x1[3] * cs1[3];
                            if (n == 0) { w1.x = cvt_pk_bf16(a0, a1); w1.y = cvt_pk_bf16(a2, a3); w2.x = cvt_pk_bf16(b0, b1); w2.y = cvt_pk_bf16(b2, b3); }
                            else        { w1.z = cvt_pk_bf16(a0, a1); w1.w = cvt_pk_bf16(a2, a3); w2.z = cvt_pk_bf16(b0, b1); w2.w = cvt_pk_bf16(b2, b3); }
                        }
                        bf16_t* rowp = dst + (size_t)row * RW;
                        *(u32x4*)rowp = w1; *(u32x4*)(rowp + HALF) = w2;
                    }
            } else {
#pragma unroll
                for (int ai = 0; ai < 2; ++ai)
#pragma unroll
                    for (int m = 0; m < 4; ++m) {
                        bf16_t* rowp = dst + (size_t)(row0 + ai * HALF + m * 16) * RW;
#pragma unroll
                        for (int bj = 0; bj < 2; ++bj) { const f32x4 v0 = acc[ai][bj][m][0], v1 = acc[ai][bj][m][1]; u32x4 w;
                            w.x = cvt_pk_bf16(v0[0], v0[1]); w.y = cvt_pk_bf16(v0[2], v0[3]); w.z = cvt_pk_bf16(v1[0], v1[1]); w.w = cvt_pk_bf16(v1[2], v1[3]);
                            *(u32x4*)(rowp + bj * HALF) = w; }
                    }
            }
        }
    }
};
struct EpiPool {
    static constexpr bool PERM = true, AFTER_DRAIN = false;
    unsigned char* MIX; const float* pscale;
    __device__ __forceinline__ void operator()(const f32x4 (&acc)[2][2][4][2], const Unit& u, int wr, int wc, int fr, int fq) const {
        const int row0 = u.pm * BM + wr * 64 + fr, col0 = u.pn * BM + wc * 32 + 8 * fq;
#pragma unroll
        for (int ai = 0; ai < 2; ++ai)
#pragma unroll
            for (int m = 0; m < 4; ++m) {
                unsigned char* rowp = MIX + (size_t)(row0 + ai * HALF + m * 16) * DM + col0;
#pragma unroll
                for (int bj = 0; bj < 2; ++bj) { const f32x4 v0 = acc[ai][bj][m][0] * *(const f32x4*)(pscale + col0 + bj * HALF), v1 = acc[ai][bj][m][1] * *(const f32x4*)(pscale + col0 + bj * HALF + 4); u32x2 w;
                    w.x = pk4_fp8(v0[0], v0[1], v0[2], v0[3]); w.y = pk4_fp8(v1[0], v1[1], v1[2], v1[3]);
                    *(u32x2*)(rowp + bj * HALF) = w; }
            }
    }
};

template <class Epi, class Sched, bool ALIGN_EPI = false>
__device__ __forceinline__ void gemm_phase(PG8_LAS unsigned char* lds, const Gemm g, const Sched& S, const Epi& E) {
    const int tid = threadIdx.x, wid = __builtin_amdgcn_readfirstlane(tid >> 6), lane = tid & 63, wr = wid >> 2, wc = wid & 3, fr = lane & 15, fq = lane >> 4;
    unsigned voffA[2], voffB[2];
#pragma unroll
    for (int i = 0; i < 2; ++i) { int R, C; stage_rc(tid * 16 + i * 8192, R, C); const int Rb = Epi::PERM ? ((R & ~31) + perm32(R & 31)) : R;
        voffA[i] = (unsigned)(R * g.lda + C) * 2u; voffB[i] = (unsigned)(Rb * g.ldb + C) * 2u; }
    const size_t kstep = (size_t)(BK * 2);
    const size_t hstepA = (size_t)HALF * g.lda * 2, hstepB = (size_t)HALF * g.ldb * 2;
    const size_t tstepA = 2 * hstepA, tstepB = 2 * hstepB;
    const size_t astep = (size_t)g.acol * 2;
    const unsigned ldsw = (unsigned)wid * 1024u;
    const int aoff = lds_byte(wr * 64 + fr, fq * 8), boff = lds_byte(wc * 32 + fr, fq * 8);
#define PG8_SA(b, h) (((b) * 2 + (h)) * HTB)
#define PG8_SB(b, h) ((4 + (b) * 2 + (h)) * HTB)
#define PG8_STAGE(bufoff, gbase, voff) do { _Pragma("unroll") for (int _i = 0; _i < 2; ++_i) \
        __builtin_amdgcn_global_load_lds((const unsigned*)((const char*)(gbase) + (voff)[_i]), (PG8_LAS unsigned*)(lds + (bufoff) + ldsw + _i * 8192), 16, 0, 0); } while (0)
#define PG8_LDA(dst, b, h) do { _Pragma("unroll") for (int m = 0; m < 4; ++m) _Pragma("unroll") for (int k = 0; k < 2; ++k) dst[m][k] = *(const PG8_LAS bf16x8*)(lds + PG8_SA(b, h) + aoff + m * 2048 + k * 1024); } while (0)
#define PG8_LDB(dst, b, h) do { _Pragma("unroll") for (int n = 0; n < 2; ++n) _Pragma("unroll") for (int k = 0; k < 2; ++k) dst[n][k] = *(const PG8_LAS bf16x8*)(lds + PG8_SB(b, h) + boff + n * 2048 + k * 1024); } while (0)
#define PG8_MMA(ai, bj, At, Bt) do { __builtin_amdgcn_s_setprio(1); _Pragma("unroll") for (int m = 0; m < 4; ++m) _Pragma("unroll") for (int n = 0; n < 2; ++n) _Pragma("unroll") for (int k = 0; k < 2; ++k) \
        acc[ai][bj][m][n] = __builtin_amdgcn_mfma_f32_16x16x32_bf16(Bt[n][k], At[m][k], acc[ai][bj][m][n], 0, 0, 0); __builtin_amdgcn_s_setprio(0); } while (0)
#define PG8_WAIT_V(n) asm volatile("s_waitcnt vmcnt(" #n ")" ::: "memory")
#define PG8_WAIT_L(n) asm volatile("s_waitcnt lgkmcnt(" #n ")" ::: "memory")
#define PG8_BAR __builtin_amdgcn_s_barrier()
#define PG8_SCHED __builtin_amdgcn_sched_barrier(0)
    Unit cur, nxt; int ui = 0;
    if (!S.next(0, cur)) return;
    f32x4 acc[2][2][4][2];
#pragma unroll
    for (int a = 0; a < 2; ++a)
#pragma unroll
        for (int b = 0; b < 2; ++b)
#pragma unroll
            for (int m = 0; m < 4; ++m)
#pragma unroll
                for (int n = 0; n < 2; ++n) acc[a][b][m][n] = (f32x4){0.f, 0.f, 0.f, 0.f};
    bf16x8 At[4][2], B0[2][2], B1[2][2];
    const char* cA = (const char*)g.A + (size_t)cur.pm * tstepA + (size_t)cur.pn * astep + (cur.kp > 0 ? (size_t)cur.kp * g.kpiece * 2 : 0); const char* cB = (const char*)g.Bt + (size_t)cur.pn * tstepB + (cur.kp > 0 ? (size_t)cur.kp * g.kpiece * 2 : 0);
    S.a_ready(cur);
    PG8_STAGE(PG8_SB(0, 0), cB, voffB); PG8_STAGE(PG8_SB(0, 1), cB + hstepB, voffB); PG8_STAGE(PG8_SA(0, 0), cA, voffA); PG8_STAGE(PG8_SA(0, 1), cA + hstepA, voffA);
    if (wr == 1) PG8_BAR;
    PG8_WAIT_V(2); PG8_BAR;
    PG8_STAGE(PG8_SB(1, 0), cB + kstep, voffB); PG8_STAGE(PG8_SA(1, 0), cA + kstep, voffA); PG8_STAGE(PG8_SB(1, 1), cB + hstepB + kstep, voffB);
    PG8_WAIT_V(6); PG8_BAR;
    for (;;) {
        const bool has_next = S.next(ui + 1, nxt);
        const size_t nko = (has_next && nxt.kp > 0) ? (size_t)nxt.kp * g.kpiece * 2 : 0;
        const char* nA = has_next ? (const char*)g.A + (size_t)nxt.pm * tstepA + (size_t)nxt.pn * astep + nko : cA; const char* nB = has_next ? (const char*)g.Bt + (size_t)nxt.pn * tstepB + nko : cB;
        const int nt = (cur.kp < 0 ? g.K : g.kpiece) / BK;
        for (int t = 0; t < nt; t += 2) {
            const bool last = (t == nt - 2);
            const char* a1 = cA + (size_t)(t + 1) * kstep;
            const char* a2 = last ? nA : cA + (size_t)(t + 2) * kstep; const char* b2 = last ? nB : cB + (size_t)(t + 2) * kstep;
            const char* a3 = a2 + kstep; const char* b3 = b2 + kstep;
            if (last && has_next) S.a_ready(nxt);
            PG8_LDB(B0, 0, 0); PG8_LDB(B1, 0, 1); PG8_SCHED; PG8_LDA(At, 0, 0); PG8_STAGE(PG8_SA(1, 1), a1 + hstepA, voffA);
            PG8_WAIT_V(8); PG8_WAIT_L(0); PG8_BAR; PG8_MMA(0, 0, At, B0); PG8_MMA(0, 1, At, B1); PG8_BAR; PG8_SCHED;
            PG8_LDA(At, 0, 1); PG8_STAGE(PG8_SB(0, 0), b2, voffB); PG8_STAGE(PG8_SB(0, 1), b2 + hstepB, voffB); PG8_STAGE(PG8_SA(0, 0), a2, voffA);
            PG8_WAIT_V(8); PG8_WAIT_L(0); PG8_BAR; PG8_MMA(1, 0, At, B0); PG8_MMA(1, 1, At, B1); PG8_BAR; PG8_SCHED;
            PG8_LDB(B0, 1, 0); PG8_LDB(B1, 1, 1); PG8_SCHED; PG8_LDA(At, 1, 0); PG8_STAGE(PG8_SA(0, 1), a2 + hstepA, voffA);
            PG8_WAIT_V(8); PG8_WAIT_L(0); PG8_BAR; PG8_MMA(0, 0, At, B0); PG8_MMA(0, 1, At, B1); PG8_BAR; PG8_SCHED;
            PG8_LDA(At, 1, 1); PG8_STAGE(PG8_SB(1, 0), b3, voffB); PG8_STAGE(PG8_SB(1, 1), b3 + hstepB, voffB); PG8_STAGE(PG8_SA(1, 0), a3, voffA);
            PG8_WAIT_V(8); PG8_WAIT_L(0); PG8_BAR; PG8_MMA(1, 0, At, B0); PG8_MMA(1, 1, At, B1); PG8_BAR; PG8_SCHED;
        }
        if constexpr (ALIGN_EPI) { if (wr == 0) PG8_BAR; }
        E(acc, cur, wr, wc, fr, fq); S.done(cur);
        if (!has_next) break;
#pragma unroll
        for (int a = 0; a < 2; ++a)
#pragma unroll
            for (int b = 0; b < 2; ++b)
#pragma unroll
                for (int m = 0; m < 4; ++m)
#pragma unroll
                    for (int n = 0; n < 2; ++n) acc[a][b][m][n] = (f32x4){0.f, 0.f, 0.f, 0.f};
        cur = nxt; cA = nA; cB = nB; ++ui;
        if constexpr (ALIGN_EPI) { if (wr == 1) PG8_BAR; }
    }
    PG8_WAIT_V(0);
    if constexpr (!ALIGN_EPI) { if (wr == 0) PG8_BAR; }
    PG8_BAR;
#undef PG8_SA
#undef PG8_SB
#undef PG8_STAGE
#undef PG8_LDA
#undef PG8_LDB
#undef PG8_MMA
#undef PG8_WAIT_V
#undef PG8_WAIT_L
#undef PG8_BAR
#undef PG8_SCHED
}
__host__ __device__ __forceinline__ int lds_byte8(int r, int cb) { return (r >> 4) * 2048 + (((cb >> 6) * 16 + (r & 15)) * 64) + ((((cb >> 4) & 3) ^ ((r >> 3) & 1)) * 16); }
__host__ __device__ __forceinline__ void stage_rc8(int b, int& R, int& C) { const int g = b >> 11, u = (b >> 6) & 31, h = u >> 4, r = u & 15, q = ((b >> 4) & 3) ^ ((r >> 3) & 1); R = 16 * g + r; C = h * 64 + q * 16; }
typedef int v8i __attribute__((ext_vector_type(8)));
__device__ __forceinline__ v8i cat8(bf16x8 lo, bf16x8 hi) { typedef int v4i __attribute__((ext_vector_type(4))); const v4i a = __builtin_bit_cast(v4i, lo), b = __builtin_bit_cast(v4i, hi); return (v8i){a[0], a[1], a[2], a[3], b[0], b[1], b[2], b[3]}; }
template <class Epi, class Sched, bool ALIGN_EPI = false>
__device__ __forceinline__ void gemm_phase8(PG8_LAS unsigned char* lds, const Gemm g, const Sched& S, const Epi& E) {
    const int tid = threadIdx.x, wid = __builtin_amdgcn_readfirstlane(tid >> 6), lane = tid & 63, wr = wid >> 2, wc = wid & 3, fr = lane & 15, fq = lane >> 4;
    unsigned voffA[2], voffB[2];
#pragma unroll
    for (int i = 0; i < 2; ++i) { int R, C; stage_rc8(tid * 16 + i * 8192, R, C); const int Rb = Epi::PERM ? ((R & ~31) + perm32(R & 31)) : R;
        voffA[i] = (unsigned)(R * g.lda + C); voffB[i] = (unsigned)(Rb * g.ldb + C); }
    const size_t kstep = (size_t)128;
    const size_t hstepA = (size_t)HALF * g.lda, hstepB = (size_t)HALF * g.ldb;
    const size_t tstepA = 2 * hstepA, tstepB = 2 * hstepB;
    const size_t astep = (size_t)g.acol;
    const unsigned ldsw = (unsigned)wid * 1024u;
    const int aoff = lds_byte8(wr * 64 + fr, fq * 32), boff = lds_byte8(wc * 32 + fr, fq * 32);
#define PG8_SA(b, h) (((b) * 2 + (h)) * HTB)
#define PG8_SB(b, h) ((4 + (b) * 2 + (h)) * HTB)
#define PG8_STAGE(bufoff, gbase, voff) do { _Pragma("unroll") for (int _i = 0; _i < 2; ++_i) \
        __builtin_amdgcn_global_load_lds((const unsigned*)((const char*)(gbase) + (voff)[_i]), (PG8_LAS unsigned*)(lds + (bufoff) + ldsw + _i * 8192), 16, 0, 0); } while (0)
#define PG8_LDA(dst, b, h) do { _Pragma("unroll") for (int m = 0; m < 4; ++m) dst[m] = cat8(*(const PG8_LAS bf16x8*)(lds + PG8_SA(b, h) + aoff + m * 2048), *(const PG8_LAS bf16x8*)(lds + PG8_SA(b, h) + (aoff ^ 16) + m * 2048)); } while (0)
#define PG8_LDB(dst, b, h) do { _Pragma("unroll") for (int n = 0; n < 2; ++n) dst[n] = cat8(*(const PG8_LAS bf16x8*)(lds + PG8_SB(b, h) + boff + n * 2048), *(const PG8_LAS bf16x8*)(lds + PG8_SB(b, h) + (boff ^ 16) + n * 2048)); } while (0)
#define PG8_MMA(ai, bj, At, Bt) do { __builtin_amdgcn_s_setprio(1); _Pragma("unroll") for (int m = 0; m < 4; ++m) _Pragma("unroll") for (int n = 0; n < 2; ++n) \
        asm volatile("v_mfma_scale_f32_16x16x128_f8f6f4 %0, %1, %2, %0, %3, %4 op_sel_hi:[0,0,0]" : "+v"(acc[ai][bj][m][n]) : "v"(Bt[n]), "v"(At[m]), "v"(wsc), "v"(asc)); __builtin_amdgcn_s_setprio(0); } while (0)
#define PG8_WAIT_V(n) asm volatile("s_waitcnt vmcnt(" #n ")" ::: "memory")
#define PG8_WAIT_L(n) asm volatile("s_waitcnt lgkmcnt(" #n ")" ::: "memory")
#define PG8_BAR __builtin_amdgcn_s_barrier()
#define PG8_SCHED __builtin_amdgcn_sched_barrier(0)
    Unit cur, nxt; int ui = 0;
    if (!S.next(0, cur)) return;
    f32x4 acc[2][2][4][2];
#pragma unroll
    for (int a = 0; a < 2; ++a)
#pragma unroll
        for (int b = 0; b < 2; ++b)
#pragma unroll
            for (int m = 0; m < 4; ++m)
#pragma unroll
                for (int n = 0; n < 2; ++n) acc[a][b][m][n] = (f32x4){0.f, 0.f, 0.f, 0.f};
    v8i At[4], B0[2], B1[2];
    int wsc = g.wscale, asc = 0x7f7f7f7f;
    asm volatile("" : "+v"(wsc), "+v"(asc));
    const char* cA = (const char*)g.A + (size_t)cur.pm * tstepA + (size_t)cur.pn * astep + (cur.kp > 0 ? (size_t)cur.kp * g.kpiece : 0); const char* cB = (const char*)g.Bt + (size_t)cur.pn * tstepB + (cur.kp > 0 ? (size_t)cur.kp * g.kpiece : 0);
    S.a_ready(cur);
    PG8_STAGE(PG8_SB(0, 0), cB, voffB); PG8_STAGE(PG8_SB(0, 1), cB + hstepB, voffB); PG8_STAGE(PG8_SA(0, 0), cA, voffA); PG8_STAGE(PG8_SA(0, 1), cA + hstepA, voffA);
    if (wr == 1) PG8_BAR;
    PG8_WAIT_V(2); PG8_BAR;
    PG8_STAGE(PG8_SB(1, 0), cB + kstep, voffB); PG8_STAGE(PG8_SA(1, 0), cA + kstep, voffA); PG8_STAGE(PG8_SB(1, 1), cB + hstepB + kstep, voffB);
    PG8_WAIT_V(6); PG8_BAR;
    for (;;) {
        const bool has_next = S.next(ui + 1, nxt);
        const size_t nko = (has_next && nxt.kp > 0) ? (size_t)nxt.kp * g.kpiece : 0;
        const char* nA = has_next ? (const char*)g.A + (size_t)nxt.pm * tstepA + (size_t)nxt.pn * astep + nko : cA; const char* nB = has_next ? (const char*)g.Bt + (size_t)nxt.pn * tstepB + nko : cB;
        const int nt = (cur.kp < 0 ? g.K : g.kpiece) / 128;
        for (int t = 0; t < nt; t += 2) {
            const bool last = (t == nt - 2);
            const char* a1 = cA + (size_t)(t + 1) * kstep;
            const char* a2 = last ? nA : cA + (size_t)(t + 2) * kstep; const char* b2 = last ? nB : cB + (size_t)(t + 2) * kstep;
            const char* a3 = a2 + kstep; const char* b3 = b2 + kstep;
            if (last && has_next) S.a_ready(nxt);
            PG8_LDB(B0, 0, 0); PG8_LDB(B1, 0, 1); PG8_SCHED; PG8_LDA(At, 0, 0); PG8_STAGE(PG8_SA(1, 1), a1 + hstepA, voffA);
            PG8_WAIT_V(8); PG8_WAIT_L(0); PG8_BAR; PG8_MMA(0, 0, At, B0); PG8_MMA(0, 1, At, B1); PG8_BAR; PG8_SCHED;
            PG8_LDA(At, 0, 1); PG8_STAGE(PG8_SB(0, 0), b2, voffB); PG8_STAGE(PG8_SB(0, 1), b2 + hstepB, voffB); PG8_STAGE(PG8_SA(0, 0), a2, voffA);
            PG8_WAIT_V(8); PG8_WAIT_L(0); PG8_BAR; PG8_MMA(1, 0, At, B0); PG8_MMA(1, 1, At, B1); PG8_BAR; PG8_SCHED;
            PG8_LDB(B0, 1, 0); PG8_LDB(B1, 1, 1); PG8_SCHED; PG8_LDA(At, 1, 0); PG8_STAGE(PG8_SA(0, 1), a2 + hstepA, voffA);
            PG8_WAIT_V(8); PG8_WAIT_L(0); PG8_BAR; PG8_MMA(0, 0, At, B0); PG8_MMA(0, 1, At, B1); PG8_BAR; PG8_SCHED;
            PG8_LDA(At, 1, 1); PG8_STAGE(PG8_SB(1, 0), b3, voffB); PG8_STAGE(PG8_SB(1, 1), b3 + hstepB, voffB); PG8_STAGE(PG8_SA(1, 0), a3, voffA);
            PG8_WAIT_V(8); PG8_WAIT_L(0); PG8_BAR; PG8_MMA(1, 0, At, B0); PG8_MMA(1, 1, At, B1); PG8_BAR; PG8_SCHED;
        }
        if constexpr (ALIGN_EPI) { if (wr == 0) PG8_BAR; }
        asm volatile("s_nop 15\n\ts_nop 15" ::: "memory");
        E(acc, cur, wr, wc, fr, fq); S.done(cur);
        if (!has_next) break;
#pragma unroll
        for (int a = 0; a < 2; ++a)
#pragma unroll
            for (int b = 0; b < 2; ++b)
#pragma unroll
                for (int m = 0; m < 4; ++m)
#pragma unroll
                    for (int n = 0; n < 2; ++n) acc[a][b][m][n] = (f32x4){0.f, 0.f, 0.f, 0.f};
        cur = nxt; cA = nA; cB = nB; ++ui;
        if constexpr (ALIGN_EPI) { if (wr == 1) PG8_BAR; }
    }
    PG8_WAIT_V(0);
    if constexpr (!ALIGN_EPI) { if (wr == 0) PG8_BAR; }
    PG8_BAR;
#undef PG8_SA
#undef PG8_SB
#undef PG8_STAGE
#undef PG8_LDA
#undef PG8_LDB
#undef PG8_MMA
#undef PG8_WAIT_V
#undef PG8_WAIT_L
#undef PG8_BAR
#undef PG8_SCHED
}
}

constexpr int NWAVES = 8;
constexpr int N_PHASES = 15;
constexpr size_t MiB = 1u << 20;
constexpr size_t WS_CTL = 0, CTL_ZERO_BYTES = 64 * 1024;
constexpr size_t WS_SC = 1 * MiB;
constexpr size_t WS_ROT = 2 * MiB;
constexpr size_t WS_MODS = 5 * MiB;
constexpr size_t WS_WPOOL = 15 * MiB;
constexpr size_t WS_WOUT = 16 * MiB;
constexpr size_t WS_WIN = 24 * MiB;
constexpr size_t WS_W1 = 44 * MiB;
constexpr size_t WS_W1D = 88 * MiB;
constexpr size_t WS_W2 = 110 * MiB;
constexpr size_t WS_W2D = 154 * MiB;
constexpr size_t WS_H = 176 * MiB;
constexpr size_t WS_X = 210 * MiB;
constexpr size_t WS_ACT = 278 * MiB;
constexpr size_t WS_QKVG = WS_ACT;
constexpr size_t WS_PM = WS_ACT + 68 * MiB;
constexpr size_t WS_U = 372 * MiB;
constexpr size_t WS_MIX = 406 * MiB;
constexpr size_t WS_UT = 440 * MiB;
constexpr size_t WS_OI = 504 * MiB;
constexpr size_t WS_ST = 536 * MiB;
constexpr size_t WS_SLAB = 568 * MiB;
constexpr size_t WS_MODSB = 612 * MiB;
constexpr size_t WS_END = 622 * MiB;
static_assert((WS_MODSB - WS_MODS) / 4 == MODSB_DELTA, "mods slab offset");
static_assert(WS_SLAB - WS_X == SLAB_MINUS_X, "slab offset");
constexpr int KP_DOWN = 512, KP_OUT = 512;
constexpr float WMUL_UP = 32.0f, WMUL_DOWN = 64.0f; constexpr int WSC_UP = 0x7a7a7a7a, WSC_DOWN = 0x79797979;
static_assert(WS_SC + 160 * 2048 * 2 <= WS_ROT && WS_ROT + (size_t)NPOS * 128 * 8 <= WS_MODS && WS_MODS + (size_t)NMODROW * NMOD * 4 <= WS_WPOOL, "ws map 1");
static_assert(WS_W1 + (size_t)2 * DFF * DM * 2 <= WS_W1D && WS_W1D + (size_t)DM * DFF * 2 <= WS_W2 && WS_W2D + (size_t)DM * DFF * 2 <= WS_H, "ws map 2");
static_assert(WS_H + (size_t)MTOK * DM * 2 <= WS_X && WS_X + (size_t)MTOK * DM * 4 <= WS_ACT && WS_ACT + (size_t)MTOK * DFF * 2 <= WS_U, "ws map 3");
static_assert(WS_PM + (size_t)MTOK * PW * 2 <= WS_U && WS_U + (size_t)MTOK * PW * 4 <= WS_MIX && WS_MIX + (size_t)MTOK * DM * 2 <= WS_UT, "ws map 4");
constexpr int CW_BAR = 1024;

constexpr int RING_BYTES = 131072;
constexpr int LDSCTL_OFF = 136 * 1024, MISC_OFF = LDSCTL_OFF + 320;
constexpr int LDS_BYTES = 147456;

#define GAS __attribute__((address_space(1)))
#define LAS __attribute__((address_space(3)))
typedef unsigned short bf16;
typedef unsigned v4u __attribute__((ext_vector_type(4)));
typedef unsigned v2u __attribute__((ext_vector_type(2)));
typedef float f32x4 __attribute__((ext_vector_type(4)));
typedef float f32x16 __attribute__((ext_vector_type(16)));
typedef short bf16x8 __attribute__((ext_vector_type(8)));
typedef short bf16x4 __attribute__((ext_vector_type(4)));
typedef GAS unsigned gu32;
#define RLX_AGENT __ATOMIC_RELAXED, __HIP_MEMORY_SCOPE_AGENT
#define LDS_WAIT() asm volatile("s_waitcnt lgkmcnt(0)" ::: "memory")
#define VM_WAIT() asm volatile("s_waitcnt vmcnt(0)" ::: "memory")
__device__ __forceinline__ unsigned f2bf(float f) { unsigned u = __builtin_bit_cast(unsigned, f); return (u + 0x7fffu + ((u >> 16) & 1u)) >> 16; }
__device__ __forceinline__ unsigned pk2(float lo, float hi) { return f2bf(lo) | (f2bf(hi) << 16); }
__device__ __forceinline__ float bf2f(unsigned short v) { return __builtin_bit_cast(float, (unsigned)v << 16); }
__device__ __forceinline__ float silu1(float x) { return x * __builtin_amdgcn_rcpf(1.0f + __builtin_amdgcn_exp2f(-1.4426950408889634f * x)); }

#define XB_TMO      128
#define XB_XCNT(j)  (256  + 64 * (j))
#define XB_XSUB(j)  (1280 + 64 * (j))
#define XB_XGEN(j)  (2304 + 64 * (j))
#define XB_TOP      3328
#define XB_TOPGEN   3392
#define XCD_BAR_WORDS 3456
#define XB_SPIN_CAP (1u << 20)
static_assert((CW_BAR + 2 * XCD_BAR_WORDS) * 4 <= (int)CTL_ZERO_BYTES, "barrier words inside the memset region");

__device__ __forceinline__ unsigned xb_ld(unsigned* p)              { return __hip_atomic_load(p, __ATOMIC_RELAXED, __HIP_MEMORY_SCOPE_AGENT); }
__device__ __forceinline__ unsigned xb_add(unsigned* p, unsigned v) { return __hip_atomic_fetch_add(p, v, __ATOMIC_RELAXED, __HIP_MEMORY_SCOPE_AGENT); }
__device__ __forceinline__ unsigned xb_xcc_id() { return (unsigned)__builtin_amdgcn_s_getreg((3 << 11) | 20) & 0xFu; }
#define XB_SPIN(cond, bar) do { unsigned _sp = 0; while (cond) { __builtin_amdgcn_s_sleep(1); \
    if ((++_sp & 255u) == 0u) { if (xb_ld(&(bar)[XB_TMO])) break; if (_sp > XB_SPIN_CAP) { atomicAdd(&(bar)[XB_TMO], 1u); break; } } } } while (0)

struct XcdBarrier { unsigned* bar; unsigned x; volatile LAS unsigned* st; };
__device__ __forceinline__ XcdBarrier xcd_barrier_post(unsigned* bar, volatile LAS unsigned* st) {
    XcdBarrier b; b.bar = bar; b.x = xb_xcc_id(); b.st = st;
    if (threadIdx.x == 0) (void)xb_add(&bar[XB_XCNT(b.x)], 1u);
    return b;
}
__device__ __forceinline__ void xcd_barrier_complete(unsigned* bar, unsigned x, unsigned& nloc, unsigned& nx) {
    const unsigned G = gridDim.x * gridDim.y * gridDim.z;
    unsigned sum, cnt, mine, sp = 0u;
    for (;;) {
        sum = 0u; cnt = 0u; mine = 0u;
#pragma unroll
        for (unsigned j = 0; j < 16; ++j) { const unsigned c = xb_ld(&bar[XB_XCNT(j)]); sum += c; cnt += (c > 0u) ? 1u : 0u; mine = (j == x) ? c : mine; }
        if (sum == G) break;
        __builtin_amdgcn_s_sleep(1);
        if ((++sp & 255u) == 0u) { if (xb_ld(&bar[XB_TMO])) break; if (sp > XB_SPIN_CAP) { atomicAdd(&bar[XB_TMO], 1u); break; } }
    }
    nloc = mine > 0u ? mine : 1u; nx = cnt > 0u ? cnt : 1u;
}
__device__ __forceinline__ void xcd_barrier(const XcdBarrier& b) {
    asm volatile("s_waitcnt vmcnt(0)" ::: "memory");
    __syncthreads();
    if (threadIdx.x == 0) {
        unsigned* bar = b.bar;
        __builtin_amdgcn_s_waitcnt(0);
        unsigned nloc = b.st[0], nx = b.st[1];
        if (nloc == 0u) { xcd_barrier_complete(bar, b.x, nloc, nx); b.st[0] = nloc; b.st[1] = nx; }
        const unsigned old = xb_add(&bar[XB_XSUB(b.x)], 1u);
        const unsigned gen = old / nloc;
        if (old + 1u == (gen + 1u) * nloc) {
            __builtin_amdgcn_fence(__ATOMIC_RELEASE, "agent");
            asm volatile("s_waitcnt vmcnt(0)" ::: "memory");
            const unsigned og = xb_add(&bar[XB_TOP], 1u);
            const unsigned tg = og / nx;
            if (og + 1u == (tg + 1u) * nx) xb_add(&bar[XB_TOPGEN], 1u);
            else XB_SPIN(xb_ld(&bar[XB_TOPGEN]) == tg, bar);
            __builtin_amdgcn_fence(__ATOMIC_ACQUIRE, "agent");
            asm volatile("s_waitcnt vmcnt(0)" ::: "memory");
        } else {
            XB_SPIN(xb_ld(&bar[XB_TOPGEN]) == gen, bar);
            __builtin_amdgcn_fence(__ATOMIC_ACQUIRE, "agent");
            asm volatile("s_waitcnt vmcnt(0)" ::: "memory");
        }
    }
    __syncthreads();
}

struct Args { const float* in[22]; float* out; unsigned char* ws; int ph_lo, ph_hi, bar_region, pad; };
static_assert(sizeof(Args) == 22 * 8 + 8 + 8 + 16, "Args has no padding");
#define INP(i) (A.in[i])
struct Frame {
    LAS unsigned char* lds;
    volatile LAS unsigned* MISC;
    int tid, lane, wave;
    int vcu, G;
    GAS unsigned char* ws;
    GAS float* out;
};
#define WSP(T, off) ((T*)(GAS T*)(F.ws + (off)))
__device__ __forceinline__ int relaunder(Frame& F) { int t2 = threadIdx.x; asm volatile("" : "+v"(t2)); F.tid = t2; GAS unsigned char* w = F.ws; asm volatile("" : "+s"(w)); F.ws = w; GAS float* o = F.out; asm volatile("" : "+s"(o)); F.out = o; return 0; }
__device__ __forceinline__ int lane_of(const Frame& F) { int l = F.tid & 63; asm volatile("" : "+v"(l)); return l; }

__device__ __forceinline__ float wave_sum(float v) {
#pragma unroll
    for (int o = 1; o < 64; o <<= 1) v += __shfl_xor(v, o);
    return v;
}

constexpr int TPITCH = 260;
constexpr int TILE_BYTES = 64 * TPITCH * 4;
static_assert(2 * TILE_BYTES <= LDSCTL_OFF && MISC_OFF + 128 <= LDS_BYTES, "LDS map");
constexpr int P0_NA = 3 * ((DM / 64) * (DFF / 256)) + (DM / 64) * (INC / 256) + (DM / 64) * (DM / 256);
constexpr int P0_NB = 3 * ((DM / 64) * (DFF / 256));
constexpr int P0_NP = 4 * ((HD / 64) * (HD / 256));
static_assert((DFF / 64) * (DM / 256) == (DM / 64) * (DFF / 256), "down and gate/up have the same item count");
constexpr int CW_QUEUE2 = 192;
constexpr int CW_QUEUE = 64;
struct P0Item { const float* src; unsigned char* dst; int N, ldkb, f8; float mul; };
__device__ __forceinline__ void p0_decode(const Args& A, unsigned char* ws, int it, int w, P0Item& d) {
    constexpr int B_F = (DM / 64) * (DFF / 256), B_D = (DFF / 64) * (DM / 256), B_IN = (DM / 64) * (INC / 256), B_OUT = (DM / 64) * (DM / 256), B_P = (HD / 64) * (HD / 256);
    int r = it; const float* W; int K, Nn, mode = 0, f8 = 1; unsigned char* WT; float mul = WMUL_UP;
    if (r < B_F) { W = INP(9); K = DM; Nn = DFF; WT = ws + WS_W1; mode = 1; }
    else if ((r -= B_F) < B_F) { W = INP(10); K = DM; Nn = DFF; WT = ws + WS_W1; mode = 2; }
    else if ((r -= B_F) < B_D) { W = INP(11); K = DFF; Nn = DM; WT = ws + WS_W1D; mul = WMUL_DOWN; }
    else if ((r -= B_D) < B_IN) { W = INP(13); K = DM; Nn = INC; WT = ws + WS_WIN; f8 = 0; mul = 1.0f; }
    else if ((r -= B_IN) < B_OUT) { W = INP(16); K = DM; Nn = DM; WT = ws + WS_WOUT; }
    else if ((r -= B_OUT) < B_F) { W = INP(18); K = DM; Nn = DFF; WT = ws + WS_W2; mode = 1; }
    else if ((r -= B_F) < B_F) { W = INP(19); K = DM; Nn = DFF; WT = ws + WS_W2; mode = 2; }
    else if ((r -= B_F) < B_D) { W = INP(20); K = DFF; Nn = DM; WT = ws + WS_W2D; mul = WMUL_DOWN; }
    else { r -= B_D; const int g = r / B_P; r -= g * B_P; W = INP(14) + (size_t)g * HD * HD; K = HD; Nn = HD; WT = ws + WS_WPOOL + (size_t)g * HD * HD * 2; f8 = 0; mul = 1.0f; }
    const int nng = Nn / 256, bt = r >> 2, kq = bt / nng, ng = bt - kq * nng, kb = 4 * kq + (r & 3), k0 = 64 * kb, n0 = 256 * ng + 32 * w;
    const int drow = (mode == 0) ? n0 : (256 * (n0 >> 7) + (n0 & 127) + (mode == 2 ? 128 : 0));
    d.src = W + (size_t)k0 * Nn + 256 * ng; d.N = Nn; d.f8 = f8; d.mul = mul;
    d.ldkb = f8 ? K : 2 * K; d.dst = WT + (size_t)drow * d.ldkb + (f8 ? k0 : 2 * k0);
}
__device__ __forceinline__ void tile_load(const float* src, int N, f32x4 (&t)[8], int w, int lane) {
#pragma unroll
    for (int i = 0; i < 8; ++i) t[i] = __builtin_nontemporal_load((const f32x4*)(src + (size_t)(8 * w + i) * N + 4 * lane));
}
__device__ __forceinline__ void tile_store(LAS float* buf, const f32x4 (&t)[8], float mul, int w, int lane) {
#pragma unroll
    for (int i = 0; i < 8; ++i) *(LAS f32x4*)(buf + (8 * w + i) * TPITCH + 4 * lane) = t[i] * mul;
}
__device__ __forceinline__ void p0_convert(const P0Item& d, const LAS float* buf, int w, int lane, bool NT) {
    if (d.f8) {
        const int c = lane & 3;
#pragma unroll
        for (int j = 0; j < 2; ++j) { const int n = (lane >> 2) + 16 * j; const LAS float* s = buf + (16 * c) * TPITCH + 32 * w + n;
            v4u o; o.x = pg8::pk4_fp8(s[0 * TPITCH], s[1 * TPITCH], s[2 * TPITCH], s[3 * TPITCH]); o.y = pg8::pk4_fp8(s[4 * TPITCH], s[5 * TPITCH], s[6 * TPITCH], s[7 * TPITCH]);
            o.z = pg8::pk4_fp8(s[8 * TPITCH], s[9 * TPITCH], s[10 * TPITCH], s[11 * TPITCH]); o.w = pg8::pk4_fp8(s[12 * TPITCH], s[13 * TPITCH], s[14 * TPITCH], s[15 * TPITCH]);
            if (NT) __builtin_nontemporal_store(o, (v4u*)(d.dst + (size_t)n * d.ldkb + 16 * c)); else *(GAS v4u*)(d.dst + (size_t)n * d.ldkb + 16 * c) = o; }
    } else {
        const int c = lane & 7;
#pragma unroll
        for (int j = 0; j < 4; ++j) { const int n = (lane >> 3) + 8 * j; const LAS float* s = buf + (8 * c) * TPITCH + 32 * w + n;
            v4u o; o.x = pk2(s[0 * TPITCH], s[1 * TPITCH]); o.y = pk2(s[2 * TPITCH], s[3 * TPITCH]); o.z = pk2(s[4 * TPITCH], s[5 * TPITCH]); o.w = pk2(s[6 * TPITCH], s[7 * TPITCH]);
            if (NT) __builtin_nontemporal_store(o, (v4u*)(d.dst + (size_t)n * d.ldkb + 16 * c)); else *(GAS v4u*)(d.dst + (size_t)n * d.ldkb + 16 * c) = o; }
    }
}
__device__ __forceinline__ void p0_prologue(Frame& F, const Args& A) {
    const int flane = lane_of(F);
    const int w = F.wave;
    const int gt = F.vcu * (NWAVES * 64) + F.tid, NT = F.G * NWAVES * 64;
    for (int i = gt; i < 160 * DM / 4; i += NT) {
        const int m = (4 * i) / DM, k = (4 * i) % DM;
        f32x4 v = (f32x4){0.f, 0.f, 0.f, 0.f};
        if (m < NB) v = *(const f32x4*)(INP(2) + (size_t)m * DM + k); else if (m < NMODROW) v = *(const f32x4*)(INP(3) + (size_t)(m - NB) * DM + k);
        v2u o; o.x = pk2(silu1(v[0]), silu1(v[1])); o.y = pk2(silu1(v[2]), silu1(v[3]));
        *(GAS v2u*)(WSP(bf16, WS_SC) + ((size_t)(((k >> 4) * 5 + (m >> 5)) * 64 + ((k >> 3) & 1) * 32 + (m & 31)) * 8 + (k & 7))) = o;
    }
    for (int i = gt; i < NPOS * 128; i += NT) {
        const int p = i >> 7, fi = i & 127;
        const float pos = (float)(p < SEQ ? p : PAST + (p - SEQ));
        const float inv = (float)exp(-(double)fi * (9.210340371976184 / 128.0));
        const float ang = pos * inv;
        float s, c; sincosf(ang, &s, &c);
        WSP(float, WS_ROT)[2 * (size_t)i] = c; WSP(float, WS_ROT)[2 * (size_t)i + 1] = s;
    }
}

constexpr int QB = 2;
constexpr int NB_EARLY = 2112;
static_assert((P0_NA + P0_NB + P0_NP) % QB == 0 && NB_EARLY % QB == 0 && NB_EARLY <= P0_NB, "whole batches");
__device__ __forceinline__ void conv_queue(Frame& F, const Args& A, int qw, int vsplit, int vskip, int nv, int maxb) {
    const int flane = lane_of(F);
    const int w8 = F.wave;
    LAS float* buf0 = (LAS float*)F.lds; LAS float* buf1 = (LAS float*)(F.lds + TILE_BYTES);
    volatile LAS int* qslot = (volatile LAS int*)(F.lds + MISC_OFF + 64);
    unsigned* qhead = (unsigned*)(F.ws + WS_CTL) + qw;
    constexpr int T_END = 1 << 26;
    int taken = 0;
#define CQ_TICKET() ((taken < maxb) ? (++taken, (int)__hip_atomic_fetch_add(qhead, 1u, __ATOMIC_RELAXED, __HIP_MEMORY_SCOPE_AGENT)) : T_END)
#define CQ_REAL(v) ((v) < vsplit ? (v) : (v) + vskip)
    if (F.tid == 0) { const int t0 = CQ_TICKET(); qslot[0] = t0; qslot[1] = (QB * t0 < nv) ? CQ_TICKET() : T_END; }
    __syncthreads();
    int bb = qslot[0], nb = qslot[1];
    __syncthreads();
    int ic = QB * bb, sb = 0, bp = 0;
    if (ic < nv) {
        P0Item cur, nxt; f32x4 t[8];
        int rc = CQ_REAL(ic);
        p0_decode(A, (unsigned char*)F.ws, rc, w8, cur); tile_load(cur.src, cur.N, t, w8, flane); tile_store(buf0, t, cur.mul, w8, flane);
        __syncthreads();
        int par = 0;
        for (;;) {
            const int in = (sb < QB - 1) ? ic + 1 : QB * nb;
            const bool more = in < nv;
            const int rn = CQ_REAL(in);
            if (more) { p0_decode(A, (unsigned char*)F.ws, rn, w8, nxt); tile_load(nxt.src, nxt.N, t, w8, flane); }
            if (sb == 0 && F.tid == 0) qslot[bp] = CQ_TICKET();
            p0_convert(cur, par ? buf1 : buf0, w8, flane, rc >= P0_NA && rc < P0_NA + P0_NB);
            if (more) { tile_store(par ? buf0 : buf1, t, nxt.mul, w8, flane); cur = nxt; ic = in; rc = rn; }
            __syncthreads();
            if (!more) break;
            if (++sb == QB) { sb = 0; bb = nb; nb = qslot[bp]; bp ^= 1; }
            par ^= 1;
        }
    }
#undef CQ_TICKET
#undef CQ_REAL
}

__device__ __forceinline__ void p1_adaln(Frame& F, const Args& A) {
    const int flane = lane_of(F);
    LAS float* red = (LAS float*)F.lds;
    const int lane = flane, w = F.wave, r = lane & 31, hh = lane >> 5;
    const bool spread = (F.G == 256);
    const int u0 = spread ? (((F.vcu & 31) < 18) ? (F.vcu >> 5) * 18 + (F.vcu & 31) : 2 * (NMOD / 256)) : F.vcu;
    for (int u = u0; u < 2 * (NMOD / 256); u += F.G) {
        const int cg = u >> 1, kh = u & 1;
        f32x16 acc[5];
#pragma unroll
        for (int t = 0; t < 5; ++t)
#pragma unroll
            for (int i = 0; i < 16; ++i) acc[t][i] = 0.f;
        const float* Wt = INP(6) + (size_t)(1024 * kh) * NMOD + 256 * cg;
        const bf16* Sp = WSP(bf16, WS_SC) + ((size_t)(64 * kh) * 5 * 64 + lane) * 8;
        LAS float* const tb0 = (LAS float*)F.lds; LAS float* const tb1 = (LAS float*)(F.lds + TILE_BYTES);
        f32x4 t[8]; bf16x8 sc[20];
        tile_load(Wt, NMOD, t, w, lane);
#pragma unroll
        for (int q = 0; q < 20; ++q) sc[q] = *(const bf16x8*)(Sp + (size_t)(q * 64) * 8);
        tile_store(tb0, t, 1.0f, w, lane);
        __syncthreads();
        for (int i = 0; i < 16; ++i) {
            const LAS float* cb = (i & 1) ? tb1 : tb0;
            if (i < 15) tile_load(Wt + (size_t)(64 * (i + 1)) * NMOD, NMOD, t, w, lane);
            __builtin_amdgcn_sched_barrier(0);
#pragma unroll
            for (int s4 = 0; s4 < 4; ++s4) {
                const LAS float* ap = cb + (16 * s4 + 8 * hh) * TPITCH + 32 * w + r;
                v4u au; au.x = pk2(ap[0 * TPITCH], ap[1 * TPITCH]); au.y = pk2(ap[2 * TPITCH], ap[3 * TPITCH]); au.z = pk2(ap[4 * TPITCH], ap[5 * TPITCH]); au.w = pk2(ap[6 * TPITCH], ap[7 * TPITCH]);
                const bf16x8 a = __builtin_bit_cast(bf16x8, au);
#pragma unroll
                for (int tt = 0; tt < 5; ++tt) acc[tt] = __builtin_amdgcn_mfma_f32_32x32x16_bf16(a, sc[5 * s4 + tt], acc[tt], 0, 0, 0);
            }
            __builtin_amdgcn_sched_barrier(0);
            if (i < 15) {
#pragma unroll
                for (int q = 0; q < 20; ++q) sc[q] = *(const bf16x8*)(Sp + (size_t)((20 * (i + 1) + q) * 64) * 8);
                __builtin_amdgcn_sched_barrier(0);
                tile_store((i & 1) ? tb0 : tb1, t, 1.0f, w, lane);
            }
            __syncthreads();
        }
        float* dst = WSP(float, WS_MODS) + (kh ? MODSB_DELTA : (size_t)0);
#pragma unroll
        for (int pass = 0; pass < 2; ++pass) {
            if ((w >> 2) == pass) { LAS float* rs = red + (w & 3) * (160 * 33);
#pragma unroll
                for (int t = 0; t < 5; ++t)
#pragma unroll
                    for (int i = 0; i < 16; ++i) rs[(32 * t + r) * 33 + (i & 3) + 8 * (i >> 2) + 4 * hh] = acc[t][i]; }
            __syncthreads();
            const int c0 = 256 * cg + 128 * pass;
            for (int idx = F.tid; idx < NMODROW * 128; idx += NWAVES * 64) { const int m = idx >> 7, c = idx & 127;
                dst[(size_t)m * NMOD + c0 + c] = red[(c >> 5) * (160 * 33) + m * 33 + (c & 31)] + (kh ? 0.f : INP(7)[c0 + c]); }
            __syncthreads();
        }
    }
    conv_queue(F, A, CW_QUEUE, P0_NA, NB_EARLY, P0_NA + P0_NB + P0_NP - NB_EARLY, 1 << 24);
}

__device__ __forceinline__ f32x4 ld4_bf16(const bf16* p) { const v2u v = *(const v2u*)p;
    return (f32x4){__builtin_bit_cast(float, v.x << 16), __builtin_bit_cast(float, v.x & 0xffff0000u), __builtin_bit_cast(float, v.y << 16), __builtin_bit_cast(float, v.y & 0xffff0000u)}; }
template <bool OUT8, int NP, bool S16, bool FIN>
__device__ __forceinline__ void norm_sample_rows(Frame& F, const float* srcS32, const float* gain, int sub, bf16* Hd, float* yS) {
    const int flane = lane_of(F);
    const int w = F.wave;
    bf16* X16 = WSP(bf16, WS_X); const bf16* slab = WSP(bf16, WS_SLAB);
    LAS float* part = (LAS float*)F.lds;
    int par = 0;
    for (int hr0 = F.vcu; hr0 < MS; hr0 += 2 * F.G) {
        const int k = 256 * w + 4 * flane;
        int hrs[2]; hrs[0] = hr0; hrs[1] = (hr0 + F.G < MS) ? hr0 + F.G : hr0;
        f32x4 v[2]; f32x4 sv[2][NP > 0 ? NP : 1]; f32x4 g4, s0[2], s1[2], h0[2], h1[2];
#pragma unroll
        for (int q = 0; q < 2; ++q) { const int hr = hrs[q], m = MP + hr;
            v[q] = S16 ? ld4_bf16(X16 + (size_t)m * DM + k) : *(const f32x4*)(srcS32 + (size_t)hr * DM + k);
#pragma unroll
            for (int p = 0; p < NP; ++p) sv[q][p] = ld4_bf16(slab + ((size_t)p * MS + hr) * DM + k); }
        g4 = *(const f32x4*)(gain + k);
        if (!FIN) {
#pragma unroll
            for (int q = 0; q < 2; ++q) { const float* sh = WSP(float, WS_MODS) + (size_t)pg8::modrow_of(MP + hrs[q]) * NMOD + (size_t)(3 * sub) * DM; const float* sc = sh + DM;
                s0[q] = *(const f32x4*)(sc + k); s1[q] = *(const f32x4*)(sc + MODSB_DELTA + k); h0[q] = *(const f32x4*)(sh + k); h1[q] = *(const f32x4*)(sh + MODSB_DELTA + k); }
        }
        float ssw[2];
#pragma unroll
        for (int q = 0; q < 2; ++q) {
            if (NP > 0) {
#pragma unroll
                for (int p = 0; p < NP; ++p) v[q] += sv[q][p];
                if (!FIN) { v2u pk; pk.x = pk2(v[q][0], v[q][1]); pk.y = pk2(v[q][2], v[q][3]); *(GAS v2u*)(X16 + (size_t)(MP + hrs[q]) * DM + k) = pk; }
            }
            ssw[q] = wave_sum((v[q][0] * v[q][0] + v[q][1] * v[q][1]) + (v[q][2] * v[q][2] + v[q][3] * v[q][3]));
        }
        if (flane == 0) { part[par * 16 + w] = ssw[0]; part[par * 16 + 8 + w] = ssw[1]; }
        __syncthreads();
#pragma unroll
        for (int q = 0; q < 2; ++q) { const int hr = hrs[q], m = MP + hr;
            float ss = 0.f;
#pragma unroll
            for (int i = 0; i < 8; ++i) ss += part[par * 16 + 8 * q + i];
            const float rstd = 1.0f / sqrtf(ss * (1.0f / DM) + EPS);
            if (FIN) { *(f32x4*)(yS + (size_t)hr * DM + k) = (v[q] * rstd) * g4; }
            else {
                const f32x4 o = (v[q] * rstd) * g4 * ((s0[q] + s1[q]) + 1.0f) + (h0[q] + h1[q]);
                if (OUT8) { *(GAS unsigned*)((unsigned char*)Hd + (size_t)m * DM + k) = pg8::pk4_fp8(o[0], o[1], o[2], o[3]); }
                else { v2u pk; pk.x = pk2(o[0], o[1]); pk.y = pk2(o[2], o[3]); *(GAS v2u*)(Hd + (size_t)m * DM + k) = pk; }
            }
        }
        par ^= 1;
    }
    __syncthreads();
}
template <int OUTM, bool P16>
__device__ __forceinline__ void norm_prompt_rows(Frame& F, const float* srcP32, const float* gain, int sub, bf16* Hd, float* yP) {
    const int flane0 = lane_of(F);
    const bf16* X16 = WSP(bf16, WS_X);
    constexpr int RB = P16 ? 4 : 2;
#define NPR_LOAD(slot, row) do { _Pragma("unroll") for (int j = 0; j < 4; ++j) { const size_t o = (size_t)(row) * DM + 8 * (flane + 64 * j); \
            if (P16) raw[P16 ? (slot) : 0][j] = *(const v4u*)(X16 + o); \
            else { vf[P16 ? 0 : (slot)][j][0] = *(const f32x4*)(srcP32 + o); vf[P16 ? 0 : (slot)][j][1] = *(const f32x4*)(srcP32 + o + 4); } } } while (0)
#define NPR_GET(slot, j, x0, x1) do { if (P16) { const v4u q = raw[P16 ? (slot) : 0][j]; \
            x0 = (f32x4){__builtin_bit_cast(float, q.x << 16), __builtin_bit_cast(float, q.x & 0xffff0000u), __builtin_bit_cast(float, q.y << 16), __builtin_bit_cast(float, q.y & 0xffff0000u)}; \
            x1 = (f32x4){__builtin_bit_cast(float, q.z << 16), __builtin_bit_cast(float, q.z & 0xffff0000u), __builtin_bit_cast(float, q.w << 16), __builtin_bit_cast(float, q.w & 0xffff0000u)}; } \
        else { x0 = vf[P16 ? 0 : (slot)][j][0]; x1 = vf[P16 ? 0 : (slot)][j][1]; } } while (0)
    LAS float* const modA = (LAS float*)F.lds; LAS float* const modB = modA + DM;
    for (int mb = 32 * F.vcu; mb < MP; mb += 32 * F.G) {
        const int m0 = mb + 4 * F.wave;
        int flane = flane0; asm volatile("" : "+v"(flane));
        v4u raw[P16 ? RB : 1][4]; f32x4 vf[P16 ? 1 : RB][4][2];
#pragma unroll
        for (int r = 0; r < RB; ++r) NPR_LOAD(r, m0 + r);
        f32x4 Am[4][2], Bm[4][2];
        if (OUTM == 2) {
#pragma unroll
            for (int j = 0; j < 4; ++j)
#pragma unroll
                for (int hf = 0; hf < 2; ++hf) { Am[j][hf] = *(const f32x4*)(gain + 8 * (flane + 64 * j) + 4 * hf); Bm[j][hf] = (f32x4){0.f, 0.f, 0.f, 0.f}; }
        } else {
            { const int k = 4 * (64 * F.wave + flane);
                const float* sh = WSP(float, WS_MODS) + (size_t)pg8::modrow_of(mb) * NMOD + (size_t)(3 * sub) * DM; const float* sc = sh + DM;
                const f32x4 g4 = *(const f32x4*)(gain + k), s0 = *(const f32x4*)(sc + k), s1 = *(const f32x4*)(sc + MODSB_DELTA + k), h0 = *(const f32x4*)(sh + k), h1 = *(const f32x4*)(sh + MODSB_DELTA + k);
                *(LAS f32x4*)(modA + k) = g4 * ((s0 + s1) + 1.0f); *(LAS f32x4*)(modB + k) = h0 + h1; }
            __syncthreads();
#pragma unroll
            for (int j = 0; j < 4; ++j)
#pragma unroll
                for (int hf = 0; hf < 2; ++hf) { const int k = 8 * (flane + 64 * j) + 4 * hf; Am[j][hf] = *(const LAS f32x4*)(modA + k); Bm[j][hf] = *(const LAS f32x4*)(modB + k); }
        }
#pragma unroll
        for (int r = 0; r < 4; ++r) {
            const int slot = r % RB;
            float ss = 0.f;
#pragma unroll
            for (int j = 0; j < 4; ++j) { f32x4 x0, x1; NPR_GET(slot, j, x0, x1);
                ss += ((x0[0] * x0[0] + x0[1] * x0[1]) + (x0[2] * x0[2] + x0[3] * x0[3])) + ((x1[0] * x1[0] + x1[1] * x1[1]) + (x1[2] * x1[2] + x1[3] * x1[3])); }
            const float rstd = 1.0f / sqrtf(wave_sum(ss) * (1.0f / DM) + EPS);
#pragma unroll
            for (int j = 0; j < 4; ++j) { const size_t o = (size_t)(m0 + r) * DM + 8 * (flane + 64 * j);
                f32x4 x0, x1; NPR_GET(slot, j, x0, x1);
                const f32x4 o0 = (x0 * rstd) * Am[j][0] + Bm[j][0], o1 = (x1 * rstd) * Am[j][1] + Bm[j][1];
                if (OUTM == 2) { __builtin_nontemporal_store(o0, (f32x4*)(yP + o)); __builtin_nontemporal_store(o1, (f32x4*)(yP + o + 4)); }
                else if (OUTM == 1) { v2u pk; pk.x = pg8::pk4_fp8(o0[0], o0[1], o0[2], o0[3]); pk.y = pg8::pk4_fp8(o1[0], o1[1], o1[2], o1[3]); *(GAS v2u*)((unsigned char*)Hd + o) = pk; }
                else { v4u pk; pk.x = pk2(o0[0], o0[1]); pk.y = pk2(o0[2], o0[3]); pk.z = pk2(o1[0], o1[1]); pk.w = pk2(o1[2], o1[3]); *(GAS v4u*)(Hd + o) = pk; } }
            if (r + RB < 4) NPR_LOAD(slot, m0 + r + RB);
            __builtin_amdgcn_sched_barrier(0);
        }
        if (OUTM != 2) __syncthreads();
    }
#undef NPR_LOAD
#undef NPR_GET
}
template <bool OUT8, int NP, bool P16, bool S16>
__device__ __forceinline__ void norm_mod(Frame& F, const float* srcP32, const float* srcS32, const float* gain, int sub, bf16* Hd) {
    norm_sample_rows<OUT8, NP, S16, false>(F, srcS32, gain, sub, Hd, nullptr);
    norm_prompt_rows<OUT8 ? 1 : 0, P16>(F, srcP32, gain, sub, Hd, nullptr);
}
template <int NP>
__device__ __forceinline__ void final_norm(Frame& F, const Args& A) {
    norm_sample_rows<false, NP, true, true>(F, nullptr, INP(21), 0, nullptr, (float*)(F.out + O_YS));
    norm_prompt_rows<2, true>(F, nullptr, INP(21), 0, nullptr, (float*)(F.out + O_YP));
}

#define MFMA16(a, b, c) __builtin_amdgcn_mfma_f32_16x16x32_bf16(a, b, c, 0, 0, 0)
__device__ __forceinline__ float log2_gamma(int h) { return h == 0 ? -0.045803689613124747f : h == 1 ? -0.022720076500083405f : h == 2 ? -0.011315313227834146f : -0.0056465631411130581f; }
constexpr int TP = 136;

__device__ __forceinline__ void retA_unit(Frame& F, int unit) {
    const int flane = lane_of(F);
    const int half = unit & 1, c = (unit >> 1) & 15, bh = unit >> 5, b = bh >> 2, h = bh & 3;
    const int m0 = b * SEQ + c * CH;
    const int tid = F.tid, lane = flane, w = F.wave, fr = lane & 15, fq = lane >> 4;
    LAS bf16* VT = (LAS bf16*)F.lds; LAS bf16* KT = VT + 256 * TP; LAS bf16* PP = KT + 128 * TP;
    const bf16* Qg = WSP(bf16, WS_QKVG) + (size_t)m0 * RW + h * HD;
    const bf16* Kg = Qg + (size_t)MTOK * RW; const bf16* Vg = Kg + (size_t)MTOK * RW;
    const float l2g = log2_gamma(h);
    constexpr int QP = 264;
    LAS bf16* QT = KT;
    static_assert(64 * QP <= 128 * TP, "q tile fits the K^T region");
    const bool act = 16 * w < 64 * half + 64;
    bf16x8 kk[4], bb[8];
    {
        bf16x8 vv[8], qq[4];
#pragma unroll
        for (int it = 0; it < 8; ++it) { const int idx = it * 512 + tid, tok = idx & 127, ch = idx >> 7; vv[it] = *(const bf16x8*)(Vg + (size_t)tok * RW + ch * 8); }
#pragma unroll
        for (int it = 0; it < 4; ++it) { const int idx = it * 512 + tid, row = idx >> 5, ch = idx & 31; qq[it] = *(const bf16x8*)(Qg + (size_t)(64 * half + row) * RW + ch * 8); }
#pragma unroll
        for (int it = 0; it < 4; ++it) { const int idx = it * 512 + tid, tok = idx & 127, ch = idx >> 7; kk[it] = *(const bf16x8*)(Kg + (size_t)tok * RW + half * 128 + ch * 8); }
        if (act) {
#pragma unroll
            for (int s = 0; s < 8; ++s) bb[s] = *(const bf16x8*)(Kg + (size_t)(16 * w + fr) * RW + 32 * s + 8 * fq);
        }
#pragma unroll
        for (int it = 0; it < 4; ++it) { const int idx = it * 512 + tid, row = idx >> 5, ch = idx & 31; *(LAS bf16x8*)(QT + row * QP + ch * 8) = qq[it]; }
#pragma unroll
        for (int it = 0; it < 8; ++it) { const int idx = it * 512 + tid, tok = idx & 127, ch = idx >> 7;
#pragma unroll
            for (int e = 0; e < 8; ++e) VT[(ch * 8 + e) * TP + tok] = (bf16)vv[it][e]; }
    }
    __syncthreads();
    {
        f32x4 acc[4];
#pragma unroll
        for (int i = 0; i < 4; ++i) acc[i] = (f32x4){0.f, 0.f, 0.f, 0.f};
        if (act) {
#pragma unroll
            for (int s = 0; s < 8; ++s) {
#pragma unroll
                for (int i = 0; i < 4; ++i) { const bf16x8 aa = *(const LAS bf16x8*)(QT + (16 * i + fr) * QP + 32 * s + 8 * fq); acc[i] = MFMA16(aa, bb[s], acc[i]); }
            }
        }
#pragma unroll
        for (int i = 0; i < 4; ++i)
#pragma unroll
            for (int r = 0; r < 4; ++r) { const int nl = 16 * i + 4 * fq + r, n = 64 * half + nl, m = 16 * w + fr, dn = n - m;
                const float val = dn >= 0 ? acc[i][r] * __builtin_amdgcn_exp2f((float)dn * l2g) : 0.f;
                PP[nl * TP + m] = (bf16)f2bf(val); }
    }
    __syncthreads();
#pragma unroll
    for (int it = 0; it < 4; ++it) { const int idx = it * 512 + tid, tok = idx & 127, ch = idx >> 7;
        const float kd = __builtin_amdgcn_exp2f((float)(127 - tok) * l2g);
#pragma unroll
        for (int e = 0; e < 8; ++e) KT[(ch * 8 + e) * TP + tok] = (bf16)f2bf(bf2f((bf16)kk[it][e]) * kd); }
    {
        f32x4 o[2][4];
#pragma unroll
        for (int j = 0; j < 2; ++j)
#pragma unroll
            for (int i = 0; i < 4; ++i) o[j][i] = (f32x4){0.f, 0.f, 0.f, 0.f};
#pragma unroll
        for (int s = 0; s < 4; ++s) {
            bf16x8 a[4];
#pragma unroll
            for (int i = 0; i < 4; ++i) a[i] = *(const LAS bf16x8*)(PP + (16 * i + fr) * TP + 32 * s + 8 * fq);
#pragma unroll
            for (int j = 0; j < 2; ++j) { const bf16x8 bb = *(const LAS bf16x8*)(VT + (32 * w + 8 * (fr >> 2) + 4 * j + (fr & 3)) * TP + 32 * s + 8 * fq);
#pragma unroll
                for (int i = 0; i < 4; ++i) o[j][i] = MFMA16(bb, a[i], o[j][i]); }
        }
#pragma unroll
        for (int i = 0; i < 4; ++i) { v4u pk; pk.x = pk2(o[0][i][0], o[0][i][1]); pk.y = pk2(o[0][i][2], o[0][i][3]); pk.z = pk2(o[1][i][0], o[1][i][1]); pk.w = pk2(o[1][i][2], o[1][i][3]);
            *(GAS v4u*)(WSP(bf16, WS_OI) + (size_t)(m0 + 64 * half + 16 * i + fr) * RW + h * HD + 32 * w + 8 * fq) = pk; }
    }
    __syncthreads();
    {
        f32x4 ua[2][8];
#pragma unroll
        for (int i = 0; i < 2; ++i)
#pragma unroll
            for (int j = 0; j < 8; ++j) ua[i][j] = (f32x4){0.f, 0.f, 0.f, 0.f};
#pragma unroll
        for (int s = 0; s < 4; ++s) {
            bf16x8 a[2];
#pragma unroll
            for (int i = 0; i < 2; ++i) a[i] = *(const LAS bf16x8*)(VT + (16 * (2 * w + i) + fr) * TP + 32 * s + 8 * fq);
#pragma unroll
            for (int j = 0; j < 8; ++j) { const bf16x8 bb = *(const LAS bf16x8*)(KT + (32 * (j >> 1) + 8 * (fr >> 2) + 4 * (j & 1) + (fr & 3)) * TP + 32 * s + 8 * fq);
#pragma unroll
                for (int i = 0; i < 2; ++i) ua[i][j] = MFMA16(bb, a[i], ua[i][j]); }
        }
        bf16* UTu = WSP(bf16, WS_UT) + (size_t)(bh * NCH + c) * HD * HD;
#pragma unroll
        for (int i = 0; i < 2; ++i)
#pragma unroll
            for (int p = 0; p < 4; ++p) { v4u pk; pk.x = pk2(ua[i][2 * p][0], ua[i][2 * p][1]); pk.y = pk2(ua[i][2 * p][2], ua[i][2 * p][3]); pk.z = pk2(ua[i][2 * p + 1][0], ua[i][2 * p + 1][1]); pk.w = pk2(ua[i][2 * p + 1][2], ua[i][2 * p + 1][3]);
                *(GAS v4u*)(UTu + (size_t)(16 * (2 * w + i) + fr) * HD + 128 * half + 32 * p + 8 * fq) = pk; }
    }
    __syncthreads();
}

#define RETC_LOAD_OG() do { _Pragma("unroll") for (int p = 0; p < 4; ++p) { const v4u a0 = *(const v4u*)(oip + 64 * p), a1 = *(const v4u*)(oip + 64 * p + 8), g0_ = *(const v4u*)(gp + 64 * p), g1_ = *(const v4u*)(gp + 64 * p + 8); \
        oiv[4 * p] = (v2u){a0.x, a0.y}; oiv[4 * p + 1] = (v2u){a0.z, a0.w}; oiv[4 * p + 2] = (v2u){a1.x, a1.y}; oiv[4 * p + 3] = (v2u){a1.z, a1.w}; \
        gvv[4 * p] = (v2u){g0_.x, g0_.y}; gvv[4 * p + 1] = (v2u){g0_.z, g0_.w}; gvv[4 * p + 2] = (v2u){g1_.x, g1_.y}; gvv[4 * p + 3] = (v2u){g1_.z, g1_.w}; } } while (0)
__device__ __forceinline__ void retC_unit(Frame& F, int unit) {
    const int flane = lane_of(F);
    const int c = unit & 15, bh = unit >> 4, b = bh >> 2, h = bh & 3;
    const int m0 = b * SEQ + c * CH;
    const int tid = F.tid, lane = flane, w = F.wave, fr = lane & 15, fq = lane >> 4;
    const bf16* Qg = WSP(bf16, WS_QKVG) + (size_t)m0 * RW + h * HD;
    const bf16* Gg = Qg + (size_t)3 * MTOK * RW;
    const float l2g = log2_gamma(h);
    f32x4 acc[16];
#pragma unroll
    for (int j = 0; j < 16; ++j) acc[j] = (f32x4){0.f, 0.f, 0.f, 0.f};
    const int n = 16 * w + fr; const size_t row = (size_t)(m0 + n);
    const bf16* oip = WSP(bf16, WS_OI) + row * RW + h * HD + 16 * fq;
    const bf16* gp = Gg + (size_t)n * RW + 16 * fq;
    v2u oiv[16], gvv[16];
    if (c == 0) {
        RETC_LOAD_OG();
    }
    if (c > 0) {
        const bf16* STc = WSP(bf16, WS_ST) + (size_t)(bh * NCH + c) * HD * HD;
        {
            v4u st[16];
#pragma unroll
            for (int it = 0; it < 16; ++it) st[it] = *(const v4u*)(STc + (size_t)(it * 512 + tid) * 8);
#pragma unroll
            for (int it = 0; it < 16; ++it) { const int idx = it * 512 + tid, row = idx >> 5, ch = idx & 31;
                *(LAS v4u*)(F.lds + row * 512 + ((ch ^ ((((row >> 4) & 3) << 2) | (row & 3))) * 16)) = st[it]; }
        }
        bf16x8 qf[8];
#pragma unroll
        for (int s = 0; s < 8; ++s) qf[s] = *(const bf16x8*)(Qg + (size_t)(16 * w + fr) * RW + 32 * s + 8 * fq);
        RETC_LOAD_OG();
        __syncthreads();
#pragma unroll
        for (int s = 0; s < 8; ++s) {
#pragma unroll
            for (int j = 0; j < 16; ++j) { const bf16x8 aa = *(const LAS bf16x8*)(F.lds + (64 * (j >> 2) + 16 * (fr >> 2) + 4 * (j & 3) + (fr & 3)) * 512 + (((4 * s + fq) ^ fr) * 16)); acc[j] = MFMA16(aa, qf[s], acc[j]); }
        }
    }
    {
        const float qd = __builtin_amdgcn_exp2f((float)(n + 1) * l2g);
        float ss = 0.f;
#pragma unroll
        for (int j = 0; j < 16; ++j) { const v2u q2 = oiv[j];
            const f32x4 oi4 = (f32x4){__builtin_bit_cast(float, q2.x << 16), __builtin_bit_cast(float, q2.x & 0xffff0000u), __builtin_bit_cast(float, q2.y << 16), __builtin_bit_cast(float, q2.y & 0xffff0000u)};
            const f32x4 o = oi4 + acc[j] * qd; acc[j] = o; ss += (o[0] * o[0] + o[1] * o[1]) + (o[2] * o[2] + o[3] * o[3]); }
        ss += __shfl_xor(ss, 16); ss += __shfl_xor(ss, 32);
        const float rs = 1.0f / sqrtf(ss * (1.0f / HD) + EPS);
        unsigned char* mp = WSP(unsigned char, WS_MIX) + row * DM + PW + h * HD + 16 * fq;
#pragma unroll
        for (int p = 0; p < 4; ++p) { unsigned pkv[4];
#pragma unroll
            for (int t = 0; t < 4; ++t) { const int j = 4 * p + t; const v2u gv = gvv[j];
                const float g0 = bf2f((bf16)(gv.x & 0xffffu)), g1 = bf2f((bf16)(gv.x >> 16)), g2 = bf2f((bf16)(gv.y & 0xffffu)), g3 = bf2f((bf16)(gv.y >> 16));
                pkv[t] = pg8::pk4_fp8(silu1(g0) * acc[j][0] * rs, silu1(g1) * acc[j][1] * rs, silu1(g2) * acc[j][2] * rs, silu1(g3) * acc[j][3] * rs); }
            v4u o4; o4.x = pkv[0]; o4.y = pkv[1]; o4.z = pkv[2]; o4.w = pkv[3];
            *(GAS v4u*)(mp + 64 * p) = o4; }
    }
    __syncthreads();
}

#undef RETC_LOAD_OG
__device__ __forceinline__ void retS_unit(Frame& F, const Args& A, int unit) {
    const int flane = lane_of(F);
    const int b = unit >> 2, h = unit & 3, row0 = MP + 4 * b;
    const int tid = F.tid, lane = flane, w = F.wave;
    LAS float* qs = (LAS float*)F.lds; LAS float* kr = qs + 1024; LAS float* vs = kr + 1024; LAS float* red = vs + 1024; LAS float* dots = red + 8192;
    const bf16* Qg = WSP(bf16, WS_QKVG); const bf16* Kg = Qg + (size_t)MTOK * RW; const bf16* Vg = Kg + (size_t)MTOK * RW; const bf16* Gg = Vg + (size_t)MTOK * RW;
    const float l2g = log2_gamma(h);
    const f32x4* S0 = (const f32x4*)(INP(5) + (size_t)unit * HD * HD);
    f32x4* S1 = (f32x4*)(F.out + O_RETS + (size_t)unit * HD * HD);
    f32x4 s[8], sn[8];
#pragma unroll
    for (int u = 0; u < 8; ++u) s[u] = __builtin_nontemporal_load(S0 + (size_t)(32 * w + u) * 64 + lane);
    for (int i = tid; i < 1024; i += NWAVES * 64) { const int t = i >> 8, d = i & 255; const size_t off = (size_t)(row0 + t) * RW + h * HD + d;
        qs[i] = bf2f(Qg[off]); kr[i] = bf2f(Kg[off]); vs[i] = bf2f(Vg[off]); }
    __syncthreads();
#pragma unroll
    for (int jj = 0; jj < 2; ++jj) { const int p = 2 * w + jj, t = p >> 2, m = p & 3;
        const f32x4 a = *(const LAS f32x4*)(qs + t * 256 + 4 * lane), k4 = *(const LAS f32x4*)(kr + m * 256 + 4 * lane);
        const float d = wave_sum((a[0] * k4[0] + a[1] * k4[1]) + (a[2] * k4[2] + a[3] * k4[3]));
        if (lane == 0) dots[p] = d; }
    f32x4 v4[4], oq[4];
#pragma unroll
    for (int t = 0; t < 4; ++t) { v4[t] = *(const LAS f32x4*)(vs + t * 256 + 4 * lane); oq[t] = (f32x4){0.f, 0.f, 0.f, 0.f}; }
    const float cdec = __builtin_amdgcn_exp2f(4.0f * l2g);
    const float kd0 = __builtin_amdgcn_exp2f(3.0f * l2g), kd1 = __builtin_amdgcn_exp2f(2.0f * l2g), kd2 = __builtin_amdgcn_exp2f(l2g);
#pragma unroll
    for (int it = 0; it < 4; ++it) {
        const int dk0 = 32 * w + 8 * it;
        if (it < 3) {
#pragma unroll
            for (int u = 0; u < 8; ++u) sn[u] = __builtin_nontemporal_load(S0 + (size_t)(dk0 + 8 + u) * 64 + lane);
        }
#pragma unroll
        for (int u = 0; u < 8; ++u) { const int dk = dk0 + u;
            const float q0 = qs[dk], q1 = qs[256 + dk], q2 = qs[512 + dk], q3 = qs[768 + dk];
            const float k0 = kr[dk] * kd0, k1 = kr[256 + dk] * kd1, k2 = kr[512 + dk] * kd2, k3 = kr[768 + dk];
            oq[0] += s[u] * q0; oq[1] += s[u] * q1; oq[2] += s[u] * q2; oq[3] += s[u] * q3;
            __builtin_nontemporal_store(s[u] * cdec + v4[0] * k0 + v4[1] * k1 + v4[2] * k2 + v4[3] * k3, S1 + (size_t)dk * 64 + lane); }
#pragma unroll
        for (int u = 0; u < 8; ++u) s[u] = sn[u];
    }
#pragma unroll
    for (int t = 0; t < 4; ++t) *(LAS f32x4*)(red + (w * 4 + t) * 256 + 4 * lane) = oq[t];
    __syncthreads();
    if (w < 4) {
        const int t = w;
        f32x4 o = (f32x4){0.f, 0.f, 0.f, 0.f};
#pragma unroll
        for (int ww = 0; ww < 8; ++ww) o += *(const LAS f32x4*)(red + (ww * 4 + t) * 256 + 4 * lane);
        o = o * __builtin_amdgcn_exp2f((float)(t + 1) * l2g);
#pragma unroll
        for (int m = 0; m < 4; ++m) if (m <= t) o += v4[m] * (dots[t * 4 + m] * __builtin_amdgcn_exp2f((float)(t - m) * l2g));
        const float ss = wave_sum((o[0] * o[0] + o[1] * o[1]) + (o[2] * o[2] + o[3] * o[3]));
        const float rs = 1.0f / sqrtf(ss * (1.0f / HD) + EPS);
        const size_t row = (size_t)(row0 + t);
        const v2u gp = *(const v2u*)(Gg + row * RW + h * HD + 4 * lane);
        const float g0 = bf2f((bf16)(gp.x & 0xffffu)), g1 = bf2f((bf16)(gp.x >> 16)), g2 = bf2f((bf16)(gp.y & 0xffffu)), g3 = bf2f((bf16)(gp.y >> 16));
        *(GAS unsigned*)(WSP(unsigned char, WS_MIX) + row * DM + PW + h * HD + 4 * lane) = pg8::pk4_fp8(silu1(g0) * o[0] * rs, silu1(g1) * o[1] * rs, silu1(g2) * o[2] * rs, silu1(g3) * o[3] * rs);
    }
    __syncthreads();
}

__device__ __forceinline__ void scan_states(Frame& F) {
    const int bx = (int)blockIdx.x; const bool bal = (F.G == 256), heavy = bx < 136;
    const int i0 = bal ? (heavy ? 16 * 8192 : (bx - 136) * 1093) + F.tid : F.vcu * (NWAVES * 64) + F.tid;
    const int i1 = bal ? (heavy ? 0 : ((bx - 135) * 1093 < 16 * 8192 ? (bx - 135) * 1093 : 16 * 8192)) : 16 * 8192;
    const int istep = bal ? NWAVES * 64 : F.G * NWAVES * 64;
    for (int i = i0; i < i1; i += istep) {
        const int bh = i >> 13, e8 = i & 8191, h = bh & 3;
        const bf16* up = WSP(bf16, WS_UT) + ((size_t)bh * NCH * 8192 + e8) * 8;
        v4u uv[16];
#pragma unroll
        for (int c = 0; c < 16; ++c) uv[c] = *(const v4u*)(up + (size_t)c * 65536);
        const float g128 = __builtin_amdgcn_exp2f(128.0f * log2_gamma(h));
        f32x4 S0 = (f32x4){0.f, 0.f, 0.f, 0.f}, S1 = S0;
#pragma unroll
        for (int c = 0; c < 16; ++c) { const v4u q = uv[c];
            S0 = S0 * g128 + (f32x4){__builtin_bit_cast(float, q.x << 16), __builtin_bit_cast(float, q.x & 0xffff0000u), __builtin_bit_cast(float, q.y << 16), __builtin_bit_cast(float, q.y & 0xffff0000u)};
            S1 = S1 * g128 + (f32x4){__builtin_bit_cast(float, q.z << 16), __builtin_bit_cast(float, q.z & 0xffff0000u), __builtin_bit_cast(float, q.w << 16), __builtin_bit_cast(float, q.w & 0xffff0000u)};
            if (c < 15) { v4u pk; pk.x = pk2(S0[0], S0[1]); pk.y = pk2(S0[2], S0[3]); pk.z = pk2(S1[0], S1[1]); pk.w = pk2(S1[2], S1[3]); *(GAS v4u*)(WSP(bf16, WS_ST) + ((size_t)(bh * NCH + c + 1) * 8192 + e8) * 8) = pk; }
        }
        const int dv = (8 * e8) >> 8, dk = (8 * e8) & 255;
        float* rp = (float*)(F.out + O_RETP + (size_t)bh * HD * HD + dv);
#pragma unroll
        for (int q = 0; q < 4; ++q) { rp[(size_t)(dk + q) * HD] = S0[q]; rp[(size_t)(dk + 4 + q) * HD] = S1[q]; }
    }
}

__device__ __forceinline__ void pool_prompt_item(Frame& F, int item, int q) {
    const int b = item >> 8, t0 = (item & 255) * 8, g = q >> 6, wn = 2 << g;
    const bf16* U16 = WSP(bf16, WS_U) + (size_t)b * SEQ * PW + 4 * q;
#define U4_AT(t) ld4_bf16(U16 + (size_t)(t) * PW)
    f32x4 hv[15], cur[8], old[8];
#pragma unroll
    for (int j = 1; j < 16; ++j) { const int t = t0 - j; const bool ok = (j < wn) && (t >= 0); hv[j - 1] = U4_AT(ok ? t : t0) * (ok ? 1.0f : 0.0f); }
#pragma unroll
    for (int i = 0; i < 8; ++i) { const int t = t0 + i, to = t - wn; const bool ok = (i >= 1) && (to >= 0);
        cur[i] = U4_AT(t); old[i] = U4_AT(ok ? to : t) * (ok ? 1.0f : 0.0f); }
    f32x4 sum = (f32x4){0.f, 0.f, 0.f, 0.f};
#pragma unroll
    for (int j = 0; j < 15; ++j) sum += hv[j];
#pragma unroll
    for (int i = 0; i < 8; ++i) {
        const int t = t0 + i;
        sum += cur[i]; sum -= old[i];
        const float cnt = (float)((t + 1 < wn) ? (t + 1) : wn);
        const f32x4 mv = sum / cnt - cur[i];
        v2u pk; pk.x = pk2(mv[0], mv[1]); pk.y = pk2(mv[2], mv[3]);
        *(GAS v2u*)(WSP(bf16, WS_PM) + ((size_t)(b * SEQ + t) * PW + 4 * q)) = pk;
    }
}
#undef U4_AT
__device__ __forceinline__ void pool_sample_item(Frame& F, const Args& A, int b, int q) {
    const int g = q >> 6, wn = 2 << g;
    const f32x4* SP4 = (const f32x4*)(INP(4) + (size_t)b * 15 * PW) + q;
    const bf16* US16 = WSP(bf16, WS_U) + (size_t)(MP + 4 * b) * PW + 4 * q;
    f32x4 ue[19];
#pragma unroll
    for (int i = 0; i < 15; ++i) ue[i] = SP4[(size_t)i * 256];
#pragma unroll
    for (int t = 0; t < 4; ++t) ue[15 + t] = ld4_bf16(US16 + (size_t)t * PW);
#pragma unroll
    for (int t = 0; t < 4; ++t) {
        f32x4 sum = (f32x4){0.f, 0.f, 0.f, 0.f};
#pragma unroll
        for (int j = 0; j < 16; ++j) sum += ue[15 + t - j] * ((j < wn) ? 1.0f : 0.0f);
        const f32x4 mv = sum / (float)wn - ue[15 + t];
        v2u pk; pk.x = pk2(mv[0], mv[1]); pk.y = pk2(mv[2], mv[3]);
        *(GAS v2u*)(WSP(bf16, WS_PM) + ((size_t)(MP + 4 * b + t) * PW + 4 * q)) = pk;
    }
}
__device__ __forceinline__ f32x4 up4_bf16(const v2u v) { return (f32x4){__builtin_bit_cast(float, v.x << 16), __builtin_bit_cast(float, v.x & 0xffff0000u), __builtin_bit_cast(float, v.y << 16), __builtin_bit_cast(float, v.y & 0xffff0000u)}; }
__device__ __forceinline__ void pool_phase(Frame& F, const Args& A) {
    const int q = F.tid & 255, sub = F.tid >> 8;
    {
        const int g = q >> 6, wn = 2 << g;
#define POOL_LOAD(HV, CU, OL, item) do { const int b_ = (item) >> 8, t0_ = ((item) & 255) * 8; const bf16* U16_ = WSP(bf16, WS_U) + (size_t)b_ * SEQ * PW + 4 * q; \
        _Pragma("unroll") for (int j = 1; j < 16; ++j) { const int t = t0_ - j; const bool ok = (j < wn) && (t >= 0); HV[j - 1] = *(const v2u*)(U16_ + (size_t)(ok ? t : t0_) * PW); } \
        _Pragma("unroll") for (int i = 0; i < 8; ++i) { const int t = t0_ + i, to = t - wn; const bool ok = (i >= 1) && (to >= 0); CU[i] = *(const v2u*)(U16_ + (size_t)t * PW); OL[i] = *(const v2u*)(U16_ + (size_t)(ok ? to : t) * PW); } } while (0)
#define POOL_COMP(HV, CU, OL, item) do { const int b_ = (item) >> 8, t0_ = ((item) & 255) * 8; \
        f32x4 sum = (f32x4){0.f, 0.f, 0.f, 0.f}; \
        _Pragma("unroll") for (int j = 1; j < 16; ++j) { const int t = t0_ - j; const bool ok = (j < wn) && (t >= 0); sum += up4_bf16(HV[j - 1]) * (ok ? 1.0f : 0.0f); } \
        _Pragma("unroll") for (int i = 0; i < 8; ++i) { const int t = t0_ + i, to = t - wn; const bool ok = (i >= 1) && (to >= 0); \
            const f32x4 c4 = up4_bf16(CU[i]); sum += c4; sum -= up4_bf16(OL[i]) * (ok ? 1.0f : 0.0f); \
            const float rc = __builtin_amdgcn_rcpf((float)((t + 1 < wn) ? (t + 1) : wn)); \
            const f32x4 mv = sum * rc - c4; \
            v2u pk; pk.x = pk2(mv[0], mv[1]); pk.y = pk2(mv[2], mv[3]); \
            *(GAS v2u*)(WSP(bf16, WS_PM) + ((size_t)(b_ * SEQ + t) * PW + 4 * q)) = pk; } } while (0)
        for (int bi = F.vcu; bi < 512; bi += F.G) {
            const int itA = 2 * bi + sub;
            v2u hA[15], cA[8], oA[8];
            POOL_LOAD(hA, cA, oA, itA);
            POOL_COMP(hA, cA, oA, itA);
        }
#undef POOL_LOAD
#undef POOL_COMP
    }
    {
        const int bs = (F.G == 256) ? (((F.vcu & 31) >= 24) ? (F.vcu >> 5) * 8 + (F.vcu & 31) - 24 : 64) : F.G - 1 - F.vcu;
        for (int bi = bs; bi < 64; bi += F.G) pool_sample_item(F, A, 2 * bi + sub, q);
    }
    const int gt = F.vcu * (NWAVES * 64) + F.tid, NT = F.G * NWAVES * 64;
    f32x4* o4 = (f32x4*)F.out;
    for (int i = gt; i < NB * 15 * 256; i += NT) { const int qq = i & 255, r = (i >> 8) % 15, b = (i >> 8) / 15;
        o4[O_POOLP / 4 + i] = ld4_bf16(WSP(bf16, WS_U) + (((size_t)b * SEQ + (SEQ - 15) + r) * 256 + qq) * 4); }
    for (int i0 = gt; i0 < DB * 15 * 256; i0 += 4 * NT) {
        f32x4 v[4];
#pragma unroll
        for (int k = 0; k < 4; ++k) { const int i = i0 + k * NT; const int ic = (i < DB * 15 * 256) ? i : i0; const int qq = ic & 255, r = (ic >> 8) % 15, b = (ic >> 8) / 15;
            v[k] = (r < 11) ? ((const f32x4*)INP(4))[((size_t)b * 15 + r + 4) * 256 + qq] : ld4_bf16(WSP(bf16, WS_U) + (((size_t)(MP + 4 * b) + (r - 11)) * 256 + qq) * 4); }
#pragma unroll
        for (int k = 0; k < 4; ++k) { const int i = i0 + k * NT; if (i < DB * 15 * 256) o4[O_POOLS / 4 + i] = v[k]; }
    }
}


__global__ void __launch_bounds__(NWAVES * 64, 2) mk_fwd(Args args) {
    extern __shared__ __attribute__((aligned(16))) unsigned char lds[];
    Frame F;
    F.lds = (LAS unsigned char*)lds;
    F.MISC = (volatile LAS unsigned*)(F.lds + MISC_OFF);
    F.tid = threadIdx.x; F.wave = __builtin_amdgcn_readfirstlane(F.tid >> 6);
    F.G = gridDim.x; { const int bx = blockIdx.x; F.vcu = (F.G % 8 == 0) ? (bx % 8) * (F.G / 8) + bx / 8 : bx; }
    unsigned char* ws = args.ws; const Args& A = args;
    F.out = (GAS float*)args.out;
    F.ws = (GAS unsigned char*)ws;
    for (int u = F.tid; u < (LDS_BYTES - LDSCTL_OFF) / 4; u += NWAVES * 64) ((LAS unsigned*)(F.lds + LDSCTL_OFF))[u] = 0u;
    __syncthreads();
    if (!MK_PER_PHASE) (void)xcd_barrier_post((unsigned*)(ws + WS_CTL) + CW_BAR + args.bar_region * XCD_BAR_WORDS, F.MISC + 8);
    const int lo = args.ph_lo, hi = args.ph_hi;
#ifdef PROBE_TA
    if (blockIdx.x == 0 && threadIdx.x == 0) ((unsigned long long*)(ws + WS_CTL + 49152))[0] = __builtin_amdgcn_s_memrealtime();
#endif
#ifndef PH_MASK
#define PH_MASK 0x7fff
#endif
#define IN(k) (((PH_MASK >> (k)) & 1) && lo <= (k) && (k) < hi)
#ifndef REP_MASK
#define REP_MASK 0
#endif
#ifdef PROBE_TA
#define STAMP_AFTER(k) do { if (blockIdx.x == 0 && threadIdx.x == 0) ((unsigned long long*)(A.ws + WS_CTL + 49152))[(k) + 1] = __builtin_amdgcn_s_memrealtime(); } while (0)
#else
#define STAMP_AFTER(k) do { } while (0)
#endif
#define NREP(k) ((((REP_MASK) >> (k)) & 1) ? 2 : 1)
#define SEAM(k) do { if (!MK_PER_PHASE && (IN((k) + 1) || rep_ + 1 < NREP(k))) { XcdBarrier bar_; bar_.bar = (unsigned*)(A.ws + WS_CTL) + CW_BAR + A.bar_region * XCD_BAR_WORDS; bar_.x = xb_xcc_id(); bar_.st = (volatile LAS unsigned*)(F.lds + MISC_OFF) + 8; xcd_barrier(bar_); } STAMP_AFTER(k); } while (0)

#define EARLY_COPY(nunits, budget) do { if ((int)blockIdx.x >= (nunits) % F.G) { asm volatile("s_waitcnt vmcnt(0)" ::: "memory"); __syncthreads(); \
        { int t2_ = threadIdx.x; asm volatile("" : "+v"(t2_)); F.tid = t2_; } conv_queue(F, A, CW_QUEUE2, 0, P0_NA, NB_EARLY, (budget)); } } while (0)
    if (IN(0)) for (int rep_ = relaunder(F); rep_ < NREP(0); ++rep_) { p0_prologue(F, A); SEAM(0); }
    if (IN(1)) for (int rep_ = relaunder(F); rep_ < NREP(1); ++rep_) { p1_adaln(F, A); SEAM(1); }
    if (IN(2)) for (int rep_ = relaunder(F); rep_ < NREP(2); ++rep_) { norm_mod<true, 0, false, false>(F, INP(0), INP(1), INP(8), 0, WSP(bf16, WS_H)); SEAM(2); }
    if (IN(3)) for (int rep_ = relaunder(F); rep_ < NREP(3); ++rep_) {
        pg8::Gemm g{WSP(bf16, WS_H), WSP(bf16, WS_W1), DM, DM, DM, 0, 0, WSC_UP}; pg8::StaticOrder S; S.init(MTOK, 2 * DFF, F.G, (int)blockIdx.x);
        pg8::EpiSwiglu E{WSP(unsigned char, WS_ACT)};
        pg8::gemm_phase8<pg8::EpiSwiglu, pg8::StaticOrder, true>(F.lds, g, S, E);
        EARLY_COPY((MTOK / 256) * (2 * DFF / 256), 2);
        SEAM(3);
    }
    if (IN(4)) for (int rep_ = relaunder(F); rep_ < NREP(4); ++rep_) {
        pg8::Gemm g{WSP(bf16, WS_ACT), WSP(bf16, WS_W1D), DFF, DFF, DFF, 0, KP_DOWN, WSC_DOWN}; pg8::SplitOrder S; S.init(DM, DFF / KP_DOWN, F.G, (int)blockIdx.x);
        pg8::EpiResid<false> E{INP(0), WSP(bf16, WS_X), WSP(float, WS_MODS) + 2 * DM, 0.5f};
        pg8::gemm_phase8<decltype(E), pg8::SplitOrder, true>(F.lds, g, S, E);
        EARLY_COPY((MP / 256) * (DM / 256) + (MS / 256) * (DM / 256) * (DFF / KP_DOWN), 1);
        SEAM(4);
    }
    if (IN(5)) for (int rep_ = relaunder(F); rep_ < NREP(5); ++rep_) { norm_mod<false, DFF / KP_DOWN, true, false>(F, nullptr, INP(1), INP(12), 1, WSP(bf16, WS_H)); SEAM(5); }
    if (IN(6)) for (int rep_ = relaunder(F); rep_ < NREP(6); ++rep_) {
        pg8::Gemm g{WSP(bf16, WS_H), WSP(bf16, WS_WIN), DM, DM, DM, 0, 0, 0}; pg8::StaticOrder S; S.init(MTOK, INC, F.G, (int)blockIdx.x);
        pg8::EpiWin E{WSP(bf16, WS_U), WSP(bf16, WS_QKVG), WSP(float, WS_ROT)};
        pg8::gemm_phase<pg8::EpiWin, pg8::StaticOrder, true>(F.lds, g, S, E);
        EARLY_COPY((MTOK / 256) * (INC / 256), 6);
        SEAM(6);
    }
    if (IN(7)) for (int rep_ = relaunder(F); rep_ < NREP(7); ++rep_) {
        for (int u = F.vcu; u < NB * NH * NCH * 2; u += F.G) retA_unit(F, u);
        pool_phase(F, A);
        SEAM(7);
    }
    if (IN(8)) for (int rep_ = relaunder(F); rep_ < NREP(8); ++rep_) {
        {
            pg8::Gemm g{WSP(bf16, WS_PM), WSP(bf16, WS_WPOOL), PW, HD, HD, HD, 0, 0}; pg8::StaticOrder S; S.init(MTOK, PW, F.G, (int)blockIdx.x);
            pg8::EpiPool E{WSP(unsigned char, WS_MIX), INP(15)};
            pg8::gemm_phase<pg8::EpiPool, pg8::StaticOrder, true>(F.lds, g, S, E);
        }
        __syncthreads();
        { int t2 = threadIdx.x; asm volatile("" : "+v"(t2)); F.tid = t2; }
        for (int u = F.vcu; u < DB * NH; u += F.G) retS_unit(F, A, u);
        scan_states(F);
        SEAM(8);
    }
    if (IN(9)) for (int rep_ = relaunder(F); rep_ < NREP(9); ++rep_) { for (int u = F.vcu; u < NB * NH * NCH; u += F.G) retC_unit(F, u); SEAM(9); }
    if (IN(10)) for (int rep_ = relaunder(F); rep_ < NREP(10); ++rep_) {
        pg8::Gemm g{WSP(bf16, WS_MIX), WSP(bf16, WS_WOUT), DM, DM, DM, 0, KP_OUT, WSC_UP}; pg8::SplitOrder S; S.init(DM, DM / KP_OUT, F.G, (int)blockIdx.x);
        pg8::EpiResid<true> E{nullptr, WSP(bf16, WS_X), WSP(float, WS_MODS) + 5 * DM, 1.0f};
        pg8::gemm_phase8<decltype(E), pg8::SplitOrder, true>(F.lds, g, S, E);
        EARLY_COPY((MP / 256) * (DM / 256) + (MS / 256) * (DM / 256) * (DM / KP_OUT), 1 << 24);
        SEAM(10);
    }
    if (IN(11)) for (int rep_ = relaunder(F); rep_ < NREP(11); ++rep_) { norm_mod<true, DM / KP_OUT, true, true>(F, nullptr, nullptr, INP(17), 2, WSP(bf16, WS_H)); SEAM(11); }
    if (IN(12)) for (int rep_ = relaunder(F); rep_ < NREP(12); ++rep_) {
        pg8::Gemm g{WSP(bf16, WS_H), WSP(bf16, WS_W2), DM, DM, DM, 0, 0, WSC_UP}; pg8::StaticOrder S; S.init(MTOK, 2 * DFF, F.G, (int)blockIdx.x);
        pg8::EpiSwiglu E{WSP(unsigned char, WS_ACT)};
        pg8::gemm_phase8<pg8::EpiSwiglu, pg8::StaticOrder, true>(F.lds, g, S, E);
        SEAM(12);
    }
    if (IN(13)) for (int rep_ = relaunder(F); rep_ < NREP(13); ++rep_) {
        pg8::Gemm g{WSP(bf16, WS_ACT), WSP(bf16, WS_W2D), DFF, DFF, DFF, 0, KP_DOWN, WSC_DOWN}; pg8::SplitOrder S; S.init(DM, DFF / KP_DOWN, F.G, (int)blockIdx.x);
        pg8::EpiResid<true> E{nullptr, WSP(bf16, WS_X), WSP(float, WS_MODS) + 8 * DM, 0.5f};
        pg8::gemm_phase8<decltype(E), pg8::SplitOrder, true>(F.lds, g, S, E);
        SEAM(13);
    }
    if (IN(14)) for (int rep_ = relaunder(F); rep_ < NREP(14); ++rep_) { final_norm<DFF / KP_DOWN>(F, A); if (rep_ + 1 < NREP(14)) { SEAM(14); } }
#ifdef PROBE_TA
    if (blockIdx.x == 0 && threadIdx.x == 0) {
        unsigned long long* ts = (unsigned long long*)(ws + WS_CTL + 49152);
        const unsigned long long now = __builtin_amdgcn_s_memrealtime(); ts[15] = now;
        unsigned long long qa = (ts[PROBE_TA + 1] - ts[PROBE_TA]) / 400ull, qb = (ts[PROBE_TB + 1] - ts[PROBE_TB]) / 400ull;
        if (qa > 99ull) qa = 99ull; if (qb > 99ull) qb = 99ull;
        const unsigned long long until = now + qa * 2000ull + qb * 200000ull;
        while (__builtin_amdgcn_s_memrealtime() < until) __builtin_amdgcn_s_sleep(64);
    }
#endif
#undef IN
#undef SEAM
}

extern "C" void kernel_launch(void* const* d_in, const int* in_sizes, int n_in, void* d_out, int out_size, void* d_ws, size_t ws_size, hipStream_t stream) {
    static int grid = 0;
    if (grid == 0) {
        if (n_in != 22 || (size_t)out_size != O_END || ws_size < WS_END) { fprintf(stderr, "kernel_launch: unexpected shapes (n_in %d out %d ws %zu)\n", n_in, out_size, ws_size); grid = -1; return; }
        int dev = 0, cus = 0, per_cu = 0;
        if (hipGetDevice(&dev) != hipSuccess || hipDeviceGetAttribute(&cus, hipDeviceAttributeMultiprocessorCount, dev) != hipSuccess) { grid = -1; return; }
        if (hipFuncSetAttribute((const void*)mk_fwd, hipFuncAttributeMaxDynamicSharedMemorySize, LDS_BYTES) != hipSuccess) { fprintf(stderr, "kernel_launch: hipFuncSetAttribute failed\n"); grid = -1; return; }
        if (hipOccupancyMaxActiveBlocksPerMultiprocessor(&per_cu, (const void*)mk_fwd, NWAVES * 64, LDS_BYTES) != hipSuccess || per_cu < 1) { fprintf(stderr, "kernel_launch: occupancy query says %d blocks/CU\n", per_cu); (void)hipGetLastError(); grid = -1; return; }
        grid = cus;
    }
    if (grid < 0) return;
    (void)hipMemsetAsync((char*)d_ws + WS_CTL, 0, CTL_ZERO_BYTES, stream);
    Args a{};
    for (int i = 0; i < 22; ++i) a.in[i] = (const float*)d_in[i];
    a.out = (float*)d_out; a.ws = (unsigned char*)d_ws;
#if MK_PER_PHASE
    for (int p = 0; p < N_PHASES; ++p) { a.ph_lo = p; a.ph_hi = p + 1; hipLaunchKernelGGL(mk_fwd, dim3(grid), dim3(NWAVES * 64), LDS_BYTES, stream, a); }
#else
    a.ph_lo = 0; a.ph_hi = N_PHASES;
    hipLaunchKernelGGL(mk_fwd, dim3(grid), dim3(NWAVES * 64), LDS_BYTES, stream, a);
#ifdef PROBE_LO
    a.ph_lo = PROBE_LO; a.ph_hi = PROBE_HI; a.bar_region = 1;
    hipLaunchKernelGGL(mk_fwd, dim3(grid), dim3(NWAVES * 64), LDS_BYTES, stream, a);
#endif
#endif
}
```
